# Optimizing an MI355X kernel written in HIP

```python
import jax, jax.numpy as jnp
from jax import lax
import numpy as np

D_MODEL = 1024
BATCH = 4
SEQ = 4096
DEPTH = 4

GRID_W = 64
NA_HEADS = 8
NA_HEAD_DIM = 64
NA_WIN_ROWS = 8
NA_WIN_COLS = 16
D_NA = NA_HEADS * NA_HEAD_DIM
SGU_GROUPS = 8
SGU_GROUP_DIM = 64
SGU_CHUNK = 128
D_SGU = SGU_GROUPS * SGU_GROUP_DIM
D_MIX = D_NA + D_SGU
D_IN = 3 * D_NA + 2 * D_SGU
MOE_GROUPS = 4
MOE_EXPERTS_PER_GROUP = 4
MOE_EXPERTS = MOE_GROUPS * MOE_EXPERTS_PER_GROUP
MOE_TOP_K = 2
D_EXPERT = 256
DEEPNORM_ALPHA = (2 * DEPTH) ** 0.25
DEEPNORM_BETA = (8 * DEPTH) ** -0.25
LN_EPS = 1e-5

kernel_name = "hybrid_natten_sgu_hmoe_deepnorm"


def layer_norm(x, g, b):
    xf = x.astype(jnp.float32)
    mu = jnp.mean(xf, axis=-1, keepdims=True)
    xc = xf - mu
    var = jnp.mean(jnp.square(xc), axis=-1, keepdims=True)
    y = xc * lax.rsqrt(var + LN_EPS) * g.astype(jnp.float32) + b.astype(jnp.float32)
    return y.astype(x.dtype)


def rms_norm(x, g):
    xf = x.astype(jnp.float32)
    y = xf * lax.rsqrt(jnp.mean(jnp.square(xf), axis=-1, keepdims=True) + LN_EPS)
    return (y * g.astype(jnp.float32)).astype(x.dtype)


def neighbourhood_attention(q, k, v, rel_bias):
    B, T, H, Dh = q.shape
    rows = T // GRID_W
    kh = min(NA_WIN_ROWS, rows)
    kw = NA_WIN_COLS
    qg = q.reshape(B, rows, GRID_W, H, Dh)
    kg = k.reshape(B, rows, GRID_W, H, Dh)
    vg = v.reshape(B, rows, GRID_W, H, Dh)
    cols = np.arange(GRID_W)
    col_start = np.clip(cols - kw // 2, 0, GRID_W - kw)
    col_idx = col_start[:, None] + np.arange(kw)[None, :]
    dc = jnp.asarray(col_idx - cols[:, None], jnp.int32)
    row_start = np.clip(np.arange(rows) - kh // 2, 0, rows - kh)

    def one_row(args):
        r, rs = args
        q_r = lax.dynamic_index_in_dim(qg, r, axis=1, keepdims=False)
        k_r = lax.dynamic_slice_in_dim(kg, rs, kh, axis=1)
        v_r = lax.dynamic_slice_in_dim(vg, rs, kh, axis=1)
        k_n = k_r[:, :, col_idx]
        v_n = v_r[:, :, col_idx]
        dr = rs + jnp.arange(kh, dtype=jnp.int32) - r
        bias = rel_bias[:, dr[None, :, None] + (NA_WIN_ROWS - 1),
                        dc[:, None, :] + (NA_WIN_COLS - 1)]
        s = jnp.einsum('bchd,bicjhd->bhcij', q_r, k_n)
        logits = s.astype(jnp.float32) + bias.astype(jnp.float32)
        p = jax.nn.softmax(logits.reshape(B, H, GRID_W, kh * kw), axis=-1)
        p = p.reshape(B, H, GRID_W, kh, kw).astype(v.dtype)
        return jnp.einsum('bhcij,bicjhd->bchd', p, v_n)

    out = lax.map(one_row, (jnp.arange(rows, dtype=jnp.int32),
                            jnp.asarray(row_start, jnp.int32)))
    return jnp.transpose(out, (1, 0, 2, 3, 4)).reshape(B, T, H * Dh)


def spatial_gating(u, vs, ln_g, ln_b, w_s, b_s):
    B, T, _ = u.shape
    n_chunks = T // SGU_CHUNK
    vg = vs.reshape(B, T, SGU_GROUPS, SGU_GROUP_DIM)
    vg = layer_norm(vg, ln_g.reshape(SGU_GROUPS, SGU_GROUP_DIM), ln_b.reshape(SGU_GROUPS, SGU_GROUP_DIM))
    vg = vg.reshape(B, n_chunks, SGU_CHUNK, SGU_GROUPS, SGU_GROUP_DIM)
    mixed = jnp.einsum('gpq,bnqgd->bnpgd', w_s, vg) + jnp.transpose(b_s)[:, :, None]
    return u * mixed.reshape(B, T, D_SGU)


def hierarchical_moe(h, w_rg, b_rg, w_re, b_re, w_gate, w_up, w_down):
    B, T, D = h.shape
    hf = h.reshape(B * T, D)
    g_logits = (hf @ w_rg).astype(jnp.float32) + b_rg.astype(jnp.float32)
    p_group = jax.nn.softmax(g_logits, axis=-1)
    g_star = jnp.argmax(g_logits, axis=-1)
    gate_group = jnp.take_along_axis(p_group, g_star[:, None], axis=1)
    e_logits = ((hf @ w_re).astype(jnp.float32) + b_re.astype(jnp.float32)
                ).reshape(B * T, MOE_GROUPS, MOE_EXPERTS_PER_GROUP)
    e_sel = jnp.take_along_axis(e_logits, g_star[:, None, None], axis=1)[:, 0]
    top_vals, top_idx = lax.top_k(e_sel, MOE_TOP_K)
    top_w = jax.nn.softmax(top_vals, axis=-1)
    within = jnp.sum(jax.nn.one_hot(top_idx, MOE_EXPERTS_PER_GROUP, dtype=jnp.float32)
                     * top_w[..., None], axis=1)
    combine = (jax.nn.one_hot(g_star, MOE_GROUPS, dtype=jnp.float32)[:, :, None]
               * within[:, None, :] * gate_group[:, :, None]).reshape(B * T, MOE_EXPERTS)
    combine = combine.astype(h.dtype)
    y = jnp.zeros_like(hf)
    for e in range(MOE_EXPERTS):
        act = jax.nn.silu(hf @ w_gate[e]) * (hf @ w_up[e])
        y = y + combine[:, e:e + 1] * (act @ w_down[e])
    return y.reshape(B, T, D)


def setup_inputs(seed: int = 0) -> dict:
    key = jax.random.key(seed)
    ks = jax.random.split(key, 20)
    f32 = jnp.float32
    nrm = lambda k, shape, s: jax.random.normal(k, shape, f32) * s
    x = jax.random.normal(ks[0], (BATCH, SEQ, D_MODEL), f32)
    col_scale = jnp.concatenate([jnp.ones((2 * D_NA,), f32),
                                 jnp.full((D_NA,), DEEPNORM_BETA, f32),
                                 jnp.ones((2 * D_SGU,), f32)])
    w_in = nrm(ks[1], (DEPTH, D_MODEL, D_IN), D_MODEL ** -0.5) * col_scale
    w_out = nrm(ks[2], (DEPTH, D_MIX, D_MODEL), DEEPNORM_BETA * D_MIX ** -0.5)
    na_rel_bias = nrm(ks[3], (DEPTH, NA_HEADS, 2 * NA_WIN_ROWS - 1, 2 * NA_WIN_COLS - 1), 0.02)
    sgu_ln_g = 1.0 + nrm(ks[4], (DEPTH, D_SGU), 0.02)
    sgu_ln_b = nrm(ks[5], (DEPTH, D_SGU), 0.02)
    sgu_w = nrm(ks[6], (DEPTH, SGU_GROUPS, SGU_CHUNK, SGU_CHUNK), SGU_CHUNK ** -0.5)
    sgu_b = 1.0 + nrm(ks[7], (DEPTH, SGU_GROUPS, SGU_CHUNK), 0.02)
    mix_norm_g = 1.0 + nrm(ks[8], (DEPTH, D_MIX), 0.02)
    ln1_g = 1.0 + nrm(ks[9], (DEPTH, D_MODEL), 0.02)
    ln1_b = nrm(ks[10], (DEPTH, D_MODEL), 0.02)
    router_group_w = nrm(ks[11], (DEPTH, D_MODEL, MOE_GROUPS), D_MODEL ** -0.5)
    router_group_b = nrm(ks[12], (DEPTH, MOE_GROUPS), 0.01)
    router_expert_w = nrm(ks[13], (DEPTH, D_MODEL, MOE_EXPERTS), D_MODEL ** -0.5)
    router_expert_b = nrm(ks[14], (DEPTH, MOE_EXPERTS), 0.01)
    expert_w_gate = nrm(ks[15], (DEPTH, MOE_EXPERTS, D_MODEL, D_EXPERT), DEEPNORM_BETA * D_MODEL ** -0.5)
    expert_w_up = nrm(ks[16], (DEPTH, MOE_EXPERTS, D_MODEL, D_EXPERT), DEEPNORM_BETA * D_MODEL ** -0.5)
    expert_w_down = nrm(ks[17], (DEPTH, MOE_EXPERTS, D_EXPERT, D_MODEL), DEEPNORM_BETA * D_EXPERT ** -0.5)
    ln2_g = 1.0 + nrm(ks[18], (DEPTH, D_MODEL), 0.02)
    ln2_b = nrm(ks[19], (DEPTH, D_MODEL), 0.02)
    return {"x": x, "w_in": w_in, "w_out": w_out, "na_rel_bias": na_rel_bias,
            "sgu_ln_g": sgu_ln_g, "sgu_ln_b": sgu_ln_b, "sgu_w": sgu_w, "sgu_b": sgu_b,
            "mix_norm_g": mix_norm_g, "ln1_g": ln1_g, "ln1_b": ln1_b,
            "router_group_w": router_group_w, "router_group_b": router_group_b,
            "router_expert_w": router_expert_w, "router_expert_b": router_expert_b,
            "expert_w_gate": expert_w_gate, "expert_w_up": expert_w_up,
            "expert_w_down": expert_w_down, "ln2_g": ln2_g, "ln2_b": ln2_b}


def reference(x, w_in, w_out, na_rel_bias, sgu_ln_g, sgu_ln_b, sgu_w, sgu_b, mix_norm_g,
              ln1_g, ln1_b, router_group_w, router_group_b, router_expert_w, router_expert_b,
              expert_w_gate, expert_w_up, expert_w_down, ln2_g, ln2_b):
    B, T, _ = x.shape
    splits = [D_NA, 2 * D_NA, 3 * D_NA, 3 * D_NA + D_SGU]
    for l in range(DEPTH):
        proj = jnp.einsum('btd,de->bte', x, w_in[l])
        q, k, v, u, vs = jnp.split(proj, splits, axis=-1)
        q = q.reshape(B, T, NA_HEADS, NA_HEAD_DIM) * (NA_HEAD_DIM ** -0.5)
        k = k.reshape(B, T, NA_HEADS, NA_HEAD_DIM)
        v = v.reshape(B, T, NA_HEADS, NA_HEAD_DIM)
        a_out = neighbourhood_attention(q, k, v, na_rel_bias[l])
        s_out = spatial_gating(jax.nn.gelu(u), jax.nn.gelu(vs), sgu_ln_g[l], sgu_ln_b[l],
                               sgu_w[l], sgu_b[l])
        mixed = jnp.concatenate([rms_norm(a_out, mix_norm_g[l, :D_NA]),
                                 rms_norm(s_out, mix_norm_g[l, D_NA:])], axis=-1)
        mix_out = jnp.einsum('bte,ed->btd', mixed, w_out[l])
        x = layer_norm(DEEPNORM_ALPHA * x + mix_out, ln1_g[l], ln1_b[l])
        moe_out = hierarchical_moe(x, router_group_w[l], router_group_b[l],
                                   router_expert_w[l], router_expert_b[l],
                                   expert_w_gate[l], expert_w_up[l], expert_w_down[l])
        x = layer_norm(DEEPNORM_ALPHA * x + moe_out, ln2_g[l], ln2_b[l])
    return x
```

```cpp
#include <hip/hip_runtime.h>
#include <hip/hip_cooperative_groups.h>
#include <stdint.h>
#include <cstdio>
namespace cg = cooperative_groups;

#ifndef MEGA
#define MEGA 1
#endif
#define DUP_PH 0

typedef unsigned short bf16_t;
typedef short bf16x8 __attribute__((ext_vector_type(8)));
typedef float f32x4 __attribute__((ext_vector_type(4)));
typedef unsigned u32x4 __attribute__((ext_vector_type(4)));
typedef unsigned u32x2 __attribute__((ext_vector_type(2)));

#define NTOK 16384
#define LN_EPS 1e-5f
#define ALPHA 1.681792830507429f
#define NCONV_ITEMS 3985
#define SMEM_BYTES 69632

struct Params {
  const float *x, *w_in, *w_out, *rel_bias, *sgu_ln_g, *sgu_ln_b, *sgu_w, *sgu_b, *mix_g, *ln1_g, *ln1_b,
      *rg_w, *rg_b, *re_w, *re_b, *w_gate, *w_up, *w_down, *ln2_g, *ln2_b;
  float* out;
  bf16_t *Wt_in, *Wt_out, *Wgu, *Wdn, *Wsgu, *xb, *qk, *vT, *ub, *vnT, *mixed, *act, *y, *hb;
  float *x1, *ssq, *wlist, *Wr_e, *Wr_g;
  int *counts, *list, *tokinfo;
  unsigned* bar;
  int never;
  int pad_;
};

__device__ __forceinline__ unsigned cvt_pk_bf16(float lo, float hi) {
  unsigned r; asm("v_cvt_pk_bf16_f32 %0, %1, %2" : "=v"(r) : "v"(lo), "v"(hi)); return r;
}
__device__ __forceinline__ void store_bf16x4(bf16_t* p, float a, float b, float c, float d) {
  u32x2 v; v.x = cvt_pk_bf16(a, b); v.y = cvt_pk_bf16(c, d); *(u32x2*)p = v;
}
__device__ __forceinline__ float gelu_tanh(float x) {
  float z = 0.7978845608028654f * (x + 0.044715f * x * x * x);
  return x / (1.0f + __expf(-2.0f * z));
}
__device__ __forceinline__ int otid() { int t = threadIdx.x; asm volatile("" : "+v"(t)); return t; }
__device__ __forceinline__ float silu(float x) { return x / (1.0f + __expf(-x)); }
template <int CTRL>
__device__ __forceinline__ float dpp_mov(float v) {
  return __builtin_bit_cast(float, __builtin_amdgcn_update_dpp(0, __builtin_bit_cast(int, v), CTRL, 0xf, 0xf, true));
}
__device__ __forceinline__ float row16_sum(float v) {
  v += dpp_mov<0xB1>(v); v += dpp_mov<0x4E>(v); v += dpp_mov<0x141>(v); v += dpp_mov<0x140>(v); return v;
}
__device__ __forceinline__ float wave_sum(float v) {
  v = row16_sum(v); v += __shfl_xor(v, 16); v += __shfl_xor(v, 32); return v;
}

struct NoMid { __device__ __forceinline__ void operator()(f32x4 (&)[4][4]) const {} };
struct MidScale {
  float s[4];
  __device__ __forceinline__ void operator()(f32x4 (&acc)[4][4]) const {
#pragma unroll
    for (int i = 0; i < 4; ++i)
#pragma unroll
      for (int j = 0; j < 4; ++j) acc[i][j] *= s[i];
  }
};

#define GLDS16(gptr, lptr) __builtin_amdgcn_global_load_lds((const unsigned*)(gptr), (__attribute__((address_space(3))) unsigned*)(lptr), 16, 0, 0)

template <class Mid>
__device__ __forceinline__ void gemm_main(unsigned char* smem, const bf16_t* pa0, const bf16_t* pa1, const bf16_t* pa2,
                                          const bf16_t* pa3, const bf16_t* pb0, const bf16_t* pb1, const bf16_t* pb2,
                                          const bf16_t* pb3, int nk, int kmid, bool swapped, f32x4 (&acc)[4][4],
                                          const Mid& mid) {
  const int tid = otid(), lane = tid & 63, wid = tid >> 6, wr = wid >> 1, wc = wid & 1;
  const int srow = tid >> 3;
  const int lch = ((tid & 7) ^ ((srow >> 1) & 7)) * 8 - (tid & 7) * 8;
  pa0 += lch; pa1 += lch; pa2 += lch; pa3 += lch; pb0 += lch; pb1 += lch; pb2 += lch; pb3 += lch;
  const int soff = __builtin_amdgcn_readfirstlane(wid) * 1024;
  const int qi = lane & 15, g = lane >> 4, s = qi >> 1;
  const int aside = swapped ? 16384 : 0, bside = swapped ? 0 : 16384;
  const int offA0 = aside + (wr * 64 + qi) * 128 + (((0 + g) ^ s) << 4);
  const int offA1 = aside + (wr * 64 + qi) * 128 + (((4 + g) ^ s) << 4);
  const int offB0 = bside + (wc * 64 + qi) * 128 + (((0 + g) ^ s) << 4);
  const int offB1 = bside + (wc * 64 + qi) * 128 + (((4 + g) ^ s) << 4);
  {
    unsigned char* d = smem + soff;
    GLDS16(pa0, d); GLDS16(pa1, d + 4096); GLDS16(pa2, d + 8192); GLDS16(pa3, d + 12288);
    GLDS16(pb0, d + 16384); GLDS16(pb1, d + 20480); GLDS16(pb2, d + 24576); GLDS16(pb3, d + 28672);
  }
  asm volatile("s_waitcnt vmcnt(0)" ::: "memory");
  __syncthreads();
  for (int kt = 0; kt < nk; ++kt) {
    unsigned char* buf = smem + ((kt & 1) << 15);
    if (kt + 1 < nk) {
      const int ko = (kt + 1) * 64;
      unsigned char* d = smem + (((kt + 1) & 1) << 15) + soff;
      GLDS16(pa0 + ko, d); GLDS16(pa1 + ko, d + 4096); GLDS16(pa2 + ko, d + 8192); GLDS16(pa3 + ko, d + 12288);
      GLDS16(pb0 + ko, d + 16384); GLDS16(pb1 + ko, d + 20480); GLDS16(pb2 + ko, d + 24576); GLDS16(pb3 + ko, d + 28672);
    }
    if (kt == kmid) mid(acc);
    {
      bf16x8 af0[4], bf0[4], af1[4], bf1[4];
#pragma unroll
      for (int i = 0; i < 4; ++i) af0[i] = *(const bf16x8*)(buf + offA0 + i * 2048);
#pragma unroll
      for (int j = 0; j < 4; ++j) bf0[j] = *(const bf16x8*)(buf + offB0 + j * 2048);
#pragma unroll
      for (int i = 0; i < 4; ++i) af1[i] = *(const bf16x8*)(buf + offA1 + i * 2048);
#pragma unroll
      for (int j = 0; j < 4; ++j) bf1[j] = *(const bf16x8*)(buf + offB1 + j * 2048);
      asm volatile("s_waitcnt lgkmcnt(8)" ::: "memory");
      __builtin_amdgcn_s_setprio(1);
#pragma unroll
      for (int i = 0; i < 4; ++i)
#pragma unroll
        for (int j = 0; j < 4; ++j) acc[i][j] = __builtin_amdgcn_mfma_f32_16x16x32_bf16(bf0[j], af0[i], acc[i][j], 0, 0, 0);
      asm volatile("s_waitcnt lgkmcnt(0)" ::: "memory");
#pragma unroll
      for (int i = 0; i < 4; ++i)
#pragma unroll
        for (int j = 0; j < 4; ++j) acc[i][j] = __builtin_amdgcn_mfma_f32_16x16x32_bf16(bf1[j], af1[i], acc[i][j], 0, 0, 0);
      __builtin_amdgcn_s_setprio(0);
    }
    asm volatile("s_waitcnt vmcnt(0)" ::: "memory");
    __syncthreads();
  }
}

#define ZERO_ACC(acc)                                   \
  _Pragma("unroll") for (int i_ = 0; i_ < 4; ++i_)      \
  _Pragma("unroll") for (int j_ = 0; j_ < 4; ++j_) acc[i_][j_] = (f32x4){0.f, 0.f, 0.f, 0.f};

__device__ void conv_x(const Params& p, int bid, int nblk) {
  const size_t n8 = (size_t)NTOK * 1024 / 8;
  for (size_t i = (size_t)bid * 256 + threadIdx.x; i < n8; i += (size_t)nblk * 256) {
    const float4 a = *(const float4*)(p.x + i * 8), b = *(const float4*)(p.x + i * 8 + 4);
    u32x4 v; v.x = cvt_pk_bf16(a.x, a.y); v.y = cvt_pk_bf16(a.z, a.w); v.z = cvt_pk_bf16(b.x, b.y); v.w = cvt_pk_bf16(b.z, b.w);
    *(u32x4*)(p.xb + i * 8) = v;
  }
}

__device__ void tconv_tile(float* tile, const float* src, int src_ld, const float* kscale, bf16_t* dst, int dst_ld, int rstep) {
  const int t = otid();
#pragma unroll
  for (int i = 0; i < 4; ++i) {
    const int k = (t >> 4) + 16 * i, n4 = (t & 15) * 4;
    float4 v = *(const float4*)(src + (size_t)k * src_ld + n4);
    if (kscale) { const float sc = kscale[k]; v.x *= sc; v.y *= sc; v.z *= sc; v.w *= sc; }
    float* d = tile + k * 65 + n4;
    d[0] = v.x; d[1] = v.y; d[2] = v.z; d[3] = v.w;
  }
  __syncthreads();
  {
    const int n = t >> 2, kc = (t & 3) * 16;
    float f[16];
#pragma unroll
    for (int q = 0; q < 16; ++q) f[q] = tile[(kc + q) * 65 + n];
    u32x4 v0, v1;
    v0.x = cvt_pk_bf16(f[0], f[1]); v0.y = cvt_pk_bf16(f[2], f[3]); v0.z = cvt_pk_bf16(f[4], f[5]); v0.w = cvt_pk_bf16(f[6], f[7]);
    v1.x = cvt_pk_bf16(f[8], f[9]); v1.y = cvt_pk_bf16(f[10], f[11]); v1.z = cvt_pk_bf16(f[12], f[13]); v1.w = cvt_pk_bf16(f[14], f[15]);
    bf16_t* o = dst + (size_t)((n >> 4) * rstep + (n & 15)) * dst_ld + kc;
    *(u32x4*)o = v0; *(u32x4*)(o + 8) = v1;
  }
  __syncthreads();
}

__device__ void conv_item(const Params& p, int l, int it, unsigned char* smem) {
  float* tile = (float*)smem;
  if (it < 640) {
    const int kt = it / 40, ntile = it % 40;
    tconv_tile(tile, p.w_in + (size_t)l * 1024 * 2560 + (size_t)kt * 64 * 2560 + ntile * 64, 2560, nullptr,
               p.Wt_in + (size_t)ntile * 64 * 1024 + kt * 64, 1024, 16);
  } else if (it < 896) {
    const int r = it - 640, kt = r / 16, ntile = r % 16;
    tconv_tile(tile, p.w_out + (size_t)l * 1024 * 1024 + (size_t)kt * 64 * 1024 + ntile * 64, 1024, p.mix_g + l * 1024 + kt * 64,
               p.Wt_out + (size_t)ntile * 64 * 1024 + kt * 64, 1024, 16);
  } else if (it < 2944) {
    const int r0 = it - 896, e = r0 >> 7, r = r0 & 127, which = r >> 6, r2 = r & 63, kt = r2 >> 2, ntile = r2 & 3;
    const float* src = (which ? p.w_up : p.w_gate) + (size_t)(l * 16 + e) * 1024 * 256 + (size_t)kt * 64 * 256 + ntile * 64;
    tconv_tile(tile, src, 256, nullptr, p.Wgu + (size_t)e * 512 * 1024 + (size_t)(ntile * 128 + which * 16) * 1024 + kt * 64, 1024, 32);
  } else if (it < 3968) {
    const int r0 = it - 2944, e = r0 >> 6, r = r0 & 63, kt = r >> 4, ntile = r & 15;
    tconv_tile(tile, p.w_down + (size_t)(l * 16 + e) * 256 * 1024 + (size_t)kt * 64 * 1024 + ntile * 64, 1024, nullptr,
               p.Wdn + (size_t)e * 1024 * 256 + (size_t)ntile * 64 * 256 + kt * 64, 256, 16);
  } else if (it == 3984) {
    for (int i = threadIdx.x; i < 16384; i += 256) {
      const int s_ = i & 3, j = (i >> 2) & 15, g = (i >> 6) & 3, kb = i >> 8;
      p.Wr_e[i] = p.re_w[(size_t)(l * 1024 + 16 * kb + 4 * g + s_) * 16 + j];
    }
    for (int i = threadIdx.x; i < 4096; i += 256) {
      const int s_ = i & 3, j = (i >> 2) & 3, g = (i >> 4) & 3, kb = i >> 6;
      p.Wr_g[i] = p.rg_w[(size_t)(l * 1024 + 16 * kb + 4 * g + s_) * 4 + j];
    }
  } else {
    const int j = it - 3968;
    const float* src = p.sgu_w + (size_t)l * 131072 + (size_t)j * 8192 + threadIdx.x * 32;
    bf16_t* dst = p.Wsgu + (size_t)j * 8192 + threadIdx.x * 32;
#pragma unroll
    for (int q = 0; q < 4; ++q) {
      const float4 a = *(const float4*)(src + q * 8), b = *(const float4*)(src + q * 8 + 4);
      u32x4 v; v.x = cvt_pk_bf16(a.x, a.y); v.y = cvt_pk_bf16(a.z, a.w); v.z = cvt_pk_bf16(b.x, b.y); v.w = cvt_pk_bf16(b.z, b.w);
      *(u32x4*)(dst + q * 8) = v;
    }
  }
}

__device__ void p1_tile(const Params& p, int l, int t, unsigned char* smem) {
  const int x_ = t & 7, j_ = t >> 3, rd_ = j_ >> 6, lb_ = j_ & 63;
  const int mt = (rd_ < 4) ? (x_ * 16 + (rd_ & 1) * 8 + (lb_ & 7)) : (x_ * 16 + (lb_ & 15));
  const int nt = (rd_ < 4) ? ((rd_ >> 1) * 8 + (lb_ >> 3)) : (16 + (lb_ >> 4));
  const int type = nt >> 2;
  const bool swapped = (type == 2) || (type == 4);
  const int tid = otid(), lane = tid & 63, wid = tid >> 6, wr = wid >> 1, wc = wid & 1;
  const int srow = tid >> 3, sch = tid & 7, qi = lane & 15, g = lane >> 4;
  const bf16_t* A = p.xb + (size_t)(mt * 128 + srow) * 1024 + sch * 8;
  const bf16_t* B = p.Wt_in + (size_t)(nt * 128 + srow) * 1024 + sch * 8;
  f32x4 acc[4][4];
  ZERO_ACC(acc);
  gemm_main(smem, A, A + 32 * 1024, A + 64 * 1024, A + 96 * 1024, B, B + 32 * 1024, B + 64 * 1024, B + 96 * 1024, 16, -1, swapped, acc, NoMid());
  if (!swapped) {
#pragma unroll
    for (int i = 0; i < 4; ++i) {
      const int m = mt * 128 + wr * 64 + i * 16 + qi;
#pragma unroll
      for (int j = 0; j < 4; ++j) {
        const int n = nt * 128 + wc * 64 + j * 16 + 4 * g;
        f32x4 v = acc[i][j];
        if (type == 0) v *= 0.125f;
        if (type == 3) { v[0] = gelu_tanh(v[0]); v[1] = gelu_tanh(v[1]); v[2] = gelu_tanh(v[2]); v[3] = gelu_tanh(v[3]); }
        bf16_t* dst = (type == 3) ? (p.ub + (size_t)m * 512 + (n - 1536)) : (p.qk + (size_t)m * 1024 + n);
        store_bf16x4(dst, v[0], v[1], v[2], v[3]);
      }
    }
  } else {
    const int bidx = (mt * 128) >> 12, tokbase = (mt * 128) & 4095;
    bf16_t* dstb = (type == 2) ? p.vT : p.vnT;
    const int fbase = (type == 2) ? 1024 : 2048;
    if (type == 4) {
#pragma unroll
      for (int i = 0; i < 4; ++i)
#pragma unroll
        for (int j = 0; j < 4; ++j)
#pragma unroll
          for (int r = 0; r < 4; ++r) acc[i][j][r] = gelu_tanh(acc[i][j][r]);
      float gam[4], bet[4];
#pragma unroll
      for (int i = 0; i < 4; ++i) {
        const int f = nt * 128 + wr * 64 + i * 16 + qi - 2048;
        gam[i] = p.sgu_ln_g[l * 512 + f]; bet[i] = p.sgu_ln_b[l * 512 + f];
      }
#pragma unroll
      for (int j = 0; j < 4; ++j)
#pragma unroll
        for (int r = 0; r < 4; ++r) {
          float s1 = acc[0][j][r] + acc[1][j][r] + acc[2][j][r] + acc[3][j][r];
          s1 = row16_sum(s1);
          const float mu = s1 * (1.0f / 64.0f);
          float s2 = 0.f;
#pragma unroll
          for (int i = 0; i < 4; ++i) { const float d = acc[i][j][r] - mu; s2 += d * d; }
          s2 = row16_sum(s2);
          const float rstd = rsqrtf(s2 * (1.0f / 64.0f) + LN_EPS);
#pragma unroll
          for (int i = 0; i < 4; ++i) acc[i][j][r] = (acc[i][j][r] - mu) * rstd * gam[i] + bet[i];
        }
    }
#pragma unroll
    for (int i = 0; i < 4; ++i) {
      const int f = nt * 128 + wr * 64 + i * 16 + qi - fbase;
#pragma unroll
      for (int j = 0; j < 4; ++j) {
        const int tok = tokbase + wc * 64 + j * 16 + 4 * g;
        store_bf16x4(dstb + ((size_t)(bidx * 512 + f)) * 4096 + tok, acc[i][j][0], acc[i][j][1], acc[i][j][2], acc[i][j][3]);
      }
    }
  }
}

__device__ void attn_item(const Params& p, int l, int it, unsigned char* smem) {
  const int h = it & 7, br = it >> 3, r = br & 63, b = br >> 6;
  const int rs = min(max(r - 4, 0), 56);
  const int tid = otid(), lane = tid & 63, w = tid >> 6, qi = lane & 15, g = lane >> 4;
  unsigned char* Kb = smem;
  unsigned char* Vb = smem + 32768;
  float* sbias = (float*)(smem + 32768 + 33792);
  const int c0 = (w == 0) ? 0 : (w == 1) ? 8 : (w == 2) ? 24 : 32;
  const int cq = 16 * w + qi, cs = min(max(cq - 8, 0), 48);
  const size_t tokq = (size_t)b * 4096 + r * 64 + cq;
  const int krow = tid >> 3, kch = tid & 7;
  const int ksoff = krow * 128 + ((kch ^ ((krow >> 1) & 7)) << 4);
  const bf16_t* kg = p.qk + ((size_t)b * 4096 + rs * 64 + krow) * 1024 + 512 + h * 64 + kch * 8;
  const int vd = tid >> 5, vc = tid & 31;
  const int vsoff = vd * 528 + vc * 16;
  const bf16_t* vg = p.vT + ((size_t)(b * 512 + h * 64 + vd)) * 4096 + rs * 64 + vc * 8;
  u32x4 st[8];
  __syncthreads();
  for (int i = tid; i < 465; i += 256) sbias[i] = p.rel_bias[(size_t)(l * 8 + h) * 465 + i];
#pragma unroll
  for (int i = 0; i < 8; ++i) st[i] = *(const u32x4*)(kg + (size_t)(32 * i) * 1024);
#pragma unroll
  for (int i = 0; i < 8; ++i) *(u32x4*)(Kb + ksoff + i * 4096) = st[i];
  bf16x8 qf0 = *(const bf16x8*)(p.qk + tokq * 1024 + h * 64 + g * 8);
  bf16x8 qf1 = *(const bf16x8*)(p.qk + tokq * 1024 + h * 64 + 32 + g * 8);
  __syncthreads();
#pragma unroll
  for (int i = 0; i < 8; ++i) st[i] = *(const u32x4*)(kg + (size_t)(256 + 32 * i) * 1024);
  f32x4 s[8][2];
#pragma unroll
  for (int jh = 0; jh < 2; ++jh) {
#pragma unroll
    for (int jj = 0; jj < 4; ++jj)
#pragma unroll
      for (int ch = 0; ch < 2; ++ch) {
        const int kl = jj * 64 + c0 + 16 * ch + qi;
        const int sw = (kl >> 1) & 7;
        const bf16x8 kf0 = *(const bf16x8*)(Kb + kl * 128 + (((0 + g) ^ sw) << 4));
        const bf16x8 kf1 = *(const bf16x8*)(Kb + kl * 128 + (((4 + g) ^ sw) << 4));
        f32x4 a = {0.f, 0.f, 0.f, 0.f};
        a = __builtin_amdgcn_mfma_f32_16x16x32_bf16(kf0, qf0, a, 0, 0, 0);
        a = __builtin_amdgcn_mfma_f32_16x16x32_bf16(kf1, qf1, a, 0, 0, 0);
        s[jh * 4 + jj][ch] = a;
      }
    if (jh == 0) {
      __syncthreads();
#pragma unroll
      for (int i = 0; i < 8; ++i) *(u32x4*)(Kb + ksoff + i * 4096) = st[i];
#pragma unroll
      for (int i = 0; i < 8; ++i) st[i] = *(const u32x4*)(vg + (size_t)(8 * i) * 4096);
      __syncthreads();
    }
  }
#pragma unroll
  for (int i = 0; i < 8; ++i) *(u32x4*)(Vb + vsoff + i * 8 * 528) = st[i];
#pragma unroll
  for (int i = 0; i < 8; ++i) st[i] = *(const u32x4*)(vg + (size_t)(8 * i) * 4096 + 256);
  float mx = -1e30f;
#pragma unroll
  for (int j = 0; j < 8; ++j)
#pragma unroll
    for (int ch = 0; ch < 2; ++ch)
#pragma unroll
      for (int rg = 0; rg < 4; ++rg) {
        const int kc = c0 + 16 * ch + 4 * g + rg;
        const bool valid = (kc >= cs) && (kc < cs + 16);
        const int bidx = valid ? ((rs + j - r + 7) * 31 + (kc - cq) + 15) : 0;
        const float v = valid ? (s[j][ch][rg] + sbias[bidx]) : -1e30f;
        s[j][ch][rg] = v;
        mx = fmaxf(mx, v);
      }
  mx = fmaxf(mx, __shfl_xor(mx, 16)); mx = fmaxf(mx, __shfl_xor(mx, 32));
  float sum = 0.f;
#pragma unroll
  for (int j = 0; j < 8; ++j)
#pragma unroll
    for (int ch = 0; ch < 2; ++ch)
#pragma unroll
      for (int rg = 0; rg < 4; ++rg) { const float e = __expf(s[j][ch][rg] - mx); s[j][ch][rg] = e; sum += e; }
  sum += __shfl_xor(sum, 16); sum += __shfl_xor(sum, 32);
  const float inv = 1.0f / sum;
  bf16x8 pf[8];
#pragma unroll
  for (int j = 0; j < 8; ++j) {
    u32x4 pw;
    pw.x = cvt_pk_bf16(s[j][0][0], s[j][0][1]); pw.y = cvt_pk_bf16(s[j][0][2], s[j][0][3]);
    pw.z = cvt_pk_bf16(s[j][1][0], s[j][1][1]); pw.w = cvt_pk_bf16(s[j][1][2], s[j][1][3]);
    pf[j] = __builtin_bit_cast(bf16x8, pw);
  }
  f32x4 o[4];
#pragma unroll
  for (int dt = 0; dt < 4; ++dt) o[dt] = (f32x4){0.f, 0.f, 0.f, 0.f};
  __syncthreads();
#pragma unroll
  for (int jh = 0; jh < 2; ++jh) {
#pragma unroll
    for (int jj = 0; jj < 4; ++jj)
#pragma unroll
      for (int dt = 0; dt < 4; ++dt) {
        const unsigned char* vp = Vb + (dt * 16 + qi) * 528 + (jj * 64 + c0 + 4 * g) * 2;
        const u32x2 lo = *(const u32x2*)vp, hi = *(const u32x2*)(vp + 32);
        u32x4 vw; vw.x = lo.x; vw.y = lo.y; vw.z = hi.x; vw.w = hi.y;
        o[dt] = __builtin_amdgcn_mfma_f32_16x16x32_bf16(__builtin_bit_cast(bf16x8, vw), pf[jh * 4 + jj], o[dt], 0, 0, 0);
      }
    if (jh == 0) {
      __syncthreads();
#pragma unroll
      for (int i = 0; i < 8; ++i) *(u32x4*)(Vb + vsoff + i * 8 * 528) = st[i];
      __syncthreads();
    }
  }
  float sq = 0.f;
#pragma unroll
  for (int dt = 0; dt < 4; ++dt) {
    o[dt] *= inv;
    sq += o[dt][0] * o[dt][0] + o[dt][1] * o[dt][1] + o[dt][2] * o[dt][2] + o[dt][3] * o[dt][3];
    store_bf16x4(p.mixed + tokq * 1024 + h * 64 + dt * 16 + 4 * g, o[dt][0], o[dt][1], o[dt][2], o[dt][3]);
  }
  sq += __shfl_xor(sq, 16); sq += __shfl_xor(sq, 32);
  if (g == 0) p.ssq[tokq * 16 + h] = sq;
}

__device__ void sgu_item(const Params& p, int l, int it, unsigned char* smem) {
  const int grp = it & 7, bc = it >> 3, chunk = bc & 31, b = bc >> 5;
  const int tid = otid(), lane = tid & 63, w = tid >> 6, qi = lane & 15, g = lane >> 4;
  const int p0 = 32 * w;
  const int wbase = __builtin_amdgcn_readfirstlane(w) * 1024;
  const int lc = ((tid & 15) ^ ((tid >> 4) & 15)) << 3;
  const bf16_t* wsrc = p.Wsgu + ((size_t)(grp * 128 + (tid >> 4))) * 128 + lc;
  const bf16_t* vsrc = p.vnT + ((size_t)(b * 512 + grp * 64 + (tid >> 4))) * 4096 + chunk * 128 + lc;
  __syncthreads();
#pragma unroll
  for (int i = 0; i < 8; ++i) GLDS16(wsrc + (size_t)(16 * i) * 128, smem + i * 4096 + wbase);
#pragma unroll
  for (int i = 0; i < 4; ++i) GLDS16(vsrc + (size_t)(16 * i) * 4096, smem + 32768 + i * 4096 + wbase);
  asm volatile("s_waitcnt vmcnt(0)" ::: "memory");
  __syncthreads();
  f32x4 acc[2][4];
#pragma unroll
  for (int mt = 0; mt < 2; ++mt)
#pragma unroll
    for (int nt = 0; nt < 4; ++nt) acc[mt][nt] = (f32x4){0.f, 0.f, 0.f, 0.f};
#pragma unroll
  for (int ks = 0; ks < 4; ++ks) {
    const int co = ((ks * 4 + g) ^ qi) << 4;
    bf16x8 wf[2], vf[4];
#pragma unroll
    for (int mt = 0; mt < 2; ++mt) wf[mt] = *(const bf16x8*)(smem + (p0 + 16 * mt + qi) * 256 + co);
#pragma unroll
    for (int nt = 0; nt < 4; ++nt) vf[nt] = *(const bf16x8*)(smem + 32768 + (16 * nt + qi) * 256 + co);
#pragma unroll
    for (int mt = 0; mt < 2; ++mt)
#pragma unroll
      for (int nt = 0; nt < 4; ++nt) acc[mt][nt] = __builtin_amdgcn_mfma_f32_16x16x32_bf16(vf[nt], wf[mt], acc[mt][nt], 0, 0, 0);
  }
#pragma unroll
  for (int mt = 0; mt < 2; ++mt) {
    const int pp = p0 + 16 * mt + qi;
    const size_t tok = (size_t)b * 4096 + chunk * 128 + pp;
    const float bias = p.sgu_b[(size_t)(l * 8 + grp) * 128 + pp];
    float sq = 0.f;
#pragma unroll
    for (int nt = 0; nt < 4; ++nt) {
      const int d = 16 * nt + 4 * g;
      const u32x2 uu = *(const u32x2*)(p.ub + tok * 512 + grp * 64 + d);
      const float u0 = __uint_as_float(uu.x << 16), u1 = __uint_as_float(uu.x & 0xffff0000u);
      const float u2 = __uint_as_float(uu.y << 16), u3 = __uint_as_float(uu.y & 0xffff0000u);
      const float v0 = u0 * (acc[mt][nt][0] + bias), v1 = u1 * (acc[mt][nt][1] + bias);
      const float v2 = u2 * (acc[mt][nt][2] + bias), v3 = u3 * (acc[mt][nt][3] + bias);
      sq += v0 * v0 + v1 * v1 + v2 * v2 + v3 * v3;
      store_bf16x4(p.mixed + tok * 1024 + 512 + grp * 64 + d, v0, v1, v2, v3);
    }
    sq += __shfl_xor(sq, 16); sq += __shfl_xor(sq, 32);
    if (g == 0) p.ssq[tok * 16 + 8 + grp] = sq;
  }
}

__device__ void p3_tile(const Params& p, int l, int t, unsigned char* smem) {
  const int x_ = t & 7, j_ = t >> 3, rd_ = j_ >> 6, lb_ = j_ & 63;
  const int mt = x_ * 16 + rd_ * 8 + (lb_ & 7), nt = lb_ >> 3;
  const int tid = otid(), lane = tid & 63, wid = tid >> 6, wr = wid >> 1, wc = wid & 1;
  const int srow = tid >> 3, sch = tid & 7, qi = lane & 15, g = lane >> 4;
  const bf16_t* A = p.mixed + (size_t)(mt * 128 + srow) * 1024 + sch * 8;
  const bf16_t* B = p.Wt_out + (size_t)(nt * 128 + srow) * 1024 + sch * 8;
  MidScale mid; float rss[4];
#pragma unroll
  for (int i = 0; i < 4; ++i) {
    const int m = mt * 128 + wr * 64 + i * 16 + qi;
    const float4 a0 = *(const float4*)(p.ssq + (size_t)m * 16), a1 = *(const float4*)(p.ssq + (size_t)m * 16 + 4);
    const float4 b0 = *(const float4*)(p.ssq + (size_t)m * 16 + 8), b1 = *(const float4*)(p.ssq + (size_t)m * 16 + 12);
    const float sa = (a0.x + a0.y + a0.z + a0.w) + (a1.x + a1.y + a1.z + a1.w);
    const float sb = (b0.x + b0.y + b0.z + b0.w) + (b1.x + b1.y + b1.z + b1.w);
    const float ra = rsqrtf(sa * (1.0f / 512.0f) + LN_EPS), rb = rsqrtf(sb * (1.0f / 512.0f) + LN_EPS);
    mid.s[i] = ra / rb; rss[i] = rb;
  }
  f32x4 acc[4][4];
  ZERO_ACC(acc);
  gemm_main(smem, A, A + 32 * 1024, A + 64 * 1024, A + 96 * 1024, B, B + 32 * 1024, B + 64 * 1024, B + 96 * 1024, 16, 8, false, acc, mid);
#pragma unroll
  for (int i = 0; i < 4; ++i) {
    const int m = mt * 128 + wr * 64 + i * 16 + qi;
#pragma unroll
    for (int j = 0; j < 4; ++j) {
      const int n = nt * 128 + wc * 64 + j * 16 + 4 * g;
      const u32x2 xr = *(const u32x2*)(p.xb + (size_t)m * 1024 + n);
      const float o0 = ALPHA * __uint_as_float(xr.x << 16) + acc[i][j][0] * rss[i];
      const float o1 = ALPHA * __uint_as_float(xr.x & 0xffff0000u) + acc[i][j][1] * rss[i];
      const float o2 = ALPHA * __uint_as_float(xr.y << 16) + acc[i][j][2] * rss[i];
      const float o3 = ALPHA * __uint_as_float(xr.y & 0xffff0000u) + acc[i][j][3] * rss[i];
      store_bf16x4(p.hb + (size_t)m * 1024 + n, o0, o1, o2, o3);
    }
  }
}

__device__ void p4_batch(const Params& p, int l, int batch, unsigned char* smem) {
  const int tid = otid(), lane = tid & 63, w = tid >> 6;
  int* scnt = (int*)smem;
  int* sbase = scnt + 16;
  __syncthreads();
  if (tid < 16) scnt[tid] = 0;
  __syncthreads();
  const int tokw = batch * 32 + w * 8;
  {
    float4 gm[4], bt[4];
#pragma unroll
    for (int q = 0; q < 4; ++q) {
      gm[q] = *(const float4*)(p.ln1_g + l * 1024 + q * 256 + lane * 4);
      bt[q] = *(const float4*)(p.ln1_b + l * 1024 + q * 256 + lane * 4);
    }
#pragma unroll 4
    for (int t = 0; t < 8; ++t) {
      float* xr = p.x1 + (size_t)(tokw + t) * 1024 + lane * 4;
      const bf16_t* hr = p.hb + (size_t)(tokw + t) * 1024 + lane * 4;
      float4 v[4];
#pragma unroll
      for (int q = 0; q < 4; ++q) {
        const u32x2 hh = *(const u32x2*)(hr + q * 256);
        v[q].x = __uint_as_float(hh.x << 16); v[q].y = __uint_as_float(hh.x & 0xffff0000u);
        v[q].z = __uint_as_float(hh.y << 16); v[q].w = __uint_as_float(hh.y & 0xffff0000u);
      }
      float s1 = 0.f;
#pragma unroll
      for (int q = 0; q < 4; ++q) s1 += (v[q].x + v[q].y) + (v[q].z + v[q].w);
      const float mu = wave_sum(s1) * (1.0f / 1024.0f);
      float s2 = 0.f;
#pragma unroll
      for (int q = 0; q < 4; ++q) {
        const float d0 = v[q].x - mu, d1 = v[q].y - mu, d2 = v[q].z - mu, d3 = v[q].w - mu;
        s2 += (d0 * d0 + d1 * d1) + (d2 * d2 + d3 * d3);
      }
      const float rstd = rsqrtf(wave_sum(s2) * (1.0f / 1024.0f) + LN_EPS);
#pragma unroll
      for (int q = 0; q < 4; ++q) {
        float4 o;
        o.x = (v[q].x - mu) * rstd * gm[q].x + bt[q].x; o.y = (v[q].y - mu) * rstd * gm[q].y + bt[q].y;
        o.z = (v[q].z - mu) * rstd * gm[q].z + bt[q].z; o.w = (v[q].w - mu) * rstd * gm[q].w + bt[q].w;
        *(float4*)(xr + q * 256) = o;
        store_bf16x4(p.xb + (size_t)(tokw + t) * 1024 + q * 256 + lane * 4, o.x, o.y, o.z, o.w);
      }
    }
  }
  asm volatile("s_waitcnt vmcnt(0)" ::: "memory");
  const int j = lane & 15, g = lane >> 4;
  const int tok = tokw + (j & 7);
  const float* xrow = p.x1 + (size_t)tok * 1024 + 4 * g;
  const float* we = p.Wr_e + (size_t)(g * 16 + j) * 4;
  const float* wg = p.Wr_g + (size_t)(g * 4 + (j & 3)) * 4;
  const float gsel = (j < 4) ? 1.0f : 0.0f;
  f32x4 De = {0.f, 0.f, 0.f, 0.f}, Dg = {0.f, 0.f, 0.f, 0.f};
#pragma unroll 8
  for (int kb = 0; kb < 64; ++kb) {
    const float4 xv = *(const float4*)(xrow + kb * 16);
    const float4 wev = *(const float4*)(we + kb * 256);
    float4 wgv = *(const float4*)(wg + kb * 64);
    wgv.x *= gsel; wgv.y *= gsel; wgv.z *= gsel; wgv.w *= gsel;
    De = __builtin_amdgcn_mfma_f32_16x16x4f32(wev.x, xv.x, De, 0, 0, 0);
    Dg = __builtin_amdgcn_mfma_f32_16x16x4f32(wgv.x, xv.x, Dg, 0, 0, 0);
    De = __builtin_amdgcn_mfma_f32_16x16x4f32(wev.y, xv.y, De, 0, 0, 0);
    Dg = __builtin_amdgcn_mfma_f32_16x16x4f32(wgv.y, xv.y, Dg, 0, 0, 0);
    De = __builtin_amdgcn_mfma_f32_16x16x4f32(wev.z, xv.z, De, 0, 0, 0);
    Dg = __builtin_amdgcn_mfma_f32_16x16x4f32(wgv.z, xv.z, Dg, 0, 0, 0);
    De = __builtin_amdgcn_mfma_f32_16x16x4f32(wev.w, xv.w, De, 0, 0, 0);
    Dg = __builtin_amdgcn_mfma_f32_16x16x4f32(wgv.w, xv.w, Dg, 0, 0, 0);
  }
  float gl[4];
#pragma unroll
  for (int k = 0; k < 4; ++k) gl[k] = __shfl(Dg[k], j) + p.rg_b[l * 4 + k];
  int gs = 0; float gmax = gl[0];
#pragma unroll
  for (int k = 1; k < 4; ++k) { const bool bb = gl[k] > gmax; gmax = bb ? gl[k] : gmax; gs = bb ? k : gs; }
  float psum = 0.f;
#pragma unroll
  for (int k = 0; k < 4; ++k) psum += __expf(gl[k] - gmax);
  const float gate = 1.0f / psum;
  float es[4];
#pragma unroll
  for (int k = 0; k < 4; ++k) es[k] = De[k] + p.re_b[l * 16 + 4 * g + k];
  int i0 = 0; float v0 = es[0];
#pragma unroll
  for (int k = 1; k < 4; ++k) { const bool bb = es[k] > v0; v0 = bb ? es[k] : v0; i0 = bb ? k : i0; }
  int i1 = 0; float v1 = -3.0e38f;
#pragma unroll
  for (int k = 0; k < 4; ++k) { const bool bb = (k != i0) && (es[k] > v1); v1 = bb ? es[k] : v1; i1 = bb ? k : i1; }
  const float ex = __expf(v1 - v0);
  const float tw0 = 1.0f / (1.0f + ex), tw1 = ex / (1.0f + ex);
  const bool commit = (g == gs) && (j < 8);
  const int e0 = gs * 4 + i0, e1 = gs * 4 + i1;
  int lp0 = 0, lp1 = 0;
  if (commit) { lp0 = atomicAdd(&scnt[e0], 1); lp1 = atomicAdd(&scnt[e1], 1); }
  __syncthreads();
  if (tid < 16) sbase[tid] = atomicAdd(p.counts + l * 16 + tid, scnt[tid]);
  __syncthreads();
  if (commit) {
    const int pos0 = sbase[e0] + lp0, pos1 = sbase[e1] + lp1;
    p.list[e0 * NTOK + pos0] = tok; p.wlist[e0 * NTOK + pos0] = gate * tw0;
    p.list[e1 * NTOK + pos1] = tok; p.wlist[e1 * NTOK + pos1] = gate * tw1;
    int4 ti; ti.x = e0; ti.y = pos0; ti.z = e1; ti.w = pos1;
    *(int4*)(p.tokinfo + (size_t)tok * 4) = ti;
  }
}

__device__ __forceinline__ int moe_total_mtiles(const int* cnts) {
  int tot = 0;
#pragma unroll
  for (int e = 0; e < 16; ++e) tot += (cnts[e] + 127) >> 7;
  return tot;
}
__device__ __forceinline__ void moe_find(const int* cnts, int mi, int& e_out, int& ml, int& off, int& cnt) {
  int rem = mi, o = 0; e_out = 0; ml = 0; off = 0; cnt = 1;
  bool found = false;
#pragma unroll
  for (int e = 0; e < 16; ++e) {
    const int c = cnts[e], mtl = (c + 127) >> 7;
    if (!found && rem < mtl) { found = true; e_out = e; ml = rem; off = o; cnt = c; }
    rem -= mtl; o += c;
  }
}

__device__ void p5_tile(const Params& p, int l, int t, int mtot, unsigned char* smem) {
  const int mi = (t >> 5) * 8 + (t & 7), nt = (t >> 3) & 3;
  if (mi >= mtot) return;
  int e, ml, off, cnt;
  moe_find(p.counts + l * 16, mi, e, ml, off, cnt);
  const int tid = otid(), lane = tid & 63, wid = tid >> 6, wr = wid >> 1, wc = wid & 1;
  const int srow = tid >> 3, sch = tid & 7, qi = lane & 15, g = lane >> 4;
  const bf16_t* pa[4];
#pragma unroll
  for (int i = 0; i < 4; ++i) {
    const int ridx = min(ml * 128 + srow + 32 * i, cnt - 1);
    const int tok = p.list[e * NTOK + ridx];
    pa[i] = p.xb + (size_t)tok * 1024 + sch * 8;
  }
  const bf16_t* B = p.Wgu + ((size_t)e * 512 + nt * 128 + srow) * 1024 + sch * 8;
  f32x4 acc[4][4];
  ZERO_ACC(acc);
  gemm_main(smem, pa[0], pa[1], pa[2], pa[3], B, B + 32 * 1024, B + 64 * 1024, B + 96 * 1024, 16, -1, false, acc, NoMid());
#pragma unroll
  for (int i = 0; i < 4; ++i) {
    const int rloc = ml * 128 + wr * 64 + i * 16 + qi;
    if (rloc < cnt) {
      const size_t slot = (size_t)off + rloc;
#pragma unroll
      for (int jp = 0; jp < 2; ++jp) {
        const f32x4 ga = acc[i][2 * jp], up = acc[i][2 * jp + 1];
        const int col = 64 * nt + 32 * wc + 16 * jp + 4 * g;
        store_bf16x4(p.act + slot * 256 + col, silu(ga[0]) * up[0], silu(ga[1]) * up[1], silu(ga[2]) * up[2], silu(ga[3]) * up[3]);
      }
    }
  }
}

__device__ void p6_tile(const Params& p, int l, int t, int mtot, unsigned char* smem) {
  const int mi = (t >> 6) * 8 + (t & 7), nt = (t >> 3) & 7;
  if (mi >= mtot) return;
  int e, ml, off, cnt;
  moe_find(p.counts + l * 16, mi, e, ml, off, cnt);
  const int tid = otid(), lane = tid & 63, wid = tid >> 6, wr = wid >> 1, wc = wid & 1;
  const int srow = tid >> 3, sch = tid & 7, qi = lane & 15, g = lane >> 4;
  const bf16_t* pa[4];
#pragma unroll
  for (int i = 0; i < 4; ++i) {
    const int ridx = min(ml * 128 + srow + 32 * i, cnt - 1);
    pa[i] = p.act + ((size_t)off + ridx) * 256 + sch * 8;
  }
  const bf16_t* B = p.Wdn + ((size_t)e * 1024 + nt * 128 + srow) * 256 + sch * 8;
  f32x4 acc[4][4];
  ZERO_ACC(acc);
  gemm_main(smem, pa[0], pa[1], pa[2], pa[3], B, B + 32 * 256, B + 64 * 256, B + 96 * 256, 4, -1, false, acc, NoMid());
#pragma unroll
  for (int i = 0; i < 4; ++i) {
    const int rloc = ml * 128 + wr * 64 + i * 16 + qi;
    if (rloc < cnt) {
      const float wgt = p.wlist[e * NTOK + rloc];
      const size_t slot = (size_t)off + rloc;
#pragma unroll
      for (int j = 0; j < 4; ++j) {
        const int n = nt * 128 + wc * 64 + j * 16 + 4 * g;
        store_bf16x4(p.y + slot * 1024 + n, acc[i][j][0] * wgt, acc[i][j][1] * wgt, acc[i][j][2] * wgt, acc[i][j][3] * wgt);
      }
    }
  }
}

template <int NT>
__device__ __forceinline__ void p7_tokens(const Params& p, int l, int tok0, int tstride) {
  const int lane = otid() & 63;
  int4 ti[NT];
#pragma unroll
  for (int u = 0; u < NT; ++u) ti[u] = *(const int4*)(p.tokinfo + (size_t)(tok0 + u * tstride) * 4);
  int off0[NT], off1[NT];
#pragma unroll
  for (int u = 0; u < NT; ++u) { off0[u] = 0; off1[u] = 0; }
#pragma unroll
  for (int e = 0; e < 16; ++e) {
    const int c = p.counts[l * 16 + e];
#pragma unroll
    for (int u = 0; u < NT; ++u) { if (e < ti[u].x) off0[u] += c; if (e < ti[u].z) off1[u] += c; }
  }
  float4 xr[NT][4]; u32x2 ya[NT][4], yb[NT][4];
#pragma unroll
  for (int u = 0; u < NT; ++u) {
    const int tok = tok0 + u * tstride;
    const size_t s0 = (size_t)off0[u] + ti[u].y, s1 = (size_t)off1[u] + ti[u].w;
#pragma unroll
    for (int q = 0; q < 4; ++q) {
      const int c = q * 256 + lane * 4;
      xr[u][q] = *(const float4*)(p.x1 + (size_t)tok * 1024 + c);
      ya[u][q] = *(const u32x2*)(p.y + s0 * 1024 + c);
      yb[u][q] = *(const u32x2*)(p.y + s1 * 1024 + c);
    }
  }
  float4 gg[4], bb[4];
#pragma unroll
  for (int q = 0; q < 4; ++q) {
    gg[q] = *(const float4*)(p.ln2_g + l * 1024 + q * 256 + lane * 4);
    bb[q] = *(const float4*)(p.ln2_b + l * 1024 + q * 256 + lane * 4);
  }
#pragma unroll
  for (int u = 0; u < NT; ++u) {
    const int tok = tok0 + u * tstride;
    float hv[16];
#pragma unroll
    for (int q = 0; q < 4; ++q) {
      hv[q * 4 + 0] = ALPHA * xr[u][q].x + (__uint_as_float(ya[u][q].x << 16) + __uint_as_float(yb[u][q].x << 16));
      hv[q * 4 + 1] = ALPHA * xr[u][q].y + (__uint_as_float(ya[u][q].x & 0xffff0000u) + __uint_as_float(yb[u][q].x & 0xffff0000u));
      hv[q * 4 + 2] = ALPHA * xr[u][q].z + (__uint_as_float(ya[u][q].y << 16) + __uint_as_float(yb[u][q].y << 16));
      hv[q * 4 + 3] = ALPHA * xr[u][q].w + (__uint_as_float(ya[u][q].y & 0xffff0000u) + __uint_as_float(yb[u][q].y & 0xffff0000u));
    }
    float s1s = 0.f;
#pragma unroll
    for (int c = 0; c < 16; ++c) s1s += hv[c];
    const float mu = wave_sum(s1s) * (1.0f / 1024.0f);
    float s2 = 0.f;
#pragma unroll
    for (int c = 0; c < 16; ++c) { const float d = hv[c] - mu; s2 += d * d; }
    const float rstd = rsqrtf(wave_sum(s2) * (1.0f / 1024.0f) + LN_EPS);
#pragma unroll
    for (int q = 0; q < 4; ++q) {
      const int c = q * 256 + lane * 4;
      float4 o;
      o.x = (hv[q * 4 + 0] - mu) * rstd * gg[q].x + bb[q].x; o.y = (hv[q * 4 + 1] - mu) * rstd * gg[q].y + bb[q].y;
      o.z = (hv[q * 4 + 2] - mu) * rstd * gg[q].z + bb[q].z; o.w = (hv[q * 4 + 3] - mu) * rstd * gg[q].w + bb[q].w;
      if (l == 3) *(float4*)(p.out + (size_t)tok * 1024 + c) = o;
      else store_bf16x4(p.xb + (size_t)tok * 1024 + c, o.x, o.y, o.z, o.w);
    }
  }
}

#define XB_TMO      128
#define XB_XCNT(j)  (256  + 64 * (j))
#define XB_XSUB(j)  (1280 + 64 * (j))
#define XB_XGEN(j)  (2304 + 64 * (j))
#define XB_TOP      3328
#define XB_TOPGEN   3392
#define XCD_BAR_WORDS 3456
#define XB_SPIN_CAP (1u << 22)
__device__ __forceinline__ unsigned xb_ld(unsigned* p) { return __hip_atomic_load(p, __ATOMIC_RELAXED, __HIP_MEMORY_SCOPE_AGENT); }
__device__ __forceinline__ unsigned xb_add(unsigned* p, unsigned v) { return __hip_atomic_fetch_add(p, v, __ATOMIC_RELAXED, __HIP_MEMORY_SCOPE_AGENT); }
__device__ __forceinline__ unsigned xb_xcc_id() { return (unsigned)__builtin_amdgcn_s_getreg((3 << 11) | 20) & 0xFu; }
#define XB_SPIN(cond, bar) do { unsigned _sp = 0; while (cond) { __builtin_amdgcn_s_sleep(1); \
    if ((++_sp & 255u) == 0u) { if (xb_ld(&(bar)[XB_TMO])) break; if (_sp > XB_SPIN_CAP) { atomicAdd(&(bar)[XB_TMO], 1u); break; } } } } while (0)
struct XcdBarrier { unsigned* bar; unsigned x; volatile unsigned* st; };
__device__ __forceinline__ XcdBarrier xcd_barrier_post(unsigned* bar, volatile unsigned* st) {
  XcdBarrier b; b.bar = bar; b.x = xb_xcc_id(); b.st = st;
  if (threadIdx.x == 0) (void)xb_add(&bar[XB_XCNT(b.x)], 1u);
  return b;
}
__device__ __forceinline__ void xcd_barrier_complete(unsigned* bar, unsigned x, unsigned& nloc, unsigned& nx) {
  const unsigned G = gridDim.x;
  unsigned sum, cnt, mine, sp = 0u;
  for (;;) {
    sum = 0u; cnt = 0u; mine = 0u;
#pragma unroll
    for (unsigned j = 0; j < 16; ++j) { const unsigned c = xb_ld(&bar[XB_XCNT(j)]); sum += c; cnt += (c > 0u) ? 1u : 0u; mine = (j == x) ? c : mine; }
    if (sum == G) break;
    __builtin_amdgcn_s_sleep(1);
    if ((++sp & 255u) == 0u) { if (xb_ld(&bar[XB_TMO])) break; if (sp > XB_SPIN_CAP) { atomicAdd(&bar[XB_TMO], 1u); break; } }
  }
  nloc = mine > 0u ? mine : 1u; nx = cnt > 0u ? cnt : 1u;
}
__device__ __forceinline__ void xcd_barrier(const XcdBarrier& b) {
  asm volatile("s_waitcnt vmcnt(0)" ::: "memory");
  __syncthreads();
  if (threadIdx.x == 0) {
    unsigned* bar = b.bar;
    __builtin_amdgcn_s_waitcnt(0);
    unsigned nloc = b.st[0], nx = b.st[1];
    if (nloc == 0u) { xcd_barrier_complete(bar, b.x, nloc, nx); b.st[0] = nloc; b.st[1] = nx; }
    const unsigned old = xb_add(&bar[XB_XSUB(b.x)], 1u);
    const unsigned gen = old / nloc;
    if (old + 1u == (gen + 1u) * nloc) {
      __builtin_amdgcn_fence(__ATOMIC_RELEASE, "agent");
      asm volatile("s_waitcnt vmcnt(0)" ::: "memory");
      const unsigned og = xb_add(&bar[XB_TOP], 1u);
      const unsigned tg = og / nx;
      if (og + 1u == (tg + 1u) * nx) xb_add(&bar[XB_TOPGEN], 1u);
      else XB_SPIN(xb_ld(&bar[XB_TOPGEN]) == tg, bar);
      __builtin_amdgcn_fence(__ATOMIC_ACQUIRE, "agent");
      xb_add(&bar[XB_XGEN(b.x)], 1u);
      asm volatile("s_waitcnt vmcnt(0)" ::: "memory");
    } else {
      XB_SPIN(xb_ld(&bar[XB_XGEN(b.x)]) == gen, bar);
      __builtin_amdgcn_fence(__ATOMIC_ACQUIRE, "agent");
      asm volatile("s_waitcnt vmcnt(0)" ::: "memory");
    }
  }
  __syncthreads();
}

__device__ __forceinline__ void run_phase(const Params& p, int ph, int l, int bid, int nblk, unsigned char* smem, float* sbias) {
  switch (ph) {
    case 0: {
      if (bid == 0 && threadIdx.x < 64) p.counts[threadIdx.x] = 0;
      conv_x(p, bid, nblk);
      for (int it = bid; it < NCONV_ITEMS; it += nblk) conv_item(p, 0, it, smem);
    } break;
    case 1: for (int t = bid; t < 2560; t += nblk) p1_tile(p, l, t, smem); break;
    case 2:
      for (int it = bid; it < 3072; it += nblk) {
        if (it < 2048) attn_item(p, l, it, smem); else sgu_item(p, l, it - 2048, smem);
      }
      break;
    case 3: for (int t = bid; t < 1024; t += nblk) p3_tile(p, l, t, smem); break;
    case 4: for (int it = bid; it < NTOK / 32; it += nblk) p4_batch(p, l, it, smem); break;
    case 5: { const int mtot = moe_total_mtiles(p.counts + l * 16), nt = ((mtot + 7) >> 3) * 32; for (int t = bid; t < nt; t += nblk) p5_tile(p, l, t, mtot, smem); } break;
    case 6: { const int mtot = moe_total_mtiles(p.counts + l * 16), nt = ((mtot + 7) >> 3) * 64; for (int t = bid; t < nt; t += nblk) p6_tile(p, l, t, mtot, smem); } break;
    case 7: {
      { const int nw = nblk * 4; int tok = bid * 4 + (threadIdx.x >> 6);
        for (; tok + 3 * nw < NTOK; tok += 4 * nw) p7_tokens<4>(p, l, tok, nw);
        for (; tok < NTOK; tok += nw) p7_tokens<1>(p, l, tok, nw); }
      if (l < 3) for (int it = bid; it < NCONV_ITEMS; it += nblk) conv_item(p, l + 1, it, smem);
    } break;
  }
}

template <int PH>
__global__ void __launch_bounds__(256, 2) phase_kernel(Params p, int l) {
  __shared__ __attribute__((aligned(16))) unsigned char smem[SMEM_BYTES];
  run_phase(p, PH, l, blockIdx.x, gridDim.x, smem, (float*)smem);
}

#if MEGA
__global__ void __launch_bounds__(256, 2) mega_kernel(Params p) {
  __shared__ __attribute__((aligned(16))) unsigned char smem[SMEM_BYTES];
  __shared__ uint4 xb_words;
  float* sbias = (float*)smem;
  cg::grid_group grid = cg::this_grid();
  const int bid = blockIdx.x, nblk = gridDim.x;
  if (threadIdx.x == 0) xb_words = make_uint4(0u, 0u, 0u, 0u);
  __syncthreads();
  XcdBarrier xb = xcd_barrier_post(p.bar, (volatile unsigned*)&xb_words);
  run_phase(p, 0, 0, bid, nblk, smem, sbias);
  if (p.never) grid.sync();
  xcd_barrier(xb);
#pragma unroll 1
  for (int l = 0; l < 4; ++l) {
#pragma unroll 1
    for (int ph = 1; ph <= 7; ++ph) {
      run_phase(p, ph, l, bid, nblk, smem, sbias);
#if DUP_PH
      if (ph == DUP_PH) { xcd_barrier(xb); run_phase(p, ph, l, bid, nblk, smem, sbias); }
#endif
      if (!(l == 3 && ph == 7)) xcd_barrier(xb);
    }
  }
}
#endif

extern "C" void kernel_launch(void* const* d_in, const int* in_sizes, int n_in, void* d_out, int out_size, void* d_ws,
                              size_t ws_size, hipStream_t stream) {
  Params p{};
  p.x = (const float*)d_in[0]; p.w_in = (const float*)d_in[1]; p.w_out = (const float*)d_in[2]; p.rel_bias = (const float*)d_in[3];
  p.sgu_ln_g = (const float*)d_in[4]; p.sgu_ln_b = (const float*)d_in[5]; p.sgu_w = (const float*)d_in[6]; p.sgu_b = (const float*)d_in[7];
  p.mix_g = (const float*)d_in[8]; p.ln1_g = (const float*)d_in[9]; p.ln1_b = (const float*)d_in[10];
  p.rg_w = (const float*)d_in[11]; p.rg_b = (const float*)d_in[12]; p.re_w = (const float*)d_in[13]; p.re_b = (const float*)d_in[14];
  p.w_gate = (const float*)d_in[15]; p.w_up = (const float*)d_in[16]; p.w_down = (const float*)d_in[17];
  p.ln2_g = (const float*)d_in[18]; p.ln2_b = (const float*)d_in[19];
  p.out = (float*)d_out;
  unsigned char* w = (unsigned char*)d_ws;
  size_t o = 0;
  auto take = [&](size_t bytes) { unsigned char* r = w + o; o += (bytes + 255) & ~(size_t)255; return r; };
  p.Wt_in = (bf16_t*)take((size_t)2560 * 1024 * 2);
  p.Wt_out = (bf16_t*)take((size_t)1024 * 1024 * 2);
  p.Wgu = (bf16_t*)take((size_t)16 * 512 * 1024 * 2);
  p.Wdn = (bf16_t*)take((size_t)16 * 1024 * 256 * 2);
  p.Wsgu = (bf16_t*)take((size_t)8 * 128 * 128 * 2);
  p.xb = (bf16_t*)take((size_t)NTOK * 1024 * 2);
  p.x1 = (float*)take((size_t)NTOK * 1024 * 4);
  unsigned char* r1 = take((size_t)NTOK * 2560 * 2);
  p.qk = (bf16_t*)r1;
  p.vT = (bf16_t*)(r1 + (size_t)NTOK * 1024 * 2);
  p.ub = (bf16_t*)(r1 + (size_t)NTOK * 1536 * 2);
  p.vnT = (bf16_t*)(r1 + (size_t)NTOK * 2048 * 2);
  p.y = (bf16_t*)r1;
  p.hb = (bf16_t*)r1;
  unsigned char* r2 = take((size_t)NTOK * 1024 * 2);
  p.mixed = (bf16_t*)r2;
  p.act = (bf16_t*)r2;
  p.ssq = (float*)take((size_t)NTOK * 16 * 4);
  p.wlist = (float*)take((size_t)16 * NTOK * 4);
  p.list = (int*)take((size_t)16 * NTOK * 4);
  p.tokinfo = (int*)take((size_t)NTOK * 4 * 4);
  p.counts = (int*)take(256);
  p.Wr_e = (float*)take(16384 * 4);
  p.Wr_g = (float*)take(4096 * 4);
  p.bar = (unsigned*)take(XCD_BAR_WORDS * 4);
#if MEGA
  static int grid_blocks = 0;
  if (!grid_blocks) {
    int dev = 0, cus = 0, per_cu = 0;
    hipGetDevice(&dev);
    hipDeviceGetAttribute(&cus, hipDeviceAttributeMultiprocessorCount, dev);
    hipOccupancyMaxActiveBlocksPerMultiprocessor(&per_cu, mega_kernel, 256, 0);
    if (per_cu > 2) per_cu = 2;
    grid_blocks = cus * per_cu;
  }
  (void)hipMemsetAsync(p.bar, 0, XCD_BAR_WORDS * 4, stream);
  void* args[] = {&p};
  hipError_t e = hipLaunchCooperativeKernel((void*)mega_kernel, dim3(grid_blocks), dim3(256), args, 0, stream);
  if (e != hipSuccess) fprintf(stderr, "cooperative launch failed: %s (grid %d)\n", hipGetErrorString(e), grid_blocks);
#else
  const int G = 512;
  phase_kernel<0><<<G, 256, 0, stream>>>(p, 0);
  for (int l = 0; l < 4; ++l) {
    phase_kernel<1><<<G, 256, 0, stream>>>(p, l);
    phase_kernel<2><<<G, 256, 0, stream>>>(p, l);
    phase_kernel<3><<<G, 256, 0, stream>>>(p, l);
    phase_kernel<4><<<G, 256, 0, stream>>>(p, l);
    phase_kernel<5><<<G, 256, 0, stream>>>(p, l);
    phase_kernel<6><<<G, 256, 0, stream>>>(p, l);
    phase_kernel<7><<<G, 256, 0, stream>>>(p, l);
  }
#endif
}
```

```cpp
#include <hip/hip_runtime.h>
#include <hip/hip_cooperative_groups.h>
#include <stdint.h>
#include <cstdio>
namespace cg = cooperative_groups;

#ifndef MEGA
#define MEGA 1
#endif
#define DUP_PH 0

typedef unsigned short bf16_t;
typedef short bf16x8 __attribute__((ext_vector_type(8)));
typedef float f32x4 __attribute__((ext_vector_type(4)));
typedef unsigned u32x4 __attribute__((ext_vector_type(4)));
typedef unsigned u32x2 __attribute__((ext_vector_type(2)));

#define NTOK 16384
#define LN_EPS 1e-5f
#define ALPHA 1.681792830507429f
#define NCONV_ITEMS 3985
#define SMEM_BYTES 69632

struct Params {
  const float *x, *w_in, *w_out, *rel_bias, *sgu_ln_g, *sgu_ln_b, *sgu_w, *sgu_b, *mix_g, *ln1_g, *ln1_b,
      *rg_w, *rg_b, *re_w, *re_b, *w_gate, *w_up, *w_down, *ln2_g, *ln2_b;
  float* out;
  bf16_t *Wt_in, *Wt_out, *Wgu, *Wdn, *Wsgu, *xb, *qk, *vT, *ub, *vnT, *mixed, *act, *y, *hb;
  float *x1, *ssq, *wlist;
  bf16_t *Wr_eh, *Wr_el, *Wr_gh, *Wr_gl;
  int *counts, *list, *tokinfo;
  unsigned* bar;
  int never;
  int pad_;
};

__device__ __forceinline__ unsigned cvt_pk_bf16(float lo, float hi) {
  unsigned r; asm("v_cvt_pk_bf16_f32 %0, %1, %2" : "=v"(r) : "v"(lo), "v"(hi)); return r;
}
__device__ __forceinline__ void store_bf16x4(bf16_t* p, float a, float b, float c, float d) {
  u32x2 v; v.x = cvt_pk_bf16(a, b); v.y = cvt_pk_bf16(c, d); *(u32x2*)p = v;
}
__device__ __forceinline__ float gelu_tanh(float x) {
  float z = 0.7978845608028654f * (x + 0.044715f * x * x * x);
  return x / (1.0f + __expf(-2.0f * z));
}
__device__ __forceinline__ int otid() { int t = threadIdx.x; asm volatile("" : "+v"(t)); return t; }
__device__ __forceinline__ float silu(float x) { return x / (1.0f + __expf(-x)); }
template <int CTRL>
__device__ __forceinline__ float dpp_mov(float v) {
  return __builtin_bit_cast(float, __builtin_amdgcn_update_dpp(0, __builtin_bit_cast(int, v), CTRL, 0xf, 0xf, true));
}
__device__ __forceinline__ float row16_sum(float v) {
  v += dpp_mov<0xB1>(v); v += dpp_mov<0x4E>(v); v += dpp_mov<0x141>(v); v += dpp_mov<0x140>(v); return v;
}
__device__ __forceinline__ float wave_sum(float v) {
  v = row16_sum(v); v += __shfl_xor(v, 16); v += __shfl_xor(v, 32); return v;
}

struct NoMid { __device__ __forceinline__ void operator()(f32x4 (&)[4][4]) const {} };
struct MidScale {
  float s[4];
  __device__ __forceinline__ void operator()(f32x4 (&acc)[4][4]) const {
#pragma unroll
    for (int i = 0; i < 4; ++i)
#pragma unroll
      for (int j = 0; j < 4; ++j) acc[i][j] *= s[i];
  }
};

#define GLDS16(gptr, lptr) __builtin_amdgcn_global_load_lds((const unsigned*)(gptr), (__attribute__((address_space(3))) unsigned*)(lptr), 16, 0, 0)

template <class Mid>
__device__ __forceinline__ void gemm_main(unsigned char* smem, const bf16_t* pa0, const bf16_t* pa1, const bf16_t* pa2,
                                          const bf16_t* pa3, const bf16_t* pb0, const bf16_t* pb1, const bf16_t* pb2,
                                          const bf16_t* pb3, int nk, int kmid, bool swapped, f32x4 (&acc)[4][4],
                                          const Mid& mid) {
  const int tid = otid(), lane = tid & 63, wid = tid >> 6, wr = wid >> 1, wc = wid & 1;
  const int srow = tid >> 3;
  const int lch = ((tid & 7) ^ ((srow >> 1) & 7)) * 8 - (tid & 7) * 8;
  pa0 += lch; pa1 += lch; pa2 += lch; pa3 += lch; pb0 += lch; pb1 += lch; pb2 += lch; pb3 += lch;
  const int soff = __builtin_amdgcn_readfirstlane(wid) * 1024;
  const int qi = lane & 15, g = lane >> 4, s = qi >> 1;
  const int aside = swapped ? 16384 : 0, bside = swapped ? 0 : 16384;
  const int offA0 = aside + (wr * 64 + qi) * 128 + (((0 + g) ^ s) << 4);
  const int offA1 = aside + (wr * 64 + qi) * 128 + (((4 + g) ^ s) << 4);
  const int offB0 = bside + (wc * 64 + qi) * 128 + (((0 + g) ^ s) << 4);
  const int offB1 = bside + (wc * 64 + qi) * 128 + (((4 + g) ^ s) << 4);
  {
    unsigned char* d = smem + soff;
    GLDS16(pa0, d); GLDS16(pa1, d + 4096); GLDS16(pa2, d + 8192); GLDS16(pa3, d + 12288);
    GLDS16(pb0, d + 16384); GLDS16(pb1, d + 20480); GLDS16(pb2, d + 24576); GLDS16(pb3, d + 28672);
  }
  asm volatile("s_waitcnt vmcnt(0)" ::: "memory");
  __syncthreads();
  for (int kt = 0; kt < nk; ++kt) {
    unsigned char* buf = smem + ((kt & 1) << 15);
    if (kt + 1 < nk) {
      const int ko = (kt + 1) * 64;
      unsigned char* d = smem + (((kt + 1) & 1) << 15) + soff;
      GLDS16(pa0 + ko, d); GLDS16(pa1 + ko, d + 4096); GLDS16(pa2 + ko, d + 8192); GLDS16(pa3 + ko, d + 12288);
      GLDS16(pb0 + ko, d + 16384); GLDS16(pb1 + ko, d + 20480); GLDS16(pb2 + ko, d + 24576); GLDS16(pb3 + ko, d + 28672);
    }
    if (kt == kmid) mid(acc);
    {
      bf16x8 af0[4], bf0[4], af1[4], bf1[4];
#pragma unroll
      for (int i = 0; i < 4; ++i) af0[i] = *(const bf16x8*)(buf + offA0 + i * 2048);
#pragma unroll
      for (int j = 0; j < 4; ++j) bf0[j] = *(const bf16x8*)(buf + offB0 + j * 2048);
#pragma unroll
      for (int i = 0; i < 4; ++i) af1[i] = *(const bf16x8*)(buf + offA1 + i * 2048);
#pragma unroll
      for (int j = 0; j < 4; ++j) bf1[j] = *(const bf16x8*)(buf + offB1 + j * 2048);
      asm volatile("s_waitcnt lgkmcnt(8)" ::: "memory");
      __builtin_amdgcn_s_setprio(1);
#pragma unroll
      for (int i = 0; i < 4; ++i)
#pragma unroll
        for (int j = 0; j < 4; ++j) acc[i][j] = __builtin_amdgcn_mfma_f32_16x16x32_bf16(bf0[j], af0[i], acc[i][j], 0, 0, 0);
      asm volatile("s_waitcnt lgkmcnt(0)" ::: "memory");
#pragma unroll
      for (int i = 0; i < 4; ++i)
#pragma unroll
        for (int j = 0; j < 4; ++j) acc[i][j] = __builtin_amdgcn_mfma_f32_16x16x32_bf16(bf1[j], af1[i], acc[i][j], 0, 0, 0);
      __builtin_amdgcn_s_setprio(0);
    }
    asm volatile("s_waitcnt vmcnt(0)" ::: "memory");
    __syncthreads();
  }
}

#define ZERO_ACC(acc)                                   \
  _Pragma("unroll") for (int i_ = 0; i_ < 4; ++i_)      \
  _Pragma("unroll") for (int j_ = 0; j_ < 4; ++j_) acc[i_][j_] = (f32x4){0.f, 0.f, 0.f, 0.f};

__device__ void conv_x(const Params& p, int bid, int nblk) {
  const size_t n8 = (size_t)NTOK * 1024 / 8;
  for (size_t i = (size_t)bid * 256 + threadIdx.x; i < n8; i += (size_t)nblk * 256) {
    const float4 a = *(const float4*)(p.x + i * 8), b = *(const float4*)(p.x + i * 8 + 4);
    u32x4 v; v.x = cvt_pk_bf16(a.x, a.y); v.y = cvt_pk_bf16(a.z, a.w); v.z = cvt_pk_bf16(b.x, b.y); v.w = cvt_pk_bf16(b.z, b.w);
    *(u32x4*)(p.xb + i * 8) = v;
  }
}

__device__ void tconv_tile(float* tile, const float* src, int src_ld, const float* kscale, bf16_t* dst, int dst_ld, int rstep) {
  const int t = otid();
#pragma unroll
  for (int i = 0; i < 4; ++i) {
    const int k = (t >> 4) + 16 * i, n4 = (t & 15) * 4;
    float4 v = *(const float4*)(src + (size_t)k * src_ld + n4);
    if (kscale) { const float sc = kscale[k]; v.x *= sc; v.y *= sc; v.z *= sc; v.w *= sc; }
    float* d = tile + k * 65 + n4;
    d[0] = v.x; d[1] = v.y; d[2] = v.z; d[3] = v.w;
  }
  __syncthreads();
  {
    const int n = t >> 2, kc = (t & 3) * 16;
    float f[16];
#pragma unroll
    for (int q = 0; q < 16; ++q) f[q] = tile[(kc + q) * 65 + n];
    u32x4 v0, v1;
    v0.x = cvt_pk_bf16(f[0], f[1]); v0.y = cvt_pk_bf16(f[2], f[3]); v0.z = cvt_pk_bf16(f[4], f[5]); v0.w = cvt_pk_bf16(f[6], f[7]);
    v1.x = cvt_pk_bf16(f[8], f[9]); v1.y = cvt_pk_bf16(f[10], f[11]); v1.z = cvt_pk_bf16(f[12], f[13]); v1.w = cvt_pk_bf16(f[14], f[15]);
    bf16_t* o = dst + (size_t)((n >> 4) * rstep + (n & 15)) * dst_ld + kc;
    *(u32x4*)o = v0; *(u32x4*)(o + 8) = v1;
  }
  __syncthreads();
}

__device__ void conv_item(const Params& p, int l, int it, unsigned char* smem) {
  float* tile = (float*)smem;
  if (it < 640) {
    const int kt = it / 40, ntile = it % 40;
    tconv_tile(tile, p.w_in + (size_t)l * 1024 * 2560 + (size_t)kt * 64 * 2560 + ntile * 64, 2560, nullptr,
               p.Wt_in + (size_t)ntile * 64 * 1024 + kt * 64, 1024, 16);
  } else if (it < 896) {
    const int r = it - 640, kt = r / 16, ntile = r % 16;
    tconv_tile(tile, p.w_out + (size_t)l * 1024 * 1024 + (size_t)kt * 64 * 1024 + ntile * 64, 1024, p.mix_g + l * 1024 + kt * 64,
               p.Wt_out + (size_t)ntile * 64 * 1024 + kt * 64, 1024, 16);
  } else if (it < 2944) {
    const int r0 = it - 896, e = r0 >> 7, r = r0 & 127, which = r >> 6, r2 = r & 63, kt = r2 >> 2, ntile = r2 & 3;
    const float* src = (which ? p.w_up : p.w_gate) + (size_t)(l * 16 + e) * 1024 * 256 + (size_t)kt * 64 * 256 + ntile * 64;
    tconv_tile(tile, src, 256, nullptr, p.Wgu + (size_t)e * 512 * 1024 + (size_t)(ntile * 128 + which * 16) * 1024 + kt * 64, 1024, 32);
  } else if (it < 3968) {
    const int r0 = it - 2944, e = r0 >> 6, r = r0 & 63, kt = r >> 4, ntile = r & 15;
    tconv_tile(tile, p.w_down + (size_t)(l * 16 + e) * 256 * 1024 + (size_t)kt * 64 * 1024 + ntile * 64, 1024, nullptr,
               p.Wdn + (size_t)e * 1024 * 256 + (size_t)ntile * 64 * 256 + kt * 64, 256, 16);
  } else if (it == 3984) {
    for (int i = threadIdx.x; i < 16384; i += 256) {
      const int jj = i & 7, j = (i >> 3) & 15, g = (i >> 7) & 3, kb = i >> 9;
      const int k = 32 * kb + 8 * g + jj;
      const float we = p.re_w[(size_t)(l * 1024 + k) * 16 + j];
      const float wg = (j < 4) ? p.rg_w[(size_t)(l * 1024 + k) * 4 + j] : 0.0f;
      const unsigned eh = cvt_pk_bf16(we, 0.f) & 0xffffu, gh = cvt_pk_bf16(wg, 0.f) & 0xffffu;
      const unsigned el = cvt_pk_bf16(we - __uint_as_float(eh << 16), 0.f) & 0xffffu;
      const unsigned gl = cvt_pk_bf16(wg - __uint_as_float(gh << 16), 0.f) & 0xffffu;
      p.Wr_eh[i] = (bf16_t)eh; p.Wr_el[i] = (bf16_t)el; p.Wr_gh[i] = (bf16_t)gh; p.Wr_gl[i] = (bf16_t)gl;
    }
  } else {
    const int j = it - 3968;
    const float* src = p.sgu_w + (size_t)l * 131072 + (size_t)j * 8192 + threadIdx.x * 32;
    bf16_t* dst = p.Wsgu + (size_t)j * 8192 + threadIdx.x * 32;
#pragma unroll
    for (int q = 0; q < 4; ++q) {
      const float4 a = *(const float4*)(src + q * 8), b = *(const float4*)(src + q * 8 + 4);
      u32x4 v; v.x = cvt_pk_bf16(a.x, a.y); v.y = cvt_pk_bf16(a.z, a.w); v.z = cvt_pk_bf16(b.x, b.y); v.w = cvt_pk_bf16(b.z, b.w);
      *(u32x4*)(dst + q * 8) = v;
    }
  }
}

__device__ void p1_tile(const Params& p, int l, int t, unsigned char* smem) {
  const int x_ = t & 7, j_ = t >> 3, rd_ = j_ >> 6, lb_ = j_ & 63;
  const int mt = (rd_ < 4) ? (x_ * 16 + (rd_ & 1) * 8 + (lb_ & 7)) : (x_ * 16 + (lb_ & 15));
  const int nt = (rd_ < 4) ? ((rd_ >> 1) * 8 + (lb_ >> 3)) : (16 + (lb_ >> 4));
  const int type = nt >> 2;
  const bool swapped = (type == 2) || (type == 4);
  const int tid = otid(), lane = tid & 63, wid = tid >> 6, wr = wid >> 1, wc = wid & 1;
  const int srow = tid >> 3, sch = tid & 7, qi = lane & 15, g = lane >> 4;
  const bf16_t* A = p.xb + (size_t)(mt * 128 + srow) * 1024 + sch * 8;
  const bf16_t* B = p.Wt_in + (size_t)(nt * 128 + srow) * 1024 + sch * 8;
  f32x4 acc[4][4];
  ZERO_ACC(acc);
  gemm_main(smem, A, A + 32 * 1024, A + 64 * 1024, A + 96 * 1024, B, B + 32 * 1024, B + 64 * 1024, B + 96 * 1024, 16, -1, swapped, acc, NoMid());
  if (!swapped) {
#pragma unroll
    for (int i = 0; i < 4; ++i) {
      const int m = mt * 128 + wr * 64 + i * 16 + qi;
#pragma unroll
      for (int j = 0; j < 4; ++j) {
        const int n = nt * 128 + wc * 64 + j * 16 + 4 * g;
        f32x4 v = acc[i][j];
        if (type == 0) v *= 0.125f;
        if (type == 3) { v[0] = gelu_tanh(v[0]); v[1] = gelu_tanh(v[1]); v[2] = gelu_tanh(v[2]); v[3] = gelu_tanh(v[3]); }
        bf16_t* dst = (type == 3) ? (p.ub + (size_t)m * 512 + (n - 1536)) : (p.qk + (size_t)m * 1024 + n);
        store_bf16x4(dst, v[0], v[1], v[2], v[3]);
      }
    }
  } else {
    const int bidx = (mt * 128) >> 12, tokbase = (mt * 128) & 4095;
    bf16_t* dstb = (type == 2) ? p.vT : p.vnT;
    const int fbase = (type == 2) ? 1024 : 2048;
    if (type == 4) {
#pragma unroll
      for (int i = 0; i < 4; ++i)
#pragma unroll
        for (int j = 0; j < 4; ++j)
#pragma unroll
          for (int r = 0; r < 4; ++r) acc[i][j][r] = gelu_tanh(acc[i][j][r]);
      float gam[4], bet[4];
#pragma unroll
      for (int i = 0; i < 4; ++i) {
        const int f = nt * 128 + wr * 64 + i * 16 + qi - 2048;
        gam[i] = p.sgu_ln_g[l * 512 + f]; bet[i] = p.sgu_ln_b[l * 512 + f];
      }
#pragma unroll
      for (int j = 0; j < 4; ++j)
#pragma unroll
        for (int r = 0; r < 4; ++r) {
          float s1 = acc[0][j][r] + acc[1][j][r] + acc[2][j][r] + acc[3][j][r];
          s1 = row16_sum(s1);
          const float mu = s1 * (1.0f / 64.0f);
          float s2 = 0.f;
#pragma unroll
          for (int i = 0; i < 4; ++i) { const float d = acc[i][j][r] - mu; s2 += d * d; }
          s2 = row16_sum(s2);
          const float rstd = rsqrtf(s2 * (1.0f / 64.0f) + LN_EPS);
#pragma unroll
          for (int i = 0; i < 4; ++i) acc[i][j][r] = (acc[i][j][r] - mu) * rstd * gam[i] + bet[i];
        }
    }
#pragma unroll
    for (int i = 0; i < 4; ++i) {
      const int f = nt * 128 + wr * 64 + i * 16 + qi - fbase;
#pragma unroll
      for (int j = 0; j < 4; ++j) {
        const int tok = tokbase + wc * 64 + j * 16 + 4 * g;
        store_bf16x4(dstb + ((size_t)(bidx * 512 + f)) * 4096 + tok, acc[i][j][0], acc[i][j][1], acc[i][j][2], acc[i][j][3]);
      }
    }
  }
}

__device__ void attn_item(const Params& p, int l, int it, unsigned char* smem) {
  const int h = it & 7, br = it >> 3, r = br & 63, b = br >> 6;
  const int rs = min(max(r - 4, 0), 56);
  const int tid = otid(), lane = tid & 63, w = tid >> 6, qi = lane & 15, g = lane >> 4;
  unsigned char* Kb = smem;
  unsigned char* Vb = smem + 32768;
  float* sbias = (float*)(smem + 32768 + 33792);
  const int c0 = (w == 0) ? 0 : (w == 1) ? 8 : (w == 2) ? 24 : 32;
  const int cq = 16 * w + qi, cs = min(max(cq - 8, 0), 48);
  const size_t tokq = (size_t)b * 4096 + r * 64 + cq;
  const int krow = tid >> 3, kch = tid & 7;
  const int ksoff = krow * 128 + ((kch ^ ((krow >> 1) & 7)) << 4);
  const bf16_t* kg = p.qk + ((size_t)b * 4096 + rs * 64 + krow) * 1024 + 512 + h * 64 + kch * 8;
  const int vd = tid >> 5, vc = tid & 31;
  const int vsoff = vd * 528 + vc * 16;
  const bf16_t* vg = p.vT + ((size_t)(b * 512 + h * 64 + vd)) * 4096 + rs * 64 + vc * 8;
  u32x4 st[8];
  __syncthreads();
  for (int i = tid; i < 465; i += 256) sbias[i] = p.rel_bias[(size_t)(l * 8 + h) * 465 + i];
#pragma unroll
  for (int i = 0; i < 8; ++i) st[i] = *(const u32x4*)(kg + (size_t)(32 * i) * 1024);
#pragma unroll
  for (int i = 0; i < 8; ++i) *(u32x4*)(Kb + ksoff + i * 4096) = st[i];
  bf16x8 qf0 = *(const bf16x8*)(p.qk + tokq * 1024 + h * 64 + g * 8);
  bf16x8 qf1 = *(const bf16x8*)(p.qk + tokq * 1024 + h * 64 + 32 + g * 8);
  __syncthreads();
#pragma unroll
  for (int i = 0; i < 8; ++i) st[i] = *(const u32x4*)(kg + (size_t)(256 + 32 * i) * 1024);
  f32x4 s[8][2];
#pragma unroll
  for (int jh = 0; jh < 2; ++jh) {
#pragma unroll
    for (int jj = 0; jj < 4; ++jj)
#pragma unroll
      for (int ch = 0; ch < 2; ++ch) {
        const int kl = jj * 64 + c0 + 16 * ch + qi;
        const int sw = (kl >> 1) & 7;
        const bf16x8 kf0 = *(const bf16x8*)(Kb + kl * 128 + (((0 + g) ^ sw) << 4));
        const bf16x8 kf1 = *(const bf16x8*)(Kb + kl * 128 + (((4 + g) ^ sw) << 4));
        f32x4 a = {0.f, 0.f, 0.f, 0.f};
        a = __builtin_amdgcn_mfma_f32_16x16x32_bf16(kf0, qf0, a, 0, 0, 0);
        a = __builtin_amdgcn_mfma_f32_16x16x32_bf16(kf1, qf1, a, 0, 0, 0);
        s[jh * 4 + jj][ch] = a;
      }
    if (jh == 0) {
      __syncthreads();
#pragma unroll
      for (int i = 0; i < 8; ++i) *(u32x4*)(Kb + ksoff + i * 4096) = st[i];
#pragma unroll
      for (int i = 0; i < 8; ++i) st[i] = *(const u32x4*)(vg + (size_t)(8 * i) * 4096);
      __syncthreads();
    }
  }
#pragma unroll
  for (int i = 0; i < 8; ++i) *(u32x4*)(Vb + vsoff + i * 8 * 528) = st[i];
#pragma unroll
  for (int i = 0; i < 8; ++i) st[i] = *(const u32x4*)(vg + (size_t)(8 * i) * 4096 + 256);
  float mx = -1e30f;
#pragma unroll
  for (int j = 0; j < 8; ++j)
#pragma unroll
    for (int ch = 0; ch < 2; ++ch)
#pragma unroll
      for (int rg = 0; rg < 4; ++rg) {
        const int kc = c0 + 16 * ch + 4 * g + rg;
        const bool valid = (kc >= cs) && (kc < cs + 16);
        const int bidx = valid ? ((rs + j - r + 7) * 31 + (kc - cq) + 15) : 0;
        const float v = valid ? (s[j][ch][rg] + sbias[bidx]) : -1e30f;
        s[j][ch][rg] = v;
        mx = fmaxf(mx, v);
      }
  mx = fmaxf(mx, __shfl_xor(mx, 16)); mx = fmaxf(mx, __shfl_xor(mx, 32));
  float sum = 0.f;
#pragma unroll
  for (int j = 0; j < 8; ++j)
#pragma unroll
    for (int ch = 0; ch < 2; ++ch)
#pragma unroll
      for (int rg = 0; rg < 4; ++rg) { const float e = __expf(s[j][ch][rg] - mx); s[j][ch][rg] = e; sum += e; }
  sum += __shfl_xor(sum, 16); sum += __shfl_xor(sum, 32);
  const float inv = 1.0f / sum;
  bf16x8 pf[8];
#pragma unroll
  for (int j = 0; j < 8; ++j) {
    u32x4 pw;
    pw.x = cvt_pk_bf16(s[j][0][0], s[j][0][1]); pw.y = cvt_pk_bf16(s[j][0][2], s[j][0][3]);
    pw.z = cvt_pk_bf16(s[j][1][0], s[j][1][1]); pw.w = cvt_pk_bf16(s[j][1][2], s[j][1][3]);
    pf[j] = __builtin_bit_cast(bf16x8, pw);
  }
  f32x4 o[4];
#pragma unroll
  for (int dt = 0; dt < 4; ++dt) o[dt] = (f32x4){0.f, 0.f, 0.f, 0.f};
  __syncthreads();
#pragma unroll
  for (int jh = 0; jh < 2; ++jh) {
#pragma unroll
    for (int jj = 0; jj < 4; ++jj)
#pragma unroll
      for (int dt = 0; dt < 4; ++dt) {
        const unsigned char* vp = Vb + (dt * 16 + qi) * 528 + (jj * 64 + c0 + 4 * g) * 2;
        const u32x2 lo = *(const u32x2*)vp, hi = *(const u32x2*)(vp + 32);
        u32x4 vw; vw.x = lo.x; vw.y = lo.y; vw.z = hi.x; vw.w = hi.y;
        o[dt] = __builtin_amdgcn_mfma_f32_16x16x32_bf16(__builtin_bit_cast(bf16x8, vw), pf[jh * 4 + jj], o[dt], 0, 0, 0);
      }
    if (jh == 0) {
      __syncthreads();
#pragma unroll
      for (int i = 0; i < 8; ++i) *(u32x4*)(Vb + vsoff + i * 8 * 528) = st[i];
      __syncthreads();
    }
  }
  float sq = 0.f;
#pragma unroll
  for (int dt = 0; dt < 4; ++dt) {
    o[dt] *= inv;
    sq += o[dt][0] * o[dt][0] + o[dt][1] * o[dt][1] + o[dt][2] * o[dt][2] + o[dt][3] * o[dt][3];
    store_bf16x4(p.mixed + tokq * 1024 + h * 64 + dt * 16 + 4 * g, o[dt][0], o[dt][1], o[dt][2], o[dt][3]);
  }
  sq += __shfl_xor(sq, 16); sq += __shfl_xor(sq, 32);
  if (g == 0) p.ssq[tokq * 16 + h] = sq;
}

__device__ void sgu_item(const Params& p, int l, int it, unsigned char* smem) {
  const int grp = it & 7, bc = it >> 3, chunk = bc & 31, b = bc >> 5;
  const int tid = otid(), lane = tid & 63, w = tid >> 6, qi = lane & 15, g = lane >> 4;
  const int p0 = 32 * w;
  const int wbase = __builtin_amdgcn_readfirstlane(w) * 1024;
  const int lc = ((tid & 15) ^ ((tid >> 4) & 15)) << 3;
  const bf16_t* wsrc = p.Wsgu + ((size_t)(grp * 128 + (tid >> 4))) * 128 + lc;
  const bf16_t* vsrc = p.vnT + ((size_t)(b * 512 + grp * 64 + (tid >> 4))) * 4096 + chunk * 128 + lc;
  __syncthreads();
#pragma unroll
  for (int i = 0; i < 8; ++i) GLDS16(wsrc + (size_t)(16 * i) * 128, smem + i * 4096 + wbase);
#pragma unroll
  for (int i = 0; i < 4; ++i) GLDS16(vsrc + (size_t)(16 * i) * 4096, smem + 32768 + i * 4096 + wbase);
  asm volatile("s_waitcnt vmcnt(0)" ::: "memory");
  __syncthreads();
  f32x4 acc[2][4];
#pragma unroll
  for (int mt = 0; mt < 2; ++mt)
#pragma unroll
    for (int nt = 0; nt < 4; ++nt) acc[mt][nt] = (f32x4){0.f, 0.f, 0.f, 0.f};
#pragma unroll
  for (int ks = 0; ks < 4; ++ks) {
    const int co = ((ks * 4 + g) ^ qi) << 4;
    bf16x8 wf[2], vf[4];
#pragma unroll
    for (int mt = 0; mt < 2; ++mt) wf[mt] = *(const bf16x8*)(smem + (p0 + 16 * mt + qi) * 256 + co);
#pragma unroll
    for (int nt = 0; nt < 4; ++nt) vf[nt] = *(const bf16x8*)(smem + 32768 + (16 * nt + qi) * 256 + co);
#pragma unroll
    for (int mt = 0; mt < 2; ++mt)
#pragma unroll
      for (int nt = 0; nt < 4; ++nt) acc[mt][nt] = __builtin_amdgcn_mfma_f32_16x16x32_bf16(vf[nt], wf[mt], acc[mt][nt], 0, 0, 0);
  }
#pragma unroll
  for (int mt = 0; mt < 2; ++mt) {
    const int pp = p0 + 16 * mt + qi;
    const size_t tok = (size_t)b * 4096 + chunk * 128 + pp;
    const float bias = p.sgu_b[(size_t)(l * 8 + grp) * 128 + pp];
    float sq = 0.f;
#pragma unroll
    for (int nt = 0; nt < 4; ++nt) {
      const int d = 16 * nt + 4 * g;
      const u32x2 uu = *(const u32x2*)(p.ub + tok * 512 + grp * 64 + d);
      const float u0 = __uint_as_float(uu.x << 16), u1 = __uint_as_float(uu.x & 0xffff0000u);
      const float u2 = __uint_as_float(uu.y << 16), u3 = __uint_as_float(uu.y & 0xffff0000u);
      const float v0 = u0 * (acc[mt][nt][0] + bias), v1 = u1 * (acc[mt][nt][1] + bias);
      const float v2 = u2 * (acc[mt][nt][2] + bias), v3 = u3 * (acc[mt][nt][3] + bias);
      sq += v0 * v0 + v1 * v1 + v2 * v2 + v3 * v3;
      store_bf16x4(p.mixed + tok * 1024 + 512 + grp * 64 + d, v0, v1, v2, v3);
    }
    sq += __shfl_xor(sq, 16); sq += __shfl_xor(sq, 32);
    if (g == 0) p.ssq[tok * 16 + 8 + grp] = sq;
  }
}

__device__ void p3_tile(const Params& p, int l, int t, unsigned char* smem) {
  const int x_ = t & 7, j_ = t >> 3, rd_ = j_ >> 6, lb_ = j_ & 63;
  const int mt = x_ * 16 + rd_ * 8 + (lb_ & 7), nt = lb_ >> 3;
  const int tid = otid(), lane = tid & 63, wid = tid >> 6, wr = wid >> 1, wc = wid & 1;
  const int srow = tid >> 3, sch = tid & 7, qi = lane & 15, g = lane >> 4;
  const bf16_t* A = p.mixed + (size_t)(mt * 128 + srow) * 1024 + sch * 8;
  const bf16_t* B = p.Wt_out + (size_t)(nt * 128 + srow) * 1024 + sch * 8;
  MidScale mid; float rss[4];
#pragma unroll
  for (int i = 0; i < 4; ++i) {
    const int m = mt * 128 + wr * 64 + i * 16 + qi;
    const float4 a0 = *(const float4*)(p.ssq + (size_t)m * 16), a1 = *(const float4*)(p.ssq + (size_t)m * 16 + 4);
    const float4 b0 = *(const float4*)(p.ssq + (size_t)m * 16 + 8), b1 = *(const float4*)(p.ssq + (size_t)m * 16 + 12);
    const float sa = (a0.x + a0.y + a0.z + a0.w) + (a1.x + a1.y + a1.z + a1.w);
    const float sb = (b0.x + b0.y + b0.z + b0.w) + (b1.x + b1.y + b1.z + b1.w);
    const float ra = rsqrtf(sa * (1.0f / 512.0f) + LN_EPS), rb = rsqrtf(sb * (1.0f / 512.0f) + LN_EPS);
    mid.s[i] = ra / rb; rss[i] = rb;
  }
  f32x4 acc[4][4];
  ZERO_ACC(acc);
  gemm_main(smem, A, A + 32 * 1024, A + 64 * 1024, A + 96 * 1024, B, B + 32 * 1024, B + 64 * 1024, B + 96 * 1024, 16, 8, false, acc, mid);
#pragma unroll
  for (int i = 0; i < 4; ++i) {
    const int m = mt * 128 + wr * 64 + i * 16 + qi;
#pragma unroll
    for (int j = 0; j < 4; ++j) {
      const int n = nt * 128 + wc * 64 + j * 16 + 4 * g;
      const u32x2 xr = *(const u32x2*)(p.xb + (size_t)m * 1024 + n);
      const float o0 = ALPHA * __uint_as_float(xr.x << 16) + acc[i][j][0] * rss[i];
      const float o1 = ALPHA * __uint_as_float(xr.x & 0xffff0000u) + acc[i][j][1] * rss[i];
      const float o2 = ALPHA * __uint_as_float(xr.y << 16) + acc[i][j][2] * rss[i];
      const float o3 = ALPHA * __uint_as_float(xr.y & 0xffff0000u) + acc[i][j][3] * rss[i];
      store_bf16x4(p.hb + (size_t)m * 1024 + n, o0, o1, o2, o3);
    }
  }
}

__device__ void p4_batch(const Params& p, int l, int batch, unsigned char* smem) {
  const int tid = otid(), lane = tid & 63, w = tid >> 6;
  int* scnt = (int*)smem;
  int* sbase = scnt + 16;
  __syncthreads();
  if (tid < 16) scnt[tid] = 0;
  __syncthreads();
  const int tokw = batch * 32 + w * 8;
  {
    float4 gm[4], bt[4];
#pragma unroll
    for (int q = 0; q < 4; ++q) {
      gm[q] = *(const float4*)(p.ln1_g + l * 1024 + q * 256 + lane * 4);
      bt[q] = *(const float4*)(p.ln1_b + l * 1024 + q * 256 + lane * 4);
    }
#pragma unroll 4
    for (int t = 0; t < 8; ++t) {
      float* xr = p.x1 + (size_t)(tokw + t) * 1024 + lane * 4;
      const bf16_t* hr = p.hb + (size_t)(tokw + t) * 1024 + lane * 4;
      float4 v[4];
#pragma unroll
      for (int q = 0; q < 4; ++q) {
        const u32x2 hh = *(const u32x2*)(hr + q * 256);
        v[q].x = __uint_as_float(hh.x << 16); v[q].y = __uint_as_float(hh.x & 0xffff0000u);
        v[q].z = __uint_as_float(hh.y << 16); v[q].w = __uint_as_float(hh.y & 0xffff0000u);
      }
      float s1 = 0.f;
#pragma unroll
      for (int q = 0; q < 4; ++q) s1 += (v[q].x + v[q].y) + (v[q].z + v[q].w);
      const float mu = wave_sum(s1) * (1.0f / 1024.0f);
      float s2 = 0.f;
#pragma unroll
      for (int q = 0; q < 4; ++q) {
        const float d0 = v[q].x - mu, d1 = v[q].y - mu, d2 = v[q].z - mu, d3 = v[q].w - mu;
        s2 += (d0 * d0 + d1 * d1) + (d2 * d2 + d3 * d3);
      }
      const float rstd = rsqrtf(wave_sum(s2) * (1.0f / 1024.0f) + LN_EPS);
#pragma unroll
      for (int q = 0; q < 4; ++q) {
        float4 o;
        o.x = (v[q].x - mu) * rstd * gm[q].x + bt[q].x; o.y = (v[q].y - mu) * rstd * gm[q].y + bt[q].y;
        o.z = (v[q].z - mu) * rstd * gm[q].z + bt[q].z; o.w = (v[q].w - mu) * rstd * gm[q].w + bt[q].w;
        *(float4*)(xr + q * 256) = o;
        store_bf16x4(p.xb + (size_t)(tokw + t) * 1024 + q * 256 + lane * 4, o.x, o.y, o.z, o.w);
      }
    }
  }
  asm volatile("s_waitcnt vmcnt(0)" ::: "memory");
  const int j = lane & 15, g = lane >> 4;
  const int tok = tokw + (j & 7);
  const float* xrow = p.x1 + (size_t)tok * 1024 + 8 * g;
  const size_t wof = (size_t)(g * 16 + j) * 8;
  f32x4 De = {0.f, 0.f, 0.f, 0.f}, Dg = {0.f, 0.f, 0.f, 0.f};
#pragma unroll 4
  for (int kb = 0; kb < 32; ++kb) {
    const float4 xa = *(const float4*)(xrow + kb * 32), xc = *(const float4*)(xrow + kb * 32 + 4);
    const bf16x8 weh = *(const bf16x8*)(p.Wr_eh + wof + kb * 512), wel = *(const bf16x8*)(p.Wr_el + wof + kb * 512);
    const bf16x8 wgh = *(const bf16x8*)(p.Wr_gh + wof + kb * 512), wgl = *(const bf16x8*)(p.Wr_gl + wof + kb * 512);
    u32x4 h, lo;
    h.x = cvt_pk_bf16(xa.x, xa.y); h.y = cvt_pk_bf16(xa.z, xa.w); h.z = cvt_pk_bf16(xc.x, xc.y); h.w = cvt_pk_bf16(xc.z, xc.w);
    lo.x = cvt_pk_bf16(xa.x - __uint_as_float(h.x << 16), xa.y - __uint_as_float(h.x & 0xffff0000u));
    lo.y = cvt_pk_bf16(xa.z - __uint_as_float(h.y << 16), xa.w - __uint_as_float(h.y & 0xffff0000u));
    lo.z = cvt_pk_bf16(xc.x - __uint_as_float(h.z << 16), xc.y - __uint_as_float(h.z & 0xffff0000u));
    lo.w = cvt_pk_bf16(xc.z - __uint_as_float(h.w << 16), xc.w - __uint_as_float(h.w & 0xffff0000u));
    const bf16x8 xh = __builtin_bit_cast(bf16x8, h), xl = __builtin_bit_cast(bf16x8, lo);
    De = __builtin_amdgcn_mfma_f32_16x16x32_bf16(weh, xh, De, 0, 0, 0);
    Dg = __builtin_amdgcn_mfma_f32_16x16x32_bf16(wgh, xh, Dg, 0, 0, 0);
    De = __builtin_amdgcn_mfma_f32_16x16x32_bf16(weh, xl, De, 0, 0, 0);
    Dg = __builtin_amdgcn_mfma_f32_16x16x32_bf16(wgh, xl, Dg, 0, 0, 0);
    De = __builtin_amdgcn_mfma_f32_16x16x32_bf16(wel, xh, De, 0, 0, 0);
    Dg = __builtin_amdgcn_mfma_f32_16x16x32_bf16(wgl, xh, Dg, 0, 0, 0);
  }
  float gl[4];
#pragma unroll
  for (int k = 0; k < 4; ++k) gl[k] = __shfl(Dg[k], j) + p.rg_b[l * 4 + k];
  int gs = 0; float gmax = gl[0];
#pragma unroll
  for (int k = 1; k < 4; ++k) { const bool bb = gl[k] > gmax; gmax = bb ? gl[k] : gmax; gs = bb ? k : gs; }
  float psum = 0.f;
#pragma unroll
  for (int k = 0; k < 4; ++k) psum += __expf(gl[k] - gmax);
  const float gate = 1.0f / psum;
  float es[4];
#pragma unroll
  for (int k = 0; k < 4; ++k) es[k] = De[k] + p.re_b[l * 16 + 4 * g + k];
  int i0 = 0; float v0 = es[0];
#pragma unroll
  for (int k = 1; k < 4; ++k) { const bool bb = es[k] > v0; v0 = bb ? es[k] : v0; i0 = bb ? k : i0; }
  int i1 = 0; float v1 = -3.0e38f;
#pragma unroll
  for (int k = 0; k < 4; ++k) { const bool bb = (k != i0) && (es[k] > v1); v1 = bb ? es[k] : v1; i1 = bb ? k : i1; }
  const float ex = __expf(v1 - v0);
  const float tw0 = 1.0f / (1.0f + ex), tw1 = ex / (1.0f + ex);
  const bool commit = (g == gs) && (j < 8);
  const int e0 = gs * 4 + i0, e1 = gs * 4 + i1;
  int lp0 = 0, lp1 = 0;
  if (commit) { lp0 = atomicAdd(&scnt[e0], 1); lp1 = atomicAdd(&scnt[e1], 1); }
  __syncthreads();
  if (tid < 16) sbase[tid] = atomicAdd(p.counts + l * 16 + tid, scnt[tid]);
  __syncthreads();
  if (commit) {
    const int pos0 = sbase[e0] + lp0, pos1 = sbase[e1] + lp1;
    p.list[e0 * NTOK + pos0] = tok; p.wlist[e0 * NTOK + pos0] = gate * tw0;
    p.list[e1 * NTOK + pos1] = tok; p.wlist[e1 * NTOK + pos1] = gate * tw1;
    int4 ti; ti.x = e0; ti.y = pos0; ti.z = e1; ti.w = pos1;
    *(int4*)(p.tokinfo + (size_t)tok * 4) = ti;
  }
}

__device__ __forceinline__ int moe_total_mtiles(const int* cnts) {
  int tot = 0;
#pragma unroll
  for (int e = 0; e < 16; ++e) tot += (cnts[e] + 127) >> 7;
  return tot;
}
__device__ __forceinline__ void moe_find(const int* cnts, int mi, int& e_out, int& ml, int& off, int& cnt) {
  int rem = mi, o = 0; e_out = 0; ml = 0; off = 0; cnt = 1;
  bool found = false;
#pragma unroll
  for (int e = 0; e < 16; ++e) {
    const int c = cnts[e], mtl = (c + 127) >> 7;
    if (!found && rem < mtl) { found = true; e_out = e; ml = rem; off = o; cnt = c; }
    rem -= mtl; o += c;
  }
}

__device__ void p5_tile(const Params& p, int l, int t, int mtot, unsigned char* smem) {
  const int mi = (t >> 5) * 8 + (t & 7), nt = (t >> 3) & 3;
  if (mi >= mtot) return;
  int e, ml, off, cnt;
  moe_find(p.counts + l * 16, mi, e, ml, off, cnt);
  const int tid = otid(), lane = tid & 63, wid = tid >> 6, wr = wid >> 1, wc = wid & 1;
  const int srow = tid >> 3, sch = tid & 7, qi = lane & 15, g = lane >> 4;
  const bf16_t* pa[4];
#pragma unroll
  for (int i = 0; i < 4; ++i) {
    const int ridx = min(ml * 128 + srow + 32 * i, cnt - 1);
    const int tok = p.list[e * NTOK + ridx];
    pa[i] = p.xb + (size_t)tok * 1024 + sch * 8;
  }
  const bf16_t* B = p.Wgu + ((size_t)e * 512 + nt * 128 + srow) * 1024 + sch * 8;
  f32x4 acc[4][4];
  ZERO_ACC(acc);
  gemm_main(smem, pa[0], pa[1], pa[2], pa[3], B, B + 32 * 1024, B + 64 * 1024, B + 96 * 1024, 16, -1, false, acc, NoMid());
#pragma unroll
  for (int i = 0; i < 4; ++i) {
    const int rloc = ml * 128 + wr * 64 + i * 16 + qi;
    if (rloc < cnt) {
      const size_t slot = (size_t)off + rloc;
#pragma unroll
      for (int jp = 0; jp < 2; ++jp) {
        const f32x4 ga = acc[i][2 * jp], up = acc[i][2 * jp + 1];
        const int col = 64 * nt + 32 * wc + 16 * jp + 4 * g;
        store_bf16x4(p.act + slot * 256 + col, silu(ga[0]) * up[0], silu(ga[1]) * up[1], silu(ga[2]) * up[2], silu(ga[3]) * up[3]);
      }
    }
  }
}

__device__ void p6_tile(const Params& p, int l, int t, int mtot, unsigned char* smem) {
  const int mi = (t >> 6) * 8 + (t & 7), nt = (t >> 3) & 7;
  if (mi >= mtot) return;
  int e, ml, off, cnt;
  moe_find(p.counts + l * 16, mi, e, ml, off, cnt);
  const int tid = otid(), lane = tid & 63, wid = tid >> 6, wr = wid >> 1, wc = wid & 1;
  const int srow = tid >> 3, sch = tid & 7, qi = lane & 15, g = lane >> 4;
  const bf16_t* pa[4];
#pragma unroll
  for (int i = 0; i < 4; ++i) {
    const int ridx = min(ml * 128 + srow + 32 * i, cnt - 1);
    pa[i] = p.act + ((size_t)off + ridx) * 256 + sch * 8;
  }
  const bf16_t* B = p.Wdn + ((size_t)e * 1024 + nt * 128 + srow) * 256 + sch * 8;
  f32x4 acc[4][4];
  ZERO_ACC(acc);
  gemm_main(smem, pa[0], pa[1], pa[2], pa[3], B, B + 32 * 256, B + 64 * 256, B + 96 * 256, 4, -1, false, acc, NoMid());
#pragma unroll
  for (int i = 0; i < 4; ++i) {
    const int rloc = ml * 128 + wr * 64 + i * 16 + qi;
    if (rloc < cnt) {
      const float wgt = p.wlist[e * NTOK + rloc];
      const size_t slot = (size_t)off + rloc;
#pragma unroll
      for (int j = 0; j < 4; ++j) {
        const int n = nt * 128 + wc * 64 + j * 16 + 4 * g;
        store_bf16x4(p.y + slot * 1024 + n, acc[i][j][0] * wgt, acc[i][j][1] * wgt, acc[i][j][2] * wgt, acc[i][j][3] * wgt);
      }
    }
  }
}

template <int NT>
__device__ __forceinline__ void p7_tokens(const Params& p, int l, int tok0, int tstride) {
  const int lane = otid() & 63;
  int4 ti[NT];
#pragma unroll
  for (int u = 0; u < NT; ++u) ti[u] = *(const int4*)(p.tokinfo + (size_t)(tok0 + u * tstride) * 4);
  int off0[NT], off1[NT];
#pragma unroll
  for (int u = 0; u < NT; ++u) { off0[u] = 0; off1[u] = 0; }
#pragma unroll
  for (int e = 0; e < 16; ++e) {
    const int c = p.counts[l * 16 + e];
#pragma unroll
    for (int u = 0; u < NT; ++u) { if (e < ti[u].x) off0[u] += c; if (e < ti[u].z) off1[u] += c; }
  }
  float4 xr[NT][4]; u32x2 ya[NT][4], yb[NT][4];
#pragma unroll
  for (int u = 0; u < NT; ++u) {
    const int tok = tok0 + u * tstride;
    const size_t s0 = (size_t)off0[u] + ti[u].y, s1 = (size_t)off1[u] + ti[u].w;
#pragma unroll
    for (int q = 0; q < 4; ++q) {
      const int c = q * 256 + lane * 4;
      xr[u][q] = *(const float4*)(p.x1 + (size_t)tok * 1024 + c);
      ya[u][q] = *(const u32x2*)(p.y + s0 * 1024 + c);
      yb[u][q] = *(const u32x2*)(p.y + s1 * 1024 + c);
    }
  }
  float4 gg[4], bb[4];
#pragma unroll
  for (int q = 0; q < 4; ++q) {
    gg[q] = *(const float4*)(p.ln2_g + l * 1024 + q * 256 + lane * 4);
    bb[q] = *(const float4*)(p.ln2_b + l * 1024 + q * 256 + lane * 4);
  }
#pragma unroll
  for (int u = 0; u < NT; ++u) {
    const int tok = tok0 + u * tstride;
    float hv[16];
#pragma unroll
    for (int q = 0; q < 4; ++q) {
      hv[q * 4 + 0] = ALPHA * xr[u][q].x + (__uint_as_float(ya[u][q].x << 16) + __uint_as_float(yb[u][q].x << 16));
      hv[q * 4 + 1] = ALPHA * xr[u][q].y + (__uint_as_float(ya[u][q].x & 0xffff0000u) + __uint_as_float(yb[u][q].x & 0xffff0000u));
      hv[q * 4 + 2] = ALPHA * xr[u][q].z + (__uint_as_float(ya[u][q].y << 16) + __uint_as_float(yb[u][q].y << 16));
      hv[q * 4 + 3] = ALPHA * xr[u][q].w + (__uint_as_float(ya[u][q].y & 0xffff0000u) + __uint_as_float(yb[u][q].y & 0xffff0000u));
    }
    float s1s = 0.f;
#pragma unroll
    for (int c = 0; c < 16; ++c) s1s += hv[c];
    const float mu = wave_sum(s1s) * (1.0f / 1024.0f);
    float s2 = 0.f;
#pragma unroll
    for (int c = 0; c < 16; ++c) { const float d = hv[c] - mu; s2 += d * d; }
    const float rstd = rsqrtf(wave_sum(s2) * (1.0f / 1024.0f) + LN_EPS);
#pragma unroll
    for (int q = 0; q < 4; ++q) {
      const int c = q * 256 + lane * 4;
      float4 o;
      o.x = (hv[q * 4 + 0] - mu) * rstd * gg[q].x + bb[q].x; o.y = (hv[q * 4 + 1] - mu) * rstd * gg[q].y + bb[q].y;
      o.z = (hv[q * 4 + 2] - mu) * rstd * gg[q].z + bb[q].z; o.w = (hv[q * 4 + 3] - mu) * rstd * gg[q].w + bb[q].w;
      if (l == 3) *(float4*)(p.out + (size_t)tok * 1024 + c) = o;
      else store_bf16x4(p.xb + (size_t)tok * 1024 + c, o.x, o.y, o.z, o.w);
    }
  }
}

#define XB_TMO      128
#define XB_XCNT(j)  (256  + 64 * (j))
#define XB_XSUB(j)  (1280 + 64 * (j))
#define XB_XGEN(j)  (2304 + 64 * (j))
#define XB_TOP      3328
#define XB_TOPGEN   3392
#define XCD_BAR_WORDS 3456
#define XB_SPIN_CAP (1u << 22)
__device__ __forceinline__ unsigned xb_ld(unsigned* p) { return __hip_atomic_load(p, __ATOMIC_RELAXED, __HIP_MEMORY_SCOPE_AGENT); }
__device__ __forceinline__ unsigned xb_add(unsigned* p, unsigned v) { return __hip_atomic_fetch_add(p, v, __ATOMIC_RELAXED, __HIP_MEMORY_SCOPE_AGENT); }
__device__ __forceinline__ unsigned xb_xcc_id() { return (unsigned)__builtin_amdgcn_s_getreg((3 << 11) | 20) & 0xFu; }
#define XB_SPIN(cond, bar) do { unsigned _sp = 0; while (cond) { __builtin_amdgcn_s_sleep(1); \
    if ((++_sp & 255u) == 0u) { if (xb_ld(&(bar)[XB_TMO])) break; if (_sp > XB_SPIN_CAP) { atomicAdd(&(bar)[XB_TMO], 1u); break; } } } } while (0)
struct XcdBarrier { unsigned* bar; unsigned x; volatile unsigned* st; };
__device__ __forceinline__ XcdBarrier xcd_barrier_post(unsigned* bar, volatile unsigned* st) {
  XcdBarrier b; b.bar = bar; b.x = xb_xcc_id(); b.st = st;
  if (threadIdx.x == 0) (void)xb_add(&bar[XB_XCNT(b.x)], 1u);
  return b;
}
__device__ __forceinline__ void xcd_barrier_complete(unsigned* bar, unsigned x, unsigned& nloc, unsigned& nx) {
  const unsigned G = gridDim.x;
  unsigned sum, cnt, mine, sp = 0u;
  for (;;) {
    sum = 0u; cnt = 0u; mine = 0u;
#pragma unroll
    for (unsigned j = 0; j < 16; ++j) { const unsigned c = xb_ld(&bar[XB_XCNT(j)]); sum += c; cnt += (c > 0u) ? 1u : 0u; mine = (j == x) ? c : mine; }
    if (sum == G) break;
    __builtin_amdgcn_s_sleep(1);
    if ((++sp & 255u) == 0u) { if (xb_ld(&bar[XB_TMO])) break; if (sp > XB_SPIN_CAP) { atomicAdd(&bar[XB_TMO], 1u); break; } }
  }
  nloc = mine > 0u ? mine : 1u; nx = cnt > 0u ? cnt : 1u;
}
__device__ __forceinline__ void xcd_barrier(const XcdBarrier& b) {
  asm volatile("s_waitcnt vmcnt(0)" ::: "memory");
  __syncthreads();
  if (threadIdx.x == 0) {
    unsigned* bar = b.bar;
    __builtin_amdgcn_s_waitcnt(0);
    unsigned nloc = b.st[0], nx = b.st[1];
    if (nloc == 0u) { xcd_barrier_complete(bar, b.x, nloc, nx); b.st[0] = nloc; b.st[1] = nx; }
    const unsigned old = xb_add(&bar[XB_XSUB(b.x)], 1u);
    const unsigned gen = old / nloc;
    if (old + 1u == (gen + 1u) * nloc) {
      __builtin_amdgcn_fence(__ATOMIC_RELEASE, "agent");
      asm volatile("s_waitcnt vmcnt(0)" ::: "memory");
      const unsigned og = xb_add(&bar[XB_TOP], 1u);
      const unsigned tg = og / nx;
      if (og + 1u == (tg + 1u) * nx) xb_add(&bar[XB_TOPGEN], 1u);
      else XB_SPIN(xb_ld(&bar[XB_TOPGEN]) == tg, bar);
      __builtin_amdgcn_fence(__ATOMIC_ACQUIRE, "agent");
      xb_add(&bar[XB_XGEN(b.x)], 1u);
      asm volatile("s_waitcnt vmcnt(0)" ::: "memory");
    } else {
      XB_SPIN(xb_ld(&bar[XB_XGEN(b.x)]) == gen, bar);
      __builtin_amdgcn_fence(__ATOMIC_ACQUIRE, "agent");
      asm volatile("s_waitcnt vmcnt(0)" ::: "memory");
    }
  }
  __syncthreads();
}

__device__ __forceinline__ void run_phase(const Params& p, int ph, int l, int bid, int nblk, unsigned char* smem, float* sbias) {
  switch (ph) {
    case 0: {
      if (bid == 0 && threadIdx.x < 64) p.counts[threadIdx.x] = 0;
      conv_x(p, bid, nblk);
      for (int it = bid; it < NCONV_ITEMS; it += nblk) conv_item(p, 0, it, smem);
    } break;
    case 1: for (int t = bid; t < 2560; t += nblk) p1_tile(p, l, t, smem); break;
    case 2:
      for (int it = bid; it < 3072; it += nblk) {
        if (it < 2048) attn_item(p, l, it, smem); else sgu_item(p, l, it - 2048, smem);
      }
      break;
    case 3: for (int t = bid; t < 1024; t += nblk) p3_tile(p, l, t, smem); break;
    case 4: for (int it = bid; it < NTOK / 32; it += nblk) p4_batch(p, l, it, smem); break;
    case 5: { const int mtot = moe_total_mtiles(p.counts + l * 16), nt = ((mtot + 7) >> 3) * 32; for (int t = bid; t < nt; t += nblk) p5_tile(p, l, t, mtot, smem); } break;
    case 6: { const int mtot = moe_total_mtiles(p.counts + l * 16), nt = ((mtot + 7) >> 3) * 64; for (int t = bid; t < nt; t += nblk) p6_tile(p, l, t, mtot, smem); } break;
    case 7: {
      { const int nw = nblk * 4; int tok = bid * 4 + (threadIdx.x >> 6);
        for (; tok + 3 * nw < NTOK; tok += 4 * nw) p7_tokens<4>(p, l, tok, nw);
        for (; tok < NTOK; tok += nw) p7_tokens<1>(p, l, tok, nw); }
      if (l < 3) for (int it = bid; it < NCONV_ITEMS; it += nblk) conv_item(p, l + 1, it, smem);
    } break;
  }
}

template <int PH>
__global__ void __launch_bounds__(256, 2) phase_kernel(Params p, int l) {
  __shared__ __attribute__((aligned(16))) unsigned char smem[SMEM_BYTES];
  run_phase(p, PH, l, blockIdx.x, gridDim.x, smem, (float*)smem);
}

#if MEGA
__global__ void __launch_bounds__(256, 2) mega_kernel(Params p) {
  __shared__ __attribute__((aligned(16))) unsigned char smem[SMEM_BYTES];
  __shared__ uint4 xb_words;
  float* sbias = (float*)smem;
  cg::grid_group grid = cg::this_grid();
  const int bid = blockIdx.x, nblk = gridDim.x;
  if (threadIdx.x == 0) xb_words = make_uint4(0u, 0u, 0u, 0u);
  __syncthreads();
  XcdBarrier xb = xcd_barrier_post(p.bar, (volatile unsigned*)&xb_words);
  run_phase(p, 0, 0, bid, nblk, smem, sbias);
  if (p.never) grid.sync();
  xcd_barrier(xb);
#pragma unroll 1
  for (int l = 0; l < 4; ++l) {
#pragma unroll 1
    for (int ph = 1; ph <= 7; ++ph) {
      run_phase(p, ph, l, bid, nblk, smem, sbias);
#if DUP_PH
      if (ph == DUP_PH) { xcd_barrier(xb); run_phase(p, ph, l, bid, nblk, smem, sbias); }
#endif
      if (!(l == 3 && ph == 7)) xcd_barrier(xb);
    }
  }
}
#endif

extern "C" void kernel_launch(void* const* d_in, const int* in_sizes, int n_in, void* d_out, int out_size, void* d_ws,
                              size_t ws_size, hipStream_t stream) {
  Params p{};
  p.x = (const float*)d_in[0]; p.w_in = (const float*)d_in[1]; p.w_out = (const float*)d_in[2]; p.rel_bias = (const float*)d_in[3];
  p.sgu_ln_g = (const float*)d_in[4]; p.sgu_ln_b = (const float*)d_in[5]; p.sgu_w = (const float*)d_in[6]; p.sgu_b = (const float*)d_in[7];
  p.mix_g = (const float*)d_in[8]; p.ln1_g = (const float*)d_in[9]; p.ln1_b = (const float*)d_in[10];
  p.rg_w = (const float*)d_in[11]; p.rg_b = (const float*)d_in[12]; p.re_w = (const float*)d_in[13]; p.re_b = (const float*)d_in[14];
  p.w_gate = (const float*)d_in[15]; p.w_up = (const float*)d_in[16]; p.w_down = (const float*)d_in[17];
  p.ln2_g = (const float*)d_in[18]; p.ln2_b = (const float*)d_in[19];
  p.out = (float*)d_out;
  unsigned char* w = (unsigned char*)d_ws;
  size_t o = 0;
  auto take = [&](size_t bytes) { unsigned char* r = w + o; o += (bytes + 255) & ~(size_t)255; return r; };
  p.Wt_in = (bf16_t*)take((size_t)2560 * 1024 * 2);
  p.Wt_out = (bf16_t*)take((size_t)1024 * 1024 * 2);
  p.Wgu = (bf16_t*)take((size_t)16 * 512 * 1024 * 2);
  p.Wdn = (bf16_t*)take((size_t)16 * 1024 * 256 * 2);
  p.Wsgu = (bf16_t*)take((size_t)8 * 128 * 128 * 2);
  p.xb = (bf16_t*)take((size_t)NTOK * 1024 * 2);
  p.x1 = (float*)take((size_t)NTOK * 1024 * 4);
  unsigned char* r1 = take((size_t)NTOK * 2560 * 2);
  p.qk = (bf16_t*)r1;
  p.vT = (bf16_t*)(r1 + (size_t)NTOK * 1024 * 2);
  p.ub = (bf16_t*)(r1 + (size_t)NTOK * 1536 * 2);
  p.vnT = (bf16_t*)(r1 + (size_t)NTOK * 2048 * 2);
  p.y = (bf16_t*)r1;
  p.hb = (bf16_t*)r1;
  unsigned char* r2 = take((size_t)NTOK * 1024 * 2);
  p.mixed = (bf16_t*)r2;
  p.act = (bf16_t*)r2;
  p.ssq = (float*)take((size_t)NTOK * 16 * 4);
  p.wlist = (float*)take((size_t)16 * NTOK * 4);
  p.list = (int*)take((size_t)16 * NTOK * 4);
  p.tokinfo = (int*)take((size_t)NTOK * 4 * 4);
  p.counts = (int*)take(256);
  p.Wr_eh = (bf16_t*)take(16384 * 2); p.Wr_el = (bf16_t*)take(16384 * 2);
  p.Wr_gh = (bf16_t*)take(16384 * 2); p.Wr_gl = (bf16_t*)take(16384 * 2);
  p.bar = (unsigned*)take(XCD_BAR_WORDS * 4);
#if MEGA
  static int grid_blocks = 0;
  if (!grid_blocks) {
    int dev = 0, cus = 0, per_cu = 0;
    hipGetDevice(&dev);
    hipDeviceGetAttribute(&cus, hipDeviceAttributeMultiprocessorCount, dev);
    hipOccupancyMaxActiveBlocksPerMultiprocessor(&per_cu, mega_kernel, 256, 0);
    if (per_cu > 2) per_cu = 2;
    grid_blocks = cus * per_cu;
  }
  (void)hipMemsetAsync(p.bar, 0, XCD_BAR_WORDS * 4, stream);
  void* args[] = {&p};
  hipError_t e = hipLaunchCooperativeKernel((void*)mega_kernel, dim3(grid_blocks), dim3(256), args, 0, stream);
  if (e != hipSuccess) fprintf(stderr, "cooperative launch failed: %s (grid %d)\n", hipGetErrorString(e), grid_blocks);
#else
  const int G = 512;
  phase_kernel<0><<<G, 256, 0, stream>>>(p, 0);
  for (int l = 0; l < 4; ++l) {
    phase_kernel<1><<<G, 256, 0, stream>>>(p, l);
    phase_kernel<2><<<G, 256, 0, stream>>>(p, l);
    phase_kernel<3><<<G, 256, 0, stream>>>(p, l);
    phase_kernel<4><<<G, 256, 0, stream>>>(p, l);
    phase_kernel<5><<<G, 256, 0, stream>>>(p, l);
    phase_kernel<6><<<G, 256, 0, stream>>>(p, l);
    phase_kernel<7><<<G, 256, 0, stream>>>(p, l);
  }
#endif
}
```

```cpp
#include <hip/hip_runtime.h>
#include <hip/hip_cooperative_groups.h>
#include <stdint.h>
#include <cstdio>
namespace cg = cooperative_groups;

#ifndef MEGA
#define MEGA 1
#endif
#define DUP_PH 0

typedef unsigned short bf16_t;
typedef short bf16x8 __attribute__((ext_vector_type(8)));
typedef float f32x4 __attribute__((ext_vector_type(4)));
typedef unsigned u32x4 __attribute__((ext_vector_type(4)));
typedef unsigned u32x2 __attribute__((ext_vector_type(2)));

#define NTOK 16384
#define LN_EPS 1e-5f
#define ALPHA 1.681792830507429f
#define NCONV_ITEMS 3985
#define SMEM_BYTES 69632

struct Params {
  const float *x, *w_in, *w_out, *rel_bias, *sgu_ln_g, *sgu_ln_b, *sgu_w, *sgu_b, *mix_g, *ln1_g, *ln1_b,
      *rg_w, *rg_b, *re_w, *re_b, *w_gate, *w_up, *w_down, *ln2_g, *ln2_b;
  float* out;
  bf16_t *Wt_in, *Wt_out, *Wgu, *Wdn, *Wsgu, *xb, *qk, *vT, *ub, *vnT, *mixed, *act, *y, *hb;
  float *x1, *ssq, *wlist;
  bf16_t *Wr_eh, *Wr_el, *Wr_gh, *Wr_gl;
  int *counts, *list, *tokinfo;
  unsigned* bar;
  int never;
  int pad_;
};

__device__ __forceinline__ unsigned cvt_pk_bf16(float lo, float hi) {
  unsigned r; asm("v_cvt_pk_bf16_f32 %0, %1, %2" : "=v"(r) : "v"(lo), "v"(hi)); return r;
}
__device__ __forceinline__ void store_bf16x4(bf16_t* p, float a, float b, float c, float d) {
  u32x2 v; v.x = cvt_pk_bf16(a, b); v.y = cvt_pk_bf16(c, d); *(u32x2*)p = v;
}
__device__ __forceinline__ float gelu_tanh(float x) {
  float z = 0.7978845608028654f * (x + 0.044715f * x * x * x);
  return x / (1.0f + __expf(-2.0f * z));
}
__device__ __forceinline__ int otid() { int t = threadIdx.x; asm volatile("" : "+v"(t)); return t; }
__device__ __forceinline__ float silu(float x) { return x / (1.0f + __expf(-x)); }
template <int CTRL>
__device__ __forceinline__ float dpp_mov(float v) {
  return __builtin_bit_cast(float, __builtin_amdgcn_update_dpp(0, __builtin_bit_cast(int, v), CTRL, 0xf, 0xf, true));
}
__device__ __forceinline__ float row16_sum(float v) {
  v += dpp_mov<0xB1>(v); v += dpp_mov<0x4E>(v); v += dpp_mov<0x141>(v); v += dpp_mov<0x140>(v); return v;
}
__device__ __forceinline__ float wave_sum(float v) {
  v = row16_sum(v); v += __shfl_xor(v, 16); v += __shfl_xor(v, 32); return v;
}

struct NoMid { __device__ __forceinline__ void operator()(f32x4 (&)[4][4]) const {} };
struct MidScale {
  float s[4];
  __device__ __forceinline__ void operator()(f32x4 (&acc)[4][4]) const {
#pragma unroll
    for (int i = 0; i < 4; ++i)
#pragma unroll
      for (int j = 0; j < 4; ++j) acc[i][j] *= s[i];
  }
};

#define GLDS16(gptr, lptr) __builtin_amdgcn_global_load_lds((const unsigned*)(gptr), (__attribute__((address_space(3))) unsigned*)(lptr), 16, 0, 0)

template <class Mid>
__device__ __forceinline__ void gemm_main(unsigned char* smem, const bf16_t* pa0, const bf16_t* pa1, const bf16_t* pa2,
                                          const bf16_t* pa3, const bf16_t* pb0, const bf16_t* pb1, const bf16_t* pb2,
                                          const bf16_t* pb3, int nk, int kmid, bool swapped, f32x4 (&acc)[4][4],
                                          const Mid& mid) {
  const int tid = otid(), lane = tid & 63, wid = tid >> 6, wr = wid >> 1, wc = wid & 1;
  const int srow = tid >> 3;
  const int lch = ((tid & 7) ^ ((srow >> 1) & 7)) * 8 - (tid & 7) * 8;
  pa0 += lch; pa1 += lch; pa2 += lch; pa3 += lch; pb0 += lch; pb1 += lch; pb2 += lch; pb3 += lch;
  const int soff = __builtin_amdgcn_readfirstlane(wid) * 1024;
  const int qi = lane & 15, g = lane >> 4, s = qi >> 1;
  const int aside = swapped ? 16384 : 0, bside = swapped ? 0 : 16384;
  const int offA0 = aside + (wr * 64 + qi) * 128 + (((0 + g) ^ s) << 4);
  const int offA1 = aside + (wr * 64 + qi) * 128 + (((4 + g) ^ s) << 4);
  const int offB0 = bside + (wc * 64 + qi) * 128 + (((0 + g) ^ s) << 4);
  const int offB1 = bside + (wc * 64 + qi) * 128 + (((4 + g) ^ s) << 4);
  {
    unsigned char* d = smem + soff;
    GLDS16(pa0, d); GLDS16(pa1, d + 4096); GLDS16(pa2, d + 8192); GLDS16(pa3, d + 12288);
    GLDS16(pb0, d + 16384); GLDS16(pb1, d + 20480); GLDS16(pb2, d + 24576); GLDS16(pb3, d + 28672);
  }
  asm volatile("s_waitcnt vmcnt(0)" ::: "memory");
  __syncthreads();
  for (int kt = 0; kt < nk; ++kt) {
    unsigned char* buf = smem + ((kt & 1) << 15);
    if (kt + 1 < nk) {
      const int ko = (kt + 1) * 64;
      unsigned char* d = smem + (((kt + 1) & 1) << 15) + soff;
      GLDS16(pa0 + ko, d); GLDS16(pa1 + ko, d + 4096); GLDS16(pa2 + ko, d + 8192); GLDS16(pa3 + ko, d + 12288);
      GLDS16(pb0 + ko, d + 16384); GLDS16(pb1 + ko, d + 20480); GLDS16(pb2 + ko, d + 24576); GLDS16(pb3 + ko, d + 28672);
    }
    if (kt == kmid) mid(acc);
    {
      bf16x8 af0[4], bf0[4], af1[4], bf1[4];
#pragma unroll
      for (int i = 0; i < 4; ++i) af0[i] = *(const bf16x8*)(buf + offA0 + i * 2048);
#pragma unroll
      for (int j = 0; j < 4; ++j) bf0[j] = *(const bf16x8*)(buf + offB0 + j * 2048);
#pragma unroll
      for (int i = 0; i < 4; ++i) af1[i] = *(const bf16x8*)(buf + offA1 + i * 2048);
#pragma unroll
      for (int j = 0; j < 4; ++j) bf1[j] = *(const bf16x8*)(buf + offB1 + j * 2048);
      asm volatile("s_waitcnt lgkmcnt(8)" ::: "memory");
      __builtin_amdgcn_s_setprio(1);
#pragma unroll
      for (int i = 0; i < 4; ++i)
#pragma unroll
        for (int j = 0; j < 4; ++j) acc[i][j] = __builtin_amdgcn_mfma_f32_16x16x32_bf16(bf0[j], af0[i], acc[i][j], 0, 0, 0);
      asm volatile("s_waitcnt lgkmcnt(0)" ::: "memory");
#pragma unroll
      for (int i = 0; i < 4; ++i)
#pragma unroll
        for (int j = 0; j < 4; ++j) acc[i][j] = __builtin_amdgcn_mfma_f32_16x16x32_bf16(bf1[j], af1[i], acc[i][j], 0, 0, 0);
      __builtin_amdgcn_s_setprio(0);
    }
    asm volatile("s_waitcnt vmcnt(0)" ::: "memory");
    __syncthreads();
  }
}

#define ZERO_ACC(acc)                                   \
  _Pragma("unroll") for (int i_ = 0; i_ < 4; ++i_)      \
  _Pragma("unroll") for (int j_ = 0; j_ < 4; ++j_) acc[i_][j_] = (f32x4){0.f, 0.f, 0.f, 0.f};

__device__ void conv_x(const Params& p, int bid, int nblk) {
  const size_t n8 = (size_t)NTOK * 1024 / 8;
  for (size_t i = (size_t)bid * 256 + threadIdx.x; i < n8; i += (size_t)nblk * 256) {
    const float4 a = *(const float4*)(p.x + i * 8), b = *(const float4*)(p.x + i * 8 + 4);
    u32x4 v; v.x = cvt_pk_bf16(a.x, a.y); v.y = cvt_pk_bf16(a.z, a.w); v.z = cvt_pk_bf16(b.x, b.y); v.w = cvt_pk_bf16(b.z, b.w);
    *(u32x4*)(p.xb + i * 8) = v;
  }
}

__device__ void tconv_tile(float* tile, const float* src, int src_ld, const float* kscale, bf16_t* dst, int dst_ld, int rstep) {
  const int t = otid();
#pragma unroll
  for (int i = 0; i < 4; ++i) {
    const int k = (t >> 4) + 16 * i, n4 = (t & 15) * 4;
    float4 v = *(const float4*)(src + (size_t)k * src_ld + n4);
    if (kscale) { const float sc = kscale[k]; v.x *= sc; v.y *= sc; v.z *= sc; v.w *= sc; }
    float* d = tile + k * 65 + n4;
    d[0] = v.x; d[1] = v.y; d[2] = v.z; d[3] = v.w;
  }
  __syncthreads();
  {
    const int n = t >> 2, kc = (t & 3) * 16;
    float f[16];
#pragma unroll
    for (int q = 0; q < 16; ++q) f[q] = tile[(kc + q) * 65 + n];
    u32x4 v0, v1;
    v0.x = cvt_pk_bf16(f[0], f[1]); v0.y = cvt_pk_bf16(f[2], f[3]); v0.z = cvt_pk_bf16(f[4], f[5]); v0.w = cvt_pk_bf16(f[6], f[7]);
    v1.x = cvt_pk_bf16(f[8], f[9]); v1.y = cvt_pk_bf16(f[10], f[11]); v1.z = cvt_pk_bf16(f[12], f[13]); v1.w = cvt_pk_bf16(f[14], f[15]);
    bf16_t* o = dst + (size_t)((n >> 4) * rstep + (n & 15)) * dst_ld + kc;
    *(u32x4*)o = v0; *(u32x4*)(o + 8) = v1;
  }
  __syncthreads();
}

__device__ void conv_item(const Params& p, int l, int it, unsigned char* smem) {
  float* tile = (float*)smem;
  if (it < 640) {
    const int kt = it / 40, ntile = it % 40;
    tconv_tile(tile, p.w_in + (size_t)l * 1024 * 2560 + (size_t)kt * 64 * 2560 + ntile * 64, 2560, nullptr,
               p.Wt_in + (size_t)ntile * 64 * 1024 + kt * 64, 1024, 16);
  } else if (it < 896) {
    const int r = it - 640, kt = r / 16, ntile = r % 16;
    tconv_tile(tile, p.w_out + (size_t)l * 1024 * 1024 + (size_t)kt * 64 * 1024 + ntile * 64, 1024, p.mix_g + l * 1024 + kt * 64,
               p.Wt_out + (size_t)ntile * 64 * 1024 + kt * 64, 1024, 16);
  } else if (it < 2944) {
    const int r0 = it - 896, e = r0 >> 7, r = r0 & 127, which = r >> 6, r2 = r & 63, kt = r2 >> 2, ntile = r2 & 3;
    const float* src = (which ? p.w_up : p.w_gate) + (size_t)(l * 16 + e) * 1024 * 256 + (size_t)kt * 64 * 256 + ntile * 64;
    tconv_tile(tile, src, 256, nullptr, p.Wgu + (size_t)e * 512 * 1024 + (size_t)(ntile * 128 + which * 16) * 1024 + kt * 64, 1024, 32);
  } else if (it < 3968) {
    const int r0 = it - 2944, e = r0 >> 6, r = r0 & 63, kt = r >> 4, ntile = r & 15;
    tconv_tile(tile, p.w_down + (size_t)(l * 16 + e) * 256 * 1024 + (size_t)kt * 64 * 1024 + ntile * 64, 1024, nullptr,
               p.Wdn + (size_t)e * 1024 * 256 + (size_t)ntile * 64 * 256 + kt * 64, 256, 16);
  } else if (it == 3984) {
    for (int i = threadIdx.x; i < 16384; i += 256) {
      const int jj = i & 7, j = (i >> 3) & 15, g = (i >> 7) & 3, kb = i >> 9;
      const int k = 32 * kb + 8 * g + jj;
      const float we = p.re_w[(size_t)(l * 1024 + k) * 16 + j];
      const float wg = (j < 4) ? p.rg_w[(size_t)(l * 1024 + k) * 4 + j] : 0.0f;
      const unsigned eh = cvt_pk_bf16(we, 0.f) & 0xffffu, gh = cvt_pk_bf16(wg, 0.f) & 0xffffu;
      const unsigned el = cvt_pk_bf16(we - __uint_as_float(eh << 16), 0.f) & 0xffffu;
      const unsigned gl = cvt_pk_bf16(wg - __uint_as_float(gh << 16), 0.f) & 0xffffu;
      p.Wr_eh[i] = (bf16_t)eh; p.Wr_el[i] = (bf16_t)el; p.Wr_gh[i] = (bf16_t)gh; p.Wr_gl[i] = (bf16_t)gl;
    }
  } else {
    const int j = it - 3968;
    const float* src = p.sgu_w + (size_t)l * 131072 + (size_t)j * 8192 + threadIdx.x * 32;
    bf16_t* dst = p.Wsgu + (size_t)j * 8192 + threadIdx.x * 32;
#pragma unroll
    for (int q = 0; q < 4; ++q) {
      const float4 a = *(const float4*)(src + q * 8), b = *(const float4*)(src + q * 8 + 4);
      u32x4 v; v.x = cvt_pk_bf16(a.x, a.y); v.y = cvt_pk_bf16(a.z, a.w); v.z = cvt_pk_bf16(b.x, b.y); v.w = cvt_pk_bf16(b.z, b.w);
      *(u32x4*)(dst + q * 8) = v;
    }
  }
}

__device__ void p1_tile(const Params& p, int l, int t, unsigned char* smem) {
  const int x_ = t & 7, j_ = t >> 3, rd_ = j_ >> 6, lb_ = j_ & 63;
  const int mt = (rd_ < 4) ? (x_ * 16 + (rd_ & 1) * 8 + (lb_ & 7)) : (x_ * 16 + (lb_ & 15));
  const int nt = (rd_ < 4) ? ((rd_ >> 1) * 8 + (lb_ >> 3)) : (16 + (lb_ >> 4));
  const int type = nt >> 2;
  const bool swapped = (type == 2) || (type == 4);
  const int tid = otid(), lane = tid & 63, wid = tid >> 6, wr = wid >> 1, wc = wid & 1;
  const int srow = tid >> 3, sch = tid & 7, qi = lane & 15, g = lane >> 4;
  const bf16_t* A = p.xb + (size_t)(mt * 128 + srow) * 1024 + sch * 8;
  const bf16_t* B = p.Wt_in + (size_t)(nt * 128 + srow) * 1024 + sch * 8;
  f32x4 acc[4][4];
  ZERO_ACC(acc);
  gemm_main(smem, A, A + 32 * 1024, A + 64 * 1024, A + 96 * 1024, B, B + 32 * 1024, B + 64 * 1024, B + 96 * 1024, 16, -1, swapped, acc, NoMid());
  if (!swapped) {
#pragma unroll
    for (int i = 0; i < 4; ++i) {
      const int m = mt * 128 + wr * 64 + i * 16 + qi;
#pragma unroll
      for (int j = 0; j < 4; ++j) {
        const int n = nt * 128 + wc * 64 + j * 16 + 4 * g;
        f32x4 v = acc[i][j];
        if (type == 0) v *= 0.125f;
        if (type == 3) { v[0] = gelu_tanh(v[0]); v[1] = gelu_tanh(v[1]); v[2] = gelu_tanh(v[2]); v[3] = gelu_tanh(v[3]); }
        bf16_t* dst = (type == 3) ? (p.ub + (size_t)m * 512 + (n - 1536)) : (p.qk + (size_t)m * 1024 + n);
        store_bf16x4(dst, v[0], v[1], v[2], v[3]);
      }
    }
  } else {
    const int bidx = (mt * 128) >> 12, tokbase = (mt * 128) & 4095;
    bf16_t* dstb = (type == 2) ? p.vT : p.vnT;
    const int fbase = (type == 2) ? 1024 : 2048;
    if (type == 4) {
#pragma unroll
      for (int i = 0; i < 4; ++i)
#pragma unroll
        for (int j = 0; j < 4; ++j)
#pragma unroll
          for (int r = 0; r < 4; ++r) acc[i][j][r] = gelu_tanh(acc[i][j][r]);
      float gam[4], bet[4];
#pragma unroll
      for (int i = 0; i < 4; ++i) {
        const int f = nt * 128 + wr * 64 + i * 16 + qi - 2048;
        gam[i] = p.sgu_ln_g[l * 512 + f]; bet[i] = p.sgu_ln_b[l * 512 + f];
      }
#pragma unroll
      for (int j = 0; j < 4; ++j)
#pragma unroll
        for (int r = 0; r < 4; ++r) {
          float s1 = acc[0][j][r] + acc[1][j][r] + acc[2][j][r] + acc[3][j][r];
          s1 = row16_sum(s1);
          const float mu = s1 * (1.0f / 64.0f);
          float s2 = 0.f;
#pragma unroll
          for (int i = 0; i < 4; ++i) { const float d = acc[i][j][r] - mu; s2 += d * d; }
          s2 = row16_sum(s2);
          const float rstd = rsqrtf(s2 * (1.0f / 64.0f) + LN_EPS);
#pragma unroll
          for (int i = 0; i < 4; ++i) acc[i][j][r] = (acc[i][j][r] - mu) * rstd * gam[i] + bet[i];
        }
    }
#pragma unroll
    for (int i = 0; i < 4; ++i) {
      const int f = nt * 128 + wr * 64 + i * 16 + qi - fbase;
#pragma unroll
      for (int j = 0; j < 4; ++j) {
        const int tok = tokbase + wc * 64 + j * 16 + 4 * g;
        store_bf16x4(dstb + ((size_t)(bidx * 512 + f)) * 4096 + tok, acc[i][j][0], acc[i][j][1], acc[i][j][2], acc[i][j][3]);
      }
    }
  }
}

__device__ void attn_item(const Params& p, int l, int it, unsigned char* smem) {
  const int h = it & 7, br = it >> 3, r = br & 63, b = br >> 6;
  const int rs = min(max(r - 4, 0), 56);
  const int tid = otid(), lane = tid & 63, w = tid >> 6, qi = lane & 15, g = lane >> 4;
  unsigned char* Kb = smem;
  unsigned char* Vb = smem + 32768;
  float* sbias = (float*)(smem + 32768 + 33792);
  const int c0 = (w == 0) ? 0 : (w == 1) ? 8 : (w == 2) ? 24 : 32;
  const int cq = 16 * w + qi, cs = min(max(cq - 8, 0), 48);
  const size_t tokq = (size_t)b * 4096 + r * 64 + cq;
  const int krow = tid >> 3, kch = tid & 7;
  const int ksoff = krow * 128 + ((kch ^ ((krow >> 1) & 7)) << 4);
  const bf16_t* kg = p.qk + ((size_t)b * 4096 + rs * 64 + krow) * 1024 + 512 + h * 64 + kch * 8;
  const int vd = tid >> 5, vc = tid & 31;
  const int vsoff = vd * 528 + vc * 16;
  const bf16_t* vg = p.vT + ((size_t)(b * 512 + h * 64 + vd)) * 4096 + rs * 64 + vc * 8;
  u32x4 st[8];
  __syncthreads();
  for (int i = tid; i < 465; i += 256) sbias[i] = p.rel_bias[(size_t)(l * 8 + h) * 465 + i];
#pragma unroll
  for (int i = 0; i < 8; ++i) st[i] = *(const u32x4*)(kg + (size_t)(32 * i) * 1024);
#pragma unroll
  for (int i = 0; i < 8; ++i) *(u32x4*)(Kb + ksoff + i * 4096) = st[i];
  bf16x8 qf0 = *(const bf16x8*)(p.qk + tokq * 1024 + h * 64 + g * 8);
  bf16x8 qf1 = *(const bf16x8*)(p.qk + tokq * 1024 + h * 64 + 32 + g * 8);
  __syncthreads();
#pragma unroll
  for (int i = 0; i < 8; ++i) st[i] = *(const u32x4*)(kg + (size_t)(256 + 32 * i) * 1024);
  f32x4 s[8][2];
#pragma unroll
  for (int jh = 0; jh < 2; ++jh) {
#pragma unroll
    for (int jj = 0; jj < 4; ++jj)
#pragma unroll
      for (int ch = 0; ch < 2; ++ch) {
        const int kl = jj * 64 + c0 + 16 * ch + qi;
        const int sw = (kl >> 1) & 7;
        const bf16x8 kf0 = *(const bf16x8*)(Kb + kl * 128 + (((0 + g) ^ sw) << 4));
        const bf16x8 kf1 = *(const bf16x8*)(Kb + kl * 128 + (((4 + g) ^ sw) << 4));
        f32x4 a = {0.f, 0.f, 0.f, 0.f};
        a = __builtin_amdgcn_mfma_f32_16x16x32_bf16(kf0, qf0, a, 0, 0, 0);
        a = __builtin_amdgcn_mfma_f32_16x16x32_bf16(kf1, qf1, a, 0, 0, 0);
        s[jh * 4 + jj][ch] = a;
      }
    if (jh == 0) {
      __syncthreads();
#pragma unroll
      for (int i = 0; i < 8; ++i) *(u32x4*)(Kb + ksoff + i * 4096) = st[i];
#pragma unroll
      for (int i = 0; i < 8; ++i) st[i] = *(const u32x4*)(vg + (size_t)(8 * i) * 4096);
      __syncthreads();
    }
  }
#pragma unroll
  for (int i = 0; i < 8; ++i) *(u32x4*)(Vb + vsoff + i * 8 * 528) = st[i];
#pragma unroll
  for (int i = 0; i < 8; ++i) st[i] = *(const u32x4*)(vg + (size_t)(8 * i) * 4096 + 256);
  float mx = -1e30f;
#pragma unroll
  for (int j = 0; j < 8; ++j)
#pragma unroll
    for (int ch = 0; ch < 2; ++ch)
#pragma unroll
      for (int rg = 0; rg < 4; ++rg) {
        const int kc = c0 + 16 * ch + 4 * g + rg;
        const bool valid = (kc >= cs) && (kc < cs + 16);
        const int bidx = valid ? ((rs + j - r + 7) * 31 + (kc - cq) + 15) : 0;
        const float v = valid ? (s[j][ch][rg] + sbias[bidx]) : -1e30f;
        s[j][ch][rg] = v;
        mx = fmaxf(mx, v);
      }
  mx = fmaxf(mx, __shfl_xor(mx, 16)); mx = fmaxf(mx, __shfl_xor(mx, 32));
  float sum = 0.f;
#pragma unroll
  for (int j = 0; j < 8; ++j)
#pragma unroll
    for (int ch = 0; ch < 2; ++ch)
#pragma unroll
      for (int rg = 0; rg < 4; ++rg) { const float e = __expf(s[j][ch][rg] - mx); s[j][ch][rg] = e; sum += e; }
  sum += __shfl_xor(sum, 16); sum += __shfl_xor(sum, 32);
  const float inv = 1.0f / sum;
  bf16x8 pf[8];
#pragma unroll
  for (int j = 0; j < 8; ++j) {
    u32x4 pw;
    pw.x = cvt_pk_bf16(s[j][0][0], s[j][0][1]); pw.y = cvt_pk_bf16(s[j][0][2], s[j][0][3]);
    pw.z = cvt_pk_bf16(s[j][1][0], s[j][1][1]); pw.w = cvt_pk_bf16(s[j][1][2], s[j][1][3]);
    pf[j] = __builtin_bit_cast(bf16x8, pw);
  }
  f32x4 o[4];
#pragma unroll
  for (int dt = 0; dt < 4; ++dt) o[dt] = (f32x4){0.f, 0.f, 0.f, 0.f};
  __syncthreads();
#pragma unroll
  for (int jh = 0; jh < 2; ++jh) {
#pragma unroll
    for (int jj = 0; jj < 4; ++jj)
#pragma unroll
      for (int dt = 0; dt < 4; ++dt) {
        const unsigned char* vp = Vb + (dt * 16 + qi) * 528 + (jj * 64 + c0 + 4 * g) * 2;
        const u32x2 lo = *(const u32x2*)vp, hi = *(const u32x2*)(vp + 32);
        u32x4 vw; vw.x = lo.x; vw.y = lo.y; vw.z = hi.x; vw.w = hi.y;
        o[dt] = __builtin_amdgcn_mfma_f32_16x16x32_bf16(__builtin_bit_cast(bf16x8, vw), pf[jh * 4 + jj], o[dt], 0, 0, 0);
      }
    if (jh == 0) {
      __syncthreads();
#pragma unroll
      for (int i = 0; i < 8; ++i) *(u32x4*)(Vb + vsoff + i * 8 * 528) = st[i];
      __syncthreads();
    }
  }
  float sq = 0.f;
#pragma unroll
  for (int dt = 0; dt < 4; ++dt) {
    o[dt] *= inv;
    sq += o[dt][0] * o[dt][0] + o[dt][1] * o[dt][1] + o[dt][2] * o[dt][2] + o[dt][3] * o[dt][3];
    store_bf16x4(p.mixed + tokq * 1024 + h * 64 + dt * 16 + 4 * g, o[dt][0], o[dt][1], o[dt][2], o[dt][3]);
  }
  sq += __shfl_xor(sq, 16); sq += __shfl_xor(sq, 32);
  if (g == 0) p.ssq[tokq * 16 + h] = sq;
}

__device__ void sgu_item(const Params& p, int l, int it, unsigned char* smem) {
  const int grp = it & 7, bc = it >> 3, chunk = bc & 31, b = bc >> 5;
  const int tid = otid(), lane = tid & 63, w = tid >> 6, qi = lane & 15, g = lane >> 4;
  const int p0 = 32 * w;
  const int wbase = __builtin_amdgcn_readfirstlane(w) * 1024;
  const int lc = ((tid & 15) ^ ((tid >> 4) & 15)) << 3;
  const bf16_t* wsrc = p.Wsgu + ((size_t)(grp * 128 + (tid >> 4))) * 128 + lc;
  const bf16_t* vsrc = p.vnT + ((size_t)(b * 512 + grp * 64 + (tid >> 4))) * 4096 + chunk * 128 + lc;
  __syncthreads();
#pragma unroll
  for (int i = 0; i < 8; ++i) GLDS16(wsrc + (size_t)(16 * i) * 128, smem + i * 4096 + wbase);
#pragma unroll
  for (int i = 0; i < 4; ++i) GLDS16(vsrc + (size_t)(16 * i) * 4096, smem + 32768 + i * 4096 + wbase);
  asm volatile("s_waitcnt vmcnt(0)" ::: "memory");
  __syncthreads();
  f32x4 acc[2][4];
#pragma unroll
  for (int mt = 0; mt < 2; ++mt)
#pragma unroll
    for (int nt = 0; nt < 4; ++nt) acc[mt][nt] = (f32x4){0.f, 0.f, 0.f, 0.f};
#pragma unroll
  for (int ks = 0; ks < 4; ++ks) {
    const int co = ((ks * 4 + g) ^ qi) << 4;
    bf16x8 wf[2], vf[4];
#pragma unroll
    for (int mt = 0; mt < 2; ++mt) wf[mt] = *(const bf16x8*)(smem + (p0 + 16 * mt + qi) * 256 + co);
#pragma unroll
    for (int nt = 0; nt < 4; ++nt) vf[nt] = *(const bf16x8*)(smem + 32768 + (16 * nt + qi) * 256 + co);
#pragma unroll
    for (int mt = 0; mt < 2; ++mt)
#pragma unroll
      for (int nt = 0; nt < 4; ++nt) acc[mt][nt] = __builtin_amdgcn_mfma_f32_16x16x32_bf16(vf[nt], wf[mt], acc[mt][nt], 0, 0, 0);
  }
#pragma unroll
  for (int mt = 0; mt < 2; ++mt) {
    const int pp = p0 + 16 * mt + qi;
    const size_t tok = (size_t)b * 4096 + chunk * 128 + pp;
    const float bias = p.sgu_b[(size_t)(l * 8 + grp) * 128 + pp];
    float sq = 0.f;
#pragma unroll
    for (int nt = 0; nt < 4; ++nt) {
      const int d = 16 * nt + 4 * g;
      const u32x2 uu = *(const u32x2*)(p.ub + tok * 512 + grp * 64 + d);
      const float u0 = __uint_as_float(uu.x << 16), u1 = __uint_as_float(uu.x & 0xffff0000u);
      const float u2 = __uint_as_float(uu.y << 16), u3 = __uint_as_float(uu.y & 0xffff0000u);
      const float v0 = u0 * (acc[mt][nt][0] + bias), v1 = u1 * (acc[mt][nt][1] + bias);
      const float v2 = u2 * (acc[mt][nt][2] + bias), v3 = u3 * (acc[mt][nt][3] + bias);
      sq += v0 * v0 + v1 * v1 + v2 * v2 + v3 * v3;
      store_bf16x4(p.mixed + tok * 1024 + 512 + grp * 64 + d, v0, v1, v2, v3);
    }
    sq += __shfl_xor(sq, 16); sq += __shfl_xor(sq, 32);
    if (g == 0) p.ssq[tok * 16 + 8 + grp] = sq;
  }
}

__device__ void p3_tile(const Params& p, int l, int t, unsigned char* smem) {
  const int x_ = t & 7, j_ = t >> 3, rd_ = j_ >> 6, lb_ = j_ & 63;
  const int mt = x_ * 16 + rd_ * 8 + (lb_ & 7), nt = lb_ >> 3;
  const int tid = otid(), lane = tid & 63, wid = tid >> 6, wr = wid >> 1, wc = wid & 1;
  const int srow = tid >> 3, sch = tid & 7, qi = lane & 15, g = lane >> 4;
  const bf16_t* A = p.mixed + (size_t)(mt * 128 + srow) * 1024 + sch * 8;
  const bf16_t* B = p.Wt_out + (size_t)(nt * 128 + srow) * 1024 + sch * 8;
  MidScale mid; float rss[4];
#pragma unroll
  for (int i = 0; i < 4; ++i) {
    const int m = mt * 128 + wr * 64 + i * 16 + qi;
    const float4 a0 = *(const float4*)(p.ssq + (size_t)m * 16), a1 = *(const float4*)(p.ssq + (size_t)m * 16 + 4);
    const float4 b0 = *(const float4*)(p.ssq + (size_t)m * 16 + 8), b1 = *(const float4*)(p.ssq + (size_t)m * 16 + 12);
    const float sa = (a0.x + a0.y + a0.z + a0.w) + (a1.x + a1.y + a1.z + a1.w);
    const float sb = (b0.x + b0.y + b0.z + b0.w) + (b1.x + b1.y + b1.z + b1.w);
    const float ra = rsqrtf(sa * (1.0f / 512.0f) + LN_EPS), rb = rsqrtf(sb * (1.0f / 512.0f) + LN_EPS);
    mid.s[i] = ra / rb; rss[i] = rb;
  }
  f32x4 acc[4][4];
  ZERO_ACC(acc);
  gemm_main(smem, A, A + 32 * 1024, A + 64 * 1024, A + 96 * 1024, B, B + 32 * 1024, B + 64 * 1024, B + 96 * 1024, 16, 8, false, acc, mid);
#pragma unroll
  for (int i = 0; i < 4; ++i) {
    const int m = mt * 128 + wr * 64 + i * 16 + qi;
#pragma unroll
    for (int j = 0; j < 4; ++j) {
      const int n = nt * 128 + wc * 64 + j * 16 + 4 * g;
      const u32x2 xr = *(const u32x2*)(p.xb + (size_t)m * 1024 + n);
      const float o0 = ALPHA * __uint_as_float(xr.x << 16) + acc[i][j][0] * rss[i];
      const float o1 = ALPHA * __uint_as_float(xr.x & 0xffff0000u) + acc[i][j][1] * rss[i];
      const float o2 = ALPHA * __uint_as_float(xr.y << 16) + acc[i][j][2] * rss[i];
      const float o3 = ALPHA * __uint_as_float(xr.y & 0xffff0000u) + acc[i][j][3] * rss[i];
      store_bf16x4(p.hb + (size_t)m * 1024 + n, o0, o1, o2, o3);
    }
  }
}

__device__ void p4_batch(const Params& p, int l, int batch, unsigned char* smem) {
  const int tid = otid(), lane = tid & 63, w = tid >> 6;
  int* scnt = (int*)smem;
  int* sbase = scnt + 16;
  __syncthreads();
  if (tid < 16) scnt[tid] = 0;
  __syncthreads();
  const int tokw = batch * 32 + w * 8;
  {
    float4 gm[4], bt[4];
#pragma unroll
    for (int q = 0; q < 4; ++q) {
      gm[q] = *(const float4*)(p.ln1_g + l * 1024 + q * 256 + lane * 4);
      bt[q] = *(const float4*)(p.ln1_b + l * 1024 + q * 256 + lane * 4);
    }
#pragma unroll 4
    for (int t = 0; t < 8; ++t) {
      float* xr = p.x1 + (size_t)(tokw + t) * 1024 + lane * 4;
      const bf16_t* hr = p.hb + (size_t)(tokw + t) * 1024 + lane * 4;
      float4 v[4];
#pragma unroll
      for (int q = 0; q < 4; ++q) {
        const u32x2 hh = *(const u32x2*)(hr + q * 256);
        v[q].x = __uint_as_float(hh.x << 16); v[q].y = __uint_as_float(hh.x & 0xffff0000u);
        v[q].z = __uint_as_float(hh.y << 16); v[q].w = __uint_as_float(hh.y & 0xffff0000u);
      }
      float s1 = 0.f;
#pragma unroll
      for (int q = 0; q < 4; ++q) s1 += (v[q].x + v[q].y) + (v[q].z + v[q].w);
      const float mu = wave_sum(s1) * (1.0f / 1024.0f);
      float s2 = 0.f;
#pragma unroll
      for (int q = 0; q < 4; ++q) {
        const float d0 = v[q].x - mu, d1 = v[q].y - mu, d2 = v[q].z - mu, d3 = v[q].w - mu;
        s2 += (d0 * d0 + d1 * d1) + (d2 * d2 + d3 * d3);
      }
      const float rstd = rsqrtf(wave_sum(s2) * (1.0f / 1024.0f) + LN_EPS);
#pragma unroll
      for (int q = 0; q < 4; ++q) {
        float4 o;
        o.x = (v[q].x - mu) * rstd * gm[q].x + bt[q].x; o.y = (v[q].y - mu) * rstd * gm[q].y + bt[q].y;
        o.z = (v[q].z - mu) * rstd * gm[q].z + bt[q].z; o.w = (v[q].w - mu) * rstd * gm[q].w + bt[q].w;
        *(float4*)(xr + q * 256) = o;
        store_bf16x4(p.xb + (size_t)(tokw + t) * 1024 + q * 256 + lane * 4, o.x, o.y, o.z, o.w);
      }
    }
  }
  asm volatile("s_waitcnt vmcnt(0)" ::: "memory");
  __syncthreads();
  const int j = lane & 15, g = lane >> 4;
  float* part = (float*)(smem + 1024);
  {
    const float* xr0 = p.x1 + (size_t)(batch * 32 + j) * 1024 + 256 * w + 8 * g;
    const float* xr1 = xr0 + 16 * 1024;
    const size_t wof = ((size_t)(8 * w * 4 + g) * 16 + j) * 8;
    f32x4 De0 = {0.f, 0.f, 0.f, 0.f}, Dg0 = De0, De1 = De0, Dg1 = De0;
#pragma unroll 2
    for (int kb = 0; kb < 8; ++kb) {
      const float4 xa0 = *(const float4*)(xr0 + kb * 32), xc0 = *(const float4*)(xr0 + kb * 32 + 4);
      const float4 xa1 = *(const float4*)(xr1 + kb * 32), xc1 = *(const float4*)(xr1 + kb * 32 + 4);
      const bf16x8 weh = *(const bf16x8*)(p.Wr_eh + wof + kb * 512), wel = *(const bf16x8*)(p.Wr_el + wof + kb * 512);
      const bf16x8 wgh = *(const bf16x8*)(p.Wr_gh + wof + kb * 512), wgl = *(const bf16x8*)(p.Wr_gl + wof + kb * 512);
      u32x4 h, lo;
      h.x = cvt_pk_bf16(xa0.x, xa0.y); h.y = cvt_pk_bf16(xa0.z, xa0.w); h.z = cvt_pk_bf16(xc0.x, xc0.y); h.w = cvt_pk_bf16(xc0.z, xc0.w);
      lo.x = cvt_pk_bf16(xa0.x - __uint_as_float(h.x << 16), xa0.y - __uint_as_float(h.x & 0xffff0000u));
      lo.y = cvt_pk_bf16(xa0.z - __uint_as_float(h.y << 16), xa0.w - __uint_as_float(h.y & 0xffff0000u));
      lo.z = cvt_pk_bf16(xc0.x - __uint_as_float(h.z << 16), xc0.y - __uint_as_float(h.z & 0xffff0000u));
      lo.w = cvt_pk_bf16(xc0.z - __uint_as_float(h.w << 16), xc0.w - __uint_as_float(h.w & 0xffff0000u));
      bf16x8 xh = __builtin_bit_cast(bf16x8, h), xl = __builtin_bit_cast(bf16x8, lo);
      De0 = __builtin_amdgcn_mfma_f32_16x16x32_bf16(weh, xh, De0, 0, 0, 0);
      Dg0 = __builtin_amdgcn_mfma_f32_16x16x32_bf16(wgh, xh, Dg0, 0, 0, 0);
      De0 = __builtin_amdgcn_mfma_f32_16x16x32_bf16(weh, xl, De0, 0, 0, 0);
      Dg0 = __builtin_amdgcn_mfma_f32_16x16x32_bf16(wgh, xl, Dg0, 0, 0, 0);
      De0 = __builtin_amdgcn_mfma_f32_16x16x32_bf16(wel, xh, De0, 0, 0, 0);
      Dg0 = __builtin_amdgcn_mfma_f32_16x16x32_bf16(wgl, xh, Dg0, 0, 0, 0);
      h.x = cvt_pk_bf16(xa1.x, xa1.y); h.y = cvt_pk_bf16(xa1.z, xa1.w); h.z = cvt_pk_bf16(xc1.x, xc1.y); h.w = cvt_pk_bf16(xc1.z, xc1.w);
      lo.x = cvt_pk_bf16(xa1.x - __uint_as_float(h.x << 16), xa1.y - __uint_as_float(h.x & 0xffff0000u));
      lo.y = cvt_pk_bf16(xa1.z - __uint_as_float(h.y << 16), xa1.w - __uint_as_float(h.y & 0xffff0000u));
      lo.z = cvt_pk_bf16(xc1.x - __uint_as_float(h.z << 16), xc1.y - __uint_as_float(h.z & 0xffff0000u));
      lo.w = cvt_pk_bf16(xc1.z - __uint_as_float(h.w << 16), xc1.w - __uint_as_float(h.w & 0xffff0000u));
      xh = __builtin_bit_cast(bf16x8, h); xl = __builtin_bit_cast(bf16x8, lo);
      De1 = __builtin_amdgcn_mfma_f32_16x16x32_bf16(weh, xh, De1, 0, 0, 0);
      Dg1 = __builtin_amdgcn_mfma_f32_16x16x32_bf16(wgh, xh, Dg1, 0, 0, 0);
      De1 = __builtin_amdgcn_mfma_f32_16x16x32_bf16(weh, xl, De1, 0, 0, 0);
      Dg1 = __builtin_amdgcn_mfma_f32_16x16x32_bf16(wgh, xl, Dg1, 0, 0, 0);
      De1 = __builtin_amdgcn_mfma_f32_16x16x32_bf16(wel, xh, De1, 0, 0, 0);
      Dg1 = __builtin_amdgcn_mfma_f32_16x16x32_bf16(wgl, xh, Dg1, 0, 0, 0);
    }
    float* pw = part + ((size_t)(w * 2) * 64 + lane) * 8;
    *(f32x4*)(pw) = De0; *(f32x4*)(pw + 4) = Dg0;
    *(f32x4*)(pw + 512) = De1; *(f32x4*)(pw + 516) = Dg1;
  }
  __syncthreads();
  const int tok = tokw + (j & 7);
  f32x4 De = {0.f, 0.f, 0.f, 0.f}, Dg = {0.f, 0.f, 0.f, 0.f};
  {
    const int ln = g * 16 + (w & 1) * 8 + (j & 7), tl = w >> 1;
#pragma unroll
    for (int ww = 0; ww < 4; ++ww) {
      const float* pr = part + ((size_t)(ww * 2 + tl) * 64 + ln) * 8;
      De += *(const f32x4*)(pr); Dg += *(const f32x4*)(pr + 4);
    }
  }
  float gl[4];
#pragma unroll
  for (int k = 0; k < 4; ++k) gl[k] = __shfl(Dg[k], j) + p.rg_b[l * 4 + k];
  int gs = 0; float gmax = gl[0];
#pragma unroll
  for (int k = 1; k < 4; ++k) { const bool bb = gl[k] > gmax; gmax = bb ? gl[k] : gmax; gs = bb ? k : gs; }
  float psum = 0.f;
#pragma unroll
  for (int k = 0; k < 4; ++k) psum += __expf(gl[k] - gmax);
  const float gate = 1.0f / psum;
  float es[4];
#pragma unroll
  for (int k = 0; k < 4; ++k) es[k] = De[k] + p.re_b[l * 16 + 4 * g + k];
  int i0 = 0; float v0 = es[0];
#pragma unroll
  for (int k = 1; k < 4; ++k) { const bool bb = es[k] > v0; v0 = bb ? es[k] : v0; i0 = bb ? k : i0; }
  int i1 = 0; float v1 = -3.0e38f;
#pragma unroll
  for (int k = 0; k < 4; ++k) { const bool bb = (k != i0) && (es[k] > v1); v1 = bb ? es[k] : v1; i1 = bb ? k : i1; }
  const float ex = __expf(v1 - v0);
  const float tw0 = 1.0f / (1.0f + ex), tw1 = ex / (1.0f + ex);
  const bool commit = (g == gs) && (j < 8);
  const int e0 = gs * 4 + i0, e1 = gs * 4 + i1;
  int lp0 = 0, lp1 = 0;
  if (commit) { lp0 = atomicAdd(&scnt[e0], 1); lp1 = atomicAdd(&scnt[e1], 1); }
  __syncthreads();
  if (tid < 16) sbase[tid] = atomicAdd(p.counts + l * 16 + tid, scnt[tid]);
  __syncthreads();
  if (commit) {
    const int pos0 = sbase[e0] + lp0, pos1 = sbase[e1] + lp1;
    p.list[e0 * NTOK + pos0] = tok; p.wlist[e0 * NTOK + pos0] = gate * tw0;
    p.list[e1 * NTOK + pos1] = tok; p.wlist[e1 * NTOK + pos1] = gate * tw1;
    int4 ti; ti.x = e0; ti.y = pos0; ti.z = e1; ti.w = pos1;
    *(int4*)(p.tokinfo + (size_t)tok * 4) = ti;
  }
}

__device__ __forceinline__ int moe_total_mtiles(const int* cnts) {
  int tot = 0;
#pragma unroll
  for (int e = 0; e < 16; ++e) tot += (cnts[e] + 127) >> 7;
  return tot;
}
__device__ __forceinline__ void moe_find(const int* cnts, int mi, int& e_out, int& ml, int& off, int& cnt) {
  int rem = mi, o = 0; e_out = 0; ml = 0; off = 0; cnt = 1;
  bool found = false;
#pragma unroll
  for (int e = 0; e < 16; ++e) {
    const int c = cnts[e], mtl = (c + 127) >> 7;
    if (!found && rem < mtl) { found = true; e_out = e; ml = rem; off = o; cnt = c; }
    rem -= mtl; o += c;
  }
}

__device__ void p5_tile(const Params& p, int l, int t, int mtot, unsigned char* smem) {
  const int mi = (t >> 5) * 8 + (t & 7), nt = (t >> 3) & 3;
  if (mi >= mtot) return;
  int e, ml, off, cnt;
  moe_find(p.counts + l * 16, mi, e, ml, off, cnt);
  const int tid = otid(), lane = tid & 63, wid = tid >> 6, wr = wid >> 1, wc = wid & 1;
  const int srow = tid >> 3, sch = tid & 7, qi = lane & 15, g = lane >> 4;
  const bf16_t* pa[4];
#pragma unroll
  for (int i = 0; i < 4; ++i) {
    const int ridx = min(ml * 128 + srow + 32 * i, cnt - 1);
    const int tok = p.list[e * NTOK + ridx];
    pa[i] = p.xb + (size_t)tok * 1024 + sch * 8;
  }
  const bf16_t* B = p.Wgu + ((size_t)e * 512 + nt * 128 + srow) * 1024 + sch * 8;
  f32x4 acc[4][4];
  ZERO_ACC(acc);
  gemm_main(smem, pa[0], pa[1], pa[2], pa[3], B, B + 32 * 1024, B + 64 * 1024, B + 96 * 1024, 16, -1, false, acc, NoMid());
#pragma unroll
  for (int i = 0; i < 4; ++i) {
    const int rloc = ml * 128 + wr * 64 + i * 16 + qi;
    if (rloc < cnt) {
      const size_t slot = (size_t)off + rloc;
#pragma unroll
      for (int jp = 0; jp < 2; ++jp) {
        const f32x4 ga = acc[i][2 * jp], up = acc[i][2 * jp + 1];
        const int col = 64 * nt + 32 * wc + 16 * jp + 4 * g;
        store_bf16x4(p.act + slot * 256 + col, silu(ga[0]) * up[0], silu(ga[1]) * up[1], silu(ga[2]) * up[2], silu(ga[3]) * up[3]);
      }
    }
  }
}

__device__ void p6_tile(const Params& p, int l, int t, int mtot, unsigned char* smem) {
  const int mi = (t >> 6) * 8 + (t & 7), nt = (t >> 3) & 7;
  if (mi >= mtot) return;
  int e, ml, off, cnt;
  moe_find(p.counts + l * 16, mi, e, ml, off, cnt);
  const int tid = otid(), lane = tid & 63, wid = tid >> 6, wr = wid >> 1, wc = wid & 1;
  const int srow = tid >> 3, sch = tid & 7, qi = lane & 15, g = lane >> 4;
  const bf16_t* pa[4];
#pragma unroll
  for (int i = 0; i < 4; ++i) {
    const int ridx = min(ml * 128 + srow + 32 * i, cnt - 1);
    pa[i] = p.act + ((size_t)off + ridx) * 256 + sch * 8;
  }
  const bf16_t* B = p.Wdn + ((size_t)e * 1024 + nt * 128 + srow) * 256 + sch * 8;
  f32x4 acc[4][4];
  ZERO_ACC(acc);
  gemm_main(smem, pa[0], pa[1], pa[2], pa[3], B, B + 32 * 256, B + 64 * 256, B + 96 * 256, 4, -1, false, acc, NoMid());
#pragma unroll
  for (int i = 0; i < 4; ++i) {
    const int rloc = ml * 128 + wr * 64 + i * 16 + qi;
    if (rloc < cnt) {
      const float wgt = p.wlist[e * NTOK + rloc];
      const size_t slot = (size_t)off + rloc;
#pragma unroll
      for (int j = 0; j < 4; ++j) {
        const int n = nt * 128 + wc * 64 + j * 16 + 4 * g;
        store_bf16x4(p.y + slot * 1024 + n, acc[i][j][0] * wgt, acc[i][j][1] * wgt, acc[i][j][2] * wgt, acc[i][j][3] * wgt);
      }
    }
  }
}

template <int NT>
__device__ __forceinline__ void p7_tokens(const Params& p, int l, int tok0, int tstride) {
  const int lane = otid() & 63;
  int4 ti[NT];
#pragma unroll
  for (int u = 0; u < NT; ++u) ti[u] = *(const int4*)(p.tokinfo + (size_t)(tok0 + u * tstride) * 4);
  int off0[NT], off1[NT];
#pragma unroll
  for (int u = 0; u < NT; ++u) { off0[u] = 0; off1[u] = 0; }
#pragma unroll
  for (int e = 0; e < 16; ++e) {
    const int c = p.counts[l * 16 + e];
#pragma unroll
    for (int u = 0; u < NT; ++u) { if (e < ti[u].x) off0[u] += c; if (e < ti[u].z) off1[u] += c; }
  }
  float4 xr[NT][4]; u32x2 ya[NT][4], yb[NT][4];
#pragma unroll
  for (int u = 0; u < NT; ++u) {
    const int tok = tok0 + u * tstride;
    const size_t s0 = (size_t)off0[u] + ti[u].y, s1 = (size_t)off1[u] + ti[u].w;
#pragma unroll
    for (int q = 0; q < 4; ++q) {
      const int c = q * 256 + lane * 4;
      xr[u][q] = *(const float4*)(p.x1 + (size_t)tok * 1024 + c);
      ya[u][q] = *(const u32x2*)(p.y + s0 * 1024 + c);
      yb[u][q] = *(const u32x2*)(p.y + s1 * 1024 + c);
    }
  }
  float4 gg[4], bb[4];
#pragma unroll
  for (int q = 0; q < 4; ++q) {
    gg[q] = *(const float4*)(p.ln2_g + l * 1024 + q * 256 + lane * 4);
    bb[q] = *(const float4*)(p.ln2_b + l * 1024 + q * 256 + lane * 4);
  }
#pragma unroll
  for (int u = 0; u < NT; ++u) {
    const int tok = tok0 + u * tstride;
    float hv[16];
#pragma unroll
    for (int q = 0; q < 4; ++q) {
      hv[q * 4 + 0] = ALPHA * xr[u][q].x + (__uint_as_float(ya[u][q].x << 16) + __uint_as_float(yb[u][q].x << 16));
      hv[q * 4 + 1] = ALPHA * xr[u][q].y + (__uint_as_float(ya[u][q].x & 0xffff0000u) + __uint_as_float(yb[u][q].x & 0xffff0000u));
      hv[q * 4 + 2] = ALPHA * xr[u][q].z + (__uint_as_float(ya[u][q].y << 16) + __uint_as_float(yb[u][q].y << 16));
      hv[q * 4 + 3] = ALPHA * xr[u][q].w + (__uint_as_float(ya[u][q].y & 0xffff0000u) + __uint_as_float(yb[u][q].y & 0xffff0000u));
    }
    float s1s = 0.f;
#pragma unroll
    for (int c = 0; c < 16; ++c) s1s += hv[c];
    const float mu = wave_sum(s1s) * (1.0f / 1024.0f);
    float s2 = 0.f;
#pragma unroll
    for (int c = 0; c < 16; ++c) { const float d = hv[c] - mu; s2 += d * d; }
    const float rstd = rsqrtf(wave_sum(s2) * (1.0f / 1024.0f) + LN_EPS);
#pragma unroll
    for (int q = 0; q < 4; ++q) {
      const int c = q * 256 + lane * 4;
      float4 o;
      o.x = (hv[q * 4 + 0] - mu) * rstd * gg[q].x + bb[q].x; o.y = (hv[q * 4 + 1] - mu) * rstd * gg[q].y + bb[q].y;
      o.z = (hv[q * 4 + 2] - mu) * rstd * gg[q].z + bb[q].z; o.w = (hv[q * 4 + 3] - mu) * rstd * gg[q].w + bb[q].w;
      if (l == 3) *(float4*)(p.out + (size_t)tok * 1024 + c) = o;
      else store_bf16x4(p.xb + (size_t)tok * 1024 + c, o.x, o.y, o.z, o.w);
    }
  }
}

#define XB_TMO      128
#define XB_XCNT(j)  (256  + 64 * (j))
#define XB_XSUB(j)  (1280 + 64 * (j))
#define XB_XGEN(j)  (2304 + 64 * (j))
#define XB_TOP      3328
#define XB_TOPGEN   3392
#define XCD_BAR_WORDS 3456
#define XB_SPIN_CAP (1u << 22)
__device__ __forceinline__ unsigned xb_ld(unsigned* p) { return __hip_atomic_load(p, __ATOMIC_RELAXED, __HIP_MEMORY_SCOPE_AGENT); }
__device__ __forceinline__ unsigned xb_add(unsigned* p, unsigned v) { return __hip_atomic_fetch_add(p, v, __ATOMIC_RELAXED, __HIP_MEMORY_SCOPE_AGENT); }
__device__ __forceinline__ unsigned xb_xcc_id() { return (unsigned)__builtin_amdgcn_s_getreg((3 << 11) | 20) & 0xFu; }
#define XB_SPIN(cond, bar) do { unsigned _sp = 0; while (cond) { __builtin_amdgcn_s_sleep(1); \
    if ((++_sp & 255u) == 0u) { if (xb_ld(&(bar)[XB_TMO])) break; if (_sp > XB_SPIN_CAP) { atomicAdd(&(bar)[XB_TMO], 1u); break; } } } } while (0)
struct XcdBarrier { unsigned* bar; unsigned x; volatile unsigned* st; };
__device__ __forceinline__ XcdBarrier xcd_barrier_post(unsigned* bar, volatile unsigned* st) {
  XcdBarrier b; b.bar = bar; b.x = xb_xcc_id(); b.st = st;
  if (threadIdx.x == 0) (void)xb_add(&bar[XB_XCNT(b.x)], 1u);
  return b;
}
__device__ __forceinline__ void xcd_barrier_complete(unsigned* bar, unsigned x, unsigned& nloc, unsigned& nx) {
  const unsigned G = gridDim.x;
  unsigned sum, cnt, mine, sp = 0u;
  for (;;) {
    sum = 0u; cnt = 0u; mine = 0u;
#pragma unroll
    for (unsigned j = 0; j < 16; ++j) { const unsigned c = xb_ld(&bar[XB_XCNT(j)]); sum += c; cnt += (c > 0u) ? 1u : 0u; mine = (j == x) ? c : mine; }
    if (sum == G) break;
    __builtin_amdgcn_s_sleep(1);
    if ((++sp & 255u) == 0u) { if (xb_ld(&bar[XB_TMO])) break; if (sp > XB_SPIN_CAP) { atomicAdd(&bar[XB_TMO], 1u); break; } }
  }
  nloc = mine > 0u ? mine : 1u; nx = cnt > 0u ? cnt : 1u;
}
__device__ __forceinline__ void xcd_barrier(const XcdBarrier& b) {
  asm volatile("s_waitcnt vmcnt(0)" ::: "memory");
  __syncthreads();
  if (threadIdx.x == 0) {
    unsigned* bar = b.bar;
    __builtin_amdgcn_s_waitcnt(0);
    unsigned nloc = b.st[0], nx = b.st[1];
    if (nloc == 0u) { xcd_barrier_complete(bar, b.x, nloc, nx); b.st[0] = nloc; b.st[1] = nx; }
    const unsigned old = xb_add(&bar[XB_XSUB(b.x)], 1u);
    const unsigned gen = old / nloc;
    if (old + 1u == (gen + 1u) * nloc) {
      __builtin_amdgcn_fence(__ATOMIC_RELEASE, "agent");
      asm volatile("s_waitcnt vmcnt(0)" ::: "memory");
      const unsigned og = xb_add(&bar[XB_TOP], 1u);
      const unsigned tg = og / nx;
      if (og + 1u == (tg + 1u) * nx) xb_add(&bar[XB_TOPGEN], 1u);
      else XB_SPIN(xb_ld(&bar[XB_TOPGEN]) == tg, bar);
      __builtin_amdgcn_fence(__ATOMIC_ACQUIRE, "agent");
      xb_add(&bar[XB_XGEN(b.x)], 1u);
      asm volatile("s_waitcnt vmcnt(0)" ::: "memory");
    } else {
      XB_SPIN(xb_ld(&bar[XB_XGEN(b.x)]) == gen, bar);
      __builtin_amdgcn_fence(__ATOMIC_ACQUIRE, "agent");
      asm volatile("s_waitcnt vmcnt(0)" ::: "memory");
    }
  }
  __syncthreads();
}

__device__ __forceinline__ void run_phase(const Params& p, int ph, int l, int bid, int nblk, unsigned char* smem, float* sbias) {
  switch (ph) {
    case 0: {
      if (bid == 0 && threadIdx.x < 64) p.counts[threadIdx.x] = 0;
      conv_x(p, bid, nblk);
      for (int it = bid; it < NCONV_ITEMS; it += nblk) conv_item(p, 0, it, smem);
    } break;
    case 1: for (int t = bid; t < 2560; t += nblk) p1_tile(p, l, t, smem); break;
    case 2:
      for (int it = bid; it < 3072; it += nblk) {
        if (it < 2048) attn_item(p, l, it, smem); else sgu_item(p, l, it - 2048, smem);
      }
      break;
    case 3: for (int t = bid; t < 1024; t += nblk) p3_tile(p, l, t, smem); break;
    case 4: for (int it = bid; it < NTOK / 32; it += nblk) p4_batch(p, l, it, smem); break;
    case 5: { const int mtot = moe_total_mtiles(p.counts + l * 16), nt = ((mtot + 7) >> 3) * 32; for (int t = bid; t < nt; t += nblk) p5_tile(p, l, t, mtot, smem); } break;
    case 6: { const int mtot = moe_total_mtiles(p.counts + l * 16), nt = ((mtot + 7) >> 3) * 64; for (int t = bid; t < nt; t += nblk) p6_tile(p, l, t, mtot, smem); } break;
    case 7: {
      { const int nw = nblk * 4; int tok = bid * 4 + (threadIdx.x >> 6);
        for (; tok + 3 * nw < NTOK; tok += 4 * nw) p7_tokens<4>(p, l, tok, nw);
        for (; tok < NTOK; tok += nw) p7_tokens<1>(p, l, tok, nw); }
      if (l < 3) for (int it = bid; it < NCONV_ITEMS; it += nblk) conv_item(p, l + 1, it, smem);
    } break;
  }
}

template <int PH>
__global__ void __launch_bounds__(256, 2) phase_kernel(Params p, int l) {
  __shared__ __attribute__((aligned(16))) unsigned char smem[SMEM_BYTES];
  run_phase(p, PH, l, blockIdx.x, gridDim.x, smem, (float*)smem);
}

#if MEGA
__global__ void __launch_bounds__(256, 2) mega_kernel(Params p) {
  __shared__ __attribute__((aligned(16))) unsigned char smem[SMEM_BYTES];
  __shared__ uint4 xb_words;
  float* sbias = (float*)smem;
  cg::grid_group grid = cg::this_grid();
  const int bid = blockIdx.x, nblk = gridDim.x;
  if (threadIdx.x == 0) xb_words = make_uint4(0u, 0u, 0u, 0u);
  __syncthreads();
  XcdBarrier xb = xcd_barrier_post(p.bar, (volatile unsigned*)&xb_words);
  run_phase(p, 0, 0, bid, nblk, smem, sbias);
  if (p.never) grid.sync();
  xcd_barrier(xb);
#pragma unroll 1
  for (int l = 0; l < 4; ++l) {
#pragma unroll 1
    for (int ph = 1; ph <= 7; ++ph) {
      run_phase(p, ph, l, bid, nblk, smem, sbias);
#if DUP_PH
      if (ph == DUP_PH) { xcd_barrier(xb); run_phase(p, ph, l, bid, nblk, smem, sbias); }
#endif
      if (!(l == 3 && ph == 7)) xcd_barrier(xb);
    }
  }
}
#endif

extern "C" void kernel_launch(void* const* d_in, const int* in_sizes, int n_in, void* d_out, int out_size, void* d_ws,
                              size_t ws_size, hipStream_t stream) {
  Params p{};
  p.x = (const float*)d_in[0]; p.w_in = (const float*)d_in[1]; p.w_out = (const float*)d_in[2]; p.rel_bias = (const float*)d_in[3];
  p.sgu_ln_g = (const float*)d_in[4]; p.sgu_ln_b = (const float*)d_in[5]; p.sgu_w = (const float*)d_in[6]; p.sgu_b = (const float*)d_in[7];
  p.mix_g = (const float*)d_in[8]; p.ln1_g = (const float*)d_in[9]; p.ln1_b = (const float*)d_in[10];
  p.rg_w = (const float*)d_in[11]; p.rg_b = (const float*)d_in[12]; p.re_w = (const float*)d_in[13]; p.re_b = (const float*)d_in[14];
  p.w_gate = (const float*)d_in[15]; p.w_up = (const float*)d_in[16]; p.w_down = (const float*)d_in[17];
  p.ln2_g = (const float*)d_in[18]; p.ln2_b = (const float*)d_in[19];
  p.out = (float*)d_out;
  unsigned char* w = (unsigned char*)d_ws;
  size_t o = 0;
  auto take = [&](size_t bytes) { unsigned char* r = w + o; o += (bytes + 255) & ~(size_t)255; return r; };
  p.Wt_in = (bf16_t*)take((size_t)2560 * 1024 * 2);
  p.Wt_out = (bf16_t*)take((size_t)1024 * 1024 * 2);
  p.Wgu = (bf16_t*)take((size_t)16 * 512 * 1024 * 2);
  p.Wdn = (bf16_t*)take((size_t)16 * 1024 * 256 * 2);
  p.Wsgu = (bf16_t*)take((size_t)8 * 128 * 128 * 2);
  p.xb = (bf16_t*)take((size_t)NTOK * 1024 * 2);
  p.x1 = (float*)take((size_t)NTOK * 1024 * 4);
  unsigned char* r1 = take((size_t)NTOK * 2560 * 2);
  p.qk = (bf16_t*)r1;
  p.vT = (bf16_t*)(r1 + (size_t)NTOK * 1024 * 2);
  p.ub = (bf16_t*)(r1 + (size_t)NTOK * 1536 * 2);
  p.vnT = (bf16_t*)(r1 + (size_t)NTOK * 2048 * 2);
  p.y = (bf16_t*)r1;
  p.hb = (bf16_t*)r1;
  unsigned char* r2 = take((size_t)NTOK * 1024 * 2);
  p.mixed = (bf16_t*)r2;
  p.act = (bf16_t*)r2;
  p.ssq = (float*)take((size_t)NTOK * 16 * 4);
  p.wlist = (float*)take((size_t)16 * NTOK * 4);
  p.list = (int*)take((size_t)16 * NTOK * 4);
  p.tokinfo = (int*)take((size_t)NTOK * 4 * 4);
  p.counts = (int*)take(256);
  p.Wr_eh = (bf16_t*)take(16384 * 2); p.Wr_el = (bf16_t*)take(16384 * 2);
  p.Wr_gh = (bf16_t*)take(16384 * 2); p.Wr_gl = (bf16_t*)take(16384 * 2);
  p.bar = (unsigned*)take(XCD_BAR_WORDS * 4);
#if MEGA
  static int grid_blocks = 0;
  if (!grid_blocks) {
    int dev = 0, cus = 0, per_cu = 0;
    hipGetDevice(&dev);
    hipDeviceGetAttribute(&cus, hipDeviceAttributeMultiprocessorCount, dev);
    hipOccupancyMaxActiveBlocksPerMultiprocessor(&per_cu, mega_kernel, 256, 0);
    if (per_cu > 2) per_cu = 2;
    grid_blocks = cus * per_cu;
  }
  (void)hipMemsetAsync(p.bar, 0, XCD_BAR_WORDS * 4, stream);
  void* args[] = {&p};
  hipError_t e = hipLaunchCooperativeKernel((void*)mega_kernel, dim3(grid_blocks), dim3(256), args, 0, stream);
  if (e != hipSuccess) fprintf(stderr, "cooperative launch failed: %s (grid %d)\n", hipGetErrorString(e), grid_blocks);
#else
  const int G = 512;
  phase_kernel<0><<<G, 256, 0, stream>>>(p, 0);
  for (int l = 0; l < 4; ++l) {
    phase_kernel<1><<<G, 256, 0, stream>>>(p, l);
    phase_kernel<2><<<G, 256, 0, stream>>>(p, l);
    phase_kernel<3><<<G, 256, 0, stream>>>(p, l);
    phase_kernel<4><<<G, 256, 0, stream>>>(p, l);
    phase_kernel<5><<<G, 256, 0, stream>>>(p, l);
    phase_kernel<6><<<G, 256, 0, stream>>>(p, l);
    phase_kernel<7><<<G, 256, 0, stream>>>(p, l);
  }
#endif
}
```

```cpp
#include <hip/hip_runtime.h>
#include <hip/hip_cooperative_groups.h>
#include <stdint.h>
#include <cstdio>
namespace cg = cooperative_groups;

#ifndef MEGA
#define MEGA 1
#endif
#define DUP_PH 0

typedef unsigned short bf16_t;
typedef short bf16x8 __attribute__((ext_vector_type(8)));
typedef float f32x4 __attribute__((ext_vector_type(4)));
typedef unsigned u32x4 __attribute__((ext_vector_type(4)));
typedef unsigned u32x2 __attribute__((ext_vector_type(2)));

#define NTOK 16384
#define LN_EPS 1e-5f
#define ALPHA 1.681792830507429f
#define NCONV_ITEMS 3985
#define SMEM_BYTES 69632

struct Params {
  const float *x, *w_in, *w_out, *rel_bias, *sgu_ln_g, *sgu_ln_b, *sgu_w, *sgu_b, *mix_g, *ln1_g, *ln1_b,
      *rg_w, *rg_b, *re_w, *re_b, *w_gate, *w_up, *w_down, *ln2_g, *ln2_b;
  float* out;
  bf16_t *Wt_in, *Wt_out, *Wgu, *Wdn, *Wsgu, *xb, *qk, *vT, *ub, *vnT, *mixed, *act, *y, *hb;
  float *x1, *ssq, *wlist;
  bf16_t *Wr_eh, *Wr_el, *Wr_gh, *Wr_gl;
  int *counts, *list, *tokinfo;
  unsigned* bar;
  int never;
  int pad_;
};

__device__ __forceinline__ unsigned cvt_pk_bf16(float lo, float hi) {
  unsigned r; asm("v_cvt_pk_bf16_f32 %0, %1, %2" : "=v"(r) : "v"(lo), "v"(hi)); return r;
}
__device__ __forceinline__ void store_bf16x4(bf16_t* p, float a, float b, float c, float d) {
  u32x2 v; v.x = cvt_pk_bf16(a, b); v.y = cvt_pk_bf16(c, d); *(u32x2*)p = v;
}
__device__ __forceinline__ float gelu_tanh(float x) {
  float z = 0.7978845608028654f * (x + 0.044715f * x * x * x);
  return x / (1.0f + __expf(-2.0f * z));
}
__device__ __forceinline__ int otid() { int t = threadIdx.x; asm volatile("" : "+v"(t)); return t; }
__device__ __forceinline__ float silu(float x) { return x / (1.0f + __expf(-x)); }
template <int CTRL>
__device__ __forceinline__ float dpp_mov(float v) {
  return __builtin_bit_cast(float, __builtin_amdgcn_update_dpp(0, __builtin_bit_cast(int, v), CTRL, 0xf, 0xf, true));
}
__device__ __forceinline__ float row16_sum(float v) {
  v += dpp_mov<0xB1>(v); v += dpp_mov<0x4E>(v); v += dpp_mov<0x141>(v); v += dpp_mov<0x140>(v); return v;
}
__device__ __forceinline__ float wave_sum(float v) {
  v = row16_sum(v); v += __shfl_xor(v, 16); v += __shfl_xor(v, 32); return v;
}

struct NoMid { __device__ __forceinline__ void operator()(f32x4 (&)[4][4]) const {} };
struct MidScale {
  float s[4];
  __device__ __forceinline__ void operator()(f32x4 (&acc)[4][4]) const {
#pragma unroll
    for (int i = 0; i < 4; ++i)
#pragma unroll
      for (int j = 0; j < 4; ++j) acc[i][j] *= s[i];
  }
};

#define GLDS16(gptr, lptr) __builtin_amdgcn_global_load_lds((const unsigned*)(gptr), (__attribute__((address_space(3))) unsigned*)(lptr), 16, 0, 0)

template <class Mid>
__device__ __forceinline__ void gemm_main(unsigned char* smem, const bf16_t* pa0, const bf16_t* pa1, const bf16_t* pa2,
                                          const bf16_t* pa3, const bf16_t* pb0, const bf16_t* pb1, const bf16_t* pb2,
                                          const bf16_t* pb3, int nk, int kmid, bool swapped, f32x4 (&acc)[4][4],
                                          const Mid& mid) {
  const int tid = otid(), lane = tid & 63, wid = tid >> 6, wr = wid >> 1, wc = wid & 1;
  const int srow = tid >> 3;
  const int lch = ((tid & 7) ^ ((srow >> 1) & 7)) * 8 - (tid & 7) * 8;
  pa0 += lch; pa1 += lch; pa2 += lch; pa3 += lch; pb0 += lch; pb1 += lch; pb2 += lch; pb3 += lch;
  const int soff = __builtin_amdgcn_readfirstlane(wid) * 1024;
  const int qi = lane & 15, g = lane >> 4, s = qi >> 1;
  const int aside = swapped ? 16384 : 0, bside = swapped ? 0 : 16384;
  const int offA0 = aside + (wr * 64 + qi) * 128 + (((0 + g) ^ s) << 4);
  const int offA1 = aside + (wr * 64 + qi) * 128 + (((4 + g) ^ s) << 4);
  const int offB0 = bside + (wc * 64 + qi) * 128 + (((0 + g) ^ s) << 4);
  const int offB1 = bside + (wc * 64 + qi) * 128 + (((4 + g) ^ s) << 4);
  {
    unsigned char* d = smem + soff;
    GLDS16(pa0, d); GLDS16(pa1, d + 4096); GLDS16(pa2, d + 8192); GLDS16(pa3, d + 12288);
    GLDS16(pb0, d + 16384); GLDS16(pb1, d + 20480); GLDS16(pb2, d + 24576); GLDS16(pb3, d + 28672);
  }
  asm volatile("s_waitcnt vmcnt(0)" ::: "memory");
  __syncthreads();
  for (int kt = 0; kt < nk; ++kt) {
    unsigned char* buf = smem + ((kt & 1) << 15);
    if (kt + 1 < nk) {
      const int ko = (kt + 1) * 64;
      unsigned char* d = smem + (((kt + 1) & 1) << 15) + soff;
      GLDS16(pa0 + ko, d); GLDS16(pa1 + ko, d + 4096); GLDS16(pa2 + ko, d + 8192); GLDS16(pa3 + ko, d + 12288);
      GLDS16(pb0 + ko, d + 16384); GLDS16(pb1 + ko, d + 20480); GLDS16(pb2 + ko, d + 24576); GLDS16(pb3 + ko, d + 28672);
    }
    if (kt == kmid) mid(acc);
    {
      bf16x8 af0[4], bf0[4], af1[4], bf1[4];
#pragma unroll
      for (int i = 0; i < 4; ++i) af0[i] = *(const bf16x8*)(buf + offA0 + i * 2048);
#pragma unroll
      for (int j = 0; j < 4; ++j) bf0[j] = *(const bf16x8*)(buf + offB0 + j * 2048);
#pragma unroll
      for (int i = 0; i < 4; ++i) af1[i] = *(const bf16x8*)(buf + offA1 + i * 2048);
#pragma unroll
      for (int j = 0; j < 4; ++j) bf1[j] = *(const bf16x8*)(buf + offB1 + j * 2048);
      asm volatile("s_waitcnt lgkmcnt(8)" ::: "memory");
      __builtin_amdgcn_s_setprio(1);
#pragma unroll
      for (int i = 0; i < 4; ++i)
#pragma unroll
        for (int j = 0; j < 4; ++j) acc[i][j] = __builtin_amdgcn_mfma_f32_16x16x32_bf16(bf0[j], af0[i], acc[i][j], 0, 0, 0);
      asm volatile("s_waitcnt lgkmcnt(0)" ::: "memory");
#pragma unroll
      for (int i = 0; i < 4; ++i)
#pragma unroll
        for (int j = 0; j < 4; ++j) acc[i][j] = __builtin_amdgcn_mfma_f32_16x16x32_bf16(bf1[j], af1[i], acc[i][j], 0, 0, 0);
      __builtin_amdgcn_s_setprio(0);
    }
    asm volatile("s_waitcnt vmcnt(0)" ::: "memory");
    __syncthreads();
  }
}

#define ZERO_ACC(acc)                                   \
  _Pragma("unroll") for (int i_ = 0; i_ < 4; ++i_)      \
  _Pragma("unroll") for (int j_ = 0; j_ < 4; ++j_) acc[i_][j_] = (f32x4){0.f, 0.f, 0.f, 0.f};

__device__ void conv_x(const Params& p, int bid, int nblk) {
  const size_t n8 = (size_t)NTOK * 1024 / 8;
  for (size_t i = (size_t)bid * 256 + threadIdx.x; i < n8; i += (size_t)nblk * 256) {
    const float4 a = *(const float4*)(p.x + i * 8), b = *(const float4*)(p.x + i * 8 + 4);
    u32x4 v; v.x = cvt_pk_bf16(a.x, a.y); v.y = cvt_pk_bf16(a.z, a.w); v.z = cvt_pk_bf16(b.x, b.y); v.w = cvt_pk_bf16(b.z, b.w);
    *(u32x4*)(p.xb + i * 8) = v;
  }
}

__device__ void tconv_tile(float* tile, const float* src, int src_ld, const float* kscale, bf16_t* dst, int dst_ld, int rstep) {
  const int t = otid();
#pragma unroll
  for (int i = 0; i < 4; ++i) {
    const int k = (t >> 4) + 16 * i, n4 = (t & 15) * 4;
    float4 v = *(const float4*)(src + (size_t)k * src_ld + n4);
    if (kscale) { const float sc = kscale[k]; v.x *= sc; v.y *= sc; v.z *= sc; v.w *= sc; }
    float* d = tile + k * 65 + n4;
    d[0] = v.x; d[1] = v.y; d[2] = v.z; d[3] = v.w;
  }
  __syncthreads();
  {
    const int n = t >> 2, kc = (t & 3) * 16;
    float f[16];
#pragma unroll
    for (int q = 0; q < 16; ++q) f[q] = tile[(kc + q) * 65 + n];
    u32x4 v0, v1;
    v0.x = cvt_pk_bf16(f[0], f[1]); v0.y = cvt_pk_bf16(f[2], f[3]); v0.z = cvt_pk_bf16(f[4], f[5]); v0.w = cvt_pk_bf16(f[6], f[7]);
    v1.x = cvt_pk_bf16(f[8], f[9]); v1.y = cvt_pk_bf16(f[10], f[11]); v1.z = cvt_pk_bf16(f[12], f[13]); v1.w = cvt_pk_bf16(f[14], f[15]);
    bf16_t* o = dst + (size_t)((n >> 4) * rstep + (n & 15)) * dst_ld + kc;
    *(u32x4*)o = v0; *(u32x4*)(o + 8) = v1;
  }
  __syncthreads();
}

__device__ void conv_item(const Params& p, int l, int it, unsigned char* smem) {
  float* tile = (float*)smem;
  if (it < 640) {
    const int kt = it / 40, ntile = it % 40;
    tconv_tile(tile, p.w_in + (size_t)l * 1024 * 2560 + (size_t)kt * 64 * 2560 + ntile * 64, 2560, nullptr,
               p.Wt_in + (size_t)ntile * 64 * 1024 + kt * 64, 1024, 16);
  } else if (it < 896) {
    const int r = it - 640, kt = r / 16, ntile = r % 16;
    tconv_tile(tile, p.w_out + (size_t)l * 1024 * 1024 + (size_t)kt * 64 * 1024 + ntile * 64, 1024, p.mix_g + l * 1024 + kt * 64,
               p.Wt_out + (size_t)ntile * 64 * 1024 + kt * 64, 1024, 16);
  } else if (it < 2944) {
    const int r0 = it - 896, e = r0 >> 7, r = r0 & 127, which = r >> 6, r2 = r & 63, kt = r2 >> 2, ntile = r2 & 3;
    const float* src = (which ? p.w_up : p.w_gate) + (size_t)(l * 16 + e) * 1024 * 256 + (size_t)kt * 64 * 256 + ntile * 64;
    tconv_tile(tile, src, 256, nullptr, p.Wgu + (size_t)e * 512 * 1024 + (size_t)(ntile * 128 + which * 16) * 1024 + kt * 64, 1024, 32);
  } else if (it < 3968) {
    const int r0 = it - 2944, e = r0 >> 6, r = r0 & 63, kt = r >> 4, ntile = r & 15;
    tconv_tile(tile, p.w_down + (size_t)(l * 16 + e) * 256 * 1024 + (size_t)kt * 64 * 1024 + ntile * 64, 1024, nullptr,
               p.Wdn + (size_t)e * 1024 * 256 + (size_t)ntile * 64 * 256 + kt * 64, 256, 16);
  } else if (it == 3984) {
    for (int i = threadIdx.x; i < 16384; i += 256) {
      const int jj = i & 7, j = (i >> 3) & 15, g = (i >> 7) & 3, kb = i >> 9;
      const int k = 32 * kb + 8 * g + jj;
      const float we = p.re_w[(size_t)(l * 1024 + k) * 16 + j];
      const float wg = (j < 4) ? p.rg_w[(size_t)(l * 1024 + k) * 4 + j] : 0.0f;
      const unsigned eh = cvt_pk_bf16(we, 0.f) & 0xffffu, gh = cvt_pk_bf16(wg, 0.f) & 0xffffu;
      const unsigned el = cvt_pk_bf16(we - __uint_as_float(eh << 16), 0.f) & 0xffffu;
      const unsigned gl = cvt_pk_bf16(wg - __uint_as_float(gh << 16), 0.f) & 0xffffu;
      p.Wr_eh[i] = (bf16_t)eh; p.Wr_el[i] = (bf16_t)el; p.Wr_gh[i] = (bf16_t)gh; p.Wr_gl[i] = (bf16_t)gl;
    }
  } else {
    const int j = it - 3968;
    const float* src = p.sgu_w + (size_t)l * 131072 + (size_t)j * 8192 + threadIdx.x * 32;
    bf16_t* dst = p.Wsgu + (size_t)j * 8192 + threadIdx.x * 32;
#pragma unroll
    for (int q = 0; q < 4; ++q) {
      const float4 a = *(const float4*)(src + q * 8), b = *(const float4*)(src + q * 8 + 4);
      u32x4 v; v.x = cvt_pk_bf16(a.x, a.y); v.y = cvt_pk_bf16(a.z, a.w); v.z = cvt_pk_bf16(b.x, b.y); v.w = cvt_pk_bf16(b.z, b.w);
      *(u32x4*)(dst + q * 8) = v;
    }
  }
}

__device__ void p1_tile(const Params& p, int l, int t, unsigned char* smem) {
  const int x_ = t & 7, j_ = t >> 3, rd_ = j_ >> 6, lb_ = j_ & 63;
  const int mt = (rd_ < 4) ? (x_ * 16 + (rd_ & 1) * 8 + (lb_ & 7)) : (x_ * 16 + (lb_ & 15));
  const int nt = (rd_ < 4) ? ((rd_ >> 1) * 8 + (lb_ >> 3)) : (16 + (lb_ >> 4));
  const int type = nt >> 2;
  const bool swapped = (type == 2) || (type == 4);
  const int tid = otid(), lane = tid & 63, wid = tid >> 6, wr = wid >> 1, wc = wid & 1;
  const int srow = tid >> 3, sch = tid & 7, qi = lane & 15, g = lane >> 4;
  const bf16_t* A = p.xb + (size_t)(mt * 128 + srow) * 1024 + sch * 8;
  const bf16_t* B = p.Wt_in + (size_t)(nt * 128 + srow) * 1024 + sch * 8;
  f32x4 acc[4][4];
  ZERO_ACC(acc);
  gemm_main(smem, A, A + 32 * 1024, A + 64 * 1024, A + 96 * 1024, B, B + 32 * 1024, B + 64 * 1024, B + 96 * 1024, 16, -1, swapped, acc, NoMid());
  if (!swapped) {
#pragma unroll
    for (int i = 0; i < 4; ++i) {
      const int m = mt * 128 + wr * 64 + i * 16 + qi;
#pragma unroll
      for (int j = 0; j < 4; ++j) {
        const int n = nt * 128 + wc * 64 + j * 16 + 4 * g;
        f32x4 v = acc[i][j];
        if (type == 0) v *= 0.125f;
        if (type == 3) { v[0] = gelu_tanh(v[0]); v[1] = gelu_tanh(v[1]); v[2] = gelu_tanh(v[2]); v[3] = gelu_tanh(v[3]); }
        bf16_t* dst = (type == 3) ? (p.ub + (size_t)m * 512 + (n - 1536)) : (p.qk + (size_t)m * 1024 + n);
        store_bf16x4(dst, v[0], v[1], v[2], v[3]);
      }
    }
  } else {
    const int bidx = (mt * 128) >> 12, tokbase = (mt * 128) & 4095;
    bf16_t* dstb = (type == 2) ? p.vT : p.vnT;
    const int fbase = (type == 2) ? 1024 : 2048;
    if (type == 4) {
#pragma unroll
      for (int i = 0; i < 4; ++i)
#pragma unroll
        for (int j = 0; j < 4; ++j)
#pragma unroll
          for (int r = 0; r < 4; ++r) acc[i][j][r] = gelu_tanh(acc[i][j][r]);
      float gam[4], bet[4];
#pragma unroll
      for (int i = 0; i < 4; ++i) {
        const int f = nt * 128 + wr * 64 + i * 16 + qi - 2048;
        gam[i] = p.sgu_ln_g[l * 512 + f]; bet[i] = p.sgu_ln_b[l * 512 + f];
      }
#pragma unroll
      for (int j = 0; j < 4; ++j)
#pragma unroll
        for (int r = 0; r < 4; ++r) {
          float s1 = acc[0][j][r] + acc[1][j][r] + acc[2][j][r] + acc[3][j][r];
          s1 = row16_sum(s1);
          const float mu = s1 * (1.0f / 64.0f);
          float s2 = 0.f;
#pragma unroll
          for (int i = 0; i < 4; ++i) { const float d = acc[i][j][r] - mu; s2 += d * d; }
          s2 = row16_sum(s2);
          const float rstd = rsqrtf(s2 * (1.0f / 64.0f) + LN_EPS);
#pragma unroll
          for (int i = 0; i < 4; ++i) acc[i][j][r] = (acc[i][j][r] - mu) * rstd * gam[i] + bet[i];
        }
    }
#pragma unroll
    for (int i = 0; i < 4; ++i) {
      const int f = nt * 128 + wr * 64 + i * 16 + qi - fbase;
#pragma unroll
      for (int j = 0; j < 4; ++j) {
        const int tok = tokbase + wc * 64 + j * 16 + 4 * g;
        store_bf16x4(dstb + ((size_t)(bidx * 512 + f)) * 4096 + tok, acc[i][j][0], acc[i][j][1], acc[i][j][2], acc[i][j][3]);
      }
    }
  }
}

__device__ void attn_phase(const Params& p, int l, int bid, int nblk, unsigned char* smem) {
  const int tid = otid(), lane = tid & 63, w = tid >> 6, qi = lane & 15, g = lane >> 4;
  unsigned char* Kb = smem;
  unsigned char* Vb = smem + 32768;
  float* sbias = (float*)(smem + 32768 + 33792);
  const int c0 = (w == 0) ? 0 : (w == 1) ? 8 : (w == 2) ? 24 : 32;
  const int cq = 16 * w + qi, cs = min(max(cq - 8, 0), 48);
  const int krow = tid >> 3, kch = tid & 7;
  const int ksoff = krow * 128 + ((kch ^ ((krow >> 1) & 7)) << 4);
  const int vd = tid >> 5, vc = tid & 31;
  const int vsoff = vd * 528 + vc * 16;
  u32x4 st[8], st2[8];
#define ATT_ISSUE_K(it_)                                                                                              \
  do {                                                                                                                \
    const int h_ = (it_) & 7, br_ = (it_) >> 3, r_ = br_ & 63, b_ = br_ >> 6, rs_ = min(max(r_ - 4, 0), 56);          \
    const bf16_t* kg_ = p.qk + ((size_t)b_ * 4096 + rs_ * 64 + krow) * 1024 + 512 + h_ * 64 + kch * 8;                \
    _Pragma("unroll") for (int i = 0; i < 8; ++i) st[i] = *(const u32x4*)(kg_ + (size_t)(32 * i) * 1024);            \
    _Pragma("unroll") for (int i = 0; i < 8; ++i) st2[i] = *(const u32x4*)(kg_ + (size_t)(256 + 32 * i) * 1024);     \
  } while (0)
  int it = bid;
  if (it < 2048) ATT_ISSUE_K(it);
  while (it < 2048) {
    const int h = it & 7, br = it >> 3, r = br & 63, b = br >> 6;
    const int rs = min(max(r - 4, 0), 56);
    const size_t tokq = (size_t)b * 4096 + r * 64 + cq;
    const bf16_t* vg = p.vT + ((size_t)(b * 512 + h * 64 + vd)) * 4096 + rs * 64 + vc * 8;
    const float rb0 = p.rel_bias[(size_t)(l * 8 + h) * 465 + tid];
    const float rb1 = p.rel_bias[(size_t)(l * 8 + h) * 465 + min(tid + 256, 464)];
    bf16x8 qf0 = *(const bf16x8*)(p.qk + tokq * 1024 + h * 64 + g * 8);
    bf16x8 qf1 = *(const bf16x8*)(p.qk + tokq * 1024 + h * 64 + 32 + g * 8);
    __syncthreads();
    sbias[tid] = rb0;
    if (tid + 256 < 465) sbias[tid + 256] = rb1;
#pragma unroll
    for (int i = 0; i < 8; ++i) *(u32x4*)(Kb + ksoff + i * 4096) = st[i];
#pragma unroll
    for (int i = 0; i < 8; ++i) st[i] = *(const u32x4*)(vg + (size_t)(8 * i) * 4096);
    __syncthreads();
    f32x4 s[8][2];
#pragma unroll
    for (int jh = 0; jh < 2; ++jh) {
#pragma unroll
      for (int jj = 0; jj < 4; ++jj)
#pragma unroll
        for (int ch = 0; ch < 2; ++ch) {
          const int kl = jj * 64 + c0 + 16 * ch + qi;
          const int sw = (kl >> 1) & 7;
          const bf16x8 kf0 = *(const bf16x8*)(Kb + kl * 128 + (((0 + g) ^ sw) << 4));
          const bf16x8 kf1 = *(const bf16x8*)(Kb + kl * 128 + (((4 + g) ^ sw) << 4));
          f32x4 a = {0.f, 0.f, 0.f, 0.f};
          a = __builtin_amdgcn_mfma_f32_16x16x32_bf16(kf0, qf0, a, 0, 0, 0);
          a = __builtin_amdgcn_mfma_f32_16x16x32_bf16(kf1, qf1, a, 0, 0, 0);
          s[jh * 4 + jj][ch] = a;
        }
      if (jh == 0) {
        __syncthreads();
#pragma unroll
        for (int i = 0; i < 8; ++i) *(u32x4*)(Kb + ksoff + i * 4096) = st2[i];
#pragma unroll
        for (int i = 0; i < 8; ++i) st2[i] = *(const u32x4*)(vg + (size_t)(8 * i) * 4096 + 256);
        __syncthreads();
      }
    }
#pragma unroll
    for (int i = 0; i < 8; ++i) *(u32x4*)(Vb + vsoff + i * 8 * 528) = st[i];
    float mx = -1e30f;
#pragma unroll
    for (int j = 0; j < 8; ++j)
#pragma unroll
      for (int ch = 0; ch < 2; ++ch)
#pragma unroll
        for (int rg = 0; rg < 4; ++rg) {
          const int kc = c0 + 16 * ch + 4 * g + rg;
          const bool valid = (kc >= cs) && (kc < cs + 16);
          const int bidx = valid ? ((rs + j - r + 7) * 31 + (kc - cq) + 15) : 0;
          const float v = valid ? (s[j][ch][rg] + sbias[bidx]) : -1e30f;
          s[j][ch][rg] = v;
          mx = fmaxf(mx, v);
        }
    mx = fmaxf(mx, __shfl_xor(mx, 16)); mx = fmaxf(mx, __shfl_xor(mx, 32));
    float sum = 0.f;
#pragma unroll
    for (int j = 0; j < 8; ++j)
#pragma unroll
      for (int ch = 0; ch < 2; ++ch)
#pragma unroll
        for (int rg = 0; rg < 4; ++rg) { const float e = __expf(s[j][ch][rg] - mx); s[j][ch][rg] = e; sum += e; }
    sum += __shfl_xor(sum, 16); sum += __shfl_xor(sum, 32);
    const float inv = 1.0f / sum;
    bf16x8 pf[8];
#pragma unroll
    for (int j = 0; j < 8; ++j) {
      u32x4 pw;
      pw.x = cvt_pk_bf16(s[j][0][0], s[j][0][1]); pw.y = cvt_pk_bf16(s[j][0][2], s[j][0][3]);
      pw.z = cvt_pk_bf16(s[j][1][0], s[j][1][1]); pw.w = cvt_pk_bf16(s[j][1][2], s[j][1][3]);
      pf[j] = __builtin_bit_cast(bf16x8, pw);
    }
    f32x4 o[4];
#pragma unroll
    for (int dt = 0; dt < 4; ++dt) o[dt] = (f32x4){0.f, 0.f, 0.f, 0.f};
    const int itn = it + nblk;
    __syncthreads();
#pragma unroll
    for (int jh = 0; jh < 2; ++jh) {
#pragma unroll
      for (int jj = 0; jj < 4; ++jj)
#pragma unroll
        for (int dt = 0; dt < 4; ++dt) {
          const unsigned char* vp = Vb + (dt * 16 + qi) * 528 + (jj * 64 + c0 + 4 * g) * 2;
          const u32x2 lo = *(const u32x2*)vp, hi = *(const u32x2*)(vp + 32);
          u32x4 vw; vw.x = lo.x; vw.y = lo.y; vw.z = hi.x; vw.w = hi.y;
          o[dt] = __builtin_amdgcn_mfma_f32_16x16x32_bf16(__builtin_bit_cast(bf16x8, vw), pf[jh * 4 + jj], o[dt], 0, 0, 0);
        }
      if (jh == 0) {
        __syncthreads();
#pragma unroll
        for (int i = 0; i < 8; ++i) *(u32x4*)(Vb + vsoff + i * 8 * 528) = st2[i];
        if (itn < 2048) ATT_ISSUE_K(itn);
        __syncthreads();
      }
    }
    float sq = 0.f;
#pragma unroll
    for (int dt = 0; dt < 4; ++dt) {
      o[dt] *= inv;
      sq += o[dt][0] * o[dt][0] + o[dt][1] * o[dt][1] + o[dt][2] * o[dt][2] + o[dt][3] * o[dt][3];
      store_bf16x4(p.mixed + tokq * 1024 + h * 64 + dt * 16 + 4 * g, o[dt][0], o[dt][1], o[dt][2], o[dt][3]);
    }
    sq += __shfl_xor(sq, 16); sq += __shfl_xor(sq, 32);
    if (g == 0) p.ssq[tokq * 16 + h] = sq;
    it = itn;
  }
#undef ATT_ISSUE_K
}

__device__ void sgu_item(const Params& p, int l, int it, unsigned char* smem) {
  const int grp = it & 7, bc = it >> 3, chunk = bc & 31, b = bc >> 5;
  const int tid = otid(), lane = tid & 63, w = tid >> 6, qi = lane & 15, g = lane >> 4;
  const int p0 = 32 * w;
  const int wbase = __builtin_amdgcn_readfirstlane(w) * 1024;
  const int lc = ((tid & 15) ^ ((tid >> 4) & 15)) << 3;
  const bf16_t* wsrc = p.Wsgu + ((size_t)(grp * 128 + (tid >> 4))) * 128 + lc;
  const bf16_t* vsrc = p.vnT + ((size_t)(b * 512 + grp * 64 + (tid >> 4))) * 4096 + chunk * 128 + lc;
  __syncthreads();
#pragma unroll
  for (int i = 0; i < 8; ++i) GLDS16(wsrc + (size_t)(16 * i) * 128, smem + i * 4096 + wbase);
#pragma unroll
  for (int i = 0; i < 4; ++i) GLDS16(vsrc + (size_t)(16 * i) * 4096, smem + 32768 + i * 4096 + wbase);
  asm volatile("s_waitcnt vmcnt(0)" ::: "memory");
  __syncthreads();
  f32x4 acc[2][4];
#pragma unroll
  for (int mt = 0; mt < 2; ++mt)
#pragma unroll
    for (int nt = 0; nt < 4; ++nt) acc[mt][nt] = (f32x4){0.f, 0.f, 0.f, 0.f};
#pragma unroll
  for (int ks = 0; ks < 4; ++ks) {
    const int co = ((ks * 4 + g) ^ qi) << 4;
    bf16x8 wf[2], vf[4];
#pragma unroll
    for (int mt = 0; mt < 2; ++mt) wf[mt] = *(const bf16x8*)(smem + (p0 + 16 * mt + qi) * 256 + co);
#pragma unroll
    for (int nt = 0; nt < 4; ++nt) vf[nt] = *(const bf16x8*)(smem + 32768 + (16 * nt + qi) * 256 + co);
#pragma unroll
    for (int mt = 0; mt < 2; ++mt)
#pragma unroll
      for (int nt = 0; nt < 4; ++nt) acc[mt][nt] = __builtin_amdgcn_mfma_f32_16x16x32_bf16(vf[nt], wf[mt], acc[mt][nt], 0, 0, 0);
  }
#pragma unroll
  for (int mt = 0; mt < 2; ++mt) {
    const int pp = p0 + 16 * mt + qi;
    const size_t tok = (size_t)b * 4096 + chunk * 128 + pp;
    const float bias = p.sgu_b[(size_t)(l * 8 + grp) * 128 + pp];
    float sq = 0.f;
#pragma unroll
    for (int nt = 0; nt < 4; ++nt) {
      const int d = 16 * nt + 4 * g;
      const u32x2 uu = *(const u32x2*)(p.ub + tok * 512 + grp * 64 + d);
      const float u0 = __uint_as_float(uu.x << 16), u1 = __uint_as_float(uu.x & 0xffff0000u);
      const float u2 = __uint_as_float(uu.y << 16), u3 = __uint_as_float(uu.y & 0xffff0000u);
      const float v0 = u0 * (acc[mt][nt][0] + bias), v1 = u1 * (acc[mt][nt][1] + bias);
      const float v2 = u2 * (acc[mt][nt][2] + bias), v3 = u3 * (acc[mt][nt][3] + bias);
      sq += v0 * v0 + v1 * v1 + v2 * v2 + v3 * v3;
      store_bf16x4(p.mixed + tok * 1024 + 512 + grp * 64 + d, v0, v1, v2, v3);
    }
    sq += __shfl_xor(sq, 16); sq += __shfl_xor(sq, 32);
    if (g == 0) p.ssq[tok * 16 + 8 + grp] = sq;
  }
}

__device__ void p3_tile(const Params& p, int l, int t, unsigned char* smem) {
  const int x_ = t & 7, j_ = t >> 3, rd_ = j_ >> 6, lb_ = j_ & 63;
  const int mt = x_ * 16 + rd_ * 8 + (lb_ & 7), nt = lb_ >> 3;
  const int tid = otid(), lane = tid & 63, wid = tid >> 6, wr = wid >> 1, wc = wid & 1;
  const int srow = tid >> 3, sch = tid & 7, qi = lane & 15, g = lane >> 4;
  const bf16_t* A = p.mixed + (size_t)(mt * 128 + srow) * 1024 + sch * 8;
  const bf16_t* B = p.Wt_out + (size_t)(nt * 128 + srow) * 1024 + sch * 8;
  MidScale mid; float rss[4];
#pragma unroll
  for (int i = 0; i < 4; ++i) {
    const int m = mt * 128 + wr * 64 + i * 16 + qi;
    const float4 a0 = *(const float4*)(p.ssq + (size_t)m * 16), a1 = *(const float4*)(p.ssq + (size_t)m * 16 + 4);
    const float4 b0 = *(const float4*)(p.ssq + (size_t)m * 16 + 8), b1 = *(const float4*)(p.ssq + (size_t)m * 16 + 12);
    const float sa = (a0.x + a0.y + a0.z + a0.w) + (a1.x + a1.y + a1.z + a1.w);
    const float sb = (b0.x + b0.y + b0.z + b0.w) + (b1.x + b1.y + b1.z + b1.w);
    const float ra = rsqrtf(sa * (1.0f / 512.0f) + LN_EPS), rb = rsqrtf(sb * (1.0f / 512.0f) + LN_EPS);
    mid.s[i] = ra / rb; rss[i] = rb;
  }
  f32x4 acc[4][4];
  ZERO_ACC(acc);
  gemm_main(smem, A, A + 32 * 1024, A + 64 * 1024, A + 96 * 1024, B, B + 32 * 1024, B + 64 * 1024, B + 96 * 1024, 16, 8, false, acc, mid);
#pragma unroll
  for (int i = 0; i < 4; ++i) {
    const int m = mt * 128 + wr * 64 + i * 16 + qi;
#pragma unroll
    for (int j = 0; j < 4; ++j) {
      const int n = nt * 128 + wc * 64 + j * 16 + 4 * g;
      const u32x2 xr = *(const u32x2*)(p.xb + (size_t)m * 1024 + n);
      const float o0 = ALPHA * __uint_as_float(xr.x << 16) + acc[i][j][0] * rss[i];
      const float o1 = ALPHA * __uint_as_float(xr.x & 0xffff0000u) + acc[i][j][1] * rss[i];
      const float o2 = ALPHA * __uint_as_float(xr.y << 16) + acc[i][j][2] * rss[i];
      const float o3 = ALPHA * __uint_as_float(xr.y & 0xffff0000u) + acc[i][j][3] * rss[i];
      store_bf16x4(p.hb + (size_t)m * 1024 + n, o0, o1, o2, o3);
    }
  }
}

__device__ void p4_batch(const Params& p, int l, int batch, unsigned char* smem) {
  const int tid = otid(), lane = tid & 63, w = tid >> 6;
  int* scnt = (int*)smem;
  int* sbase = scnt + 16;
  __syncthreads();
  if (tid < 16) scnt[tid] = 0;
  __syncthreads();
  const int tokw = batch * 32 + w * 8;
  {
    float4 gm[4], bt[4];
#pragma unroll
    for (int q = 0; q < 4; ++q) {
      gm[q] = *(const float4*)(p.ln1_g + l * 1024 + q * 256 + lane * 4);
      bt[q] = *(const float4*)(p.ln1_b + l * 1024 + q * 256 + lane * 4);
    }
#pragma unroll 4
    for (int t = 0; t < 8; ++t) {
      float* xr = p.x1 + (size_t)(tokw + t) * 1024 + lane * 4;
      const bf16_t* hr = p.hb + (size_t)(tokw + t) * 1024 + lane * 4;
      float4 v[4];
#pragma unroll
      for (int q = 0; q < 4; ++q) {
        const u32x2 hh = *(const u32x2*)(hr + q * 256);
        v[q].x = __uint_as_float(hh.x << 16); v[q].y = __uint_as_float(hh.x & 0xffff0000u);
        v[q].z = __uint_as_float(hh.y << 16); v[q].w = __uint_as_float(hh.y & 0xffff0000u);
      }
      float s1 = 0.f;
#pragma unroll
      for (int q = 0; q < 4; ++q) s1 += (v[q].x + v[q].y) + (v[q].z + v[q].w);
      const float mu = wave_sum(s1) * (1.0f / 1024.0f);
      float s2 = 0.f;
#pragma unroll
      for (int q = 0; q < 4; ++q) {
        const float d0 = v[q].x - mu, d1 = v[q].y - mu, d2 = v[q].z - mu, d3 = v[q].w - mu;
        s2 += (d0 * d0 + d1 * d1) + (d2 * d2 + d3 * d3);
      }
      const float rstd = rsqrtf(wave_sum(s2) * (1.0f / 1024.0f) + LN_EPS);
#pragma unroll
      for (int q = 0; q < 4; ++q) {
        float4 o;
        o.x = (v[q].x - mu) * rstd * gm[q].x + bt[q].x; o.y = (v[q].y - mu) * rstd * gm[q].y + bt[q].y;
        o.z = (v[q].z - mu) * rstd * gm[q].z + bt[q].z; o.w = (v[q].w - mu) * rstd * gm[q].w + bt[q].w;
        *(float4*)(xr + q * 256) = o;
        store_bf16x4(p.xb + (size_t)(tokw + t) * 1024 + q * 256 + lane * 4, o.x, o.y, o.z, o.w);
      }
    }
  }
  asm volatile("s_waitcnt vmcnt(0)" ::: "memory");
  __syncthreads();
  const int j = lane & 15, g = lane >> 4;
  float* part = (float*)(smem + 1024);
  {
    const float* xr0 = p.x1 + (size_t)(batch * 32 + j) * 1024 + 256 * w + 8 * g;
    const float* xr1 = xr0 + 16 * 1024;
    const size_t wof = ((size_t)(8 * w * 4 + g) * 16 + j) * 8;
    f32x4 De0 = {0.f, 0.f, 0.f, 0.f}, Dg0 = De0, De1 = De0, Dg1 = De0;
#pragma unroll 2
    for (int kb = 0; kb < 8; ++kb) {
      const float4 xa0 = *(const float4*)(xr0 + kb * 32), xc0 = *(const float4*)(xr0 + kb * 32 + 4);
      const float4 xa1 = *(const float4*)(xr1 + kb * 32), xc1 = *(const float4*)(xr1 + kb * 32 + 4);
      const bf16x8 weh = *(const bf16x8*)(p.Wr_eh + wof + kb * 512), wel = *(const bf16x8*)(p.Wr_el + wof + kb * 512);
      const bf16x8 wgh = *(const bf16x8*)(p.Wr_gh + wof + kb * 512), wgl = *(const bf16x8*)(p.Wr_gl + wof + kb * 512);
      u32x4 h, lo;
      h.x = cvt_pk_bf16(xa0.x, xa0.y); h.y = cvt_pk_bf16(xa0.z, xa0.w); h.z = cvt_pk_bf16(xc0.x, xc0.y); h.w = cvt_pk_bf16(xc0.z, xc0.w);
      lo.x = cvt_pk_bf16(xa0.x - __uint_as_float(h.x << 16), xa0.y - __uint_as_float(h.x & 0xffff0000u));
      lo.y = cvt_pk_bf16(xa0.z - __uint_as_float(h.y << 16), xa0.w - __uint_as_float(h.y & 0xffff0000u));
      lo.z = cvt_pk_bf16(xc0.x - __uint_as_float(h.z << 16), xc0.y - __uint_as_float(h.z & 0xffff0000u));
      lo.w = cvt_pk_bf16(xc0.z - __uint_as_float(h.w << 16), xc0.w - __uint_as_float(h.w & 0xffff0000u));
      bf16x8 xh = __builtin_bit_cast(bf16x8, h), xl = __builtin_bit_cast(bf16x8, lo);
      De0 = __builtin_amdgcn_mfma_f32_16x16x32_bf16(weh, xh, De0, 0, 0, 0);
      Dg0 = __builtin_amdgcn_mfma_f32_16x16x32_bf16(wgh, xh, Dg0, 0, 0, 0);
      De0 = __builtin_amdgcn_mfma_f32_16x16x32_bf16(weh, xl, De0, 0, 0, 0);
      Dg0 = __builtin_amdgcn_mfma_f32_16x16x32_bf16(wgh, xl, Dg0, 0, 0, 0);
      De0 = __builtin_amdgcn_mfma_f32_16x16x32_bf16(wel, xh, De0, 0, 0, 0);
      Dg0 = __builtin_amdgcn_mfma_f32_16x16x32_bf16(wgl, xh, Dg0, 0, 0, 0);
      h.x = cvt_pk_bf16(xa1.x, xa1.y); h.y = cvt_pk_bf16(xa1.z, xa1.w); h.z = cvt_pk_bf16(xc1.x, xc1.y); h.w = cvt_pk_bf16(xc1.z, xc1.w);
      lo.x = cvt_pk_bf16(xa1.x - __uint_as_float(h.x << 16), xa1.y - __uint_as_float(h.x & 0xffff0000u));
      lo.y = cvt_pk_bf16(xa1.z - __uint_as_float(h.y << 16), xa1.w - __uint_as_float(h.y & 0xffff0000u));
      lo.z = cvt_pk_bf16(xc1.x - __uint_as_float(h.z << 16), xc1.y - __uint_as_float(h.z & 0xffff0000u));
      lo.w = cvt_pk_bf16(xc1.z - __uint_as_float(h.w << 16), xc1.w - __uint_as_float(h.w & 0xffff0000u));
      xh = __builtin_bit_cast(bf16x8, h); xl = __builtin_bit_cast(bf16x8, lo);
      De1 = __builtin_amdgcn_mfma_f32_16x16x32_bf16(weh, xh, De1, 0, 0, 0);
      Dg1 = __builtin_amdgcn_mfma_f32_16x16x32_bf16(wgh, xh, Dg1, 0, 0, 0);
      De1 = __builtin_amdgcn_mfma_f32_16x16x32_bf16(weh, xl, De1, 0, 0, 0);
      Dg1 = __builtin_amdgcn_mfma_f32_16x16x32_bf16(wgh, xl, Dg1, 0, 0, 0);
      De1 = __builtin_amdgcn_mfma_f32_16x16x32_bf16(wel, xh, De1, 0, 0, 0);
      Dg1 = __builtin_amdgcn_mfma_f32_16x16x32_bf16(wgl, xh, Dg1, 0, 0, 0);
    }
    float* pw = part + ((size_t)(w * 2) * 64 + lane) * 8;
    *(f32x4*)(pw) = De0; *(f32x4*)(pw + 4) = Dg0;
    *(f32x4*)(pw + 512) = De1; *(f32x4*)(pw + 516) = Dg1;
  }
  __syncthreads();
  const int tok = tokw + (j & 7);
  f32x4 De = {0.f, 0.f, 0.f, 0.f}, Dg = {0.f, 0.f, 0.f, 0.f};
  {
    const int ln = g * 16 + (w & 1) * 8 + (j & 7), tl = w >> 1;
#pragma unroll
    for (int ww = 0; ww < 4; ++ww) {
      const float* pr = part + ((size_t)(ww * 2 + tl) * 64 + ln) * 8;
      De += *(const f32x4*)(pr); Dg += *(const f32x4*)(pr + 4);
    }
  }
  float gl[4];
#pragma unroll
  for (int k = 0; k < 4; ++k) gl[k] = __shfl(Dg[k], j) + p.rg_b[l * 4 + k];
  int gs = 0; float gmax = gl[0];
#pragma unroll
  for (int k = 1; k < 4; ++k) { const bool bb = gl[k] > gmax; gmax = bb ? gl[k] : gmax; gs = bb ? k : gs; }
  float psum = 0.f;
#pragma unroll
  for (int k = 0; k < 4; ++k) psum += __expf(gl[k] - gmax);
  const float gate = 1.0f / psum;
  float es[4];
#pragma unroll
  for (int k = 0; k < 4; ++k) es[k] = De[k] + p.re_b[l * 16 + 4 * g + k];
  int i0 = 0; float v0 = es[0];
#pragma unroll
  for (int k = 1; k < 4; ++k) { const bool bb = es[k] > v0; v0 = bb ? es[k] : v0; i0 = bb ? k : i0; }
  int i1 = 0; float v1 = -3.0e38f;
#pragma unroll
  for (int k = 0; k < 4; ++k) { const bool bb = (k != i0) && (es[k] > v1); v1 = bb ? es[k] : v1; i1 = bb ? k : i1; }
  const float ex = __expf(v1 - v0);
  const float tw0 = 1.0f / (1.0f + ex), tw1 = ex / (1.0f + ex);
  const bool commit = (g == gs) && (j < 8);
  const int e0 = gs * 4 + i0, e1 = gs * 4 + i1;
  int lp0 = 0, lp1 = 0;
  if (commit) { lp0 = atomicAdd(&scnt[e0], 1); lp1 = atomicAdd(&scnt[e1], 1); }
  __syncthreads();
  if (tid < 16) sbase[tid] = atomicAdd(p.counts + l * 16 + tid, scnt[tid]);
  __syncthreads();
  if (commit) {
    const int pos0 = sbase[e0] + lp0, pos1 = sbase[e1] + lp1;
    p.list[e0 * NTOK + pos0] = tok; p.wlist[e0 * NTOK + pos0] = gate * tw0;
    p.list[e1 * NTOK + pos1] = tok; p.wlist[e1 * NTOK + pos1] = gate * tw1;
    int4 ti; ti.x = e0; ti.y = pos0; ti.z = e1; ti.w = pos1;
    *(int4*)(p.tokinfo + (size_t)tok * 4) = ti;
  }
}

__device__ __forceinline__ int moe_total_mtiles(const int* cnts) {
  int tot = 0;
#pragma unroll
  for (int e = 0; e < 16; ++e) tot += (cnts[e] + 127) >> 7;
  return tot;
}
__device__ __forceinline__ void moe_find(const int* cnts, int mi, int& e_out, int& ml, int& off, int& cnt) {
  int rem = mi, o = 0; e_out = 0; ml = 0; off = 0; cnt = 1;
  bool found = false;
#pragma unroll
  for (int e = 0; e < 16; ++e) {
    const int c = cnts[e], mtl = (c + 127) >> 7;
    if (!found && rem < mtl) { found = true; e_out = e; ml = rem; off = o; cnt = c; }
    rem -= mtl; o += c;
  }
}

__device__ void p5_tile(const Params& p, int l, int t, int mtot, unsigned char* smem) {
  const int mi = (t >> 5) * 8 + (t & 7), nt = (t >> 3) & 3;
  if (mi >= mtot) return;
  int e, ml, off, cnt;
  moe_find(p.counts + l * 16, mi, e, ml, off, cnt);
  const int tid = otid(), lane = tid & 63, wid = tid >> 6, wr = wid >> 1, wc = wid & 1;
  const int srow = tid >> 3, sch = tid & 7, qi = lane & 15, g = lane >> 4;
  const bf16_t* pa[4];
#pragma unroll
  for (int i = 0; i < 4; ++i) {
    const int ridx = min(ml * 128 + srow + 32 * i, cnt - 1);
    const int tok = p.list[e * NTOK + ridx];
    pa[i] = p.xb + (size_t)tok * 1024 + sch * 8;
  }
  const bf16_t* B = p.Wgu + ((size_t)e * 512 + nt * 128 + srow) * 1024 + sch * 8;
  f32x4 acc[4][4];
  ZERO_ACC(acc);
  gemm_main(smem, pa[0], pa[1], pa[2], pa[3], B, B + 32 * 1024, B + 64 * 1024, B + 96 * 1024, 16, -1, false, acc, NoMid());
#pragma unroll
  for (int i = 0; i < 4; ++i) {
    const int rloc = ml * 128 + wr * 64 + i * 16 + qi;
    if (rloc < cnt) {
      const size_t slot = (size_t)off + rloc;
#pragma unroll
      for (int jp = 0; jp < 2; ++jp) {
        const f32x4 ga = acc[i][2 * jp], up = acc[i][2 * jp + 1];
        const int col = 64 * nt + 32 * wc + 16 * jp + 4 * g;
        store_bf16x4(p.act + slot * 256 + col, silu(ga[0]) * up[0], silu(ga[1]) * up[1], silu(ga[2]) * up[2], silu(ga[3]) * up[3]);
      }
    }
  }
}

__device__ void p6_tile(const Params& p, int l, int t, int mtot, unsigned char* smem) {
  const int mi = (t >> 6) * 8 + (t & 7), nt = (t >> 3) & 7;
  if (mi >= mtot) return;
  int e, ml, off, cnt;
  moe_find(p.counts + l * 16, mi, e, ml, off, cnt);
  const int tid = otid(), lane = tid & 63, wid = tid >> 6, wr = wid >> 1, wc = wid & 1;
  const int srow = tid >> 3, sch = tid & 7, qi = lane & 15, g = lane >> 4;
  const bf16_t* pa[4];
#pragma unroll
  for (int i = 0; i < 4; ++i) {
    const int ridx = min(ml * 128 + srow + 32 * i, cnt - 1);
    pa[i] = p.act + ((size_t)off + ridx) * 256 + sch * 8;
  }
  const bf16_t* B = p.Wdn + ((size_t)e * 1024 + nt * 128 + srow) * 256 + sch * 8;
  f32x4 acc[4][4];
  ZERO_ACC(acc);
  gemm_main(smem, pa[0], pa[1], pa[2], pa[3], B, B + 32 * 256, B + 64 * 256, B + 96 * 256, 4, -1, false, acc, NoMid());
#pragma unroll
  for (int i = 0; i < 4; ++i) {
    const int rloc = ml * 128 + wr * 64 + i * 16 + qi;
    if (rloc < cnt) {
      const float wgt = p.wlist[e * NTOK + rloc];
      const size_t slot = (size_t)off + rloc;
#pragma unroll
      for (int j = 0; j < 4; ++j) {
        const int n = nt * 128 + wc * 64 + j * 16 + 4 * g;
        store_bf16x4(p.y + slot * 1024 + n, acc[i][j][0] * wgt, acc[i][j][1] * wgt, acc[i][j][2] * wgt, acc[i][j][3] * wgt);
      }
    }
  }
}

template <int NT>
__device__ __forceinline__ void p7_tokens(const Params& p, int l, int tok0, int tstride) {
  const int lane = otid() & 63;
  int4 ti[NT];
#pragma unroll
  for (int u = 0; u < NT; ++u) ti[u] = *(const int4*)(p.tokinfo + (size_t)(tok0 + u * tstride) * 4);
  int off0[NT], off1[NT];
#pragma unroll
  for (int u = 0; u < NT; ++u) { off0[u] = 0; off1[u] = 0; }
#pragma unroll
  for (int e = 0; e < 16; ++e) {
    const int c = p.counts[l * 16 + e];
#pragma unroll
    for (int u = 0; u < NT; ++u) { if (e < ti[u].x) off0[u] += c; if (e < ti[u].z) off1[u] += c; }
  }
  float4 xr[NT][4]; u32x2 ya[NT][4], yb[NT][4];
#pragma unroll
  for (int u = 0; u < NT; ++u) {
    const int tok = tok0 + u * tstride;
    const size_t s0 = (size_t)off0[u] + ti[u].y, s1 = (size_t)off1[u] + ti[u].w;
#pragma unroll
    for (int q = 0; q < 4; ++q) {
      const int c = q * 256 + lane * 4;
      xr[u][q] = *(const float4*)(p.x1 + (size_t)tok * 1024 + c);
      ya[u][q] = *(const u32x2*)(p.y + s0 * 1024 + c);
      yb[u][q] = *(const u32x2*)(p.y + s1 * 1024 + c);
    }
  }
  float4 gg[4], bb[4];
#pragma unroll
  for (int q = 0; q < 4; ++q) {
    gg[q] = *(const float4*)(p.ln2_g + l * 1024 + q * 256 + lane * 4);
    bb[q] = *(const float4*)(p.ln2_b + l * 1024 + q * 256 + lane * 4);
  }
#pragma unroll
  for (int u = 0; u < NT; ++u) {
    const int tok = tok0 + u * tstride;
    float hv[16];
#pragma unroll
    for (int q = 0; q < 4; ++q) {
      hv[q * 4 + 0] = ALPHA * xr[u][q].x + (__uint_as_float(ya[u][q].x << 16) + __uint_as_float(yb[u][q].x << 16));
      hv[q * 4 + 1] = ALPHA * xr[u][q].y + (__uint_as_float(ya[u][q].x & 0xffff0000u) + __uint_as_float(yb[u][q].x & 0xffff0000u));
      hv[q * 4 + 2] = ALPHA * xr[u][q].z + (__uint_as_float(ya[u][q].y << 16) + __uint_as_float(yb[u][q].y << 16));
      hv[q * 4 + 3] = ALPHA * xr[u][q].w + (__uint_as_float(ya[u][q].y & 0xffff0000u) + __uint_as_float(yb[u][q].y & 0xffff0000u));
    }
    float s1s = 0.f;
#pragma unroll
    for (int c = 0; c < 16; ++c) s1s += hv[c];
    const float mu = wave_sum(s1s) * (1.0f / 1024.0f);
    float s2 = 0.f;
#pragma unroll
    for (int c = 0; c < 16; ++c) { const float d = hv[c] - mu; s2 += d * d; }
    const float rstd = rsqrtf(wave_sum(s2) * (1.0f / 1024.0f) + LN_EPS);
#pragma unroll
    for (int q = 0; q < 4; ++q) {
      const int c = q * 256 + lane * 4;
      float4 o;
      o.x = (hv[q * 4 + 0] - mu) * rstd * gg[q].x + bb[q].x; o.y = (hv[q * 4 + 1] - mu) * rstd * gg[q].y + bb[q].y;
      o.z = (hv[q * 4 + 2] - mu) * rstd * gg[q].z + bb[q].z; o.w = (hv[q * 4 + 3] - mu) * rstd * gg[q].w + bb[q].w;
      if (l == 3) *(float4*)(p.out + (size_t)tok * 1024 + c) = o;
      else store_bf16x4(p.xb + (size_t)tok * 1024 + c, o.x, o.y, o.z, o.w);
    }
  }
}

#define XB_TMO      128
#define XB_XCNT(j)  (256  + 64 * (j))
#define XB_XSUB(j)  (1280 + 64 * (j))
#define XB_XGEN(j)  (2304 + 64 * (j))
#define XB_TOP      3328
#define XB_TOPGEN   3392
#define XCD_BAR_WORDS 3456
#define XB_SPIN_CAP (1u << 22)
__device__ __forceinline__ unsigned xb_ld(unsigned* p) { return __hip_atomic_load(p, __ATOMIC_RELAXED, __HIP_MEMORY_SCOPE_AGENT); }
__device__ __forceinline__ unsigned xb_add(unsigned* p, unsigned v) { return __hip_atomic_fetch_add(p, v, __ATOMIC_RELAXED, __HIP_MEMORY_SCOPE_AGENT); }
__device__ __forceinline__ unsigned xb_xcc_id() { return (unsigned)__builtin_amdgcn_s_getreg((3 << 11) | 20) & 0xFu; }
#define XB_SPIN(cond, bar) do { unsigned _sp = 0; while (cond) { __builtin_amdgcn_s_sleep(1); \
    if ((++_sp & 255u) == 0u) { if (xb_ld(&(bar)[XB_TMO])) break; if (_sp > XB_SPIN_CAP) { atomicAdd(&(bar)[XB_TMO], 1u); break; } } } } while (0)
struct XcdBarrier { unsigned* bar; unsigned x; volatile unsigned* st; };
__device__ __forceinline__ XcdBarrier xcd_barrier_post(unsigned* bar, volatile unsigned* st) {
  XcdBarrier b; b.bar = bar; b.x = xb_xcc_id(); b.st = st;
  if (threadIdx.x == 0) (void)xb_add(&bar[XB_XCNT(b.x)], 1u);
  return b;
}
__device__ __forceinline__ void xcd_barrier_complete(unsigned* bar, unsigned x, unsigned& nloc, unsigned& nx) {
  const unsigned G = gridDim.x;
  unsigned sum, cnt, mine, sp = 0u;
  for (;;) {
    sum = 0u; cnt = 0u; mine = 0u;
#pragma unroll
    for (unsigned j = 0; j < 16; ++j) { const unsigned c = xb_ld(&bar[XB_XCNT(j)]); sum += c; cnt += (c > 0u) ? 1u : 0u; mine = (j == x) ? c : mine; }
    if (sum == G) break;
    __builtin_amdgcn_s_sleep(1);
    if ((++sp & 255u) == 0u) { if (xb_ld(&bar[XB_TMO])) break; if (sp > XB_SPIN_CAP) { atomicAdd(&bar[XB_TMO], 1u); break; } }
  }
  nloc = mine > 0u ? mine : 1u; nx = cnt > 0u ? cnt : 1u;
}
__device__ __forceinline__ void xcd_barrier(const XcdBarrier& b) {
  asm volatile("s_waitcnt vmcnt(0)" ::: "memory");
  __syncthreads();
  if (threadIdx.x == 0) {
    unsigned* bar = b.bar;
    __builtin_amdgcn_s_waitcnt(0);
    unsigned nloc = b.st[0], nx = b.st[1];
    if (nloc == 0u) { xcd_barrier_complete(bar, b.x, nloc, nx); b.st[0] = nloc; b.st[1] = nx; }
    const unsigned old = xb_add(&bar[XB_XSUB(b.x)], 1u);
    const unsigned gen = old / nloc;
    if (old + 1u == (gen + 1u) * nloc) {
      __builtin_amdgcn_fence(__ATOMIC_RELEASE, "agent");
      asm volatile("s_waitcnt vmcnt(0)" ::: "memory");
      const unsigned og = xb_add(&bar[XB_TOP], 1u);
      const unsigned tg = og / nx;
      if (og + 1u == (tg + 1u) * nx) xb_add(&bar[XB_TOPGEN], 1u);
      else XB_SPIN(xb_ld(&bar[XB_TOPGEN]) == tg, bar);
      __builtin_amdgcn_fence(__ATOMIC_ACQUIRE, "agent");
      xb_add(&bar[XB_XGEN(b.x)], 1u);
      asm volatile("s_waitcnt vmcnt(0)" ::: "memory");
    } else {
      XB_SPIN(xb_ld(&bar[XB_XGEN(b.x)]) == gen, bar);
      __builtin_amdgcn_fence(__ATOMIC_ACQUIRE, "agent");
      asm volatile("s_waitcnt vmcnt(0)" ::: "memory");
    }
  }
  __syncthreads();
}

__device__ __forceinline__ void run_phase(const Params& p, int ph, int l, int bid, int nblk, unsigned char* smem, float* sbias) {
  switch (ph) {
    case 0: {
      if (bid == 0 && threadIdx.x < 64) p.counts[threadIdx.x] = 0;
      conv_x(p, bid, nblk);
      for (int it = bid; it < NCONV_ITEMS; it += nblk) conv_item(p, 0, it, smem);
    } break;
    case 1: for (int t = bid; t < 2560; t += nblk) p1_tile(p, l, t, smem); break;
    case 2:
      attn_phase(p, l, bid, nblk, smem);
      for (int it = bid; it < 1024; it += nblk) sgu_item(p, l, it, smem);
      break;
    case 3: for (int t = bid; t < 1024; t += nblk) p3_tile(p, l, t, smem); break;
    case 4: for (int it = bid; it < NTOK / 32; it += nblk) p4_batch(p, l, it, smem); break;
    case 5: { const int mtot = moe_total_mtiles(p.counts + l * 16), nt = ((mtot + 7) >> 3) * 32; for (int t = bid; t < nt; t += nblk) p5_tile(p, l, t, mtot, smem); } break;
    case 6: { const int mtot = moe_total_mtiles(p.counts + l * 16), nt = ((mtot + 7) >> 3) * 64; for (int t = bid; t < nt; t += nblk) p6_tile(p, l, t, mtot, smem); } break;
    case 7: {
      { const int nw = nblk * 4; int tok = bid * 4 + (threadIdx.x >> 6);
        for (; tok + 3 * nw < NTOK; tok += 4 * nw) p7_tokens<4>(p, l, tok, nw);
        for (; tok < NTOK; tok += nw) p7_tokens<1>(p, l, tok, nw); }
      if (l < 3) for (int it = bid; it < NCONV_ITEMS; it += nblk) conv_item(p, l + 1, it, smem);
    } break;
  }
}

template <int PH>
__global__ void __launch_bounds__(256, 2) phase_kernel(Params p, int l) {
  __shared__ __attribute__((aligned(16))) unsigned char smem[SMEM_BYTES];
  run_phase(p, PH, l, blockIdx.x, gridDim.x, smem, (float*)smem);
}

#if MEGA
__global__ void __launch_bounds__(256, 2) mega_kernel(Params p) {
  __shared__ __attribute__((aligned(16))) unsigned char smem[SMEM_BYTES];
  __shared__ uint4 xb_words;
  float* sbias = (float*)smem;
  cg::grid_group grid = cg::this_grid();
  const int bid = blockIdx.x, nblk = gridDim.x;
  if (threadIdx.x == 0) xb_words = make_uint4(0u, 0u, 0u, 0u);
  __syncthreads();
  XcdBarrier xb = xcd_barrier_post(p.bar, (volatile unsigned*)&xb_words);
  run_phase(p, 0, 0, bid, nblk, smem, sbias);
  if (p.never) grid.sync();
  xcd_barrier(xb);
#pragma unroll 1
  for (int l = 0; l < 4; ++l) {
#pragma unroll 1
    for (int ph = 1; ph <= 7; ++ph) {
      run_phase(p, ph, l, bid, nblk, smem, sbias);
#if DUP_PH
      if (ph == DUP_PH) { xcd_barrier(xb); run_phase(p, ph, l, bid, nblk, smem, sbias); }
#endif
      if (!(l == 3 && ph == 7)) xcd_barrier(xb);
    }
  }
}
#endif

extern "C" void kernel_launch(void* const* d_in, const int* in_sizes, int n_in, void* d_out, int out_size, void* d_ws,
                              size_t ws_size, hipStream_t stream) {
  Params p{};
  p.x = (const float*)d_in[0]; p.w_in = (const float*)d_in[1]; p.w_out = (const float*)d_in[2]; p.rel_bias = (const float*)d_in[3];
  p.sgu_ln_g = (const float*)d_in[4]; p.sgu_ln_b = (const float*)d_in[5]; p.sgu_w = (const float*)d_in[6]; p.sgu_b = (const float*)d_in[7];
  p.mix_g = (const float*)d_in[8]; p.ln1_g = (const float*)d_in[9]; p.ln1_b = (const float*)d_in[10];
  p.rg_w = (const float*)d_in[11]; p.rg_b = (const float*)d_in[12]; p.re_w = (const float*)d_in[13]; p.re_b = (const float*)d_in[14];
  p.w_gate = (const float*)d_in[15]; p.w_up = (const float*)d_in[16]; p.w_down = (const float*)d_in[17];
  p.ln2_g = (const float*)d_in[18]; p.ln2_b = (const float*)d_in[19];
  p.out = (float*)d_out;
  unsigned char* w = (unsigned char*)d_ws;
  size_t o = 0;
  auto take = [&](size_t bytes) { unsigned char* r = w + o; o += (bytes + 255) & ~(size_t)255; return r; };
  p.Wt_in = (bf16_t*)take((size_t)2560 * 1024 * 2);
  p.Wt_out = (bf16_t*)take((size_t)1024 * 1024 * 2);
  p.Wgu = (bf16_t*)take((size_t)16 * 512 * 1024 * 2);
  p.Wdn = (bf16_t*)take((size_t)16 * 1024 * 256 * 2);
  p.Wsgu = (bf16_t*)take((size_t)8 * 128 * 128 * 2);
  p.xb = (bf16_t*)take((size_t)NTOK * 1024 * 2);
  p.x1 = (float*)take((size_t)NTOK * 1024 * 4);
  unsigned char* r1 = take((size_t)NTOK * 2560 * 2);
  p.qk = (bf16_t*)r1;
  p.vT = (bf16_t*)(r1 + (size_t)NTOK * 1024 * 2);
  p.ub = (bf16_t*)(r1 + (size_t)NTOK * 1536 * 2);
  p.vnT = (bf16_t*)(r1 + (size_t)NTOK * 2048 * 2);
  p.y = (bf16_t*)r1;
  p.hb = (bf16_t*)r1;
  unsigned char* r2 = take((size_t)NTOK * 1024 * 2);
  p.mixed = (bf16_t*)r2;
  p.act = (bf16_t*)r2;
  p.ssq = (float*)take((size_t)NTOK * 16 * 4);
  p.wlist = (float*)take((size_t)16 * NTOK * 4);
  p.list = (int*)take((size_t)16 * NTOK * 4);
  p.tokinfo = (int*)take((size_t)NTOK * 4 * 4);
  p.counts = (int*)take(256);
  p.Wr_eh = (bf16_t*)take(16384 * 2); p.Wr_el = (bf16_t*)take(16384 * 2);
  p.Wr_gh = (bf16_t*)take(16384 * 2); p.Wr_gl = (bf16_t*)take(16384 * 2);
  p.bar = (unsigned*)take(XCD_BAR_WORDS * 4);
#if MEGA
  static int grid_blocks = 0;
  if (!grid_blocks) {
    int dev = 0, cus = 0, per_cu = 0;
    hipGetDevice(&dev);
    hipDeviceGetAttribute(&cus, hipDeviceAttributeMultiprocessorCount, dev);
    hipOccupancyMaxActiveBlocksPerMultiprocessor(&per_cu, mega_kernel, 256, 0);
    if (per_cu > 2) per_cu = 2;
    grid_blocks = cus * per_cu;
  }
  (void)hipMemsetAsync(p.bar, 0, XCD_BAR_WORDS * 4, stream);
  void* args[] = {&p};
  hipError_t e = hipLaunchCooperativeKernel((void*)mega_kernel, dim3(grid_blocks), dim3(256), args, 0, stream);
  if (e != hipSuccess) fprintf(stderr, "cooperative launch failed: %s (grid %d)\n", hipGetErrorString(e), grid_blocks);
#else
  const int G = 512;
  phase_kernel<0><<<G, 256, 0, stream>>>(p, 0);
  for (int l = 0; l < 4; ++l) {
    phase_kernel<1><<<G, 256, 0, stream>>>(p, l);
    phase_kernel<2><<<G, 256, 0, stream>>>(p, l);
    phase_kernel<3><<<G, 256, 0, stream>>>(p, l);
    phase_kernel<4><<<G, 256, 0, stream>>>(p, l);
    phase_kernel<5><<<G, 256, 0, stream>>>(p, l);
    phase_kernel<6><<<G, 256, 0, stream>>>(p, l);
    phase_kernel<7><<<G, 256, 0, stream>>>(p, l);
  }
#endif
}
```

```cpp
#include <hip/hip_runtime.h>
#include <hip/hip_cooperative_groups.h>
#include <stdint.h>
#include <cstdio>
namespace cg = cooperative_groups;

#ifndef MEGA
#define MEGA 1
#endif
#define DUP_PH 0

typedef unsigned short bf16_t;
typedef short bf16x8 __attribute__((ext_vector_type(8)));
typedef float f32x4 __attribute__((ext_vector_type(4)));
typedef unsigned u32x4 __attribute__((ext_vector_type(4)));
typedef unsigned u32x2 __attribute__((ext_vector_type(2)));

#define NTOK 16384
#define LN_EPS 1e-5f
#define ALPHA 1.681792830507429f
#define NCONV_ITEMS 3985
#define SMEM_BYTES 69632

struct Params {
  const float *x, *w_in, *w_out, *rel_bias, *sgu_ln_g, *sgu_ln_b, *sgu_w, *sgu_b, *mix_g, *ln1_g, *ln1_b,
      *rg_w, *rg_b, *re_w, *re_b, *w_gate, *w_up, *w_down, *ln2_g, *ln2_b;
  float* out;
  bf16_t *Wt_in, *Wt_out, *Wgu, *Wdn, *Wsgu, *xb, *qk, *vT, *ub, *vnT, *mixed, *act, *y, *hb;
  float *x1, *ssq, *wlist;
  bf16_t *Wr_eh, *Wr_el, *Wr_gh, *Wr_gl;
  int *counts, *list, *tokinfo;
  unsigned* bar;
  int never;
  int pad_;
};

__device__ __forceinline__ unsigned cvt_pk_bf16(float lo, float hi) {
  unsigned r; asm("v_cvt_pk_bf16_f32 %0, %1, %2" : "=v"(r) : "v"(lo), "v"(hi)); return r;
}
__device__ __forceinline__ void store_bf16x4(bf16_t* p, float a, float b, float c, float d) {
  u32x2 v; v.x = cvt_pk_bf16(a, b); v.y = cvt_pk_bf16(c, d); *(u32x2*)p = v;
}
__device__ __forceinline__ float gelu_tanh(float x) {
  float z = 0.7978845608028654f * (x + 0.044715f * x * x * x);
  return x / (1.0f + __expf(-2.0f * z));
}
__device__ __forceinline__ int otid() { int t = threadIdx.x; asm volatile("" : "+v"(t)); return t; }
__device__ __forceinline__ float silu(float x) { return x / (1.0f + __expf(-x)); }
template <int CTRL>
__device__ __forceinline__ float dpp_mov(float v) {
  return __builtin_bit_cast(float, __builtin_amdgcn_update_dpp(0, __builtin_bit_cast(int, v), CTRL, 0xf, 0xf, true));
}
__device__ __forceinline__ float row16_sum(float v) {
  v += dpp_mov<0xB1>(v); v += dpp_mov<0x4E>(v); v += dpp_mov<0x141>(v); v += dpp_mov<0x140>(v); return v;
}
__device__ __forceinline__ float wave_sum(float v) {
  v = row16_sum(v); v += __shfl_xor(v, 16); v += __shfl_xor(v, 32); return v;
}

struct NoMid { __device__ __forceinline__ void operator()(f32x4 (&)[4][4]) const {} };
struct MidScale {
  float s[4];
  __device__ __forceinline__ void operator()(f32x4 (&acc)[4][4]) const {
#pragma unroll
    for (int i = 0; i < 4; ++i)
#pragma unroll
      for (int j = 0; j < 4; ++j) acc[i][j] *= s[i];
  }
};

#define GLDS16(gptr, lptr) __builtin_amdgcn_global_load_lds((const unsigned*)(gptr), (__attribute__((address_space(3))) unsigned*)(lptr), 16, 0, 0)

__device__ __forceinline__ void gemm_issue0(unsigned char* smem, const bf16_t* pa0, const bf16_t* pa1, const bf16_t* pa2,
                                            const bf16_t* pa3, const bf16_t* pb0, const bf16_t* pb1, const bf16_t* pb2,
                                            const bf16_t* pb3) {
  const int tid = otid(), wid = tid >> 6, srow = tid >> 3;
  const int lch = ((tid & 7) ^ ((srow >> 1) & 7)) * 8 - (tid & 7) * 8;
  unsigned char* d = smem + __builtin_amdgcn_readfirstlane(wid) * 1024;
  GLDS16(pa0 + lch, d); GLDS16(pa1 + lch, d + 4096); GLDS16(pa2 + lch, d + 8192); GLDS16(pa3 + lch, d + 12288);
  GLDS16(pb0 + lch, d + 16384); GLDS16(pb1 + lch, d + 20480); GLDS16(pb2 + lch, d + 24576); GLDS16(pb3 + lch, d + 28672);
}

template <bool PRE = false, class Mid>
__device__ __forceinline__ void gemm_main(unsigned char* smem, const bf16_t* pa0, const bf16_t* pa1, const bf16_t* pa2,
                                          const bf16_t* pa3, const bf16_t* pb0, const bf16_t* pb1, const bf16_t* pb2,
                                          const bf16_t* pb3, int nk, int kmid, bool swapped, f32x4 (&acc)[4][4],
                                          const Mid& mid) {
  const int tid = otid(), lane = tid & 63, wid = tid >> 6, wr = wid >> 1, wc = wid & 1;
  const int srow = tid >> 3;
  const int lch = ((tid & 7) ^ ((srow >> 1) & 7)) * 8 - (tid & 7) * 8;
  pa0 += lch; pa1 += lch; pa2 += lch; pa3 += lch; pb0 += lch; pb1 += lch; pb2 += lch; pb3 += lch;
  const int soff = __builtin_amdgcn_readfirstlane(wid) * 1024;
  const int qi = lane & 15, g = lane >> 4, s = qi >> 1;
  const int aside = swapped ? 16384 : 0, bside = swapped ? 0 : 16384;
  const int offA0 = aside + (wr * 64 + qi) * 128 + (((0 + g) ^ s) << 4);
  const int offA1 = aside + (wr * 64 + qi) * 128 + (((4 + g) ^ s) << 4);
  const int offB0 = bside + (wc * 64 + qi) * 128 + (((0 + g) ^ s) << 4);
  const int offB1 = bside + (wc * 64 + qi) * 128 + (((4 + g) ^ s) << 4);
  if (!PRE) {
    unsigned char* d = smem + soff;
    GLDS16(pa0, d); GLDS16(pa1, d + 4096); GLDS16(pa2, d + 8192); GLDS16(pa3, d + 12288);
    GLDS16(pb0, d + 16384); GLDS16(pb1, d + 20480); GLDS16(pb2, d + 24576); GLDS16(pb3, d + 28672);
  }
  asm volatile("s_waitcnt vmcnt(0)" ::: "memory");
  __syncthreads();
  for (int kt = 0; kt < nk; ++kt) {
    unsigned char* buf = smem + ((kt & 1) << 15);
    if (kt + 1 < nk) {
      const int ko = (kt + 1) * 64;
      unsigned char* d = smem + (((kt + 1) & 1) << 15) + soff;
      GLDS16(pa0 + ko, d); GLDS16(pa1 + ko, d + 4096); GLDS16(pa2 + ko, d + 8192); GLDS16(pa3 + ko, d + 12288);
      GLDS16(pb0 + ko, d + 16384); GLDS16(pb1 + ko, d + 20480); GLDS16(pb2 + ko, d + 24576); GLDS16(pb3 + ko, d + 28672);
    }
    if (kt == kmid) mid(acc);
    {
      bf16x8 af0[4], bf0[4], af1[4], bf1[4];
#pragma unroll
      for (int i = 0; i < 4; ++i) af0[i] = *(const bf16x8*)(buf + offA0 + i * 2048);
#pragma unroll
      for (int j = 0; j < 4; ++j) bf0[j] = *(const bf16x8*)(buf + offB0 + j * 2048);
#pragma unroll
      for (int i = 0; i < 4; ++i) af1[i] = *(const bf16x8*)(buf + offA1 + i * 2048);
#pragma unroll
      for (int j = 0; j < 4; ++j) bf1[j] = *(const bf16x8*)(buf + offB1 + j * 2048);
      asm volatile("s_waitcnt lgkmcnt(8)" ::: "memory");
      __builtin_amdgcn_s_setprio(1);
#pragma unroll
      for (int i = 0; i < 4; ++i)
#pragma unroll
        for (int j = 0; j < 4; ++j) acc[i][j] = __builtin_amdgcn_mfma_f32_16x16x32_bf16(bf0[j], af0[i], acc[i][j], 0, 0, 0);
      asm volatile("s_waitcnt lgkmcnt(0)" ::: "memory");
#pragma unroll
      for (int i = 0; i < 4; ++i)
#pragma unroll
        for (int j = 0; j < 4; ++j) acc[i][j] = __builtin_amdgcn_mfma_f32_16x16x32_bf16(bf1[j], af1[i], acc[i][j], 0, 0, 0);
      __builtin_amdgcn_s_setprio(0);
    }
    asm volatile("s_waitcnt vmcnt(0)" ::: "memory");
    __syncthreads();
  }
}

#define ZERO_ACC(acc)                                   \
  _Pragma("unroll") for (int i_ = 0; i_ < 4; ++i_)      \
  _Pragma("unroll") for (int j_ = 0; j_ < 4; ++j_) acc[i_][j_] = (f32x4){0.f, 0.f, 0.f, 0.f};

__device__ void conv_x(const Params& p, int bid, int nblk) {
  const size_t n8 = (size_t)NTOK * 1024 / 8;
  for (size_t i = (size_t)bid * 256 + threadIdx.x; i < n8; i += (size_t)nblk * 256) {
    const float4 a = *(const float4*)(p.x + i * 8), b = *(const float4*)(p.x + i * 8 + 4);
    u32x4 v; v.x = cvt_pk_bf16(a.x, a.y); v.y = cvt_pk_bf16(a.z, a.w); v.z = cvt_pk_bf16(b.x, b.y); v.w = cvt_pk_bf16(b.z, b.w);
    *(u32x4*)(p.xb + i * 8) = v;
  }
}

__device__ void tconv_tile(float* tile, const float* src, int src_ld, const float* kscale, bf16_t* dst, int dst_ld, int rstep) {
  const int t = otid();
#pragma unroll
  for (int i = 0; i < 4; ++i) {
    const int k = (t >> 4) + 16 * i, n4 = (t & 15) * 4;
    float4 v = *(const float4*)(src + (size_t)k * src_ld + n4);
    if (kscale) { const float sc = kscale[k]; v.x *= sc; v.y *= sc; v.z *= sc; v.w *= sc; }
    float* d = tile + k * 65 + n4;
    d[0] = v.x; d[1] = v.y; d[2] = v.z; d[3] = v.w;
  }
  __syncthreads();
  {
    const int n = t >> 2, kc = (t & 3) * 16;
    float f[16];
#pragma unroll
    for (int q = 0; q < 16; ++q) f[q] = tile[(kc + q) * 65 + n];
    u32x4 v0, v1;
    v0.x = cvt_pk_bf16(f[0], f[1]); v0.y = cvt_pk_bf16(f[2], f[3]); v0.z = cvt_pk_bf16(f[4], f[5]); v0.w = cvt_pk_bf16(f[6], f[7]);
    v1.x = cvt_pk_bf16(f[8], f[9]); v1.y = cvt_pk_bf16(f[10], f[11]); v1.z = cvt_pk_bf16(f[12], f[13]); v1.w = cvt_pk_bf16(f[14], f[15]);
    bf16_t* o = dst + (size_t)((n >> 4) * rstep + (n & 15)) * dst_ld + kc;
    *(u32x4*)o = v0; *(u32x4*)(o + 8) = v1;
  }
  __syncthreads();
}

__device__ void conv_item(const Params& p, int l, int it, unsigned char* smem) {
  float* tile = (float*)smem;
  if (it < 640) {
    const int kt = it / 40, ntile = it % 40;
    tconv_tile(tile, p.w_in + (size_t)l * 1024 * 2560 + (size_t)kt * 64 * 2560 + ntile * 64, 2560, nullptr,
               p.Wt_in + (size_t)ntile * 64 * 1024 + kt * 64, 1024, 16);
  } else if (it < 896) {
    const int r = it - 640, kt = r / 16, ntile = r % 16;
    tconv_tile(tile, p.w_out + (size_t)l * 1024 * 1024 + (size_t)kt * 64 * 1024 + ntile * 64, 1024, p.mix_g + l * 1024 + kt * 64,
               p.Wt_out + (size_t)ntile * 64 * 1024 + kt * 64, 1024, 16);
  } else if (it < 2944) {
    const int r0 = it - 896, e = r0 >> 7, r = r0 & 127, which = r >> 6, r2 = r & 63, kt = r2 >> 2, ntile = r2 & 3;
    const float* src = (which ? p.w_up : p.w_gate) + (size_t)(l * 16 + e) * 1024 * 256 + (size_t)kt * 64 * 256 + ntile * 64;
    tconv_tile(tile, src, 256, nullptr, p.Wgu + (size_t)e * 512 * 1024 + (size_t)(ntile * 128 + which * 16) * 1024 + kt * 64, 1024, 32);
  } else if (it < 3968) {
    const int r0 = it - 2944, e = r0 >> 6, r = r0 & 63, kt = r >> 4, ntile = r & 15;
    tconv_tile(tile, p.w_down + (size_t)(l * 16 + e) * 256 * 1024 + (size_t)kt * 64 * 1024 + ntile * 64, 1024, nullptr,
               p.Wdn + (size_t)e * 1024 * 256 + (size_t)ntile * 64 * 256 + kt * 64, 256, 16);
  } else if (it == 3984) {
    for (int i = threadIdx.x; i < 16384; i += 256) {
      const int jj = i & 7, j = (i >> 3) & 15, g = (i >> 7) & 3, kb = i >> 9;
      const int k = 32 * kb + 8 * g + jj;
      const float we = p.re_w[(size_t)(l * 1024 + k) * 16 + j];
      const float wg = (j < 4) ? p.rg_w[(size_t)(l * 1024 + k) * 4 + j] : 0.0f;
      const unsigned eh = cvt_pk_bf16(we, 0.f) & 0xffffu, gh = cvt_pk_bf16(wg, 0.f) & 0xffffu;
      const unsigned el = cvt_pk_bf16(we - __uint_as_float(eh << 16), 0.f) & 0xffffu;
      const unsigned gl = cvt_pk_bf16(wg - __uint_as_float(gh << 16), 0.f) & 0xffffu;
      p.Wr_eh[i] = (bf16_t)eh; p.Wr_el[i] = (bf16_t)el; p.Wr_gh[i] = (bf16_t)gh; p.Wr_gl[i] = (bf16_t)gl;
    }
  } else {
    const int j = it - 3968;
    const float* src = p.sgu_w + (size_t)l * 131072 + (size_t)j * 8192 + threadIdx.x * 32;
    bf16_t* dst = p.Wsgu + (size_t)j * 8192 + threadIdx.x * 32;
#pragma unroll
    for (int q = 0; q < 4; ++q) {
      const float4 a = *(const float4*)(src + q * 8), b = *(const float4*)(src + q * 8 + 4);
      u32x4 v; v.x = cvt_pk_bf16(a.x, a.y); v.y = cvt_pk_bf16(a.z, a.w); v.z = cvt_pk_bf16(b.x, b.y); v.w = cvt_pk_bf16(b.z, b.w);
      *(u32x4*)(dst + q * 8) = v;
    }
  }
}

__device__ __forceinline__ void p1_decode(int t, int& mt, int& nt) {
  const int x_ = t & 7, j_ = t >> 3, rd_ = j_ >> 6, lb_ = j_ & 63;
  mt = (rd_ < 4) ? (x_ * 16 + (rd_ & 1) * 8 + (lb_ & 7)) : (x_ * 16 + (lb_ & 15));
  nt = (rd_ < 4) ? ((rd_ >> 1) * 8 + (lb_ >> 3)) : (16 + (lb_ >> 4));
}
__device__ __forceinline__ void p1_epilogue(const Params& p, int l, int mt, int nt, f32x4 (&acc)[4][4]) {
  const int type = nt >> 2;
  const bool swapped = (type == 2) || (type == 4);
  const int tid = otid(), lane = tid & 63, wid = tid >> 6, wr = wid >> 1, wc = wid & 1;
  const int qi = lane & 15, g = lane >> 4;
  if (!swapped) {
#pragma unroll
    for (int i = 0; i < 4; ++i) {
      const int m = mt * 128 + wr * 64 + i * 16 + qi;
#pragma unroll
      for (int j = 0; j < 4; ++j) {
        const int n = nt * 128 + wc * 64 + j * 16 + 4 * g;
        f32x4 v = acc[i][j];
        if (type == 0) v *= 0.125f;
        if (type == 3) { v[0] = gelu_tanh(v[0]); v[1] = gelu_tanh(v[1]); v[2] = gelu_tanh(v[2]); v[3] = gelu_tanh(v[3]); }
        bf16_t* dst = (type == 3) ? (p.ub + (size_t)m * 512 + (n - 1536)) : (p.qk + (size_t)m * 1024 + n);
        store_bf16x4(dst, v[0], v[1], v[2], v[3]);
      }
    }
  } else {
    const int bidx = (mt * 128) >> 12, tokbase = (mt * 128) & 4095;
    bf16_t* dstb = (type == 2) ? p.vT : p.vnT;
    const int fbase = (type == 2) ? 1024 : 2048;
    if (type == 4) {
#pragma unroll
      for (int i = 0; i < 4; ++i)
#pragma unroll
        for (int j = 0; j < 4; ++j)
#pragma unroll
          for (int r = 0; r < 4; ++r) acc[i][j][r] = gelu_tanh(acc[i][j][r]);
      float gam[4], bet[4];
#pragma unroll
      for (int i = 0; i < 4; ++i) {
        const int f = nt * 128 + wr * 64 + i * 16 + qi - 2048;
        gam[i] = p.sgu_ln_g[l * 512 + f]; bet[i] = p.sgu_ln_b[l * 512 + f];
      }
#pragma unroll
      for (int j = 0; j < 4; ++j)
#pragma unroll
        for (int r = 0; r < 4; ++r) {
          float s1 = acc[0][j][r] + acc[1][j][r] + acc[2][j][r] + acc[3][j][r];
          s1 = row16_sum(s1);
          const float mu = s1 * (1.0f / 64.0f);
          float s2 = 0.f;
#pragma unroll
          for (int i = 0; i < 4; ++i) { const float d = acc[i][j][r] - mu; s2 += d * d; }
          s2 = row16_sum(s2);
          const float rstd = rsqrtf(s2 * (1.0f / 64.0f) + LN_EPS);
#pragma unroll
          for (int i = 0; i < 4; ++i) acc[i][j][r] = (acc[i][j][r] - mu) * rstd * gam[i] + bet[i];
        }
    }
#pragma unroll
    for (int i = 0; i < 4; ++i) {
      const int f = nt * 128 + wr * 64 + i * 16 + qi - fbase;
#pragma unroll
      for (int j = 0; j < 4; ++j) {
        const int tok = tokbase + wc * 64 + j * 16 + 4 * g;
        store_bf16x4(dstb + ((size_t)(bidx * 512 + f)) * 4096 + tok, acc[i][j][0], acc[i][j][1], acc[i][j][2], acc[i][j][3]);
      }
    }
  }
}


__device__ void p1_phase(const Params& p, int l, int bid, int nblk, unsigned char* smem) {
  const int tid0 = otid();
  int t = bid, mt = 0, nt = 0;
  const bf16_t* A = nullptr; const bf16_t* B = nullptr;
  if (t < 2560) {
    p1_decode(t, mt, nt);
    A = p.xb + (size_t)(mt * 128 + (tid0 >> 3)) * 1024 + (tid0 & 7) * 8;
    B = p.Wt_in + (size_t)(nt * 128 + (tid0 >> 3)) * 1024 + (tid0 & 7) * 8;
    __syncthreads();
    gemm_issue0(smem, A, A + 32 * 1024, A + 64 * 1024, A + 96 * 1024, B, B + 32 * 1024, B + 64 * 1024, B + 96 * 1024);
  }
  while (t < 2560) {
    const int type = nt >> 2;
    const bool swapped = (type == 2) || (type == 4);
    f32x4 acc[4][4];
    ZERO_ACC(acc);
    gemm_main<true>(smem, A, A + 32 * 1024, A + 64 * 1024, A + 96 * 1024, B, B + 32 * 1024, B + 64 * 1024, B + 96 * 1024, 16, -1, swapped, acc, NoMid());
    const int tn = t + nblk;
    int mtn = mt, ntn = nt;
    if (tn < 2560) {
      p1_decode(tn, mtn, ntn);
      const int tid = otid();
      A = p.xb + (size_t)(mtn * 128 + (tid >> 3)) * 1024 + (tid & 7) * 8;
      B = p.Wt_in + (size_t)(ntn * 128 + (tid >> 3)) * 1024 + (tid & 7) * 8;
      gemm_issue0(smem, A, A + 32 * 1024, A + 64 * 1024, A + 96 * 1024, B, B + 32 * 1024, B + 64 * 1024, B + 96 * 1024);
    }
    p1_epilogue(p, l, mt, nt, acc);
    mt = mtn; nt = ntn; t = tn;
  }
}

__device__ void attn_phase(const Params& p, int l, int bid, int nblk, unsigned char* smem) {
  const int tid = otid(), lane = tid & 63, w = tid >> 6, qi = lane & 15, g = lane >> 4;
  unsigned char* Kb = smem;
  unsigned char* Vb = smem + 32768;
  float* sbias = (float*)(smem + 32768 + 33792);
  const int c0 = (w == 0) ? 0 : (w == 1) ? 8 : (w == 2) ? 24 : 32;
  const int cq = 16 * w + qi, cs = min(max(cq - 8, 0), 48);
  const int krow = tid >> 3, kch = tid & 7;
  const int ksoff = krow * 128 + ((kch ^ ((krow >> 1) & 7)) << 4);
  const int vd = tid >> 5, vc = tid & 31;
  const int vsoff = vd * 528 + vc * 16;
  u32x4 st[8], st2[8];
#define ATT_ISSUE_K(it_)                                                                                              \
  do {                                                                                                                \
    const int h_ = (it_) & 7, br_ = (it_) >> 3, r_ = br_ & 63, b_ = br_ >> 6, rs_ = min(max(r_ - 4, 0), 56);          \
    const bf16_t* kg_ = p.qk + ((size_t)b_ * 4096 + rs_ * 64 + krow) * 1024 + 512 + h_ * 64 + kch * 8;                \
    _Pragma("unroll") for (int i = 0; i < 8; ++i) st[i] = *(const u32x4*)(kg_ + (size_t)(32 * i) * 1024);            \
    _Pragma("unroll") for (int i = 0; i < 8; ++i) st2[i] = *(const u32x4*)(kg_ + (size_t)(256 + 32 * i) * 1024);     \
  } while (0)
  int it = bid;
  if (it < 2048) ATT_ISSUE_K(it);
  while (it < 2048) {
    const int h = it & 7, br = it >> 3, r = br & 63, b = br >> 6;
    const int rs = min(max(r - 4, 0), 56);
    const size_t tokq = (size_t)b * 4096 + r * 64 + cq;
    const bf16_t* vg = p.vT + ((size_t)(b * 512 + h * 64 + vd)) * 4096 + rs * 64 + vc * 8;
    const float rb0 = p.rel_bias[(size_t)(l * 8 + h) * 465 + tid];
    const float rb1 = p.rel_bias[(size_t)(l * 8 + h) * 465 + min(tid + 256, 464)];
    bf16x8 qf0 = *(const bf16x8*)(p.qk + tokq * 1024 + h * 64 + g * 8);
    bf16x8 qf1 = *(const bf16x8*)(p.qk + tokq * 1024 + h * 64 + 32 + g * 8);
    __syncthreads();
    sbias[tid] = rb0;
    if (tid + 256 < 465) sbias[tid + 256] = rb1;
#pragma unroll
    for (int i = 0; i < 8; ++i) *(u32x4*)(Kb + ksoff + i * 4096) = st[i];
#pragma unroll
    for (int i = 0; i < 8; ++i) st[i] = *(const u32x4*)(vg + (size_t)(8 * i) * 4096);
    __syncthreads();
    f32x4 s[8][2];
#pragma unroll
    for (int jh = 0; jh < 2; ++jh) {
#pragma unroll
      for (int jj = 0; jj < 4; ++jj)
#pragma unroll
        for (int ch = 0; ch < 2; ++ch) {
          const int kl = jj * 64 + c0 + 16 * ch + qi;
          const int sw = (kl >> 1) & 7;
          const bf16x8 kf0 = *(const bf16x8*)(Kb + kl * 128 + (((0 + g) ^ sw) << 4));
          const bf16x8 kf1 = *(const bf16x8*)(Kb + kl * 128 + (((4 + g) ^ sw) << 4));
          f32x4 a = {0.f, 0.f, 0.f, 0.f};
          a = __builtin_amdgcn_mfma_f32_16x16x32_bf16(kf0, qf0, a, 0, 0, 0);
          a = __builtin_amdgcn_mfma_f32_16x16x32_bf16(kf1, qf1, a, 0, 0, 0);
          s[jh * 4 + jj][ch] = a;
        }
      if (jh == 0) {
        __syncthreads();
#pragma unroll
        for (int i = 0; i < 8; ++i) *(u32x4*)(Kb + ksoff + i * 4096) = st2[i];
#pragma unroll
        for (int i = 0; i < 8; ++i) st2[i] = *(const u32x4*)(vg + (size_t)(8 * i) * 4096 + 256);
        __syncthreads();
      }
    }
#pragma unroll
    for (int i = 0; i < 8; ++i) *(u32x4*)(Vb + vsoff + i * 8 * 528) = st[i];
    float mx = -1e30f;
#pragma unroll
    for (int j = 0; j < 8; ++j)
#pragma unroll
      for (int ch = 0; ch < 2; ++ch)
#pragma unroll
        for (int rg = 0; rg < 4; ++rg) {
          const int kc = c0 + 16 * ch + 4 * g + rg;
          const bool valid = (kc >= cs) && (kc < cs + 16);
          const int bidx = valid ? ((rs + j - r + 7) * 31 + (kc - cq) + 15) : 0;
          const float v = valid ? (s[j][ch][rg] + sbias[bidx]) : -1e30f;
          s[j][ch][rg] = v;
          mx = fmaxf(mx, v);
        }
    mx = fmaxf(mx, __shfl_xor(mx, 16)); mx = fmaxf(mx, __shfl_xor(mx, 32));
    float sum = 0.f;
#pragma unroll
    for (int j = 0; j < 8; ++j)
#pragma unroll
      for (int ch = 0; ch < 2; ++ch)
#pragma unroll
        for (int rg = 0; rg < 4; ++rg) { const float e = __expf(s[j][ch][rg] - mx); s[j][ch][rg] = e; sum += e; }
    sum += __shfl_xor(sum, 16); sum += __shfl_xor(sum, 32);
    const float inv = 1.0f / sum;
    bf16x8 pf[8];
#pragma unroll
    for (int j = 0; j < 8; ++j) {
      u32x4 pw;
      pw.x = cvt_pk_bf16(s[j][0][0], s[j][0][1]); pw.y = cvt_pk_bf16(s[j][0][2], s[j][0][3]);
      pw.z = cvt_pk_bf16(s[j][1][0], s[j][1][1]); pw.w = cvt_pk_bf16(s[j][1][2], s[j][1][3]);
      pf[j] = __builtin_bit_cast(bf16x8, pw);
    }
    f32x4 o[4];
#pragma unroll
    for (int dt = 0; dt < 4; ++dt) o[dt] = (f32x4){0.f, 0.f, 0.f, 0.f};
    const int itn = it + nblk;
    __syncthreads();
#pragma unroll
    for (int jh = 0; jh < 2; ++jh) {
#pragma unroll
      for (int jj = 0; jj < 4; ++jj)
#pragma unroll
        for (int dt = 0; dt < 4; ++dt) {
          const unsigned char* vp = Vb + (dt * 16 + qi) * 528 + (jj * 64 + c0 + 4 * g) * 2;
          const u32x2 lo = *(const u32x2*)vp, hi = *(const u32x2*)(vp + 32);
          u32x4 vw; vw.x = lo.x; vw.y = lo.y; vw.z = hi.x; vw.w = hi.y;
          o[dt] = __builtin_amdgcn_mfma_f32_16x16x32_bf16(__builtin_bit_cast(bf16x8, vw), pf[jh * 4 + jj], o[dt], 0, 0, 0);
        }
      if (jh == 0) {
        __syncthreads();
#pragma unroll
        for (int i = 0; i < 8; ++i) *(u32x4*)(Vb + vsoff + i * 8 * 528) = st2[i];
        if (itn < 2048) ATT_ISSUE_K(itn);
        __syncthreads();
      }
    }
    float sq = 0.f;
#pragma unroll
    for (int dt = 0; dt < 4; ++dt) {
      o[dt] *= inv;
      sq += o[dt][0] * o[dt][0] + o[dt][1] * o[dt][1] + o[dt][2] * o[dt][2] + o[dt][3] * o[dt][3];
      store_bf16x4(p.mixed + tokq * 1024 + h * 64 + dt * 16 + 4 * g, o[dt][0], o[dt][1], o[dt][2], o[dt][3]);
    }
    sq += __shfl_xor(sq, 16); sq += __shfl_xor(sq, 32);
    if (g == 0) p.ssq[tokq * 16 + h] = sq;
    it = itn;
  }
#undef ATT_ISSUE_K
}

__device__ void sgu_item(const Params& p, int l, int it, unsigned char* smem) {
  const int grp = it & 7, bc = it >> 3, chunk = bc & 31, b = bc >> 5;
  const int tid = otid(), lane = tid & 63, w = tid >> 6, qi = lane & 15, g = lane >> 4;
  const int p0 = 32 * w;
  const int wbase = __builtin_amdgcn_readfirstlane(w) * 1024;
  const int lc = ((tid & 15) ^ ((tid >> 4) & 15)) << 3;
  const bf16_t* wsrc = p.Wsgu + ((size_t)(grp * 128 + (tid >> 4))) * 128 + lc;
  const bf16_t* vsrc = p.vnT + ((size_t)(b * 512 + grp * 64 + (tid >> 4))) * 4096 + chunk * 128 + lc;
  __syncthreads();
#pragma unroll
  for (int i = 0; i < 8; ++i) GLDS16(wsrc + (size_t)(16 * i) * 128, smem + i * 4096 + wbase);
#pragma unroll
  for (int i = 0; i < 4; ++i) GLDS16(vsrc + (size_t)(16 * i) * 4096, smem + 32768 + i * 4096 + wbase);
  asm volatile("s_waitcnt vmcnt(0)" ::: "memory");
  __syncthreads();
  f32x4 acc[2][4];
#pragma unroll
  for (int mt = 0; mt < 2; ++mt)
#pragma unroll
    for (int nt = 0; nt < 4; ++nt) acc[mt][nt] = (f32x4){0.f, 0.f, 0.f, 0.f};
#pragma unroll
  for (int ks = 0; ks < 4; ++ks) {
    const int co = ((ks * 4 + g) ^ qi) << 4;
    bf16x8 wf[2], vf[4];
#pragma unroll
    for (int mt = 0; mt < 2; ++mt) wf[mt] = *(const bf16x8*)(smem + (p0 + 16 * mt + qi) * 256 + co);
#pragma unroll
    for (int nt = 0; nt < 4; ++nt) vf[nt] = *(const bf16x8*)(smem + 32768 + (16 * nt + qi) * 256 + co);
#pragma unroll
    for (int mt = 0; mt < 2; ++mt)
#pragma unroll
      for (int nt = 0; nt < 4; ++nt) acc[mt][nt] = __builtin_amdgcn_mfma_f32_16x16x32_bf16(vf[nt], wf[mt], acc[mt][nt], 0, 0, 0);
  }
#pragma unroll
  for (int mt = 0; mt < 2; ++mt) {
    const int pp = p0 + 16 * mt + qi;
    const size_t tok = (size_t)b * 4096 + chunk * 128 + pp;
    const float bias = p.sgu_b[(size_t)(l * 8 + grp) * 128 + pp];
    float sq = 0.f;
#pragma unroll
    for (int nt = 0; nt < 4; ++nt) {
      const int d = 16 * nt + 4 * g;
      const u32x2 uu = *(const u32x2*)(p.ub + tok * 512 + grp * 64 + d);
      const float u0 = __uint_as_float(uu.x << 16), u1 = __uint_as_float(uu.x & 0xffff0000u);
      const float u2 = __uint_as_float(uu.y << 16), u3 = __uint_as_float(uu.y & 0xffff0000u);
      const float v0 = u0 * (acc[mt][nt][0] + bias), v1 = u1 * (acc[mt][nt][1] + bias);
      const float v2 = u2 * (acc[mt][nt][2] + bias), v3 = u3 * (acc[mt][nt][3] + bias);
      sq += v0 * v0 + v1 * v1 + v2 * v2 + v3 * v3;
      store_bf16x4(p.mixed + tok * 1024 + 512 + grp * 64 + d, v0, v1, v2, v3);
    }
    sq += __shfl_xor(sq, 16); sq += __shfl_xor(sq, 32);
    if (g == 0) p.ssq[tok * 16 + 8 + grp] = sq;
  }
}

__device__ void p3_tile(const Params& p, int l, int t, unsigned char* smem) {
  const int x_ = t & 7, j_ = t >> 3, rd_ = j_ >> 6, lb_ = j_ & 63;
  const int mt = x_ * 16 + rd_ * 8 + (lb_ & 7), nt = lb_ >> 3;
  const int tid = otid(), lane = tid & 63, wid = tid >> 6, wr = wid >> 1, wc = wid & 1;
  const int srow = tid >> 3, sch = tid & 7, qi = lane & 15, g = lane >> 4;
  const bf16_t* A = p.mixed + (size_t)(mt * 128 + srow) * 1024 + sch * 8;
  const bf16_t* B = p.Wt_out + (size_t)(nt * 128 + srow) * 1024 + sch * 8;
  MidScale mid; float rss[4];
#pragma unroll
  for (int i = 0; i < 4; ++i) {
    const int m = mt * 128 + wr * 64 + i * 16 + qi;
    const float4 a0 = *(const float4*)(p.ssq + (size_t)m * 16), a1 = *(const float4*)(p.ssq + (size_t)m * 16 + 4);
    const float4 b0 = *(const float4*)(p.ssq + (size_t)m * 16 + 8), b1 = *(const float4*)(p.ssq + (size_t)m * 16 + 12);
    const float sa = (a0.x + a0.y + a0.z + a0.w) + (a1.x + a1.y + a1.z + a1.w);
    const float sb = (b0.x + b0.y + b0.z + b0.w) + (b1.x + b1.y + b1.z + b1.w);
    const float ra = rsqrtf(sa * (1.0f / 512.0f) + LN_EPS), rb = rsqrtf(sb * (1.0f / 512.0f) + LN_EPS);
    mid.s[i] = ra / rb; rss[i] = rb;
  }
  f32x4 acc[4][4];
  ZERO_ACC(acc);
  gemm_main(smem, A, A + 32 * 1024, A + 64 * 1024, A + 96 * 1024, B, B + 32 * 1024, B + 64 * 1024, B + 96 * 1024, 16, 8, false, acc, mid);
#pragma unroll
  for (int i = 0; i < 4; ++i) {
    const int m = mt * 128 + wr * 64 + i * 16 + qi;
#pragma unroll
    for (int j = 0; j < 4; ++j) {
      const int n = nt * 128 + wc * 64 + j * 16 + 4 * g;
      const u32x2 xr = *(const u32x2*)(p.xb + (size_t)m * 1024 + n);
      const float o0 = ALPHA * __uint_as_float(xr.x << 16) + acc[i][j][0] * rss[i];
      const float o1 = ALPHA * __uint_as_float(xr.x & 0xffff0000u) + acc[i][j][1] * rss[i];
      const float o2 = ALPHA * __uint_as_float(xr.y << 16) + acc[i][j][2] * rss[i];
      const float o3 = ALPHA * __uint_as_float(xr.y & 0xffff0000u) + acc[i][j][3] * rss[i];
      store_bf16x4(p.hb + (size_t)m * 1024 + n, o0, o1, o2, o3);
    }
  }
}

__device__ void p4_batch(const Params& p, int l, int batch, unsigned char* smem) {
  const int tid = otid(), lane = tid & 63, w = tid >> 6;
  int* scnt = (int*)smem;
  int* sbase = scnt + 16;
  __syncthreads();
  if (tid < 16) scnt[tid] = 0;
  __syncthreads();
  const int tokw = batch * 32 + w * 8;
  {
    float4 gm[4], bt[4];
#pragma unroll
    for (int q = 0; q < 4; ++q) {
      gm[q] = *(const float4*)(p.ln1_g + l * 1024 + q * 256 + lane * 4);
      bt[q] = *(const float4*)(p.ln1_b + l * 1024 + q * 256 + lane * 4);
    }
#pragma unroll 4
    for (int t = 0; t < 8; ++t) {
      float* xr = p.x1 + (size_t)(tokw + t) * 1024 + lane * 4;
      const bf16_t* hr = p.hb + (size_t)(tokw + t) * 1024 + lane * 4;
      float4 v[4];
#pragma unroll
      for (int q = 0; q < 4; ++q) {
        const u32x2 hh = *(const u32x2*)(hr + q * 256);
        v[q].x = __uint_as_float(hh.x << 16); v[q].y = __uint_as_float(hh.x & 0xffff0000u);
        v[q].z = __uint_as_float(hh.y << 16); v[q].w = __uint_as_float(hh.y & 0xffff0000u);
      }
      float s1 = 0.f;
#pragma unroll
      for (int q = 0; q < 4; ++q) s1 += (v[q].x + v[q].y) + (v[q].z + v[q].w);
      const float mu = wave_sum(s1) * (1.0f / 1024.0f);
      float s2 = 0.f;
#pragma unroll
      for (int q = 0; q < 4; ++q) {
        const float d0 = v[q].x - mu, d1 = v[q].y - mu, d2 = v[q].z - mu, d3 = v[q].w - mu;
        s2 += (d0 * d0 + d1 * d1) + (d2 * d2 + d3 * d3);
      }
      const float rstd = rsqrtf(wave_sum(s2) * (1.0f / 1024.0f) + LN_EPS);
#pragma unroll
      for (int q = 0; q < 4; ++q) {
        float4 o;
        o.x = (v[q].x - mu) * rstd * gm[q].x + bt[q].x; o.y = (v[q].y - mu) * rstd * gm[q].y + bt[q].y;
        o.z = (v[q].z - mu) * rstd * gm[q].z + bt[q].z; o.w = (v[q].w - mu) * rstd * gm[q].w + bt[q].w;
        *(float4*)(xr + q * 256) = o;
        store_bf16x4(p.xb + (size_t)(tokw + t) * 1024 + q * 256 + lane * 4, o.x, o.y, o.z, o.w);
      }
    }
  }
  asm volatile("s_waitcnt vmcnt(0)" ::: "memory");
  __syncthreads();
  const int j = lane & 15, g = lane >> 4;
  float* part = (float*)(smem + 1024);
  {
    const float* xr0 = p.x1 + (size_t)(batch * 32 + j) * 1024 + 256 * w + 8 * g;
    const float* xr1 = xr0 + 16 * 1024;
    const size_t wof = ((size_t)(8 * w * 4 + g) * 16 + j) * 8;
    f32x4 De0 = {0.f, 0.f, 0.f, 0.f}, Dg0 = De0, De1 = De0, Dg1 = De0;
#pragma unroll 2
    for (int kb = 0; kb < 8; ++kb) {
      const float4 xa0 = *(const float4*)(xr0 + kb * 32), xc0 = *(const float4*)(xr0 + kb * 32 + 4);
      const float4 xa1 = *(const float4*)(xr1 + kb * 32), xc1 = *(const float4*)(xr1 + kb * 32 + 4);
      const bf16x8 weh = *(const bf16x8*)(p.Wr_eh + wof + kb * 512), wel = *(const bf16x8*)(p.Wr_el + wof + kb * 512);
      const bf16x8 wgh = *(const bf16x8*)(p.Wr_gh + wof + kb * 512), wgl = *(const bf16x8*)(p.Wr_gl + wof + kb * 512);
      u32x4 h, lo;
      h.x = cvt_pk_bf16(xa0.x, xa0.y); h.y = cvt_pk_bf16(xa0.z, xa0.w); h.z = cvt_pk_bf16(xc0.x, xc0.y); h.w = cvt_pk_bf16(xc0.z, xc0.w);
      lo.x = cvt_pk_bf16(xa0.x - __uint_as_float(h.x << 16), xa0.y - __uint_as_float(h.x & 0xffff0000u));
      lo.y = cvt_pk_bf16(xa0.z - __uint_as_float(h.y << 16), xa0.w - __uint_as_float(h.y & 0xffff0000u));
      lo.z = cvt_pk_bf16(xc0.x - __uint_as_float(h.z << 16), xc0.y - __uint_as_float(h.z & 0xffff0000u));
      lo.w = cvt_pk_bf16(xc0.z - __uint_as_float(h.w << 16), xc0.w - __uint_as_float(h.w & 0xffff0000u));
      bf16x8 xh = __builtin_bit_cast(bf16x8, h), xl = __builtin_bit_cast(bf16x8, lo);
      De0 = __builtin_amdgcn_mfma_f32_16x16x32_bf16(weh, xh, De0, 0, 0, 0);
      Dg0 = __builtin_amdgcn_mfma_f32_16x16x32_bf16(wgh, xh, Dg0, 0, 0, 0);
      De0 = __builtin_amdgcn_mfma_f32_16x16x32_bf16(weh, xl, De0, 0, 0, 0);
      Dg0 = __builtin_amdgcn_mfma_f32_16x16x32_bf16(wgh, xl, Dg0, 0, 0, 0);
      De0 = __builtin_amdgcn_mfma_f32_16x16x32_bf16(wel, xh, De0, 0, 0, 0);
      Dg0 = __builtin_amdgcn_mfma_f32_16x16x32_bf16(wgl, xh, Dg0, 0, 0, 0);
      h.x = cvt_pk_bf16(xa1.x, xa1.y); h.y = cvt_pk_bf16(xa1.z, xa1.w); h.z = cvt_pk_bf16(xc1.x, xc1.y); h.w = cvt_pk_bf16(xc1.z, xc1.w);
      lo.x = cvt_pk_bf16(xa1.x - __uint_as_float(h.x << 16), xa1.y - __uint_as_float(h.x & 0xffff0000u));
      lo.y = cvt_pk_bf16(xa1.z - __uint_as_float(h.y << 16), xa1.w - __uint_as_float(h.y & 0xffff0000u));
      lo.z = cvt_pk_bf16(xc1.x - __uint_as_float(h.z << 16), xc1.y - __uint_as_float(h.z & 0xffff0000u));
      lo.w = cvt_pk_bf16(xc1.z - __uint_as_float(h.w << 16), xc1.w - __uint_as_float(h.w & 0xffff0000u));
      xh = __builtin_bit_cast(bf16x8, h); xl = __builtin_bit_cast(bf16x8, lo);
      De1 = __builtin_amdgcn_mfma_f32_16x16x32_bf16(weh, xh, De1, 0, 0, 0);
      Dg1 = __builtin_amdgcn_mfma_f32_16x16x32_bf16(wgh, xh, Dg1, 0, 0, 0);
      De1 = __builtin_amdgcn_mfma_f32_16x16x32_bf16(weh, xl, De1, 0, 0, 0);
      Dg1 = __builtin_amdgcn_mfma_f32_16x16x32_bf16(wgh, xl, Dg1, 0, 0, 0);
      De1 = __builtin_amdgcn_mfma_f32_16x16x32_bf16(wel, xh, De1, 0, 0, 0);
      Dg1 = __builtin_amdgcn_mfma_f32_16x16x32_bf16(wgl, xh, Dg1, 0, 0, 0);
    }
    float* pw = part + ((size_t)(w * 2) * 64 + lane) * 8;
    *(f32x4*)(pw) = De0; *(f32x4*)(pw + 4) = Dg0;
    *(f32x4*)(pw + 512) = De1; *(f32x4*)(pw + 516) = Dg1;
  }
  __syncthreads();
  const int tok = tokw + (j & 7);
  f32x4 De = {0.f, 0.f, 0.f, 0.f}, Dg = {0.f, 0.f, 0.f, 0.f};
  {
    const int ln = g * 16 + (w & 1) * 8 + (j & 7), tl = w >> 1;
#pragma unroll
    for (int ww = 0; ww < 4; ++ww) {
      const float* pr = part + ((size_t)(ww * 2 + tl) * 64 + ln) * 8;
      De += *(const f32x4*)(pr); Dg += *(const f32x4*)(pr + 4);
    }
  }
  float gl[4];
#pragma unroll
  for (int k = 0; k < 4; ++k) gl[k] = __shfl(Dg[k], j) + p.rg_b[l * 4 + k];
  int gs = 0; float gmax = gl[0];
#pragma unroll
  for (int k = 1; k < 4; ++k) { const bool bb = gl[k] > gmax; gmax = bb ? gl[k] : gmax; gs = bb ? k : gs; }
  float psum = 0.f;
#pragma unroll
  for (int k = 0; k < 4; ++k) psum += __expf(gl[k] - gmax);
  const float gate = 1.0f / psum;
  float es[4];
#pragma unroll
  for (int k = 0; k < 4; ++k) es[k] = De[k] + p.re_b[l * 16 + 4 * g + k];
  int i0 = 0; float v0 = es[0];
#pragma unroll
  for (int k = 1; k < 4; ++k) { const bool bb = es[k] > v0; v0 = bb ? es[k] : v0; i0 = bb ? k : i0; }
  int i1 = 0; float v1 = -3.0e38f;
#pragma unroll
  for (int k = 0; k < 4; ++k) { const bool bb = (k != i0) && (es[k] > v1); v1 = bb ? es[k] : v1; i1 = bb ? k : i1; }
  const float ex = __expf(v1 - v0);
  const float tw0 = 1.0f / (1.0f + ex), tw1 = ex / (1.0f + ex);
  const bool commit = (g == gs) && (j < 8);
  const int e0 = gs * 4 + i0, e1 = gs * 4 + i1;
  int lp0 = 0, lp1 = 0;
  if (commit) { lp0 = atomicAdd(&scnt[e0], 1); lp1 = atomicAdd(&scnt[e1], 1); }
  __syncthreads();
  if (tid < 16) sbase[tid] = atomicAdd(p.counts + l * 16 + tid, scnt[tid]);
  __syncthreads();
  if (commit) {
    const int pos0 = sbase[e0] + lp0, pos1 = sbase[e1] + lp1;
    p.list[e0 * NTOK + pos0] = tok; p.wlist[e0 * NTOK + pos0] = gate * tw0;
    p.list[e1 * NTOK + pos1] = tok; p.wlist[e1 * NTOK + pos1] = gate * tw1;
    int4 ti; ti.x = e0; ti.y = pos0; ti.z = e1; ti.w = pos1;
    *(int4*)(p.tokinfo + (size_t)tok * 4) = ti;
  }
}

__device__ __forceinline__ int moe_total_mtiles(const int* cnts) {
  int tot = 0;
#pragma unroll
  for (int e = 0; e < 16; ++e) tot += (cnts[e] + 127) >> 7;
  return tot;
}
__device__ __forceinline__ void moe_find(const int* cnts, int mi, int& e_out, int& ml, int& off, int& cnt) {
  int rem = mi, o = 0; e_out = 0; ml = 0; off = 0; cnt = 1;
  bool found = false;
#pragma unroll
  for (int e = 0; e < 16; ++e) {
    const int c = cnts[e], mtl = (c + 127) >> 7;
    if (!found && rem < mtl) { found = true; e_out = e; ml = rem; off = o; cnt = c; }
    rem -= mtl; o += c;
  }
}

__device__ void p5_tile(const Params& p, int l, int t, int mtot, unsigned char* smem) {
  const int mi = (t >> 5) * 8 + (t & 7), nt = (t >> 3) & 3;
  if (mi >= mtot) return;
  int e, ml, off, cnt;
  moe_find(p.counts + l * 16, mi, e, ml, off, cnt);
  const int tid = otid(), lane = tid & 63, wid = tid >> 6, wr = wid >> 1, wc = wid & 1;
  const int srow = tid >> 3, sch = tid & 7, qi = lane & 15, g = lane >> 4;
  const bf16_t* pa[4];
#pragma unroll
  for (int i = 0; i < 4; ++i) {
    const int ridx = min(ml * 128 + srow + 32 * i, cnt - 1);
    const int tok = p.list[e * NTOK + ridx];
    pa[i] = p.xb + (size_t)tok * 1024 + sch * 8;
  }
  const bf16_t* B = p.Wgu + ((size_t)e * 512 + nt * 128 + srow) * 1024 + sch * 8;
  f32x4 acc[4][4];
  ZERO_ACC(acc);
  gemm_main(smem, pa[0], pa[1], pa[2], pa[3], B, B + 32 * 1024, B + 64 * 1024, B + 96 * 1024, 16, -1, false, acc, NoMid());
#pragma unroll
  for (int i = 0; i < 4; ++i) {
    const int rloc = ml * 128 + wr * 64 + i * 16 + qi;
    if (rloc < cnt) {
      const size_t slot = (size_t)off + rloc;
#pragma unroll
      for (int jp = 0; jp < 2; ++jp) {
        const f32x4 ga = acc[i][2 * jp], up = acc[i][2 * jp + 1];
        const int col = 64 * nt + 32 * wc + 16 * jp + 4 * g;
        store_bf16x4(p.act + slot * 256 + col, silu(ga[0]) * up[0], silu(ga[1]) * up[1], silu(ga[2]) * up[2], silu(ga[3]) * up[3]);
      }
    }
  }
}

struct P6Tile { int e, ml, off, cnt, nt; const bf16_t* pa0; const bf16_t* pa1; const bf16_t* pa2; const bf16_t* pa3; const bf16_t* B; };
__device__ __forceinline__ int p6_next(int t, int ntot, int mtot, int nblk) {
  while (t < ntot && ((t >> 6) * 8 + (t & 7)) >= mtot) t += nblk;
  return t;
}
__device__ __forceinline__ void p6_setup(const Params& p, int l, int t, P6Tile& T) {
  const int mi = (t >> 6) * 8 + (t & 7);
  T.nt = (t >> 3) & 7;
  moe_find(p.counts + l * 16, mi, T.e, T.ml, T.off, T.cnt);
  const int tid = otid(), srow = tid >> 3, sch = tid & 7;
  const bf16_t* base = p.act + (size_t)T.off * 256 + sch * 8;
  T.pa0 = base + (size_t)min(T.ml * 128 + srow, T.cnt - 1) * 256;
  T.pa1 = base + (size_t)min(T.ml * 128 + srow + 32, T.cnt - 1) * 256;
  T.pa2 = base + (size_t)min(T.ml * 128 + srow + 64, T.cnt - 1) * 256;
  T.pa3 = base + (size_t)min(T.ml * 128 + srow + 96, T.cnt - 1) * 256;
  T.B = p.Wdn + ((size_t)T.e * 1024 + T.nt * 128 + srow) * 256 + sch * 8;
}
__device__ void p6_phase(const Params& p, int l, int bid, int nblk, unsigned char* smem) {
  const int mtot = moe_total_mtiles(p.counts + l * 16), ntot = ((mtot + 7) >> 3) * 64;
  P6Tile cur, nxt;
  int t = p6_next(bid, ntot, mtot, nblk);
  if (t < ntot) {
    p6_setup(p, l, t, cur);
    __syncthreads();
    gemm_issue0(smem, cur.pa0, cur.pa1, cur.pa2, cur.pa3, cur.B, cur.B + 32 * 256, cur.B + 64 * 256, cur.B + 96 * 256);
  }
  while (t < ntot) {
    f32x4 acc[4][4];
    ZERO_ACC(acc);
    gemm_main<true>(smem, cur.pa0, cur.pa1, cur.pa2, cur.pa3, cur.B, cur.B + 32 * 256, cur.B + 64 * 256, cur.B + 96 * 256, 4, -1, false, acc, NoMid());
    const int tn = p6_next(t + nblk, ntot, mtot, nblk);
    nxt = cur;
    if (tn < ntot) {
      p6_setup(p, l, tn, nxt);
      gemm_issue0(smem, nxt.pa0, nxt.pa1, nxt.pa2, nxt.pa3, nxt.B, nxt.B + 32 * 256, nxt.B + 64 * 256, nxt.B + 96 * 256);
    }
    {
      const int tid = otid(), lane = tid & 63, wid = tid >> 6, wr = wid >> 1, wc = wid & 1, qi = lane & 15, g = lane >> 4;
#pragma unroll
      for (int i = 0; i < 4; ++i) {
        const int rloc = cur.ml * 128 + wr * 64 + i * 16 + qi;
        if (rloc < cur.cnt) {
          const float wgt = p.wlist[cur.e * NTOK + rloc];
          const size_t slot = (size_t)cur.off + rloc;
#pragma unroll
          for (int j = 0; j < 4; ++j) {
            const int n = cur.nt * 128 + wc * 64 + j * 16 + 4 * g;
            store_bf16x4(p.y + slot * 1024 + n, acc[i][j][0] * wgt, acc[i][j][1] * wgt, acc[i][j][2] * wgt, acc[i][j][3] * wgt);
          }
        }
      }
    }
    cur = nxt; t = tn;
  }
}

template <int NT>
__device__ __forceinline__ void p7_tokens(const Params& p, int l, int tok0, int tstride) {
  const int lane = otid() & 63;
  int4 ti[NT];
#pragma unroll
  for (int u = 0; u < NT; ++u) ti[u] = *(const int4*)(p.tokinfo + (size_t)(tok0 + u * tstride) * 4);
  int off0[NT], off1[NT];
#pragma unroll
  for (int u = 0; u < NT; ++u) { off0[u] = 0; off1[u] = 0; }
#pragma unroll
  for (int e = 0; e < 16; ++e) {
    const int c = p.counts[l * 16 + e];
#pragma unroll
    for (int u = 0; u < NT; ++u) { if (e < ti[u].x) off0[u] += c; if (e < ti[u].z) off1[u] += c; }
  }
  float4 xr[NT][4]; u32x2 ya[NT][4], yb[NT][4];
#pragma unroll
  for (int u = 0; u < NT; ++u) {
    const int tok = tok0 + u * tstride;
    const size_t s0 = (size_t)off0[u] + ti[u].y, s1 = (size_t)off1[u] + ti[u].w;
#pragma unroll
    for (int q = 0; q < 4; ++q) {
      const int c = q * 256 + lane * 4;
      xr[u][q] = *(const float4*)(p.x1 + (size_t)tok * 1024 + c);
      ya[u][q] = *(const u32x2*)(p.y + s0 * 1024 + c);
      yb[u][q] = *(const u32x2*)(p.y + s1 * 1024 + c);
    }
  }
  float4 gg[4], bb[4];
#pragma unroll
  for (int q = 0; q < 4; ++q) {
    gg[q] = *(const float4*)(p.ln2_g + l * 1024 + q * 256 + lane * 4);
    bb[q] = *(const float4*)(p.ln2_b + l * 1024 + q * 256 + lane * 4);
  }
#pragma unroll
  for (int u = 0; u < NT; ++u) {
    const int tok = tok0 + u * tstride;
    float hv[16];
#pragma unroll
    for (int q = 0; q < 4; ++q) {
      hv[q * 4 + 0] = ALPHA * xr[u][q].x + (__uint_as_float(ya[u][q].x << 16) + __uint_as_float(yb[u][q].x << 16));
      hv[q * 4 + 1] = ALPHA * xr[u][q].y + (__uint_as_float(ya[u][q].x & 0xffff0000u) + __uint_as_float(yb[u][q].x & 0xffff0000u));
      hv[q * 4 + 2] = ALPHA * xr[u][q].z + (__uint_as_float(ya[u][q].y << 16) + __uint_as_float(yb[u][q].y << 16));
      hv[q * 4 + 3] = ALPHA * xr[u][q].w + (__uint_as_float(ya[u][q].y & 0xffff0000u) + __uint_as_float(yb[u][q].y & 0xffff0000u));
    }
    float s1s = 0.f;
#pragma unroll
    for (int c = 0; c < 16; ++c) s1s += hv[c];
    const float mu = wave_sum(s1s) * (1.0f / 1024.0f);
    float s2 = 0.f;
#pragma unroll
    for (int c = 0; c < 16; ++c) { const float d = hv[c] - mu; s2 += d * d; }
    const float rstd = rsqrtf(wave_sum(s2) * (1.0f / 1024.0f) + LN_EPS);
#pragma unroll
    for (int q = 0; q < 4; ++q) {
      const int c = q * 256 + lane * 4;
      float4 o;
      o.x = (hv[q * 4 + 0] - mu) * rstd * gg[q].x + bb[q].x; o.y = (hv[q * 4 + 1] - mu) * rstd * gg[q].y + bb[q].y;
      o.z = (hv[q * 4 + 2] - mu) * rstd * gg[q].z + bb[q].z; o.w = (hv[q * 4 + 3] - mu) * rstd * gg[q].w + bb[q].w;
      if (l == 3) *(float4*)(p.out + (size_t)tok * 1024 + c) = o;
      else store_bf16x4(p.xb + (size_t)tok * 1024 + c, o.x, o.y, o.z, o.w);
    }
  }
}

#define XB_TMO      128
#define XB_XCNT(j)  (256  + 64 * (j))
#define XB_XSUB(j)  (1280 + 64 * (j))
#define XB_XGEN(j)  (2304 + 64 * (j))
#define XB_TOP      3328
#define XB_TOPGEN   3392
#define XCD_BAR_WORDS 3456
#define XB_SPIN_CAP (1u << 22)
__device__ __forceinline__ unsigned xb_ld(unsigned* p) { return __hip_atomic_load(p, __ATOMIC_RELAXED, __HIP_MEMORY_SCOPE_AGENT); }
__device__ __forceinline__ unsigned xb_add(unsigned* p, unsigned v) { return __hip_atomic_fetch_add(p, v, __ATOMIC_RELAXED, __HIP_MEMORY_SCOPE_AGENT); }
__device__ __forceinline__ unsigned xb_xcc_id() { return (unsigned)__builtin_amdgcn_s_getreg((3 << 11) | 20) & 0xFu; }
#define XB_SPIN(cond, bar) do { unsigned _sp = 0; while (cond) { __builtin_amdgcn_s_sleep(1); \
    if ((++_sp & 255u) == 0u) { if (xb_ld(&(bar)[XB_TMO])) break; if (_sp > XB_SPIN_CAP) { atomicAdd(&(bar)[XB_TMO], 1u); break; } } } } while (0)
struct XcdBarrier { unsigned* bar; unsigned x; volatile unsigned* st; };
__device__ __forceinline__ XcdBarrier xcd_barrier_post(unsigned* bar, volatile unsigned* st) {
  XcdBarrier b; b.bar = bar; b.x = xb_xcc_id(); b.st = st;
  if (threadIdx.x == 0) (void)xb_add(&bar[XB_XCNT(b.x)], 1u);
  return b;
}
__device__ __forceinline__ void xcd_barrier_complete(unsigned* bar, unsigned x, unsigned& nloc, unsigned& nx) {
  const unsigned G = gridDim.x;
  unsigned sum, cnt, mine, sp = 0u;
  for (;;) {
    sum = 0u; cnt = 0u; mine = 0u;
#pragma unroll
    for (unsigned j = 0; j < 16; ++j) { const unsigned c = xb_ld(&bar[XB_XCNT(j)]); sum += c; cnt += (c > 0u) ? 1u : 0u; mine = (j == x) ? c : mine; }
    if (sum == G) break;
    __builtin_amdgcn_s_sleep(1);
    if ((++sp & 255u) == 0u) { if (xb_ld(&bar[XB_TMO])) break; if (sp > XB_SPIN_CAP) { atomicAdd(&bar[XB_TMO], 1u); break; } }
  }
  nloc = mine > 0u ? mine : 1u; nx = cnt > 0u ? cnt : 1u;
}
__device__ __forceinline__ void xcd_barrier(const XcdBarrier& b) {
  asm volatile("s_waitcnt vmcnt(0)" ::: "memory");
  __syncthreads();
  if (threadIdx.x == 0) {
    unsigned* bar = b.bar;
    __builtin_amdgcn_s_waitcnt(0);
    unsigned nloc = b.st[0], nx = b.st[1];
    if (nloc == 0u) { xcd_barrier_complete(bar, b.x, nloc, nx); b.st[0] = nloc; b.st[1] = nx; }
    const unsigned old = xb_add(&bar[XB_XSUB(b.x)], 1u);
    const unsigned gen = old / nloc;
    if (old + 1u == (gen + 1u) * nloc) {
      __builtin_amdgcn_fence(__ATOMIC_RELEASE, "agent");
      asm volatile("s_waitcnt vmcnt(0)" ::: "memory");
      const unsigned og = xb_add(&bar[XB_TOP], 1u);
      const unsigned tg = og / nx;
      if (og + 1u == (tg + 1u) * nx) xb_add(&bar[XB_TOPGEN], 1u);
      else XB_SPIN(xb_ld(&bar[XB_TOPGEN]) == tg, bar);
      __builtin_amdgcn_fence(__ATOMIC_ACQUIRE, "agent");
      xb_add(&bar[XB_XGEN(b.x)], 1u);
      asm volatile("s_waitcnt vmcnt(0)" ::: "memory");
    } else {
      XB_SPIN(xb_ld(&bar[XB_XGEN(b.x)]) == gen, bar);
      __builtin_amdgcn_fence(__ATOMIC_ACQUIRE, "agent");
      asm volatile("s_waitcnt vmcnt(0)" ::: "memory");
    }
  }
  __syncthreads();
}

__device__ __forceinline__ void run_phase(const Params& p, int ph, int l, int bid, int nblk, unsigned char* smem, float* sbias) {
  switch (ph) {
    case 0: {
      if (bid == 0 && threadIdx.x < 64) p.counts[threadIdx.x] = 0;
      conv_x(p, bid, nblk);
      for (int it = bid; it < NCONV_ITEMS; it += nblk) conv_item(p, 0, it, smem);
    } break;
    case 1: p1_phase(p, l, bid, nblk, smem); break;
    case 2:
      attn_phase(p, l, bid, nblk, smem);
      for (int it = bid; it < 1024; it += nblk) sgu_item(p, l, it, smem);
      break;
    case 3: for (int t = bid; t < 1024; t += nblk) p3_tile(p, l, t, smem); break;
    case 4: for (int it = bid; it < NTOK / 32; it += nblk) p4_batch(p, l, it, smem); break;
    case 5: { const int mtot = moe_total_mtiles(p.counts + l * 16), nt = ((mtot + 7) >> 3) * 32; for (int t = bid; t < nt; t += nblk) p5_tile(p, l, t, mtot, smem); } break;
    case 6: p6_phase(p, l, bid, nblk, smem); break;
    case 7: {
      { const int nw = nblk * 4; int tok = bid * 4 + (threadIdx.x >> 6);
        for (; tok + 3 * nw < NTOK; tok += 4 * nw) p7_tokens<4>(p, l, tok, nw);
        for (; tok < NTOK; tok += nw) p7_tokens<1>(p, l, tok, nw); }
      if (l < 3) for (int it = bid; it < NCONV_ITEMS; it += nblk) conv_item(p, l + 1, it, smem);
    } break;
  }
}

template <int PH>
__global__ void __launch_bounds__(256, 2) phase_kernel(Params p, int l) {
  __shared__ __attribute__((aligned(16))) unsigned char smem[SMEM_BYTES];
  run_phase(p, PH, l, blockIdx.x, gridDim.x, smem, (float*)smem);
}

#if MEGA
__global__ void __launch_bounds__(256, 2) mega_kernel(Params p) {
  __shared__ __attribute__((aligned(16))) unsigned char smem[SMEM_BYTES];
  __shared__ uint4 xb_words;
  float* sbias = (float*)smem;
  cg::grid_group grid = cg::this_grid();
  const int bid = blockIdx.x, nblk = gridDim.x;
  if (threadIdx.x == 0) xb_words = make_uint4(0u, 0u, 0u, 0u);
  __syncthreads();
  XcdBarrier xb = xcd_barrier_post(p.bar, (volatile unsigned*)&xb_words);
  run_phase(p, 0, 0, bid, nblk, smem, sbias);
  if (p.never) grid.sync();
  xcd_barrier(xb);
#pragma unroll 1
  for (int l = 0; l < 4; ++l) {
#pragma unroll 1
    for (int ph = 1; ph <= 7; ++ph) {
      run_phase(p, ph, l, bid, nblk, smem, sbias);
#if DUP_PH
      if (ph == DUP_PH) { xcd_barrier(xb); run_phase(p, ph, l, bid, nblk, smem, sbias); }
#endif
      if (!(l == 3 && ph == 7)) xcd_barrier(xb);
    }
  }
}
#endif

extern "C" void kernel_launch(void* const* d_in, const int* in_sizes, int n_in, void* d_out, int out_size, void* d_ws,
                              size_t ws_size, hipStream_t stream) {
  Params p{};
  p.x = (const float*)d_in[0]; p.w_in = (const float*)d_in[1]; p.w_out = (const float*)d_in[2]; p.rel_bias = (const float*)d_in[3];
  p.sgu_ln_g = (const float*)d_in[4]; p.sgu_ln_b = (const float*)d_in[5]; p.sgu_w = (const float*)d_in[6]; p.sgu_b = (const float*)d_in[7];
  p.mix_g = (const float*)d_in[8]; p.ln1_g = (const float*)d_in[9]; p.ln1_b = (const float*)d_in[10];
  p.rg_w = (const float*)d_in[11]; p.rg_b = (const float*)d_in[12]; p.re_w = (const float*)d_in[13]; p.re_b = (const float*)d_in[14];
  p.w_gate = (const float*)d_in[15]; p.w_up = (const float*)d_in[16]; p.w_down = (const float*)d_in[17];
  p.ln2_g = (const float*)d_in[18]; p.ln2_b = (const float*)d_in[19];
  p.out = (float*)d_out;
  unsigned char* w = (unsigned char*)d_ws;
  size_t o = 0;
  auto take = [&](size_t bytes) { unsigned char* r = w + o; o += (bytes + 255) & ~(size_t)255; return r; };
  p.Wt_in = (bf16_t*)take((size_t)2560 * 1024 * 2);
  p.Wt_out = (bf16_t*)take((size_t)1024 * 1024 * 2);
  p.Wgu = (bf16_t*)take((size_t)16 * 512 * 1024 * 2);
  p.Wdn = (bf16_t*)take((size_t)16 * 1024 * 256 * 2);
  p.Wsgu = (bf16_t*)take((size_t)8 * 128 * 128 * 2);
  p.xb = (bf16_t*)take((size_t)NTOK * 1024 * 2);
  p.x1 = (float*)take((size_t)NTOK * 1024 * 4);
  unsigned char* r1 = take((size_t)NTOK * 2560 * 2);
  p.qk = (bf16_t*)r1;
  p.vT = (bf16_t*)(r1 + (size_t)NTOK * 1024 * 2);
  p.ub = (bf16_t*)(r1 + (size_t)NTOK * 1536 * 2);
  p.vnT = (bf16_t*)(r1 + (size_t)NTOK * 2048 * 2);
  p.y = (bf16_t*)r1;
  p.hb = (bf16_t*)r1;
  unsigned char* r2 = take((size_t)NTOK * 1024 * 2);
  p.mixed = (bf16_t*)r2;
  p.act = (bf16_t*)r2;
  p.ssq = (float*)take((size_t)NTOK * 16 * 4);
  p.wlist = (float*)take((size_t)16 * NTOK * 4);
  p.list = (int*)take((size_t)16 * NTOK * 4);
  p.tokinfo = (int*)take((size_t)NTOK * 4 * 4);
  p.counts = (int*)take(256);
  p.Wr_eh = (bf16_t*)take(16384 * 2); p.Wr_el = (bf16_t*)take(16384 * 2);
  p.Wr_gh = (bf16_t*)take(16384 * 2); p.Wr_gl = (bf16_t*)take(16384 * 2);
  p.bar = (unsigned*)take(XCD_BAR_WORDS * 4);
#if MEGA
  static int grid_blocks = 0;
  if (!grid_blocks) {
    int dev = 0, cus = 0, per_cu = 0;
    hipGetDevice(&dev);
    hipDeviceGetAttribute(&cus, hipDeviceAttributeMultiprocessorCount, dev);
    hipOccupancyMaxActiveBlocksPerMultiprocessor(&per_cu, mega_kernel, 256, 0);
    if (per_cu > 2) per_cu = 2;
    grid_blocks = cus * per_cu;
  }
  (void)hipMemsetAsync(p.bar, 0, XCD_BAR_WORDS * 4, stream);
  void* args[] = {&p};
  hipError_t e = hipLaunchCooperativeKernel((void*)mega_kernel, dim3(grid_blocks), dim3(256), args, 0, stream);
  if (e != hipSuccess) fprintf(stderr, "cooperative launch failed: %s (grid %d)\n", hipGetErrorString(e), grid_blocks);
#else
  const int G = 512;
  phase_kernel<0><<<G, 256, 0, stream>>>(p, 0);
  for (int l = 0; l < 4; ++l) {
    phase_kernel<1><<<G, 256, 0, stream>>>(p, l);
    phase_kernel<2><<<G, 256, 0, stream>>>(p, l);
    phase_kernel<3><<<G, 256, 0, stream>>>(p, l);
    phase_kernel<4><<<G, 256, 0, stream>>>(p, l);
    phase_kernel<5><<<G, 256, 0, stream>>>(p, l);
    phase_kernel<6><<<G, 256, 0, stream>>>(p, l);
    phase_kernel<7><<<G, 256, 0, stream>>>(p, l);
  }
#endif
}
```

```cpp
#include <hip/hip_runtime.h>
#include <hip/hip_cooperative_groups.h>
#include <stdint.h>
#include <cstdio>
namespace cg = cooperative_groups;

#ifndef MEGA
#define MEGA 1
#endif
#define DUP_PH 0

typedef unsigned short bf16_t;
typedef short bf16x8 __attribute__((ext_vector_type(8)));
typedef float f32x4 __attribute__((ext_vector_type(4)));
typedef unsigned u32x4 __attribute__((ext_vector_type(4)));
typedef unsigned u32x2 __attribute__((ext_vector_type(2)));

#define NTOK 16384
#define LN_EPS 1e-5f
#define ALPHA 1.681792830507429f
#define NCONV_ITEMS 1009
#define SMEM_BYTES 69632

struct Params {
  const float *x, *w_in, *w_out, *rel_bias, *sgu_ln_g, *sgu_ln_b, *sgu_w, *sgu_b, *mix_g, *ln1_g, *ln1_b,
      *rg_w, *rg_b, *re_w, *re_b, *w_gate, *w_up, *w_down, *ln2_g, *ln2_b;
  float* out;
  bf16_t *Wt_in, *Wt_out, *Wgu, *Wdn, *Wsgu, *xb, *qk, *vT, *ub, *vnT, *mixed, *act, *y, *hb;
  float *x1, *ssq, *wlist;
  bf16_t *Wr_eh, *Wr_el, *Wr_gh, *Wr_gl;
  int *counts, *list, *tokinfo;
  unsigned* bar;
  int never;
  int pad_;
};

__device__ __forceinline__ unsigned cvt_pk_bf16(float lo, float hi) {
  unsigned r; asm("v_cvt_pk_bf16_f32 %0, %1, %2" : "=v"(r) : "v"(lo), "v"(hi)); return r;
}
__device__ __forceinline__ void store_bf16x4(bf16_t* p, float a, float b, float c, float d) {
  u32x2 v; v.x = cvt_pk_bf16(a, b); v.y = cvt_pk_bf16(c, d); *(u32x2*)p = v;
}
__device__ __forceinline__ float gelu_tanh(float x) {
  float z = 0.7978845608028654f * (x + 0.044715f * x * x * x);
  return x / (1.0f + __expf(-2.0f * z));
}
__device__ __forceinline__ int otid() { int t = threadIdx.x; asm volatile("" : "+v"(t)); return t; }
__device__ __forceinline__ float silu(float x) { return x / (1.0f + __expf(-x)); }
template <int CTRL>
__device__ __forceinline__ float dpp_mov(float v) {
  return __builtin_bit_cast(float, __builtin_amdgcn_update_dpp(0, __builtin_bit_cast(int, v), CTRL, 0xf, 0xf, true));
}
__device__ __forceinline__ float row16_sum(float v) {
  v += dpp_mov<0xB1>(v); v += dpp_mov<0x4E>(v); v += dpp_mov<0x141>(v); v += dpp_mov<0x140>(v); return v;
}
__device__ __forceinline__ float wave_sum(float v) {
  v = row16_sum(v); v += __shfl_xor(v, 16); v += __shfl_xor(v, 32); return v;
}

struct NoMid { __device__ __forceinline__ void operator()(f32x4 (&)[4][4]) const {} };
struct MidScale {
  float s[4];
  __device__ __forceinline__ void operator()(f32x4 (&acc)[4][4]) const {
#pragma unroll
    for (int i = 0; i < 4; ++i)
#pragma unroll
      for (int j = 0; j < 4; ++j) acc[i][j] *= s[i];
  }
};

#define GLDS16(gptr, lptr) __builtin_amdgcn_global_load_lds((const unsigned*)(gptr), (__attribute__((address_space(3))) unsigned*)(lptr), 16, 0, 0)

__device__ __forceinline__ void gemm_issue0(unsigned char* smem, const bf16_t* pa0, const bf16_t* pa1, const bf16_t* pa2,
                                            const bf16_t* pa3, const bf16_t* pb0, const bf16_t* pb1, const bf16_t* pb2,
                                            const bf16_t* pb3) {
  const int tid = otid(), wid = tid >> 6, srow = tid >> 3;
  const int lch = ((tid & 7) ^ ((srow >> 1) & 7)) * 8 - (tid & 7) * 8;
  unsigned char* d = smem + __builtin_amdgcn_readfirstlane(wid) * 1024;
  GLDS16(pa0 + lch, d); GLDS16(pa1 + lch, d + 4096); GLDS16(pa2 + lch, d + 8192); GLDS16(pa3 + lch, d + 12288);
  GLDS16(pb0 + lch, d + 16384); GLDS16(pb1 + lch, d + 20480); GLDS16(pb2 + lch, d + 24576); GLDS16(pb3 + lch, d + 28672);
}

template <bool PRE = false, class Mid>
__device__ __forceinline__ void gemm_main(unsigned char* smem, const bf16_t* pa0, const bf16_t* pa1, const bf16_t* pa2,
                                          const bf16_t* pa3, const bf16_t* pb0, const bf16_t* pb1, const bf16_t* pb2,
                                          const bf16_t* pb3, int nk, int kmid, bool swapped, f32x4 (&acc)[4][4],
                                          const Mid& mid) {
  const int tid = otid(), lane = tid & 63, wid = tid >> 6, wr = wid >> 1, wc = wid & 1;
  const int srow = tid >> 3;
  const int lch = ((tid & 7) ^ ((srow >> 1) & 7)) * 8 - (tid & 7) * 8;
  pa0 += lch; pa1 += lch; pa2 += lch; pa3 += lch; pb0 += lch; pb1 += lch; pb2 += lch; pb3 += lch;
  const int soff = __builtin_amdgcn_readfirstlane(wid) * 1024;
  const int qi = lane & 15, g = lane >> 4, s = qi >> 1;
  const int aside = swapped ? 16384 : 0, bside = swapped ? 0 : 16384;
  const int offA0 = aside + (wr * 64 + qi) * 128 + (((0 + g) ^ s) << 4);
  const int offA1 = aside + (wr * 64 + qi) * 128 + (((4 + g) ^ s) << 4);
  const int offB0 = bside + (wc * 64 + qi) * 128 + (((0 + g) ^ s) << 4);
  const int offB1 = bside + (wc * 64 + qi) * 128 + (((4 + g) ^ s) << 4);
  if (!PRE) {
    unsigned char* d = smem + soff;
    GLDS16(pa0, d); GLDS16(pa1, d + 4096); GLDS16(pa2, d + 8192); GLDS16(pa3, d + 12288);
    GLDS16(pb0, d + 16384); GLDS16(pb1, d + 20480); GLDS16(pb2, d + 24576); GLDS16(pb3, d + 28672);
  }
  asm volatile("s_waitcnt vmcnt(0)" ::: "memory");
  __syncthreads();
  for (int kt = 0; kt < nk; ++kt) {
    unsigned char* buf = smem + ((kt & 1) << 15);
    if (kt + 1 < nk) {
      const int ko = (kt + 1) * 64;
      unsigned char* d = smem + (((kt + 1) & 1) << 15) + soff;
      GLDS16(pa0 + ko, d); GLDS16(pa1 + ko, d + 4096); GLDS16(pa2 + ko, d + 8192); GLDS16(pa3 + ko, d + 12288);
      GLDS16(pb0 + ko, d + 16384); GLDS16(pb1 + ko, d + 20480); GLDS16(pb2 + ko, d + 24576); GLDS16(pb3 + ko, d + 28672);
    }
    if (kt == kmid) mid(acc);
    {
      bf16x8 af0[4], bf0[4], af1[4], bf1[4];
#pragma unroll
      for (int i = 0; i < 4; ++i) af0[i] = *(const bf16x8*)(buf + offA0 + i * 2048);
#pragma unroll
      for (int j = 0; j < 4; ++j) bf0[j] = *(const bf16x8*)(buf + offB0 + j * 2048);
#pragma unroll
      for (int i = 0; i < 4; ++i) af1[i] = *(const bf16x8*)(buf + offA1 + i * 2048);
#pragma unroll
      for (int j = 0; j < 4; ++j) bf1[j] = *(const bf16x8*)(buf + offB1 + j * 2048);
      asm volatile("s_waitcnt lgkmcnt(8)" ::: "memory");
      __builtin_amdgcn_s_setprio(1);
#pragma unroll
      for (int i = 0; i < 4; ++i)
#pragma unroll
        for (int j = 0; j < 4; ++j) acc[i][j] = __builtin_amdgcn_mfma_f32_16x16x32_bf16(bf0[j], af0[i], acc[i][j], 0, 0, 0);
      asm volatile("s_waitcnt lgkmcnt(0)" ::: "memory");
#pragma unroll
      for (int i = 0; i < 4; ++i)
#pragma unroll
        for (int j = 0; j < 4; ++j) acc[i][j] = __builtin_amdgcn_mfma_f32_16x16x32_bf16(bf1[j], af1[i], acc[i][j], 0, 0, 0);
      __builtin_amdgcn_s_setprio(0);
    }
    asm volatile("s_waitcnt vmcnt(0)" ::: "memory");
    __syncthreads();
  }
}

#define ZERO_ACC(acc)                                   \
  _Pragma("unroll") for (int i_ = 0; i_ < 4; ++i_)      \
  _Pragma("unroll") for (int j_ = 0; j_ < 4; ++j_) acc[i_][j_] = (f32x4){0.f, 0.f, 0.f, 0.f};

__device__ void conv_x(const Params& p, int bid, int nblk) {
  const size_t n8 = (size_t)NTOK * 1024 / 8;
#pragma unroll 4
  for (size_t i = (size_t)bid * 256 + threadIdx.x; i < n8; i += (size_t)nblk * 256) {
    const float4 a = *(const float4*)(p.x + i * 8), b = *(const float4*)(p.x + i * 8 + 4);
    u32x4 v; v.x = cvt_pk_bf16(a.x, a.y); v.y = cvt_pk_bf16(a.z, a.w); v.z = cvt_pk_bf16(b.x, b.y); v.w = cvt_pk_bf16(b.z, b.w);
    *(u32x4*)(p.xb + i * 8) = v;
  }
}

__device__ void tconv_tile(float* tile, const float* src, int src_ld, const float* kscale, bf16_t* dst, int dst_ld, int rstep) {
  const int t = otid();
  {
    const int k0 = t >> 6, n4 = (t & 63) * 4;
    float4 v[16];
#pragma unroll
    for (int i = 0; i < 16; ++i) v[i] = *(const float4*)(src + (size_t)(k0 + 4 * i) * src_ld + n4);
    if (kscale) {
#pragma unroll
      for (int i = 0; i < 16; ++i) { const float sc = kscale[k0 + 4 * i]; v[i].x *= sc; v[i].y *= sc; v[i].z *= sc; v[i].w *= sc; }
    }
#pragma unroll
    for (int i = 0; i < 16; ++i) *(float4*)(tile + (k0 + 4 * i) * 260 + n4) = v[i];
  }
  __syncthreads();
  {
    const int n = t;
    bf16_t* o = dst + (size_t)((n >> 4) * rstep + (n & 15)) * dst_ld;
#pragma unroll
    for (int c = 0; c < 8; ++c) {
      float f[8];
#pragma unroll
      for (int q = 0; q < 8; ++q) f[q] = tile[(c * 8 + q) * 260 + n];
      u32x4 v0;
      v0.x = cvt_pk_bf16(f[0], f[1]); v0.y = cvt_pk_bf16(f[2], f[3]); v0.z = cvt_pk_bf16(f[4], f[5]); v0.w = cvt_pk_bf16(f[6], f[7]);
      *(u32x4*)(o + c * 8) = v0;
    }
  }
  __syncthreads();
}

__device__ void conv_item(const Params& p, int l, int it, unsigned char* smem) {
  float* tile = (float*)smem;
  if (it < 160) {
    const int kt = it / 10, ntile = it % 10;
    tconv_tile(tile, p.w_in + (size_t)l * 1024 * 2560 + (size_t)kt * 64 * 2560 + ntile * 256, 2560, nullptr,
               p.Wt_in + (size_t)ntile * 256 * 1024 + kt * 64, 1024, 16);
  } else if (it < 224) {
    const int r = it - 160, kt = r >> 2, ntile = r & 3;
    tconv_tile(tile, p.w_out + (size_t)l * 1024 * 1024 + (size_t)kt * 64 * 1024 + ntile * 256, 1024, p.mix_g + l * 1024 + kt * 64,
               p.Wt_out + (size_t)ntile * 256 * 1024 + kt * 64, 1024, 16);
  } else if (it < 736) {
    const int r0 = it - 224, e = r0 >> 5, r = r0 & 31, which = r >> 4, kt = r & 15;
    const float* src = (which ? p.w_up : p.w_gate) + (size_t)(l * 16 + e) * 1024 * 256 + (size_t)kt * 64 * 256;
    tconv_tile(tile, src, 256, nullptr, p.Wgu + (size_t)e * 512 * 1024 + (size_t)(which * 16) * 1024 + kt * 64, 1024, 32);
  } else if (it < 992) {
    const int r0 = it - 736, e = r0 >> 4, r = r0 & 15, kt = r >> 2, ntile = r & 3;
    tconv_tile(tile, p.w_down + (size_t)(l * 16 + e) * 256 * 1024 + (size_t)kt * 64 * 1024 + ntile * 256, 1024, nullptr,
               p.Wdn + (size_t)e * 1024 * 256 + (size_t)ntile * 256 * 256 + kt * 64, 256, 16);
  } else if (it == 1008) {
    for (int i = threadIdx.x; i < 16384; i += 256) {
      const int jj = i & 7, j = (i >> 3) & 15, g = (i >> 7) & 3, kb = i >> 9;
      const int k = 32 * kb + 8 * g + jj;
      const float we = p.re_w[(size_t)(l * 1024 + k) * 16 + j];
      const float wg = (j < 4) ? p.rg_w[(size_t)(l * 1024 + k) * 4 + j] : 0.0f;
      const unsigned eh = cvt_pk_bf16(we, 0.f) & 0xffffu, gh = cvt_pk_bf16(wg, 0.f) & 0xffffu;
      const unsigned el = cvt_pk_bf16(we - __uint_as_float(eh << 16), 0.f) & 0xffffu;
      const unsigned gl = cvt_pk_bf16(wg - __uint_as_float(gh << 16), 0.f) & 0xffffu;
      p.Wr_eh[i] = (bf16_t)eh; p.Wr_el[i] = (bf16_t)el; p.Wr_gh[i] = (bf16_t)gh; p.Wr_gl[i] = (bf16_t)gl;
    }
  } else {
    const int j = it - 992;
    const float* src = p.sgu_w + (size_t)l * 131072 + (size_t)j * 8192 + threadIdx.x * 32;
    bf16_t* dst = p.Wsgu + (size_t)j * 8192 + threadIdx.x * 32;
#pragma unroll
    for (int q = 0; q < 4; ++q) {
      const float4 a = *(const float4*)(src + q * 8), b = *(const float4*)(src + q * 8 + 4);
      u32x4 v; v.x = cvt_pk_bf16(a.x, a.y); v.y = cvt_pk_bf16(a.z, a.w); v.z = cvt_pk_bf16(b.x, b.y); v.w = cvt_pk_bf16(b.z, b.w);
      *(u32x4*)(dst + q * 8) = v;
    }
  }
}

__device__ __forceinline__ void p1_decode(int t, int& mt, int& nt) {
  const int x_ = t & 7, j_ = t >> 3, rd_ = j_ >> 6, lb_ = j_ & 63;
  mt = (rd_ < 4) ? (x_ * 16 + (rd_ & 1) * 8 + (lb_ & 7)) : (x_ * 16 + (lb_ & 15));
  nt = (rd_ < 4) ? ((rd_ >> 1) * 8 + (lb_ >> 3)) : (16 + (lb_ >> 4));
}
__device__ __forceinline__ void p1_epilogue(const Params& p, int l, int mt, int nt, f32x4 (&acc)[4][4]) {
  const int type = nt >> 2;
  const bool swapped = (type == 2) || (type == 4);
  const int tid = otid(), lane = tid & 63, wid = tid >> 6, wr = wid >> 1, wc = wid & 1;
  const int qi = lane & 15, g = lane >> 4;
  if (!swapped) {
#pragma unroll
    for (int i = 0; i < 4; ++i) {
      const int m = mt * 128 + wr * 64 + i * 16 + qi;
#pragma unroll
      for (int j = 0; j < 4; ++j) {
        const int n = nt * 128 + wc * 64 + j * 16 + 4 * g;
        f32x4 v = acc[i][j];
        if (type == 0) v *= 0.125f;
        if (type == 3) { v[0] = gelu_tanh(v[0]); v[1] = gelu_tanh(v[1]); v[2] = gelu_tanh(v[2]); v[3] = gelu_tanh(v[3]); }
        bf16_t* dst = (type == 3) ? (p.ub + (size_t)m * 512 + (n - 1536)) : (p.qk + (size_t)m * 1024 + n);
        store_bf16x4(dst, v[0], v[1], v[2], v[3]);
      }
    }
  } else {
    const int bidx = (mt * 128) >> 12, tokbase = (mt * 128) & 4095;
    bf16_t* dstb = (type == 2) ? p.vT : p.vnT;
    const int fbase = (type == 2) ? 1024 : 2048;
    if (type == 4) {
#pragma unroll
      for (int i = 0; i < 4; ++i)
#pragma unroll
        for (int j = 0; j < 4; ++j)
#pragma unroll
          for (int r = 0; r < 4; ++r) acc[i][j][r] = gelu_tanh(acc[i][j][r]);
      float gam[4], bet[4];
#pragma unroll
      for (int i = 0; i < 4; ++i) {
        const int f = nt * 128 + wr * 64 + i * 16 + qi - 2048;
        gam[i] = p.sgu_ln_g[l * 512 + f]; bet[i] = p.sgu_ln_b[l * 512 + f];
      }
#pragma unroll
      for (int j = 0; j < 4; ++j)
#pragma unroll
        for (int r = 0; r < 4; ++r) {
          float s1 = acc[0][j][r] + acc[1][j][r] + acc[2][j][r] + acc[3][j][r];
          s1 = row16_sum(s1);
          const float mu = s1 * (1.0f / 64.0f);
          float s2 = 0.f;
#pragma unroll
          for (int i = 0; i < 4; ++i) { const float d = acc[i][j][r] - mu; s2 += d * d; }
          s2 = row16_sum(s2);
          const float rstd = rsqrtf(s2 * (1.0f / 64.0f) + LN_EPS);
#pragma unroll
          for (int i = 0; i < 4; ++i) acc[i][j][r] = (acc[i][j][r] - mu) * rstd * gam[i] + bet[i];
        }
    }
#pragma unroll
    for (int i = 0; i < 4; ++i) {
      const int f = nt * 128 + wr * 64 + i * 16 + qi - fbase;
#pragma unroll
      for (int j = 0; j < 4; ++j) {
        const int tok = tokbase + wc * 64 + j * 16 + 4 * g;
        store_bf16x4(dstb + ((size_t)(bidx * 512 + f)) * 4096 + tok, acc[i][j][0], acc[i][j][1], acc[i][j][2], acc[i][j][3]);
      }
    }
  }
}


__device__ void p1_phase(const Params& p, int l, int bid, int nblk, unsigned char* smem) {
  const int tid0 = otid();
  int t = bid, mt = 0, nt = 0;
  const bf16_t* A = nullptr; const bf16_t* B = nullptr;
  if (t < 2560) {
    p1_decode(t, mt, nt);
    A = p.xb + (size_t)(mt * 128 + (tid0 >> 3)) * 1024 + (tid0 & 7) * 8;
    B = p.Wt_in + (size_t)(nt * 128 + (tid0 >> 3)) * 1024 + (tid0 & 7) * 8;
    __syncthreads();
    gemm_issue0(smem, A, A + 32 * 1024, A + 64 * 1024, A + 96 * 1024, B, B + 32 * 1024, B + 64 * 1024, B + 96 * 1024);
  }
  while (t < 2560) {
    const int type = nt >> 2;
    const bool swapped = (type == 2) || (type == 4);
    f32x4 acc[4][4];
    ZERO_ACC(acc);
    gemm_main<true>(smem, A, A + 32 * 1024, A + 64 * 1024, A + 96 * 1024, B, B + 32 * 1024, B + 64 * 1024, B + 96 * 1024, 16, -1, swapped, acc, NoMid());
    const int tn = t + nblk;
    int mtn = mt, ntn = nt;
    if (tn < 2560) {
      p1_decode(tn, mtn, ntn);
      const int tid = otid();
      A = p.xb + (size_t)(mtn * 128 + (tid >> 3)) * 1024 + (tid & 7) * 8;
      B = p.Wt_in + (size_t)(ntn * 128 + (tid >> 3)) * 1024 + (tid & 7) * 8;
      gemm_issue0(smem, A, A + 32 * 1024, A + 64 * 1024, A + 96 * 1024, B, B + 32 * 1024, B + 64 * 1024, B + 96 * 1024);
    }
    p1_epilogue(p, l, mt, nt, acc);
    mt = mtn; nt = ntn; t = tn;
  }
}

__device__ void attn_phase(const Params& p, int l, int bid, int nblk, unsigned char* smem) {
  const int tid = otid(), lane = tid & 63, w = tid >> 6, qi = lane & 15, g = lane >> 4;
  unsigned char* Kb = smem;
  unsigned char* Vb = smem + 32768;
  float* sbias = (float*)(smem + 32768 + 33792);
  const int c0 = (w == 0) ? 0 : (w == 1) ? 8 : (w == 2) ? 24 : 32;
  const int cq = 16 * w + qi, cs = min(max(cq - 8, 0), 48);
  const int krow = tid >> 3, kch = tid & 7;
  const int ksoff = krow * 128 + ((kch ^ ((krow >> 1) & 7)) << 4);
  const int vd = tid >> 5, vc = tid & 31;
  const int vsoff = vd * 528 + vc * 16;
  u32x4 st[8], st2[8];
#define ATT_ISSUE_K(it_)                                                                                              \
  do {                                                                                                                \
    const int h_ = (it_) & 7, br_ = (it_) >> 3, r_ = br_ & 63, b_ = br_ >> 6, rs_ = min(max(r_ - 4, 0), 56);          \
    const bf16_t* kg_ = p.qk + ((size_t)b_ * 4096 + rs_ * 64 + krow) * 1024 + 512 + h_ * 64 + kch * 8;                \
    _Pragma("unroll") for (int i = 0; i < 8; ++i) st[i] = *(const u32x4*)(kg_ + (size_t)(32 * i) * 1024);            \
    _Pragma("unroll") for (int i = 0; i < 8; ++i) st2[i] = *(const u32x4*)(kg_ + (size_t)(256 + 32 * i) * 1024);     \
  } while (0)
  int it = bid;
  if (it < 2048) ATT_ISSUE_K(it);
  while (it < 2048) {
    const int h = it & 7, br = it >> 3, r = br & 63, b = br >> 6;
    const int rs = min(max(r - 4, 0), 56);
    const size_t tokq = (size_t)b * 4096 + r * 64 + cq;
    const bf16_t* vg = p.vT + ((size_t)(b * 512 + h * 64 + vd)) * 4096 + rs * 64 + vc * 8;
    const float rb0 = p.rel_bias[(size_t)(l * 8 + h) * 465 + tid];
    const float rb1 = p.rel_bias[(size_t)(l * 8 + h) * 465 + min(tid + 256, 464)];
    bf16x8 qf0 = *(const bf16x8*)(p.qk + tokq * 1024 + h * 64 + g * 8);
    bf16x8 qf1 = *(const bf16x8*)(p.qk + tokq * 1024 + h * 64 + 32 + g * 8);
    __syncthreads();
    sbias[tid] = rb0;
    if (tid + 256 < 465) sbias[tid + 256] = rb1;
#pragma unroll
    for (int i = 0; i < 8; ++i) *(u32x4*)(Kb + ksoff + i * 4096) = st[i];
#pragma unroll
    for (int i = 0; i < 8; ++i) st[i] = *(const u32x4*)(vg + (size_t)(8 * i) * 4096);
    __syncthreads();
    f32x4 s[8][2];
#pragma unroll
    for (int jh = 0; jh < 2; ++jh) {
#pragma unroll
      for (int jj = 0; jj < 4; ++jj)
#pragma unroll
        for (int ch = 0; ch < 2; ++ch) {
          const int kl = jj * 64 + c0 + 16 * ch + qi;
          const int sw = (kl >> 1) & 7;
          const bf16x8 kf0 = *(const bf16x8*)(Kb + kl * 128 + (((0 + g) ^ sw) << 4));
          const bf16x8 kf1 = *(const bf16x8*)(Kb + kl * 128 + (((4 + g) ^ sw) << 4));
          f32x4 a = {0.f, 0.f, 0.f, 0.f};
          a = __builtin_amdgcn_mfma_f32_16x16x32_bf16(kf0, qf0, a, 0, 0, 0);
          a = __builtin_amdgcn_mfma_f32_16x16x32_bf16(kf1, qf1, a, 0, 0, 0);
          s[jh * 4 + jj][ch] = a;
        }
      if (jh == 0) {
        __syncthreads();
#pragma unroll
        for (int i = 0; i < 8; ++i) *(u32x4*)(Kb + ksoff + i * 4096) = st2[i];
#pragma unroll
        for (int i = 0; i < 8; ++i) st2[i] = *(const u32x4*)(vg + (size_t)(8 * i) * 4096 + 256);
        __syncthreads();
      }
    }
#pragma unroll
    for (int i = 0; i < 8; ++i) *(u32x4*)(Vb + vsoff + i * 8 * 528) = st[i];
    float mx = -1e30f;
#pragma unroll
    for (int j = 0; j < 8; ++j)
#pragma unroll
      for (int ch = 0; ch < 2; ++ch)
#pragma unroll
        for (int rg = 0; rg < 4; ++rg) {
          const int kc = c0 + 16 * ch + 4 * g + rg;
          const bool valid = (kc >= cs) && (kc < cs + 16);
          const int bidx = valid ? ((rs + j - r + 7) * 31 + (kc - cq) + 15) : 0;
          const float v = valid ? (s[j][ch][rg] + sbias[bidx]) : -1e30f;
          s[j][ch][rg] = v;
          mx = fmaxf(mx, v);
        }
    mx = fmaxf(mx, __shfl_xor(mx, 16)); mx = fmaxf(mx, __shfl_xor(mx, 32));
    float sum = 0.f;
#pragma unroll
    for (int j = 0; j < 8; ++j)
#pragma unroll
      for (int ch = 0; ch < 2; ++ch)
#pragma unroll
        for (int rg = 0; rg < 4; ++rg) { const float e = __expf(s[j][ch][rg] - mx); s[j][ch][rg] = e; sum += e; }
    sum += __shfl_xor(sum, 16); sum += __shfl_xor(sum, 32);
    const float inv = 1.0f / sum;
    bf16x8 pf[8];
#pragma unroll
    for (int j = 0; j < 8; ++j) {
      u32x4 pw;
      pw.x = cvt_pk_bf16(s[j][0][0], s[j][0][1]); pw.y = cvt_pk_bf16(s[j][0][2], s[j][0][3]);
      pw.z = cvt_pk_bf16(s[j][1][0], s[j][1][1]); pw.w = cvt_pk_bf16(s[j][1][2], s[j][1][3]);
      pf[j] = __builtin_bit_cast(bf16x8, pw);
    }
    f32x4 o[4];
#pragma unroll
    for (int dt = 0; dt < 4; ++dt) o[dt] = (f32x4){0.f, 0.f, 0.f, 0.f};
    const int itn = it + nblk;
    __syncthreads();
#pragma unroll
    for (int jh = 0; jh < 2; ++jh) {
#pragma unroll
      for (int jj = 0; jj < 4; ++jj)
#pragma unroll
        for (int dt = 0; dt < 4; ++dt) {
          const unsigned char* vp = Vb + (dt * 16 + qi) * 528 + (jj * 64 + c0 + 4 * g) * 2;
          const u32x2 lo = *(const u32x2*)vp, hi = *(const u32x2*)(vp + 32);
          u32x4 vw; vw.x = lo.x; vw.y = lo.y; vw.z = hi.x; vw.w = hi.y;
          o[dt] = __builtin_amdgcn_mfma_f32_16x16x32_bf16(__builtin_bit_cast(bf16x8, vw), pf[jh * 4 + jj], o[dt], 0, 0, 0);
        }
      if (jh == 0) {
        __syncthreads();
#pragma unroll
        for (int i = 0; i < 8; ++i) *(u32x4*)(Vb + vsoff + i * 8 * 528) = st2[i];
        if (itn < 2048) ATT_ISSUE_K(itn);
        __syncthreads();
      }
    }
    float sq = 0.f;
#pragma unroll
    for (int dt = 0; dt < 4; ++dt) {
      o[dt] *= inv;
      sq += o[dt][0] * o[dt][0] + o[dt][1] * o[dt][1] + o[dt][2] * o[dt][2] + o[dt][3] * o[dt][3];
      store_bf16x4(p.mixed + tokq * 1024 + h * 64 + dt * 16 + 4 * g, o[dt][0], o[dt][1], o[dt][2], o[dt][3]);
    }
    sq += __shfl_xor(sq, 16); sq += __shfl_xor(sq, 32);
    if (g == 0) p.ssq[tokq * 16 + h] = sq;
    it = itn;
  }
#undef ATT_ISSUE_K
}

__device__ void sgu_item(const Params& p, int l, int it, unsigned char* smem) {
  const int grp = it & 7, bc = it >> 3, chunk = bc & 31, b = bc >> 5;
  const int tid = otid(), lane = tid & 63, w = tid >> 6, qi = lane & 15, g = lane >> 4;
  const int p0 = 32 * w;
  const int wbase = __builtin_amdgcn_readfirstlane(w) * 1024;
  const int lc = ((tid & 15) ^ ((tid >> 4) & 15)) << 3;
  const bf16_t* wsrc = p.Wsgu + ((size_t)(grp * 128 + (tid >> 4))) * 128 + lc;
  const bf16_t* vsrc = p.vnT + ((size_t)(b * 512 + grp * 64 + (tid >> 4))) * 4096 + chunk * 128 + lc;
  __syncthreads();
#pragma unroll
  for (int i = 0; i < 8; ++i) GLDS16(wsrc + (size_t)(16 * i) * 128, smem + i * 4096 + wbase);
#pragma unroll
  for (int i = 0; i < 4; ++i) GLDS16(vsrc + (size_t)(16 * i) * 4096, smem + 32768 + i * 4096 + wbase);
  asm volatile("s_waitcnt vmcnt(0)" ::: "memory");
  __syncthreads();
  f32x4 acc[2][4];
#pragma unroll
  for (int mt = 0; mt < 2; ++mt)
#pragma unroll
    for (int nt = 0; nt < 4; ++nt) acc[mt][nt] = (f32x4){0.f, 0.f, 0.f, 0.f};
#pragma unroll
  for (int ks = 0; ks < 4; ++ks) {
    const int co = ((ks * 4 + g) ^ qi) << 4;
    bf16x8 wf[2], vf[4];
#pragma unroll
    for (int mt = 0; mt < 2; ++mt) wf[mt] = *(const bf16x8*)(smem + (p0 + 16 * mt + qi) * 256 + co);
#pragma unroll
    for (int nt = 0; nt < 4; ++nt) vf[nt] = *(const bf16x8*)(smem + 32768 + (16 * nt + qi) * 256 + co);
#pragma unroll
    for (int mt = 0; mt < 2; ++mt)
#pragma unroll
      for (int nt = 0; nt < 4; ++nt) acc[mt][nt] = __builtin_amdgcn_mfma_f32_16x16x32_bf16(vf[nt], wf[mt], acc[mt][nt], 0, 0, 0);
  }
#pragma unroll
  for (int mt = 0; mt < 2; ++mt) {
    const int pp = p0 + 16 * mt + qi;
    const size_t tok = (size_t)b * 4096 + chunk * 128 + pp;
    const float bias = p.sgu_b[(size_t)(l * 8 + grp) * 128 + pp];
    float sq = 0.f;
#pragma unroll
    for (int nt = 0; nt < 4; ++nt) {
      const int d = 16 * nt + 4 * g;
      const u32x2 uu = *(const u32x2*)(p.ub + tok * 512 + grp * 64 + d);
      const float u0 = __uint_as_float(uu.x << 16), u1 = __uint_as_float(uu.x & 0xffff0000u);
      const float u2 = __uint_as_float(uu.y << 16), u3 = __uint_as_float(uu.y & 0xffff0000u);
      const float v0 = u0 * (acc[mt][nt][0] + bias), v1 = u1 * (acc[mt][nt][1] + bias);
      const float v2 = u2 * (acc[mt][nt][2] + bias), v3 = u3 * (acc[mt][nt][3] + bias);
      sq += v0 * v0 + v1 * v1 + v2 * v2 + v3 * v3;
      store_bf16x4(p.mixed + tok * 1024 + 512 + grp * 64 + d, v0, v1, v2, v3);
    }
    sq += __shfl_xor(sq, 16); sq += __shfl_xor(sq, 32);
    if (g == 0) p.ssq[tok * 16 + 8 + grp] = sq;
  }
}

__device__ void p3_tile(const Params& p, int l, int t, unsigned char* smem) {
  const int x_ = t & 7, j_ = t >> 3, rd_ = j_ >> 6, lb_ = j_ & 63;
  const int mt = x_ * 16 + rd_ * 8 + (lb_ & 7), nt = lb_ >> 3;
  const int tid = otid(), lane = tid & 63, wid = tid >> 6, wr = wid >> 1, wc = wid & 1;
  const int srow = tid >> 3, sch = tid & 7, qi = lane & 15, g = lane >> 4;
  const bf16_t* A = p.mixed + (size_t)(mt * 128 + srow) * 1024 + sch * 8;
  const bf16_t* B = p.Wt_out + (size_t)(nt * 128 + srow) * 1024 + sch * 8;
  MidScale mid; float rss[4];
#pragma unroll
  for (int i = 0; i < 4; ++i) {
    const int m = mt * 128 + wr * 64 + i * 16 + qi;
    const float4 a0 = *(const float4*)(p.ssq + (size_t)m * 16), a1 = *(const float4*)(p.ssq + (size_t)m * 16 + 4);
    const float4 b0 = *(const float4*)(p.ssq + (size_t)m * 16 + 8), b1 = *(const float4*)(p.ssq + (size_t)m * 16 + 12);
    const float sa = (a0.x + a0.y + a0.z + a0.w) + (a1.x + a1.y + a1.z + a1.w);
    const float sb = (b0.x + b0.y + b0.z + b0.w) + (b1.x + b1.y + b1.z + b1.w);
    const float ra = rsqrtf(sa * (1.0f / 512.0f) + LN_EPS), rb = rsqrtf(sb * (1.0f / 512.0f) + LN_EPS);
    mid.s[i] = ra / rb; rss[i] = rb;
  }
  f32x4 acc[4][4];
  ZERO_ACC(acc);
  gemm_main(smem, A, A + 32 * 1024, A + 64 * 1024, A + 96 * 1024, B, B + 32 * 1024, B + 64 * 1024, B + 96 * 1024, 16, 8, false, acc, mid);
#pragma unroll
  for (int i = 0; i < 4; ++i) {
    const int m = mt * 128 + wr * 64 + i * 16 + qi;
#pragma unroll
    for (int j = 0; j < 4; ++j) {
      const int n = nt * 128 + wc * 64 + j * 16 + 4 * g;
      const u32x2 xr = *(const u32x2*)(p.xb + (size_t)m * 1024 + n);
      const float o0 = ALPHA * __uint_as_float(xr.x << 16) + acc[i][j][0] * rss[i];
      const float o1 = ALPHA * __uint_as_float(xr.x & 0xffff0000u) + acc[i][j][1] * rss[i];
      const float o2 = ALPHA * __uint_as_float(xr.y << 16) + acc[i][j][2] * rss[i];
      const float o3 = ALPHA * __uint_as_float(xr.y & 0xffff0000u) + acc[i][j][3] * rss[i];
      store_bf16x4(p.hb + (size_t)m * 1024 + n, o0, o1, o2, o3);
    }
  }
}

__device__ void p4_batch(const Params& p, int l, int batch, unsigned char* smem) {
  const int tid = otid(), lane = tid & 63, w = tid >> 6;
  int* scnt = (int*)smem;
  int* sbase = scnt + 16;
  __syncthreads();
  if (tid < 16) scnt[tid] = 0;
  __syncthreads();
  const int tokw = batch * 32 + w * 8;
  {
    float4 gm[4], bt[4];
#pragma unroll
    for (int q = 0; q < 4; ++q) {
      gm[q] = *(const float4*)(p.ln1_g + l * 1024 + q * 256 + lane * 4);
      bt[q] = *(const float4*)(p.ln1_b + l * 1024 + q * 256 + lane * 4);
    }
#pragma unroll 4
    for (int t = 0; t < 8; ++t) {
      float* xr = p.x1 + (size_t)(tokw + t) * 1024 + lane * 4;
      const bf16_t* hr = p.hb + (size_t)(tokw + t) * 1024 + lane * 4;
      float4 v[4];
#pragma unroll
      for (int q = 0; q < 4; ++q) {
        const u32x2 hh = *(const u32x2*)(hr + q * 256);
        v[q].x = __uint_as_float(hh.x << 16); v[q].y = __uint_as_float(hh.x & 0xffff0000u);
        v[q].z = __uint_as_float(hh.y << 16); v[q].w = __uint_as_float(hh.y & 0xffff0000u);
      }
      float s1 = 0.f;
#pragma unroll
      for (int q = 0; q < 4; ++q) s1 += (v[q].x + v[q].y) + (v[q].z + v[q].w);
      const float mu = wave_sum(s1) * (1.0f / 1024.0f);
      float s2 = 0.f;
#pragma unroll
      for (int q = 0; q < 4; ++q) {
        const float d0 = v[q].x - mu, d1 = v[q].y - mu, d2 = v[q].z - mu, d3 = v[q].w - mu;
        s2 += (d0 * d0 + d1 * d1) + (d2 * d2 + d3 * d3);
      }
      const float rstd = rsqrtf(wave_sum(s2) * (1.0f / 1024.0f) + LN_EPS);
#pragma unroll
      for (int q = 0; q < 4; ++q) {
        float4 o;
        o.x = (v[q].x - mu) * rstd * gm[q].x + bt[q].x; o.y = (v[q].y - mu) * rstd * gm[q].y + bt[q].y;
        o.z = (v[q].z - mu) * rstd * gm[q].z + bt[q].z; o.w = (v[q].w - mu) * rstd * gm[q].w + bt[q].w;
        *(float4*)(xr + q * 256) = o;
        store_bf16x4(p.xb + (size_t)(tokw + t) * 1024 + q * 256 + lane * 4, o.x, o.y, o.z, o.w);
      }
    }
  }
  asm volatile("s_waitcnt vmcnt(0)" ::: "memory");
  __syncthreads();
  const int j = lane & 15, g = lane >> 4;
  float* part = (float*)(smem + 1024);
  {
    const float* xr0 = p.x1 + (size_t)(batch * 32 + j) * 1024 + 256 * w + 8 * g;
    const float* xr1 = xr0 + 16 * 1024;
    const size_t wof = ((size_t)(8 * w * 4 + g) * 16 + j) * 8;
    f32x4 De0 = {0.f, 0.f, 0.f, 0.f}, Dg0 = De0, De1 = De0, Dg1 = De0;
#pragma unroll 2
    for (int kb = 0; kb < 8; ++kb) {
      const float4 xa0 = *(const float4*)(xr0 + kb * 32), xc0 = *(const float4*)(xr0 + kb * 32 + 4);
      const float4 xa1 = *(const float4*)(xr1 + kb * 32), xc1 = *(const float4*)(xr1 + kb * 32 + 4);
      const bf16x8 weh = *(const bf16x8*)(p.Wr_eh + wof + kb * 512), wel = *(const bf16x8*)(p.Wr_el + wof + kb * 512);
      const bf16x8 wgh = *(const bf16x8*)(p.Wr_gh + wof + kb * 512), wgl = *(const bf16x8*)(p.Wr_gl + wof + kb * 512);
      u32x4 h, lo;
      h.x = cvt_pk_bf16(xa0.x, xa0.y); h.y = cvt_pk_bf16(xa0.z, xa0.w); h.z = cvt_pk_bf16(xc0.x, xc0.y); h.w = cvt_pk_bf16(xc0.z, xc0.w);
      lo.x = cvt_pk_bf16(xa0.x - __uint_as_float(h.x << 16), xa0.y - __uint_as_float(h.x & 0xffff0000u));
      lo.y = cvt_pk_bf16(xa0.z - __uint_as_float(h.y << 16), xa0.w - __uint_as_float(h.y & 0xffff0000u));
      lo.z = cvt_pk_bf16(xc0.x - __uint_as_float(h.z << 16), xc0.y - __uint_as_float(h.z & 0xffff0000u));
      lo.w = cvt_pk_bf16(xc0.z - __uint_as_float(h.w << 16), xc0.w - __uint_as_float(h.w & 0xffff0000u));
      bf16x8 xh = __builtin_bit_cast(bf16x8, h), xl = __builtin_bit_cast(bf16x8, lo);
      De0 = __builtin_amdgcn_mfma_f32_16x16x32_bf16(weh, xh, De0, 0, 0, 0);
      Dg0 = __builtin_amdgcn_mfma_f32_16x16x32_bf16(wgh, xh, Dg0, 0, 0, 0);
      De0 = __builtin_amdgcn_mfma_f32_16x16x32_bf16(weh, xl, De0, 0, 0, 0);
      Dg0 = __builtin_amdgcn_mfma_f32_16x16x32_bf16(wgh, xl, Dg0, 0, 0, 0);
      De0 = __builtin_amdgcn_mfma_f32_16x16x32_bf16(wel, xh, De0, 0, 0, 0);
      Dg0 = __builtin_amdgcn_mfma_f32_16x16x32_bf16(wgl, xh, Dg0, 0, 0, 0);
      h.x = cvt_pk_bf16(xa1.x, xa1.y); h.y = cvt_pk_bf16(xa1.z, xa1.w); h.z = cvt_pk_bf16(xc1.x, xc1.y); h.w = cvt_pk_bf16(xc1.z, xc1.w);
      lo.x = cvt_pk_bf16(xa1.x - __uint_as_float(h.x << 16), xa1.y - __uint_as_float(h.x & 0xffff0000u));
      lo.y = cvt_pk_bf16(xa1.z - __uint_as_float(h.y << 16), xa1.w - __uint_as_float(h.y & 0xffff0000u));
      lo.z = cvt_pk_bf16(xc1.x - __uint_as_float(h.z << 16), xc1.y - __uint_as_float(h.z & 0xffff0000u));
      lo.w = cvt_pk_bf16(xc1.z - __uint_as_float(h.w << 16), xc1.w - __uint_as_float(h.w & 0xffff0000u));
      xh = __builtin_bit_cast(bf16x8, h); xl = __builtin_bit_cast(bf16x8, lo);
      De1 = __builtin_amdgcn_mfma_f32_16x16x32_bf16(weh, xh, De1, 0, 0, 0);
      Dg1 = __builtin_amdgcn_mfma_f32_16x16x32_bf16(wgh, xh, Dg1, 0, 0, 0);
      De1 = __builtin_amdgcn_mfma_f32_16x16x32_bf16(weh, xl, De1, 0, 0, 0);
      Dg1 = __builtin_amdgcn_mfma_f32_16x16x32_bf16(wgh, xl, Dg1, 0, 0, 0);
      De1 = __builtin_amdgcn_mfma_f32_16x16x32_bf16(wel, xh, De1, 0, 0, 0);
      Dg1 = __builtin_amdgcn_mfma_f32_16x16x32_bf16(wgl, xh, Dg1, 0, 0, 0);
    }
    float* pw = part + ((size_t)(w * 2) * 64 + lane) * 8;
    *(f32x4*)(pw) = De0; *(f32x4*)(pw + 4) = Dg0;
    *(f32x4*)(pw + 512) = De1; *(f32x4*)(pw + 516) = Dg1;
  }
  __syncthreads();
  const int tok = tokw + (j & 7);
  f32x4 De = {0.f, 0.f, 0.f, 0.f}, Dg = {0.f, 0.f, 0.f, 0.f};
  {
    const int ln = g * 16 + (w & 1) * 8 + (j & 7), tl = w >> 1;
#pragma unroll
    for (int ww = 0; ww < 4; ++ww) {
      const float* pr = part + ((size_t)(ww * 2 + tl) * 64 + ln) * 8;
      De += *(const f32x4*)(pr); Dg += *(const f32x4*)(pr + 4);
    }
  }
  float gl[4];
#pragma unroll
  for (int k = 0; k < 4; ++k) gl[k] = __shfl(Dg[k], j) + p.rg_b[l * 4 + k];
  int gs = 0; float gmax = gl[0];
#pragma unroll
  for (int k = 1; k < 4; ++k) { const bool bb = gl[k] > gmax; gmax = bb ? gl[k] : gmax; gs = bb ? k : gs; }
  float psum = 0.f;
#pragma unroll
  for (int k = 0; k < 4; ++k) psum += __expf(gl[k] - gmax);
  const float gate = 1.0f / psum;
  float es[4];
#pragma unroll
  for (int k = 0; k < 4; ++k) es[k] = De[k] + p.re_b[l * 16 + 4 * g + k];
  int i0 = 0; float v0 = es[0];
#pragma unroll
  for (int k = 1; k < 4; ++k) { const bool bb = es[k] > v0; v0 = bb ? es[k] : v0; i0 = bb ? k : i0; }
  int i1 = 0; float v1 = -3.0e38f;
#pragma unroll
  for (int k = 0; k < 4; ++k) { const bool bb = (k != i0) && (es[k] > v1); v1 = bb ? es[k] : v1; i1 = bb ? k : i1; }
  const float ex = __expf(v1 - v0);
  const float tw0 = 1.0f / (1.0f + ex), tw1 = ex / (1.0f + ex);
  const bool commit = (g == gs) && (j < 8);
  const int e0 = gs * 4 + i0, e1 = gs * 4 + i1;
  int lp0 = 0, lp1 = 0;
  if (commit) { lp0 = atomicAdd(&scnt[e0], 1); lp1 = atomicAdd(&scnt[e1], 1); }
  __syncthreads();
  if (tid < 16) sbase[tid] = atomicAdd(p.counts + l * 16 + tid, scnt[tid]);
  __syncthreads();
  if (commit) {
    const int pos0 = sbase[e0] + lp0, pos1 = sbase[e1] + lp1;
    p.list[e0 * NTOK + pos0] = tok; p.wlist[e0 * NTOK + pos0] = gate * tw0;
    p.list[e1 * NTOK + pos1] = tok; p.wlist[e1 * NTOK + pos1] = gate * tw1;
    int4 ti; ti.x = e0; ti.y = pos0; ti.z = e1; ti.w = pos1;
    *(int4*)(p.tokinfo + (size_t)tok * 4) = ti;
  }
}

__device__ __forceinline__ int moe_total_mtiles(const int* cnts) {
  int tot = 0;
#pragma unroll
  for (int e = 0; e < 16; ++e) tot += (cnts[e] + 127) >> 7;
  return tot;
}
__device__ __forceinline__ void moe_find(const int* cnts, int mi, int& e_out, int& ml, int& off, int& cnt) {
  int rem = mi, o = 0; e_out = 0; ml = 0; off = 0; cnt = 1;
  bool found = false;
#pragma unroll
  for (int e = 0; e < 16; ++e) {
    const int c = cnts[e], mtl = (c + 127) >> 7;
    if (!found && rem < mtl) { found = true; e_out = e; ml = rem; off = o; cnt = c; }
    rem -= mtl; o += c;
  }
}

__device__ void p5_tile(const Params& p, int l, int t, int mtot, unsigned char* smem) {
  const int mi = (t >> 5) * 8 + (t & 7), nt = (t >> 3) & 3;
  if (mi >= mtot) return;
  int e, ml, off, cnt;
  moe_find(p.counts + l * 16, mi, e, ml, off, cnt);
  const int tid = otid(), lane = tid & 63, wid = tid >> 6, wr = wid >> 1, wc = wid & 1;
  const int srow = tid >> 3, sch = tid & 7, qi = lane & 15, g = lane >> 4;
  const bf16_t* pa[4];
#pragma unroll
  for (int i = 0; i < 4; ++i) {
    const int ridx = min(ml * 128 + srow + 32 * i, cnt - 1);
    const int tok = p.list[e * NTOK + ridx];
    pa[i] = p.xb + (size_t)tok * 1024 + sch * 8;
  }
  const bf16_t* B = p.Wgu + ((size_t)e * 512 + nt * 128 + srow) * 1024 + sch * 8;
  f32x4 acc[4][4];
  ZERO_ACC(acc);
  gemm_main(smem, pa[0], pa[1], pa[2], pa[3], B, B + 32 * 1024, B + 64 * 1024, B + 96 * 1024, 16, -1, false, acc, NoMid());
#pragma unroll
  for (int i = 0; i < 4; ++i) {
    const int rloc = ml * 128 + wr * 64 + i * 16 + qi;
    if (rloc < cnt) {
      const size_t slot = (size_t)off + rloc;
#pragma unroll
      for (int jp = 0; jp < 2; ++jp) {
        const f32x4 ga = acc[i][2 * jp], up = acc[i][2 * jp + 1];
        const int col = 64 * nt + 32 * wc + 16 * jp + 4 * g;
        store_bf16x4(p.act + slot * 256 + col, silu(ga[0]) * up[0], silu(ga[1]) * up[1], silu(ga[2]) * up[2], silu(ga[3]) * up[3]);
      }
    }
  }
}

struct P6Tile { int e, ml, off, cnt, nt; const bf16_t* pa0; const bf16_t* pa1; const bf16_t* pa2; const bf16_t* pa3; const bf16_t* B; };
__device__ __forceinline__ int p6_next(int t, int ntot, int mtot, int nblk) {
  while (t < ntot && ((t >> 6) * 8 + (t & 7)) >= mtot) t += nblk;
  return t;
}
__device__ __forceinline__ void p6_setup(const Params& p, int l, int t, P6Tile& T) {
  const int mi = (t >> 6) * 8 + (t & 7);
  T.nt = (t >> 3) & 7;
  moe_find(p.counts + l * 16, mi, T.e, T.ml, T.off, T.cnt);
  const int tid = otid(), srow = tid >> 3, sch = tid & 7;
  const bf16_t* base = p.act + (size_t)T.off * 256 + sch * 8;
  T.pa0 = base + (size_t)min(T.ml * 128 + srow, T.cnt - 1) * 256;
  T.pa1 = base + (size_t)min(T.ml * 128 + srow + 32, T.cnt - 1) * 256;
  T.pa2 = base + (size_t)min(T.ml * 128 + srow + 64, T.cnt - 1) * 256;
  T.pa3 = base + (size_t)min(T.ml * 128 + srow + 96, T.cnt - 1) * 256;
  T.B = p.Wdn + ((size_t)T.e * 1024 + T.nt * 128 + srow) * 256 + sch * 8;
}
__device__ void p6_phase(const Params& p, int l, int bid, int nblk, unsigned char* smem) {
  const int mtot = moe_total_mtiles(p.counts + l * 16), ntot = ((mtot + 7) >> 3) * 64;
  P6Tile cur, nxt;
  int t = p6_next(bid, ntot, mtot, nblk);
  if (t < ntot) {
    p6_setup(p, l, t, cur);
    __syncthreads();
    gemm_issue0(smem, cur.pa0, cur.pa1, cur.pa2, cur.pa3, cur.B, cur.B + 32 * 256, cur.B + 64 * 256, cur.B + 96 * 256);
  }
  while (t < ntot) {
    f32x4 acc[4][4];
    ZERO_ACC(acc);
    gemm_main<true>(smem, cur.pa0, cur.pa1, cur.pa2, cur.pa3, cur.B, cur.B + 32 * 256, cur.B + 64 * 256, cur.B + 96 * 256, 4, -1, false, acc, NoMid());
    const int tn = p6_next(t + nblk, ntot, mtot, nblk);
    nxt = cur;
    if (tn < ntot) {
      p6_setup(p, l, tn, nxt);
      gemm_issue0(smem, nxt.pa0, nxt.pa1, nxt.pa2, nxt.pa3, nxt.B, nxt.B + 32 * 256, nxt.B + 64 * 256, nxt.B + 96 * 256);
    }
    {
      const int tid = otid(), lane = tid & 63, wid = tid >> 6, wr = wid >> 1, wc = wid & 1, qi = lane & 15, g = lane >> 4;
#pragma unroll
      for (int i = 0; i < 4; ++i) {
        const int rloc = cur.ml * 128 + wr * 64 + i * 16 + qi;
        if (rloc < cur.cnt) {
          const float wgt = p.wlist[cur.e * NTOK + rloc];
          const size_t slot = (size_t)cur.off + rloc;
#pragma unroll
          for (int j = 0; j < 4; ++j) {
            const int n = cur.nt * 128 + wc * 64 + j * 16 + 4 * g;
            store_bf16x4(p.y + slot * 1024 + n, acc[i][j][0] * wgt, acc[i][j][1] * wgt, acc[i][j][2] * wgt, acc[i][j][3] * wgt);
          }
        }
      }
    }
    cur = nxt; t = tn;
  }
}

template <int NT>
__device__ __forceinline__ void p7_tokens(const Params& p, int l, int tok0, int tstride) {
  const int lane = otid() & 63;
  int4 ti[NT];
#pragma unroll
  for (int u = 0; u < NT; ++u) ti[u] = *(const int4*)(p.tokinfo + (size_t)(tok0 + u * tstride) * 4);
  int off0[NT], off1[NT];
#pragma unroll
  for (int u = 0; u < NT; ++u) { off0[u] = 0; off1[u] = 0; }
#pragma unroll
  for (int e = 0; e < 16; ++e) {
    const int c = p.counts[l * 16 + e];
#pragma unroll
    for (int u = 0; u < NT; ++u) { if (e < ti[u].x) off0[u] += c; if (e < ti[u].z) off1[u] += c; }
  }
  float4 xr[NT][4]; u32x2 ya[NT][4], yb[NT][4];
#pragma unroll
  for (int u = 0; u < NT; ++u) {
    const int tok = tok0 + u * tstride;
    const size_t s0 = (size_t)off0[u] + ti[u].y, s1 = (size_t)off1[u] + ti[u].w;
#pragma unroll
    for (int q = 0; q < 4; ++q) {
      const int c = q * 256 + lane * 4;
      xr[u][q] = *(const float4*)(p.x1 + (size_t)tok * 1024 + c);
      ya[u][q] = *(const u32x2*)(p.y + s0 * 1024 + c);
      yb[u][q] = *(const u32x2*)(p.y + s1 * 1024 + c);
    }
  }
  float4 gg[4], bb[4];
#pragma unroll
  for (int q = 0; q < 4; ++q) {
    gg[q] = *(const float4*)(p.ln2_g + l * 1024 + q * 256 + lane * 4);
    bb[q] = *(const float4*)(p.ln2_b + l * 1024 + q * 256 + lane * 4);
  }
#pragma unroll
  for (int u = 0; u < NT; ++u) {
    const int tok = tok0 + u * tstride;
    float hv[16];
#pragma unroll
    for (int q = 0; q < 4; ++q) {
      hv[q * 4 + 0] = ALPHA * xr[u][q].x + (__uint_as_float(ya[u][q].x << 16) + __uint_as_float(yb[u][q].x << 16));
      hv[q * 4 + 1] = ALPHA * xr[u][q].y + (__uint_as_float(ya[u][q].x & 0xffff0000u) + __uint_as_float(yb[u][q].x & 0xffff0000u));
      hv[q * 4 + 2] = ALPHA * xr[u][q].z + (__uint_as_float(ya[u][q].y << 16) + __uint_as_float(yb[u][q].y << 16));
      hv[q * 4 + 3] = ALPHA * xr[u][q].w + (__uint_as_float(ya[u][q].y & 0xffff0000u) + __uint_as_float(yb[u][q].y & 0xffff0000u));
    }
    float s1s = 0.f;
#pragma unroll
    for (int c = 0; c < 16; ++c) s1s += hv[c];
    const float mu = wave_sum(s1s) * (1.0f / 1024.0f);
    float s2 = 0.f;
#pragma unroll
    for (int c = 0; c < 16; ++c) { const float d = hv[c] - mu; s2 += d * d; }
    const float rstd = rsqrtf(wave_sum(s2) * (1.0f / 1024.0f) + LN_EPS);
#pragma unroll
    for (int q = 0; q < 4; ++q) {
      const int c = q * 256 + lane * 4;
      float4 o;
      o.x = (hv[q * 4 + 0] - mu) * rstd * gg[q].x + bb[q].x; o.y = (hv[q * 4 + 1] - mu) * rstd * gg[q].y + bb[q].y;
      o.z = (hv[q * 4 + 2] - mu) * rstd * gg[q].z + bb[q].z; o.w = (hv[q * 4 + 3] - mu) * rstd * gg[q].w + bb[q].w;
      if (l == 3) *(float4*)(p.out + (size_t)tok * 1024 + c) = o;
      else store_bf16x4(p.xb + (size_t)tok * 1024 + c, o.x, o.y, o.z, o.w);
    }
  }
}

#define XB_TMO      128
#define XB_XCNT(j)  (256  + 64 * (j))
#define XB_XSUB(j)  (1280 + 64 * (j))
#define XB_XGEN(j)  (2304 + 64 * (j))
#define XB_TOP      3328
#define XB_TOPGEN   3392
#define XCD_BAR_WORDS 3456
#define XB_SPIN_CAP (1u << 22)
__device__ __forceinline__ unsigned xb_ld(unsigned* p) { return __hip_atomic_load(p, __ATOMIC_RELAXED, __HIP_MEMORY_SCOPE_AGENT); }
__device__ __forceinline__ unsigned xb_add(unsigned* p, unsigned v) { return __hip_atomic_fetch_add(p, v, __ATOMIC_RELAXED, __HIP_MEMORY_SCOPE_AGENT); }
__device__ __forceinline__ unsigned xb_xcc_id() { return (unsigned)__builtin_amdgcn_s_getreg((3 << 11) | 20) & 0xFu; }
#define XB_SPIN(cond, bar) do { unsigned _sp = 0; while (cond) { __builtin_amdgcn_s_sleep(1); \
    if ((++_sp & 255u) == 0u) { if (xb_ld(&(bar)[XB_TMO])) break; if (_sp > XB_SPIN_CAP) { atomicAdd(&(bar)[XB_TMO], 1u); break; } } } } while (0)
struct XcdBarrier { unsigned* bar; unsigned x; volatile unsigned* st; };
__device__ __forceinline__ XcdBarrier xcd_barrier_post(unsigned* bar, volatile unsigned* st) {
  XcdBarrier b; b.bar = bar; b.x = xb_xcc_id(); b.st = st;
  if (threadIdx.x == 0) (void)xb_add(&bar[XB_XCNT(b.x)], 1u);
  return b;
}
__device__ __forceinline__ void xcd_barrier_complete(unsigned* bar, unsigned x, unsigned& nloc, unsigned& nx) {
  const unsigned G = gridDim.x;
  unsigned sum, cnt, mine, sp = 0u;
  for (;;) {
    sum = 0u; cnt = 0u; mine = 0u;
#pragma unroll
    for (unsigned j = 0; j < 16; ++j) { const unsigned c = xb_ld(&bar[XB_XCNT(j)]); sum += c; cnt += (c > 0u) ? 1u : 0u; mine = (j == x) ? c : mine; }
    if (sum == G) break;
    __builtin_amdgcn_s_sleep(1);
    if ((++sp & 255u) == 0u) { if (xb_ld(&bar[XB_TMO])) break; if (sp > XB_SPIN_CAP) { atomicAdd(&bar[XB_TMO], 1u); break; } }
  }
  nloc = mine > 0u ? mine : 1u; nx = cnt > 0u ? cnt : 1u;
}
__device__ __forceinline__ void xcd_barrier(const XcdBarrier& b) {
  asm volatile("s_waitcnt vmcnt(0)" ::: "memory");
  __syncthreads();
  if (threadIdx.x == 0) {
    unsigned* bar = b.bar;
    __builtin_amdgcn_s_waitcnt(0);
    unsigned nloc = b.st[0], nx = b.st[1];
    if (nloc == 0u) { xcd_barrier_complete(bar, b.x, nloc, nx); b.st[0] = nloc; b.st[1] = nx; }
    const unsigned old = xb_add(&bar[XB_XSUB(b.x)], 1u);
    const unsigned gen = old / nloc;
    if (old + 1u == (gen + 1u) * nloc) {
      __builtin_amdgcn_fence(__ATOMIC_RELEASE, "agent");
      asm volatile("s_waitcnt vmcnt(0)" ::: "memory");
      const unsigned og = xb_add(&bar[XB_TOP], 1u);
      const unsigned tg = og / nx;
      if (og + 1u == (tg + 1u) * nx) xb_add(&bar[XB_TOPGEN], 1u);
      else XB_SPIN(xb_ld(&bar[XB_TOPGEN]) == tg, bar);
      __builtin_amdgcn_fence(__ATOMIC_ACQUIRE, "agent");
      xb_add(&bar[XB_XGEN(b.x)], 1u);
      asm volatile("s_waitcnt vmcnt(0)" ::: "memory");
    } else {
      XB_SPIN(xb_ld(&bar[XB_XGEN(b.x)]) == gen, bar);
      __builtin_amdgcn_fence(__ATOMIC_ACQUIRE, "agent");
      asm volatile("s_waitcnt vmcnt(0)" ::: "memory");
    }
  }
  __syncthreads();
}

__device__ __forceinline__ void run_phase(const Params& p, int ph, int l, int bid, int nblk, unsigned char* smem, float* sbias) {
  switch (ph) {
    case 0: {
      if (bid == 0 && threadIdx.x < 64) p.counts[threadIdx.x] = 0;
      conv_x(p, bid, nblk);
      for (int it = bid; it < NCONV_ITEMS; it += nblk) conv_item(p, 0, it, smem);
    } break;
    case 1: p1_phase(p, l, bid, nblk, smem); break;
    case 2:
      attn_phase(p, l, bid, nblk, smem);
      for (int it = bid; it < 1024; it += nblk) sgu_item(p, l, it, smem);
      break;
    case 3: for (int t = bid; t < 1024; t += nblk) p3_tile(p, l, t, smem); break;
    case 4: for (int it = bid; it < NTOK / 32; it += nblk) p4_batch(p, l, it, smem); break;
    case 5: { const int mtot = moe_total_mtiles(p.counts + l * 16), nt = ((mtot + 7) >> 3) * 32; for (int t = bid; t < nt; t += nblk) p5_tile(p, l, t, mtot, smem); } break;
    case 6: p6_phase(p, l, bid, nblk, smem); break;
    case 7: {
      { const int nw = nblk * 4; int tok = bid * 4 + (threadIdx.x >> 6);
        for (; tok + 3 * nw < NTOK; tok += 4 * nw) p7_tokens<4>(p, l, tok, nw);
        for (; tok < NTOK; tok += nw) p7_tokens<1>(p, l, tok, nw); }
      if (l < 3) for (int it = bid; it < NCONV_ITEMS; it += nblk) conv_item(p, l + 1, it, smem);
    } break;
  }
}

template <int PH>
__global__ void __launch_bounds__(256, 2) phase_kernel(Params p, int l) {
  __shared__ __attribute__((aligned(16))) unsigned char smem[SMEM_BYTES];
  run_phase(p, PH, l, blockIdx.x, gridDim.x, smem, (float*)smem);
}

#if MEGA
__global__ void __launch_bounds__(256, 2) mega_kernel(Params p) {
  __shared__ __attribute__((aligned(16))) unsigned char smem[SMEM_BYTES];
  __shared__ uint4 xb_words;
  float* sbias = (float*)smem;
  cg::grid_group grid = cg::this_grid();
  const int bid = blockIdx.x, nblk = gridDim.x;
  if (threadIdx.x == 0) xb_words = make_uint4(0u, 0u, 0u, 0u);
  __syncthreads();
  XcdBarrier xb = xcd_barrier_post(p.bar, (volatile unsigned*)&xb_words);
  run_phase(p, 0, 0, bid, nblk, smem, sbias);
  if (p.never) grid.sync();
  xcd_barrier(xb);
#pragma unroll 1
  for (int l = 0; l < 4; ++l) {
#pragma unroll 1
    for (int ph = 1; ph <= 7; ++ph) {
      run_phase(p, ph, l, bid, nblk, smem, sbias);
#if DUP_PH
      if (ph == DUP_PH) { xcd_barrier(xb); run_phase(p, ph, l, bid, nblk, smem, sbias); }
#endif
      if (!(l == 3 && ph == 7)) xcd_barrier(xb);
    }
  }
}
#endif

extern "C" void kernel_launch(void* const* d_in, const int* in_sizes, int n_in, void* d_out, int out_size, void* d_ws,
                              size_t ws_size, hipStream_t stream) {
  Params p{};
  p.x = (const float*)d_in[0]; p.w_in = (const float*)d_in[1]; p.w_out = (const float*)d_in[2]; p.rel_bias = (const float*)d_in[3];
  p.sgu_ln_g = (const float*)d_in[4]; p.sgu_ln_b = (const float*)d_in[5]; p.sgu_w = (const float*)d_in[6]; p.sgu_b = (const float*)d_in[7];
  p.mix_g = (const float*)d_in[8]; p.ln1_g = (const float*)d_in[9]; p.ln1_b = (const float*)d_in[10];
  p.rg_w = (const float*)d_in[11]; p.rg_b = (const float*)d_in[12]; p.re_w = (const float*)d_in[13]; p.re_b = (const float*)d_in[14];
  p.w_gate = (const float*)d_in[15]; p.w_up = (const float*)d_in[16]; p.w_down = (const float*)d_in[17];
  p.ln2_g = (const float*)d_in[18]; p.ln2_b = (const float*)d_in[19];
  p.out = (float*)d_out;
  unsigned char* w = (unsigned char*)d_ws;
  size_t o = 0;
  auto take = [&](size_t bytes) { unsigned char* r = w + o; o += (bytes + 255) & ~(size_t)255; return r; };
  p.Wt_in = (bf16_t*)take((size_t)2560 * 1024 * 2);
  p.Wt_out = (bf16_t*)take((size_t)1024 * 1024 * 2);
  p.Wgu = (bf16_t*)take((size_t)16 * 512 * 1024 * 2);
  p.Wdn = (bf16_t*)take((size_t)16 * 1024 * 256 * 2);
  p.Wsgu = (bf16_t*)take((size_t)8 * 128 * 128 * 2);
  p.xb = (bf16_t*)take((size_t)NTOK * 1024 * 2);
  p.x1 = (float*)take((size_t)NTOK * 1024 * 4);
  unsigned char* r1 = take((size_t)NTOK * 2560 * 2);
  p.qk = (bf16_t*)r1;
  p.vT = (bf16_t*)(r1 + (size_t)NTOK * 1024 * 2);
  p.ub = (bf16_t*)(r1 + (size_t)NTOK * 1536 * 2);
  p.vnT = (bf16_t*)(r1 + (size_t)NTOK * 2048 * 2);
  p.y = (bf16_t*)r1;
  p.hb = (bf16_t*)r1;
  unsigned char* r2 = take((size_t)NTOK * 1024 * 2);
  p.mixed = (bf16_t*)r2;
  p.act = (bf16_t*)r2;
  p.ssq = (float*)take((size_t)NTOK * 16 * 4);
  p.wlist = (float*)take((size_t)16 * NTOK * 4);
  p.list = (int*)take((size_t)16 * NTOK * 4);
  p.tokinfo = (int*)take((size_t)NTOK * 4 * 4);
  p.counts = (int*)take(256);
  p.Wr_eh = (bf16_t*)take(16384 * 2); p.Wr_el = (bf16_t*)take(16384 * 2);
  p.Wr_gh = (bf16_t*)take(16384 * 2); p.Wr_gl = (bf16_t*)take(16384 * 2);
  p.bar = (unsigned*)take(XCD_BAR_WORDS * 4);
#if MEGA
  static int grid_blocks = 0;
  if (!grid_blocks) {
    int dev = 0, cus = 0, per_cu = 0;
    hipGetDevice(&dev);
    hipDeviceGetAttribute(&cus, hipDeviceAttributeMultiprocessorCount, dev);
    hipOccupancyMaxActiveBlocksPerMultiprocessor(&per_cu, mega_kernel, 256, 0);
    if (per_cu > 2) per_cu = 2;
    grid_blocks = cus * per_cu;
  }
  (void)hipMemsetAsync(p.bar, 0, XCD_BAR_WORDS * 4, stream);
  void* args[] = {&p};
  hipError_t e = hipLaunchCooperativeKernel((void*)mega_kernel, dim3(grid_blocks), dim3(256), args, 0, stream);
  if (e != hipSuccess) fprintf(stderr, "cooperative launch failed: %s (grid %d)\n", hipGetErrorString(e), grid_blocks);
#else
  const int G = 512;
  phase_kernel<0><<<G, 256, 0, stream>>>(p, 0);
  for (int l = 0; l < 4; ++l) {
    phase_kernel<1><<<G, 256, 0, stream>>>(p, l);
    phase_kernel<2><<<G, 256, 0, stream>>>(p, l);
    phase_kernel<3><<<G, 256, 0, stream>>>(p, l);
    phase_kernel<4><<<G, 256, 0, stream>>>(p, l);
    phase_kernel<5><<<G, 256, 0, stream>>>(p, l);
    phase_kernel<6><<<G, 256, 0, stream>>>(p, l);
    phase_kernel<7><<<G, 256, 0, stream>>>(p, l);
  }
#endif
}
```

```cpp
#include <hip/hip_runtime.h>
#include <hip/hip_cooperative_groups.h>
#include <stdint.h>
#include <cstdio>
namespace cg = cooperative_groups;

#ifndef MEGA
#define MEGA 1
#endif
#define DUP_PH 0

typedef unsigned short bf16_t;
typedef short bf16x8 __attribute__((ext_vector_type(8)));
typedef float f32x4 __attribute__((ext_vector_type(4)));
typedef unsigned u32x4 __attribute__((ext_vector_type(4)));
typedef unsigned u32x2 __attribute__((ext_vector_type(2)));

#define NTOK 16384
#define LN_EPS 1e-5f
#define ALPHA 1.681792830507429f
#define NCONV_ITEMS 1009
#define SMEM_BYTES 69632

struct Params {
  const float *x, *w_in, *w_out, *rel_bias, *sgu_ln_g, *sgu_ln_b, *sgu_w, *sgu_b, *mix_g, *ln1_g, *ln1_b,
      *rg_w, *rg_b, *re_w, *re_b, *w_gate, *w_up, *w_down, *ln2_g, *ln2_b;
  float* out;
  bf16_t *Wt_in, *Wt_out, *Wgu, *Wdn, *Wsgu, *xb, *qk, *vT, *ub, *vnT, *mixed, *act, *y, *hb;
  float *x1, *ssq, *wlist;
  bf16_t *Wr_eh, *Wr_el, *Wr_gh, *Wr_gl;
  int *counts, *list, *tokinfo;
  unsigned* bar;
  int never;
  int pad_;
};

__device__ __forceinline__ unsigned cvt_pk_bf16(float lo, float hi) {
  unsigned r; asm("v_cvt_pk_bf16_f32 %0, %1, %2" : "=v"(r) : "v"(lo), "v"(hi)); return r;
}
__device__ __forceinline__ void store_bf16x4(bf16_t* p, float a, float b, float c, float d) {
  u32x2 v; v.x = cvt_pk_bf16(a, b); v.y = cvt_pk_bf16(c, d); *(u32x2*)p = v;
}
__device__ __forceinline__ float gelu_tanh(float x) {
  float z = 0.7978845608028654f * (x + 0.044715f * x * x * x);
  return x * __builtin_amdgcn_rcpf(1.0f + __expf(-2.0f * z));
}
__device__ __forceinline__ int otid() { int t = threadIdx.x; asm volatile("" : "+v"(t)); return t; }
__device__ __forceinline__ float silu(float x) { return x * __builtin_amdgcn_rcpf(1.0f + __expf(-x)); }
template <int CTRL>
__device__ __forceinline__ float dpp_mov(float v) {
  return __builtin_bit_cast(float, __builtin_amdgcn_update_dpp(0, __builtin_bit_cast(int, v), CTRL, 0xf, 0xf, true));
}
__device__ __forceinline__ float row16_sum(float v) {
  v += dpp_mov<0xB1>(v); v += dpp_mov<0x4E>(v); v += dpp_mov<0x141>(v); v += dpp_mov<0x140>(v); return v;
}
__device__ __forceinline__ float wave_sum(float v) {
  v = row16_sum(v); v += __shfl_xor(v, 16); v += __shfl_xor(v, 32); return v;
}

struct NoMid { __device__ __forceinline__ void operator()(f32x4 (&)[4][4]) const {} };
struct MidScale {
  float s[4];
  __device__ __forceinline__ void operator()(f32x4 (&acc)[4][4]) const {
#pragma unroll
    for (int i = 0; i < 4; ++i)
#pragma unroll
      for (int j = 0; j < 4; ++j) acc[i][j] *= s[i];
  }
};

#define GLDS16(gptr, lptr) __builtin_amdgcn_global_load_lds((const unsigned*)(gptr), (__attribute__((address_space(3))) unsigned*)(lptr), 16, 0, 0)

__device__ __forceinline__ void gemm_issue0(unsigned char* smem, const bf16_t* pa0, const bf16_t* pa1, const bf16_t* pa2,
                                            const bf16_t* pa3, const bf16_t* pb0, const bf16_t* pb1, const bf16_t* pb2,
                                            const bf16_t* pb3) {
  const int tid = otid(), wid = tid >> 6, srow = tid >> 3;
  const int lch = ((tid & 7) ^ ((srow >> 1) & 7)) * 8 - (tid & 7) * 8;
  unsigned char* d = smem + __builtin_amdgcn_readfirstlane(wid) * 1024;
  GLDS16(pa0 + lch, d); GLDS16(pa1 + lch, d + 4096); GLDS16(pa2 + lch, d + 8192); GLDS16(pa3 + lch, d + 12288);
  GLDS16(pb0 + lch, d + 16384); GLDS16(pb1 + lch, d + 20480); GLDS16(pb2 + lch, d + 24576); GLDS16(pb3 + lch, d + 28672);
}

template <bool PRE = false, class Mid>
__device__ __forceinline__ void gemm_main(unsigned char* smem, const bf16_t* pa0, const bf16_t* pa1, const bf16_t* pa2,
                                          const bf16_t* pa3, const bf16_t* pb0, const bf16_t* pb1, const bf16_t* pb2,
                                          const bf16_t* pb3, int nk, int kmid, bool swapped, f32x4 (&acc)[4][4],
                                          const Mid& mid) {
  const int tid = otid(), lane = tid & 63, wid = tid >> 6, wr = wid >> 1, wc = wid & 1;
  const int srow = tid >> 3;
  const int lch = ((tid & 7) ^ ((srow >> 1) & 7)) * 8 - (tid & 7) * 8;
  pa0 += lch; pa1 += lch; pa2 += lch; pa3 += lch; pb0 += lch; pb1 += lch; pb2 += lch; pb3 += lch;
  const int soff = __builtin_amdgcn_readfirstlane(wid) * 1024;
  const int qi = lane & 15, g = lane >> 4, s = qi >> 1;
  const int aside = swapped ? 16384 : 0, bside = swapped ? 0 : 16384;
  const int offA0 = aside + (wr * 64 + qi) * 128 + (((0 + g) ^ s) << 4);
  const int offA1 = aside + (wr * 64 + qi) * 128 + (((4 + g) ^ s) << 4);
  const int offB0 = bside + (wc * 64 + qi) * 128 + (((0 + g) ^ s) << 4);
  const int offB1 = bside + (wc * 64 + qi) * 128 + (((4 + g) ^ s) << 4);
  if (!PRE) {
    unsigned char* d = smem + soff;
    GLDS16(pa0, d); GLDS16(pa1, d + 4096); GLDS16(pa2, d + 8192); GLDS16(pa3, d + 12288);
    GLDS16(pb0, d + 16384); GLDS16(pb1, d + 20480); GLDS16(pb2, d + 24576); GLDS16(pb3, d + 28672);
  }
  asm volatile("s_waitcnt vmcnt(0)" ::: "memory");
  __syncthreads();
  for (int kt = 0; kt < nk; ++kt) {
    unsigned char* buf = smem + ((kt & 1) << 15);
    if (kt + 1 < nk) {
      const int ko = (kt + 1) * 64;
      unsigned char* d = smem + (((kt + 1) & 1) << 15) + soff;
      GLDS16(pa0 + ko, d); GLDS16(pa1 + ko, d + 4096); GLDS16(pa2 + ko, d + 8192); GLDS16(pa3 + ko, d + 12288);
      GLDS16(pb0 + ko, d + 16384); GLDS16(pb1 + ko, d + 20480); GLDS16(pb2 + ko, d + 24576); GLDS16(pb3 + ko, d + 28672);
    }
    if (kt == kmid) mid(acc);
    {
      bf16x8 af0[4], bf0[4], af1[4], bf1[4];
#pragma unroll
      for (int i = 0; i < 4; ++i) af0[i] = *(const bf16x8*)(buf + offA0 + i * 2048);
#pragma unroll
      for (int j = 0; j < 4; ++j) bf0[j] = *(const bf16x8*)(buf + offB0 + j * 2048);
#pragma unroll
      for (int i = 0; i < 4; ++i) af1[i] = *(const bf16x8*)(buf + offA1 + i * 2048);
#pragma unroll
      for (int j = 0; j < 4; ++j) bf1[j] = *(const bf16x8*)(buf + offB1 + j * 2048);
      asm volatile("s_waitcnt lgkmcnt(8)" ::: "memory");
      __builtin_amdgcn_s_setprio(1);
#pragma unroll
      for (int i = 0; i < 4; ++i)
#pragma unroll
        for (int j = 0; j < 4; ++j) acc[i][j] = __builtin_amdgcn_mfma_f32_16x16x32_bf16(bf0[j], af0[i], acc[i][j], 0, 0, 0);
      asm volatile("s_waitcnt lgkmcnt(0)" ::: "memory");
#pragma unroll
      for (int i = 0; i < 4; ++i)
#pragma unroll
        for (int j = 0; j < 4; ++j) acc[i][j] = __builtin_amdgcn_mfma_f32_16x16x32_bf16(bf1[j], af1[i], acc[i][j], 0, 0, 0);
      __builtin_amdgcn_s_setprio(0);
    }
    asm volatile("s_waitcnt vmcnt(0)" ::: "memory");
    __syncthreads();
  }
}

#define ZERO_ACC(acc)                                   \
  _Pragma("unroll") for (int i_ = 0; i_ < 4; ++i_)      \
  _Pragma("unroll") for (int j_ = 0; j_ < 4; ++j_) acc[i_][j_] = (f32x4){0.f, 0.f, 0.f, 0.f};

__device__ void conv_x(const Params& p, int bid, int nblk) {
  const size_t n8 = (size_t)NTOK * 1024 / 8;
#pragma unroll 4
  for (size_t i = (size_t)bid * 256 + threadIdx.x; i < n8; i += (size_t)nblk * 256) {
    const float4 a = *(const float4*)(p.x + i * 8), b = *(const float4*)(p.x + i * 8 + 4);
    u32x4 v; v.x = cvt_pk_bf16(a.x, a.y); v.y = cvt_pk_bf16(a.z, a.w); v.z = cvt_pk_bf16(b.x, b.y); v.w = cvt_pk_bf16(b.z, b.w);
    *(u32x4*)(p.xb + i * 8) = v;
  }
}

__device__ void tconv_tile(float* tile, const float* src, int src_ld, const float* kscale, bf16_t* dst, int dst_ld, int rstep) {
  const int t = otid();
  {
    const int k0 = t >> 6, n4 = (t & 63) * 4;
    float4 v[16];
#pragma unroll
    for (int i = 0; i < 16; ++i) v[i] = *(const float4*)(src + (size_t)(k0 + 4 * i) * src_ld + n4);
    if (kscale) {
#pragma unroll
      for (int i = 0; i < 16; ++i) { const float sc = kscale[k0 + 4 * i]; v[i].x *= sc; v[i].y *= sc; v[i].z *= sc; v[i].w *= sc; }
    }
#pragma unroll
    for (int i = 0; i < 16; ++i) *(float4*)(tile + (k0 + 4 * i) * 260 + n4) = v[i];
  }
  __syncthreads();
  {
    const int n = t;
    bf16_t* o = dst + (size_t)((n >> 4) * rstep + (n & 15)) * dst_ld;
#pragma unroll
    for (int c = 0; c < 8; ++c) {
      float f[8];
#pragma unroll
      for (int q = 0; q < 8; ++q) f[q] = tile[(c * 8 + q) * 260 + n];
      u32x4 v0;
      v0.x = cvt_pk_bf16(f[0], f[1]); v0.y = cvt_pk_bf16(f[2], f[3]); v0.z = cvt_pk_bf16(f[4], f[5]); v0.w = cvt_pk_bf16(f[6], f[7]);
      *(u32x4*)(o + c * 8) = v0;
    }
  }
  __syncthreads();
}

__device__ void conv_item(const Params& p, int l, int it, unsigned char* smem) {
  float* tile = (float*)smem;
  if (it < 160) {
    const int kt = it / 10, ntile = it % 10;
    tconv_tile(tile, p.w_in + (size_t)l * 1024 * 2560 + (size_t)kt * 64 * 2560 + ntile * 256, 2560, nullptr,
               p.Wt_in + (size_t)ntile * 256 * 1024 + kt * 64, 1024, 16);
  } else if (it < 224) {
    const int r = it - 160, kt = r >> 2, ntile = r & 3;
    tconv_tile(tile, p.w_out + (size_t)l * 1024 * 1024 + (size_t)kt * 64 * 1024 + ntile * 256, 1024, p.mix_g + l * 1024 + kt * 64,
               p.Wt_out + (size_t)ntile * 256 * 1024 + kt * 64, 1024, 16);
  } else if (it < 736) {
    const int r0 = it - 224, e = r0 >> 5, r = r0 & 31, which = r >> 4, kt = r & 15;
    const float* src = (which ? p.w_up : p.w_gate) + (size_t)(l * 16 + e) * 1024 * 256 + (size_t)kt * 64 * 256;
    tconv_tile(tile, src, 256, nullptr, p.Wgu + (size_t)e * 512 * 1024 + (size_t)(which * 16) * 1024 + kt * 64, 1024, 32);
  } else if (it < 992) {
    const int r0 = it - 736, e = r0 >> 4, r = r0 & 15, kt = r >> 2, ntile = r & 3;
    tconv_tile(tile, p.w_down + (size_t)(l * 16 + e) * 256 * 1024 + (size_t)kt * 64 * 1024 + ntile * 256, 1024, nullptr,
               p.Wdn + (size_t)e * 1024 * 256 + (size_t)ntile * 256 * 256 + kt * 64, 256, 16);
  } else if (it == 1008) {
    for (int i = threadIdx.x; i < 16384; i += 256) {
      const int jj = i & 7, j = (i >> 3) & 15, g = (i >> 7) & 3, kb = i >> 9;
      const int k = 32 * kb + 8 * g + jj;
      const float we = p.re_w[(size_t)(l * 1024 + k) * 16 + j];
      const float wg = (j < 4) ? p.rg_w[(size_t)(l * 1024 + k) * 4 + j] : 0.0f;
      const unsigned eh = cvt_pk_bf16(we, 0.f) & 0xffffu, gh = cvt_pk_bf16(wg, 0.f) & 0xffffu;
      const unsigned el = cvt_pk_bf16(we - __uint_as_float(eh << 16), 0.f) & 0xffffu;
      const unsigned gl = cvt_pk_bf16(wg - __uint_as_float(gh << 16), 0.f) & 0xffffu;
      p.Wr_eh[i] = (bf16_t)eh; p.Wr_el[i] = (bf16_t)el; p.Wr_gh[i] = (bf16_t)gh; p.Wr_gl[i] = (bf16_t)gl;
    }
  } else {
    const int j = it - 992;
    const float* src = p.sgu_w + (size_t)l * 131072 + (size_t)j * 8192 + threadIdx.x * 32;
    bf16_t* dst = p.Wsgu + (size_t)j * 8192 + threadIdx.x * 32;
#pragma unroll
    for (int q = 0; q < 4; ++q) {
      const float4 a = *(const float4*)(src + q * 8), b = *(const float4*)(src + q * 8 + 4);
      u32x4 v; v.x = cvt_pk_bf16(a.x, a.y); v.y = cvt_pk_bf16(a.z, a.w); v.z = cvt_pk_bf16(b.x, b.y); v.w = cvt_pk_bf16(b.z, b.w);
      *(u32x4*)(dst + q * 8) = v;
    }
  }
}

__device__ __forceinline__ void p1_decode(int t, int& mt, int& nt) {
  const int x_ = t & 7, j_ = t >> 3, rd_ = j_ >> 6, lb_ = j_ & 63;
  mt = (rd_ < 4) ? (x_ * 16 + (rd_ & 1) * 8 + (lb_ & 7)) : (x_ * 16 + (lb_ & 15));
  nt = (rd_ < 4) ? ((rd_ >> 1) * 8 + (lb_ >> 3)) : (16 + (lb_ >> 4));
}
__device__ __forceinline__ void p1_epilogue(const Params& p, int l, int mt, int nt, f32x4 (&acc)[4][4]) {
  const int type = nt >> 2;
  const bool swapped = (type == 2) || (type == 4);
  const int tid = otid(), lane = tid & 63, wid = tid >> 6, wr = wid >> 1, wc = wid & 1;
  const int qi = lane & 15, g = lane >> 4;
  if (!swapped) {
#pragma unroll
    for (int i = 0; i < 4; ++i) {
      const int m = mt * 128 + wr * 64 + i * 16 + qi;
#pragma unroll
      for (int j = 0; j < 4; ++j) {
        const int n = nt * 128 + wc * 64 + j * 16 + 4 * g;
        f32x4 v = acc[i][j];
        if (type == 0) v *= 0.125f;
        if (type == 3) { v[0] = gelu_tanh(v[0]); v[1] = gelu_tanh(v[1]); v[2] = gelu_tanh(v[2]); v[3] = gelu_tanh(v[3]); }
        bf16_t* dst = (type == 3) ? (p.ub + (size_t)m * 512 + (n - 1536)) : (p.qk + (size_t)m * 1024 + n);
        store_bf16x4(dst, v[0], v[1], v[2], v[3]);
      }
    }
  } else {
    const int bidx = (mt * 128) >> 12, tokbase = (mt * 128) & 4095;
    bf16_t* dstb = (type == 2) ? p.vT : p.vnT;
    const int fbase = (type == 2) ? 1024 : 2048;
    if (type == 4) {
#pragma unroll
      for (int i = 0; i < 4; ++i)
#pragma unroll
        for (int j = 0; j < 4; ++j)
#pragma unroll
          for (int r = 0; r < 4; ++r) acc[i][j][r] = gelu_tanh(acc[i][j][r]);
      float gam[4], bet[4];
#pragma unroll
      for (int i = 0; i < 4; ++i) {
        const int f = nt * 128 + wr * 64 + i * 16 + qi - 2048;
        gam[i] = p.sgu_ln_g[l * 512 + f]; bet[i] = p.sgu_ln_b[l * 512 + f];
      }
#pragma unroll
      for (int j = 0; j < 4; ++j)
#pragma unroll
        for (int r = 0; r < 4; ++r) {
          float s1 = acc[0][j][r] + acc[1][j][r] + acc[2][j][r] + acc[3][j][r];
          s1 = row16_sum(s1);
          const float mu = s1 * (1.0f / 64.0f);
          float s2 = 0.f;
#pragma unroll
          for (int i = 0; i < 4; ++i) { const float d = acc[i][j][r] - mu; s2 += d * d; }
          s2 = row16_sum(s2);
          const float rstd = rsqrtf(s2 * (1.0f / 64.0f) + LN_EPS);
#pragma unroll
          for (int i = 0; i < 4; ++i) acc[i][j][r] = (acc[i][j][r] - mu) * rstd * gam[i] + bet[i];
        }
    }
#pragma unroll
    for (int i = 0; i < 4; ++i) {
      const int f = nt * 128 + wr * 64 + i * 16 + qi - fbase;
#pragma unroll
      for (int j = 0; j < 4; ++j) {
        const int tok = tokbase + wc * 64 + j * 16 + 4 * g;
        store_bf16x4(dstb + ((size_t)(bidx * 512 + f)) * 4096 + tok, acc[i][j][0], acc[i][j][1], acc[i][j][2], acc[i][j][3]);
      }
    }
  }
}


__device__ void p1_phase(const Params& p, int l, int bid, int nblk, unsigned char* smem) {
  const int tid0 = otid();
  int t = bid, mt = 0, nt = 0;
  const bf16_t* A = nullptr; const bf16_t* B = nullptr;
  if (t < 2560) {
    p1_decode(t, mt, nt);
    A = p.xb + (size_t)(mt * 128 + (tid0 >> 3)) * 1024 + (tid0 & 7) * 8;
    B = p.Wt_in + (size_t)(nt * 128 + (tid0 >> 3)) * 1024 + (tid0 & 7) * 8;
    __syncthreads();
    gemm_issue0(smem, A, A + 32 * 1024, A + 64 * 1024, A + 96 * 1024, B, B + 32 * 1024, B + 64 * 1024, B + 96 * 1024);
  }
  while (t < 2560) {
    const int type = nt >> 2;
    const bool swapped = (type == 2) || (type == 4);
    f32x4 acc[4][4];
    ZERO_ACC(acc);
    gemm_main<true>(smem, A, A + 32 * 1024, A + 64 * 1024, A + 96 * 1024, B, B + 32 * 1024, B + 64 * 1024, B + 96 * 1024, 16, -1, swapped, acc, NoMid());
    const int tn = t + nblk;
    int mtn = mt, ntn = nt;
    if (tn < 2560) {
      p1_decode(tn, mtn, ntn);
      const int tid = otid();
      A = p.xb + (size_t)(mtn * 128 + (tid >> 3)) * 1024 + (tid & 7) * 8;
      B = p.Wt_in + (size_t)(ntn * 128 + (tid >> 3)) * 1024 + (tid & 7) * 8;
      gemm_issue0(smem, A, A + 32 * 1024, A + 64 * 1024, A + 96 * 1024, B, B + 32 * 1024, B + 64 * 1024, B + 96 * 1024);
    }
    p1_epilogue(p, l, mt, nt, acc);
    mt = mtn; nt = ntn; t = tn;
  }
}

__device__ void attn_phase(const Params& p, int l, int bid, int nblk, unsigned char* smem) {
  const int tid = otid(), lane = tid & 63, w = tid >> 6, qi = lane & 15, g = lane >> 4;
  unsigned char* Kb = smem;
  unsigned char* Vb = smem + 32768;
  float* sbias = (float*)(smem + 32768 + 33792);
  const int c0 = (w == 0) ? 0 : (w == 1) ? 8 : (w == 2) ? 24 : 32;
  const int cq = 16 * w + qi, cs = min(max(cq - 8, 0), 48);
  const int krow = tid >> 3, kch = tid & 7;
  const int ksoff = krow * 128 + ((kch ^ ((krow >> 1) & 7)) << 4);
  const int vd = tid >> 5, vc = tid & 31;
  const int vsoff = vd * 528 + vc * 16;
  u32x4 st[8], st2[8];
#define ATT_ISSUE_K(it_)                                                                                              \
  do {                                                                                                                \
    const int h_ = (it_) & 7, br_ = (it_) >> 3, r_ = br_ & 63, b_ = br_ >> 6, rs_ = min(max(r_ - 4, 0), 56);          \
    const bf16_t* kg_ = p.qk + ((size_t)b_ * 4096 + rs_ * 64 + krow) * 1024 + 512 + h_ * 64 + kch * 8;                \
    _Pragma("unroll") for (int i = 0; i < 8; ++i) st[i] = *(const u32x4*)(kg_ + (size_t)(32 * i) * 1024);            \
    _Pragma("unroll") for (int i = 0; i < 8; ++i) st2[i] = *(const u32x4*)(kg_ + (size_t)(256 + 32 * i) * 1024);     \
  } while (0)
  int it = bid;
  if (it < 2048) ATT_ISSUE_K(it);
  while (it < 2048) {
    const int h = it & 7, br = it >> 3, r = br & 63, b = br >> 6;
    const int rs = min(max(r - 4, 0), 56);
    const size_t tokq = (size_t)b * 4096 + r * 64 + cq;
    const bf16_t* vg = p.vT + ((size_t)(b * 512 + h * 64 + vd)) * 4096 + rs * 64 + vc * 8;
    const float rb0 = p.rel_bias[(size_t)(l * 8 + h) * 465 + tid];
    const float rb1 = p.rel_bias[(size_t)(l * 8 + h) * 465 + min(tid + 256, 464)];
    bf16x8 qf0 = *(const bf16x8*)(p.qk + tokq * 1024 + h * 64 + g * 8);
    bf16x8 qf1 = *(const bf16x8*)(p.qk + tokq * 1024 + h * 64 + 32 + g * 8);
    __syncthreads();
    sbias[tid] = rb0;
    if (tid + 256 < 465) sbias[tid + 256] = rb1;
#pragma unroll
    for (int i = 0; i < 8; ++i) *(u32x4*)(Kb + ksoff + i * 4096) = st[i];
#pragma unroll
    for (int i = 0; i < 8; ++i) st[i] = *(const u32x4*)(vg + (size_t)(8 * i) * 4096);
    __syncthreads();
    f32x4 s[8][2];
#pragma unroll
    for (int jh = 0; jh < 2; ++jh) {
#pragma unroll
      for (int jj = 0; jj < 4; ++jj)
#pragma unroll
        for (int ch = 0; ch < 2; ++ch) {
          const int kl = jj * 64 + c0 + 16 * ch + qi;
          const int sw = (kl >> 1) & 7;
          const bf16x8 kf0 = *(const bf16x8*)(Kb + kl * 128 + (((0 + g) ^ sw) << 4));
          const bf16x8 kf1 = *(const bf16x8*)(Kb + kl * 128 + (((4 + g) ^ sw) << 4));
          f32x4 a = {0.f, 0.f, 0.f, 0.f};
          a = __builtin_amdgcn_mfma_f32_16x16x32_bf16(kf0, qf0, a, 0, 0, 0);
          a = __builtin_amdgcn_mfma_f32_16x16x32_bf16(kf1, qf1, a, 0, 0, 0);
          s[jh * 4 + jj][ch] = a;
        }
      if (jh == 0) {
        __syncthreads();
#pragma unroll
        for (int i = 0; i < 8; ++i) *(u32x4*)(Kb + ksoff + i * 4096) = st2[i];
#pragma unroll
        for (int i = 0; i < 8; ++i) st2[i] = *(const u32x4*)(vg + (size_t)(8 * i) * 4096 + 256);
        __syncthreads();
      }
    }
#pragma unroll
    for (int i = 0; i < 8; ++i) *(u32x4*)(Vb + vsoff + i * 8 * 528) = st[i];
    float mx = -1e30f;
#pragma unroll
    for (int j = 0; j < 8; ++j)
#pragma unroll
      for (int ch = 0; ch < 2; ++ch)
#pragma unroll
        for (int rg = 0; rg < 4; ++rg) {
          const int kc = c0 + 16 * ch + 4 * g + rg;
          const bool valid = (kc >= cs) && (kc < cs + 16);
          const int bidx = valid ? ((rs + j - r + 7) * 31 + (kc - cq) + 15) : 0;
          const float v = valid ? (s[j][ch][rg] + sbias[bidx]) : -1e30f;
          s[j][ch][rg] = v;
          mx = fmaxf(mx, v);
        }
    mx = fmaxf(mx, __shfl_xor(mx, 16)); mx = fmaxf(mx, __shfl_xor(mx, 32));
    float sum = 0.f;
#pragma unroll
    for (int j = 0; j < 8; ++j)
#pragma unroll
      for (int ch = 0; ch < 2; ++ch)
#pragma unroll
        for (int rg = 0; rg < 4; ++rg) { const float e = __expf(s[j][ch][rg] - mx); s[j][ch][rg] = e; sum += e; }
    sum += __shfl_xor(sum, 16); sum += __shfl_xor(sum, 32);
    const float inv = 1.0f / sum;
    bf16x8 pf[8];
#pragma unroll
    for (int j = 0; j < 8; ++j) {
      u32x4 pw;
      pw.x = cvt_pk_bf16(s[j][0][0], s[j][0][1]); pw.y = cvt_pk_bf16(s[j][0][2], s[j][0][3]);
      pw.z = cvt_pk_bf16(s[j][1][0], s[j][1][1]); pw.w = cvt_pk_bf16(s[j][1][2], s[j][1][3]);
      pf[j] = __builtin_bit_cast(bf16x8, pw);
    }
    f32x4 o[4];
#pragma unroll
    for (int dt = 0; dt < 4; ++dt) o[dt] = (f32x4){0.f, 0.f, 0.f, 0.f};
    const int itn = it + nblk;
    __syncthreads();
#pragma unroll
    for (int jh = 0; jh < 2; ++jh) {
#pragma unroll
      for (int jj = 0; jj < 4; ++jj)
#pragma unroll
        for (int dt = 0; dt < 4; ++dt) {
          const unsigned char* vp = Vb + (dt * 16 + qi) * 528 + (jj * 64 + c0 + 4 * g) * 2;
          const u32x2 lo = *(const u32x2*)vp, hi = *(const u32x2*)(vp + 32);
          u32x4 vw; vw.x = lo.x; vw.y = lo.y; vw.z = hi.x; vw.w = hi.y;
          o[dt] = __builtin_amdgcn_mfma_f32_16x16x32_bf16(__builtin_bit_cast(bf16x8, vw), pf[jh * 4 + jj], o[dt], 0, 0, 0);
        }
      if (jh == 0) {
        __syncthreads();
#pragma unroll
        for (int i = 0; i < 8; ++i) *(u32x4*)(Vb + vsoff + i * 8 * 528) = st2[i];
        if (itn < 2048) ATT_ISSUE_K(itn);
        __syncthreads();
      }
    }
    float sq = 0.f;
#pragma unroll
    for (int dt = 0; dt < 4; ++dt) {
      o[dt] *= inv;
      sq += o[dt][0] * o[dt][0] + o[dt][1] * o[dt][1] + o[dt][2] * o[dt][2] + o[dt][3] * o[dt][3];
      store_bf16x4(p.mixed + tokq * 1024 + h * 64 + dt * 16 + 4 * g, o[dt][0], o[dt][1], o[dt][2], o[dt][3]);
    }
    sq += __shfl_xor(sq, 16); sq += __shfl_xor(sq, 32);
    if (g == 0) p.ssq[tokq * 16 + h] = sq;
    it = itn;
  }
#undef ATT_ISSUE_K
}

__device__ void sgu_item(const Params& p, int l, int it, unsigned char* smem) {
  const int grp = it & 7, bc = it >> 3, chunk = bc & 31, b = bc >> 5;
  const int tid = otid(), lane = tid & 63, w = tid >> 6, qi = lane & 15, g = lane >> 4;
  const int p0 = 32 * w;
  const int wbase = __builtin_amdgcn_readfirstlane(w) * 1024;
  const int lc = ((tid & 15) ^ ((tid >> 4) & 15)) << 3;
  const bf16_t* wsrc = p.Wsgu + ((size_t)(grp * 128 + (tid >> 4))) * 128 + lc;
  const bf16_t* vsrc = p.vnT + ((size_t)(b * 512 + grp * 64 + (tid >> 4))) * 4096 + chunk * 128 + lc;
  __syncthreads();
#pragma unroll
  for (int i = 0; i < 8; ++i) GLDS16(wsrc + (size_t)(16 * i) * 128, smem + i * 4096 + wbase);
#pragma unroll
  for (int i = 0; i < 4; ++i) GLDS16(vsrc + (size_t)(16 * i) * 4096, smem + 32768 + i * 4096 + wbase);
  asm volatile("s_waitcnt vmcnt(0)" ::: "memory");
  __syncthreads();
  f32x4 acc[2][4];
#pragma unroll
  for (int mt = 0; mt < 2; ++mt)
#pragma unroll
    for (int nt = 0; nt < 4; ++nt) acc[mt][nt] = (f32x4){0.f, 0.f, 0.f, 0.f};
#pragma unroll
  for (int ks = 0; ks < 4; ++ks) {
    const int co = ((ks * 4 + g) ^ qi) << 4;
    bf16x8 wf[2], vf[4];
#pragma unroll
    for (int mt = 0; mt < 2; ++mt) wf[mt] = *(const bf16x8*)(smem + (p0 + 16 * mt + qi) * 256 + co);
#pragma unroll
    for (int nt = 0; nt < 4; ++nt) vf[nt] = *(const bf16x8*)(smem + 32768 + (16 * nt + qi) * 256 + co);
#pragma unroll
    for (int mt = 0; mt < 2; ++mt)
#pragma unroll
      for (int nt = 0; nt < 4; ++nt) acc[mt][nt] = __builtin_amdgcn_mfma_f32_16x16x32_bf16(vf[nt], wf[mt], acc[mt][nt], 0, 0, 0);
  }
#pragma unroll
  for (int mt = 0; mt < 2; ++mt) {
    const int pp = p0 + 16 * mt + qi;
    const size_t tok = (size_t)b * 4096 + chunk * 128 + pp;
    const float bias = p.sgu_b[(size_t)(l * 8 + grp) * 128 + pp];
    float sq = 0.f;
#pragma unroll
    for (int nt = 0; nt < 4; ++nt) {
      const int d = 16 * nt + 4 * g;
      const u32x2 uu = *(const u32x2*)(p.ub + tok * 512 + grp * 64 + d);
      const float u0 = __uint_as_float(uu.x << 16), u1 = __uint_as_float(uu.x & 0xffff0000u);
      const float u2 = __uint_as_float(uu.y << 16), u3 = __uint_as_float(uu.y & 0xffff0000u);
      const float v0 = u0 * (acc[mt][nt][0] + bias), v1 = u1 * (acc[mt][nt][1] + bias);
      const float v2 = u2 * (acc[mt][nt][2] + bias), v3 = u3 * (acc[mt][nt][3] + bias);
      sq += v0 * v0 + v1 * v1 + v2 * v2 + v3 * v3;
      store_bf16x4(p.mixed + tok * 1024 + 512 + grp * 64 + d, v0, v1, v2, v3);
    }
    sq += __shfl_xor(sq, 16); sq += __shfl_xor(sq, 32);
    if (g == 0) p.ssq[tok * 16 + 8 + grp] = sq;
  }
}

__device__ void p3_tile(const Params& p, int l, int t, unsigned char* smem) {
  const int x_ = t & 7, j_ = t >> 3, rd_ = j_ >> 6, lb_ = j_ & 63;
  const int mt = x_ * 16 + rd_ * 8 + (lb_ & 7), nt = lb_ >> 3;
  const int tid = otid(), lane = tid & 63, wid = tid >> 6, wr = wid >> 1, wc = wid & 1;
  const int srow = tid >> 3, sch = tid & 7, qi = lane & 15, g = lane >> 4;
  const bf16_t* A = p.mixed + (size_t)(mt * 128 + srow) * 1024 + sch * 8;
  const bf16_t* B = p.Wt_out + (size_t)(nt * 128 + srow) * 1024 + sch * 8;
  MidScale mid; float rss[4];
#pragma unroll
  for (int i = 0; i < 4; ++i) {
    const int m = mt * 128 + wr * 64 + i * 16 + qi;
    const float4 a0 = *(const float4*)(p.ssq + (size_t)m * 16), a1 = *(const float4*)(p.ssq + (size_t)m * 16 + 4);
    const float4 b0 = *(const float4*)(p.ssq + (size_t)m * 16 + 8), b1 = *(const float4*)(p.ssq + (size_t)m * 16 + 12);
    const float sa = (a0.x + a0.y + a0.z + a0.w) + (a1.x + a1.y + a1.z + a1.w);
    const float sb = (b0.x + b0.y + b0.z + b0.w) + (b1.x + b1.y + b1.z + b1.w);
    const float ra = rsqrtf(sa * (1.0f / 512.0f) + LN_EPS), rb = rsqrtf(sb * (1.0f / 512.0f) + LN_EPS);
    mid.s[i] = ra / rb; rss[i] = rb;
  }
  f32x4 acc[4][4];
  ZERO_ACC(acc);
  gemm_main(smem, A, A + 32 * 1024, A + 64 * 1024, A + 96 * 1024, B, B + 32 * 1024, B + 64 * 1024, B + 96 * 1024, 16, 8, false, acc, mid);
#pragma unroll
  for (int i = 0; i < 4; ++i) {
    const int m = mt * 128 + wr * 64 + i * 16 + qi;
#pragma unroll
    for (int j = 0; j < 4; ++j) {
      const int n = nt * 128 + wc * 64 + j * 16 + 4 * g;
      const u32x2 xr = *(const u32x2*)(p.xb + (size_t)m * 1024 + n);
      const float o0 = ALPHA * __uint_as_float(xr.x << 16) + acc[i][j][0] * rss[i];
      const float o1 = ALPHA * __uint_as_float(xr.x & 0xffff0000u) + acc[i][j][1] * rss[i];
      const float o2 = ALPHA * __uint_as_float(xr.y << 16) + acc[i][j][2] * rss[i];
      const float o3 = ALPHA * __uint_as_float(xr.y & 0xffff0000u) + acc[i][j][3] * rss[i];
      store_bf16x4(p.hb + (size_t)m * 1024 + n, o0, o1, o2, o3);
    }
  }
}

__device__ void p4_batch(const Params& p, int l, int batch, unsigned char* smem) {
  const int tid = otid(), lane = tid & 63, w = tid >> 6;
  int* scnt = (int*)smem;
  int* sbase = scnt + 16;
  __syncthreads();
  if (tid < 16) scnt[tid] = 0;
  __syncthreads();
  const int tokw = batch * 32 + w * 8;
  {
    float4 gm[4], bt[4];
#pragma unroll
    for (int q = 0; q < 4; ++q) {
      gm[q] = *(const float4*)(p.ln1_g + l * 1024 + q * 256 + lane * 4);
      bt[q] = *(const float4*)(p.ln1_b + l * 1024 + q * 256 + lane * 4);
    }
#pragma unroll 4
    for (int t = 0; t < 8; ++t) {
      float* xr = p.x1 + (size_t)(tokw + t) * 1024 + lane * 4;
      const bf16_t* hr = p.hb + (size_t)(tokw + t) * 1024 + lane * 4;
      float4 v[4];
#pragma unroll
      for (int q = 0; q < 4; ++q) {
        const u32x2 hh = *(const u32x2*)(hr + q * 256);
        v[q].x = __uint_as_float(hh.x << 16); v[q].y = __uint_as_float(hh.x & 0xffff0000u);
        v[q].z = __uint_as_float(hh.y << 16); v[q].w = __uint_as_float(hh.y & 0xffff0000u);
      }
      float s1 = 0.f;
#pragma unroll
      for (int q = 0; q < 4; ++q) s1 += (v[q].x + v[q].y) + (v[q].z + v[q].w);
      const float mu = wave_sum(s1) * (1.0f / 1024.0f);
      float s2 = 0.f;
#pragma unroll
      for (int q = 0; q < 4; ++q) {
        const float d0 = v[q].x - mu, d1 = v[q].y - mu, d2 = v[q].z - mu, d3 = v[q].w - mu;
        s2 += (d0 * d0 + d1 * d1) + (d2 * d2 + d3 * d3);
      }
      const float rstd = rsqrtf(wave_sum(s2) * (1.0f / 1024.0f) + LN_EPS);
#pragma unroll
      for (int q = 0; q < 4; ++q) {
        float4 o;
        o.x = (v[q].x - mu) * rstd * gm[q].x + bt[q].x; o.y = (v[q].y - mu) * rstd * gm[q].y + bt[q].y;
        o.z = (v[q].z - mu) * rstd * gm[q].z + bt[q].z; o.w = (v[q].w - mu) * rstd * gm[q].w + bt[q].w;
        *(float4*)(xr + q * 256) = o;
        store_bf16x4(p.xb + (size_t)(tokw + t) * 1024 + q * 256 + lane * 4, o.x, o.y, o.z, o.w);
      }
    }
  }
  asm volatile("s_waitcnt vmcnt(0)" ::: "memory");
  __syncthreads();
  const int j = lane & 15, g = lane >> 4;
  float* part = (float*)(smem + 1024);
  {
    const float* xr0 = p.x1 + (size_t)(batch * 32 + j) * 1024 + 256 * w + 8 * g;
    const float* xr1 = xr0 + 16 * 1024;
    const size_t wof = ((size_t)(8 * w * 4 + g) * 16 + j) * 8;
    f32x4 De0 = {0.f, 0.f, 0.f, 0.f}, Dg0 = De0, De1 = De0, Dg1 = De0;
#pragma unroll 2
    for (int kb = 0; kb < 8; ++kb) {
      const float4 xa0 = *(const float4*)(xr0 + kb * 32), xc0 = *(const float4*)(xr0 + kb * 32 + 4);
      const float4 xa1 = *(const float4*)(xr1 + kb * 32), xc1 = *(const float4*)(xr1 + kb * 32 + 4);
      const bf16x8 weh = *(const bf16x8*)(p.Wr_eh + wof + kb * 512), wel = *(const bf16x8*)(p.Wr_el + wof + kb * 512);
      const bf16x8 wgh = *(const bf16x8*)(p.Wr_gh + wof + kb * 512), wgl = *(const bf16x8*)(p.Wr_gl + wof + kb * 512);
      u32x4 h, lo;
      h.x = cvt_pk_bf16(xa0.x, xa0.y); h.y = cvt_pk_bf16(xa0.z, xa0.w); h.z = cvt_pk_bf16(xc0.x, xc0.y); h.w = cvt_pk_bf16(xc0.z, xc0.w);
      lo.x = cvt_pk_bf16(xa0.x - __uint_as_float(h.x << 16), xa0.y - __uint_as_float(h.x & 0xffff0000u));
      lo.y = cvt_pk_bf16(xa0.z - __uint_as_float(h.y << 16), xa0.w - __uint_as_float(h.y & 0xffff0000u));
      lo.z = cvt_pk_bf16(xc0.x - __uint_as_float(h.z << 16), xc0.y - __uint_as_float(h.z & 0xffff0000u));
      lo.w = cvt_pk_bf16(xc0.z - __uint_as_float(h.w << 16), xc0.w - __uint_as_float(h.w & 0xffff0000u));
      bf16x8 xh = __builtin_bit_cast(bf16x8, h), xl = __builtin_bit_cast(bf16x8, lo);
      De0 = __builtin_amdgcn_mfma_f32_16x16x32_bf16(weh, xh, De0, 0, 0, 0);
      Dg0 = __builtin_amdgcn_mfma_f32_16x16x32_bf16(wgh, xh, Dg0, 0, 0, 0);
      De0 = __builtin_amdgcn_mfma_f32_16x16x32_bf16(weh, xl, De0, 0, 0, 0);
      Dg0 = __builtin_amdgcn_mfma_f32_16x16x32_bf16(wgh, xl, Dg0, 0, 0, 0);
      De0 = __builtin_amdgcn_mfma_f32_16x16x32_bf16(wel, xh, De0, 0, 0, 0);
      Dg0 = __builtin_amdgcn_mfma_f32_16x16x32_bf16(wgl, xh, Dg0, 0, 0, 0);
      h.x = cvt_pk_bf16(xa1.x, xa1.y); h.y = cvt_pk_bf16(xa1.z, xa1.w); h.z = cvt_pk_bf16(xc1.x, xc1.y); h.w = cvt_pk_bf16(xc1.z, xc1.w);
      lo.x = cvt_pk_bf16(xa1.x - __uint_as_float(h.x << 16), xa1.y - __uint_as_float(h.x & 0xffff0000u));
      lo.y = cvt_pk_bf16(xa1.z - __uint_as_float(h.y << 16), xa1.w - __uint_as_float(h.y & 0xffff0000u));
      lo.z = cvt_pk_bf16(xc1.x - __uint_as_float(h.z << 16), xc1.y - __uint_as_float(h.z & 0xffff0000u));
      lo.w = cvt_pk_bf16(xc1.z - __uint_as_float(h.w << 16), xc1.w - __uint_as_float(h.w & 0xffff0000u));
      xh = __builtin_bit_cast(bf16x8, h); xl = __builtin_bit_cast(bf16x8, lo);
      De1 = __builtin_amdgcn_mfma_f32_16x16x32_bf16(weh, xh, De1, 0, 0, 0);
      Dg1 = __builtin_amdgcn_mfma_f32_16x16x32_bf16(wgh, xh, Dg1, 0, 0, 0);
      De1 = __builtin_amdgcn_mfma_f32_16x16x32_bf16(weh, xl, De1, 0, 0, 0);
      Dg1 = __builtin_amdgcn_mfma_f32_16x16x32_bf16(wgh, xl, Dg1, 0, 0, 0);
      De1 = __builtin_amdgcn_mfma_f32_16x16x32_bf16(wel, xh, De1, 0, 0, 0);
      Dg1 = __builtin_amdgcn_mfma_f32_16x16x32_bf16(wgl, xh, Dg1, 0, 0, 0);
    }
    float* pw = part + ((size_t)(w * 2) * 64 + lane) * 8;
    *(f32x4*)(pw) = De0; *(f32x4*)(pw + 4) = Dg0;
    *(f32x4*)(pw + 512) = De1; *(f32x4*)(pw + 516) = Dg1;
  }
  __syncthreads();
  const int tok = tokw + (j & 7);
  f32x4 De = {0.f, 0.f, 0.f, 0.f}, Dg = {0.f, 0.f, 0.f, 0.f};
  {
    const int ln = g * 16 + (w & 1) * 8 + (j & 7), tl = w >> 1;
#pragma unroll
    for (int ww = 0; ww < 4; ++ww) {
      const float* pr = part + ((size_t)(ww * 2 + tl) * 64 + ln) * 8;
      De += *(const f32x4*)(pr); Dg += *(const f32x4*)(pr + 4);
    }
  }
  float gl[4];
#pragma unroll
  for (int k = 0; k < 4; ++k) gl[k] = __shfl(Dg[k], j) + p.rg_b[l * 4 + k];
  int gs = 0; float gmax = gl[0];
#pragma unroll
  for (int k = 1; k < 4; ++k) { const bool bb = gl[k] > gmax; gmax = bb ? gl[k] : gmax; gs = bb ? k : gs; }
  float psum = 0.f;
#pragma unroll
  for (int k = 0; k < 4; ++k) psum += __expf(gl[k] - gmax);
  const float gate = 1.0f / psum;
  float es[4];
#pragma unroll
  for (int k = 0; k < 4; ++k) es[k] = De[k] + p.re_b[l * 16 + 4 * g + k];
  int i0 = 0; float v0 = es[0];
#pragma unroll
  for (int k = 1; k < 4; ++k) { const bool bb = es[k] > v0; v0 = bb ? es[k] : v0; i0 = bb ? k : i0; }
  int i1 = 0; float v1 = -3.0e38f;
#pragma unroll
  for (int k = 0; k < 4; ++k) { const bool bb = (k != i0) && (es[k] > v1); v1 = bb ? es[k] : v1; i1 = bb ? k : i1; }
  const float ex = __expf(v1 - v0);
  const float tw0 = 1.0f / (1.0f + ex), tw1 = ex / (1.0f + ex);
  const bool commit = (g == gs) && (j < 8);
  const int e0 = gs * 4 + i0, e1 = gs * 4 + i1;
  int lp0 = 0, lp1 = 0;
  if (commit) { lp0 = atomicAdd(&scnt[e0], 1); lp1 = atomicAdd(&scnt[e1], 1); }
  __syncthreads();
  if (tid < 16) sbase[tid] = atomicAdd(p.counts + l * 16 + tid, scnt[tid]);
  __syncthreads();
  if (commit) {
    const int pos0 = sbase[e0] + lp0, pos1 = sbase[e1] + lp1;
    p.list[e0 * NTOK + pos0] = tok; p.wlist[e0 * NTOK + pos0] = gate * tw0;
    p.list[e1 * NTOK + pos1] = tok; p.wlist[e1 * NTOK + pos1] = gate * tw1;
    int4 ti; ti.x = e0; ti.y = pos0; ti.z = e1; ti.w = pos1;
    *(int4*)(p.tokinfo + (size_t)tok * 4) = ti;
  }
}

__device__ __forceinline__ int moe_total_mtiles(const int* cnts) {
  int tot = 0;
#pragma unroll
  for (int e = 0; e < 16; ++e) tot += (cnts[e] + 127) >> 7;
  return tot;
}
__device__ __forceinline__ void moe_find(const int* cnts, int mi, int& e_out, int& ml, int& off, int& cnt) {
  int rem = mi, o = 0; e_out = 0; ml = 0; off = 0; cnt = 1;
  bool found = false;
#pragma unroll
  for (int e = 0; e < 16; ++e) {
    const int c = cnts[e], mtl = (c + 127) >> 7;
    if (!found && rem < mtl) { found = true; e_out = e; ml = rem; off = o; cnt = c; }
    rem -= mtl; o += c;
  }
}

__device__ void p5_tile(const Params& p, int l, int t, int mtot, unsigned char* smem) {
  const int mi = (t >> 5) * 8 + (t & 7), nt = (t >> 3) & 3;
  if (mi >= mtot) return;
  int e, ml, off, cnt;
  moe_find(p.counts + l * 16, mi, e, ml, off, cnt);
  const int tid = otid(), lane = tid & 63, wid = tid >> 6, wr = wid >> 1, wc = wid & 1;
  const int srow = tid >> 3, sch = tid & 7, qi = lane & 15, g = lane >> 4;
  const bf16_t* pa[4];
#pragma unroll
  for (int i = 0; i < 4; ++i) {
    const int ridx = min(ml * 128 + srow + 32 * i, cnt - 1);
    const int tok = p.list[e * NTOK + ridx];
    pa[i] = p.xb + (size_t)tok * 1024 + sch * 8;
  }
  const bf16_t* B = p.Wgu + ((size_t)e * 512 + nt * 128 + srow) * 1024 + sch * 8;
  f32x4 acc[4][4];
  ZERO_ACC(acc);
  gemm_main(smem, pa[0], pa[1], pa[2], pa[3], B, B + 32 * 1024, B + 64 * 1024, B + 96 * 1024, 16, -1, false, acc, NoMid());
#pragma unroll
  for (int i = 0; i < 4; ++i) {
    const int rloc = ml * 128 + wr * 64 + i * 16 + qi;
    if (rloc < cnt) {
      const size_t slot = (size_t)off + rloc;
#pragma unroll
      for (int jp = 0; jp < 2; ++jp) {
        const f32x4 ga = acc[i][2 * jp], up = acc[i][2 * jp + 1];
        const int col = 64 * nt + 32 * wc + 16 * jp + 4 * g;
        store_bf16x4(p.act + slot * 256 + col, silu(ga[0]) * up[0], silu(ga[1]) * up[1], silu(ga[2]) * up[2], silu(ga[3]) * up[3]);
      }
    }
  }
}

struct P6Tile { int e, ml, off, cnt, nt; const bf16_t* pa0; const bf16_t* pa1; const bf16_t* pa2; const bf16_t* pa3; const bf16_t* B; };
__device__ __forceinline__ int p6_next(int t, int ntot, int mtot, int nblk) {
  while (t < ntot && ((t >> 6) * 8 + (t & 7)) >= mtot) t += nblk;
  return t;
}
__device__ __forceinline__ void p6_setup(const Params& p, int l, int t, P6Tile& T) {
  const int mi = (t >> 6) * 8 + (t & 7);
  T.nt = (t >> 3) & 7;
  moe_find(p.counts + l * 16, mi, T.e, T.ml, T.off, T.cnt);
  const int tid = otid(), srow = tid >> 3, sch = tid & 7;
  const bf16_t* base = p.act + (size_t)T.off * 256 + sch * 8;
  T.pa0 = base + (size_t)min(T.ml * 128 + srow, T.cnt - 1) * 256;
  T.pa1 = base + (size_t)min(T.ml * 128 + srow + 32, T.cnt - 1) * 256;
  T.pa2 = base + (size_t)min(T.ml * 128 + srow + 64, T.cnt - 1) * 256;
  T.pa3 = base + (size_t)min(T.ml * 128 + srow + 96, T.cnt - 1) * 256;
  T.B = p.Wdn + ((size_t)T.e * 1024 + T.nt * 128 + srow) * 256 + sch * 8;
}
__device__ void p6_phase(const Params& p, int l, int bid, int nblk, unsigned char* smem) {
  const int mtot = moe_total_mtiles(p.counts + l * 16), ntot = ((mtot + 7) >> 3) * 64;
  P6Tile cur, nxt;
  int t = p6_next(bid, ntot, mtot, nblk);
  if (t < ntot) {
    p6_setup(p, l, t, cur);
    __syncthreads();
    gemm_issue0(smem, cur.pa0, cur.pa1, cur.pa2, cur.pa3, cur.B, cur.B + 32 * 256, cur.B + 64 * 256, cur.B + 96 * 256);
  }
  while (t < ntot) {
    f32x4 acc[4][4];
    ZERO_ACC(acc);
    gemm_main<true>(smem, cur.pa0, cur.pa1, cur.pa2, cur.pa3, cur.B, cur.B + 32 * 256, cur.B + 64 * 256, cur.B + 96 * 256, 4, -1, false, acc, NoMid());
    const int tn = p6_next(t + nblk, ntot, mtot, nblk);
    nxt = cur;
    if (tn < ntot) {
      p6_setup(p, l, tn, nxt);
      gemm_issue0(smem, nxt.pa0, nxt.pa1, nxt.pa2, nxt.pa3, nxt.B, nxt.B + 32 * 256, nxt.B + 64 * 256, nxt.B + 96 * 256);
    }
    {
      const int tid = otid(), lane = tid & 63, wid = tid >> 6, wr = wid >> 1, wc = wid & 1, qi = lane & 15, g = lane >> 4;
#pragma unroll
      for (int i = 0; i < 4; ++i) {
        const int rloc = cur.ml * 128 + wr * 64 + i * 16 + qi;
        if (rloc < cur.cnt) {
          const float wgt = p.wlist[cur.e * NTOK + rloc];
          const size_t slot = (size_t)cur.off + rloc;
#pragma unroll
          for (int j = 0; j < 4; ++j) {
            const int n = cur.nt * 128 + wc * 64 + j * 16 + 4 * g;
            store_bf16x4(p.y + slot * 1024 + n, acc[i][j][0] * wgt, acc[i][j][1] * wgt, acc[i][j][2] * wgt, acc[i][j][3] * wgt);
          }
        }
      }
    }
    cur = nxt; t = tn;
  }
}

template <int NT>
__device__ __forceinline__ void p7_tokens(const Params& p, int l, int tok0, int tstride) {
  const int lane = otid() & 63;
  int4 ti[NT];
#pragma unroll
  for (int u = 0; u < NT; ++u) ti[u] = *(const int4*)(p.tokinfo + (size_t)(tok0 + u * tstride) * 4);
  int off0[NT], off1[NT];
#pragma unroll
  for (int u = 0; u < NT; ++u) { off0[u] = 0; off1[u] = 0; }
#pragma unroll
  for (int e = 0; e < 16; ++e) {
    const int c = p.counts[l * 16 + e];
#pragma unroll
    for (int u = 0; u < NT; ++u) { if (e < ti[u].x) off0[u] += c; if (e < ti[u].z) off1[u] += c; }
  }
  float4 xr[NT][4]; u32x2 ya[NT][4], yb[NT][4];
#pragma unroll
  for (int u = 0; u < NT; ++u) {
    const int tok = tok0 + u * tstride;
    const size_t s0 = (size_t)off0[u] + ti[u].y, s1 = (size_t)off1[u] + ti[u].w;
#pragma unroll
    for (int q = 0; q < 4; ++q) {
      const int c = q * 256 + lane * 4;
      xr[u][q] = *(const float4*)(p.x1 + (size_t)tok * 1024 + c);
      ya[u][q] = *(const u32x2*)(p.y + s0 * 1024 + c);
      yb[u][q] = *(const u32x2*)(p.y + s1 * 1024 + c);
    }
  }
  float4 gg[4], bb[4];
#pragma unroll
  for (int q = 0; q < 4; ++q) {
    gg[q] = *(const float4*)(p.ln2_g + l * 1024 + q * 256 + lane * 4);
    bb[q] = *(const float4*)(p.ln2_b + l * 1024 + q * 256 + lane * 4);
  }
#pragma unroll
  for (int u = 0; u < NT; ++u) {
    const int tok = tok0 + u * tstride;
    float hv[16];
#pragma unroll
    for (int q = 0; q < 4; ++q) {
      hv[q * 4 + 0] = ALPHA * xr[u][q].x + (__uint_as_float(ya[u][q].x << 16) + __uint_as_float(yb[u][q].x << 16));
      hv[q * 4 + 1] = ALPHA * xr[u][q].y + (__uint_as_float(ya[u][q].x & 0xffff0000u) + __uint_as_float(yb[u][q].x & 0xffff0000u));
      hv[q * 4 + 2] = ALPHA * xr[u][q].z + (__uint_as_float(ya[u][q].y << 16) + __uint_as_float(yb[u][q].y << 16));
      hv[q * 4 + 3] = ALPHA * xr[u][q].w + (__uint_as_float(ya[u][q].y & 0xffff0000u) + __uint_as_float(yb[u][q].y & 0xffff0000u));
    }
    float s1s = 0.f;
#pragma unroll
    for (int c = 0; c < 16; ++c) s1s += hv[c];
    const float mu = wave_sum(s1s) * (1.0f / 1024.0f);
    float s2 = 0.f;
#pragma unroll
    for (int c = 0; c < 16; ++c) { const float d = hv[c] - mu; s2 += d * d; }
    const float rstd = rsqrtf(wave_sum(s2) * (1.0f / 1024.0f) + LN_EPS);
#pragma unroll
    for (int q = 0; q < 4; ++q) {
      const int c = q * 256 + lane * 4;
      float4 o;
      o.x = (hv[q * 4 + 0] - mu) * rstd * gg[q].x + bb[q].x; o.y = (hv[q * 4 + 1] - mu) * rstd * gg[q].y + bb[q].y;
      o.z = (hv[q * 4 + 2] - mu) * rstd * gg[q].z + bb[q].z; o.w = (hv[q * 4 + 3] - mu) * rstd * gg[q].w + bb[q].w;
      if (l == 3) *(float4*)(p.out + (size_t)tok * 1024 + c) = o;
      else store_bf16x4(p.xb + (size_t)tok * 1024 + c, o.x, o.y, o.z, o.w);
    }
  }
}

#define XB_TMO      128
#define XB_XCNT(j)  (256  + 64 * (j))
#define XB_XSUB(j)  (1280 + 64 * (j))
#define XB_XGEN(j)  (2304 + 64 * (j))
#define XB_TOP      3328
#define XB_TOPGEN   3392
#define XCD_BAR_WORDS 3456
#define XB_SPIN_CAP (1u << 22)
__device__ __forceinline__ unsigned xb_ld(unsigned* p) { return __hip_atomic_load(p, __ATOMIC_RELAXED, __HIP_MEMORY_SCOPE_AGENT); }
__device__ __forceinline__ unsigned xb_add(unsigned* p, unsigned v) { return __hip_atomic_fetch_add(p, v, __ATOMIC_RELAXED, __HIP_MEMORY_SCOPE_AGENT); }
__device__ __forceinline__ unsigned xb_xcc_id() { return (unsigned)__builtin_amdgcn_s_getreg((3 << 11) | 20) & 0xFu; }
#define XB_SPIN(cond, bar) do { unsigned _sp = 0; while (cond) { __builtin_amdgcn_s_sleep(1); \
    if ((++_sp & 255u) == 0u) { if (xb_ld(&(bar)[XB_TMO])) break; if (_sp > XB_SPIN_CAP) { atomicAdd(&(bar)[XB_TMO], 1u); break; } } } } while (0)
struct XcdBarrier { unsigned* bar; unsigned x; volatile unsigned* st; };
__device__ __forceinline__ XcdBarrier xcd_barrier_post(unsigned* bar, volatile unsigned* st) {
  XcdBarrier b; b.bar = bar; b.x = xb_xcc_id(); b.st = st;
  if (threadIdx.x == 0) (void)xb_add(&bar[XB_XCNT(b.x)], 1u);
  return b;
}
__device__ __forceinline__ void xcd_barrier_complete(unsigned* bar, unsigned x, unsigned& nloc, unsigned& nx) {
  const unsigned G = gridDim.x;
  unsigned sum, cnt, mine, sp = 0u;
  for (;;) {
    sum = 0u; cnt = 0u; mine = 0u;
#pragma unroll
    for (unsigned j = 0; j < 16; ++j) { const unsigned c = xb_ld(&bar[XB_XCNT(j)]); sum += c; cnt += (c > 0u) ? 1u : 0u; mine = (j == x) ? c : mine; }
    if (sum == G) break;
    __builtin_amdgcn_s_sleep(1);
    if ((++sp & 255u) == 0u) { if (xb_ld(&bar[XB_TMO])) break; if (sp > XB_SPIN_CAP) { atomicAdd(&bar[XB_TMO], 1u); break; } }
  }
  nloc = mine > 0u ? mine : 1u; nx = cnt > 0u ? cnt : 1u;
}
__device__ __forceinline__ void xcd_barrier(const XcdBarrier& b) {
  asm volatile("s_waitcnt vmcnt(0)" ::: "memory");
  __syncthreads();
  if (threadIdx.x == 0) {
    unsigned* bar = b.bar;
    __builtin_amdgcn_s_waitcnt(0);
    unsigned nloc = b.st[0], nx = b.st[1];
    if (nloc == 0u) { xcd_barrier_complete(bar, b.x, nloc, nx); b.st[0] = nloc; b.st[1] = nx; }
    const unsigned old = xb_add(&bar[XB_XSUB(b.x)], 1u);
    const unsigned gen = old / nloc;
    if (old + 1u == (gen + 1u) * nloc) {
      __builtin_amdgcn_fence(__ATOMIC_RELEASE, "agent");
      asm volatile("s_waitcnt vmcnt(0)" ::: "memory");
      const unsigned og = xb_add(&bar[XB_TOP], 1u);
      const unsigned tg = og / nx;
      if (og + 1u == (tg + 1u) * nx) xb_add(&bar[XB_TOPGEN], 1u);
      else XB_SPIN(xb_ld(&bar[XB_TOPGEN]) == tg, bar);
      __builtin_amdgcn_fence(__ATOMIC_ACQUIRE, "agent");
      xb_add(&bar[XB_XGEN(b.x)], 1u);
      asm volatile("s_waitcnt vmcnt(0)" ::: "memory");
    } else {
      XB_SPIN(xb_ld(&bar[XB_XGEN(b.x)]) == gen, bar);
      __builtin_amdgcn_fence(__ATOMIC_ACQUIRE, "agent");
      asm volatile("s_waitcnt vmcnt(0)" ::: "memory");
    }
  }
  __syncthreads();
}

__device__ __forceinline__ void run_phase(const Params& p, int ph, int l, int bid, int nblk, unsigned char* smem, float* sbias) {
  switch (ph) {
    case 0: {
      if (bid == 0 && threadIdx.x < 64) p.counts[threadIdx.x] = 0;
      conv_x(p, bid, nblk);
      for (int it = bid; it < NCONV_ITEMS; it += nblk) conv_item(p, 0, it, smem);
    } break;
    case 1: p1_phase(p, l, bid, nblk, smem); break;
    case 2:
      attn_phase(p, l, bid, nblk, smem);
      for (int it = bid; it < 1024; it += nblk) sgu_item(p, l, it, smem);
      break;
    case 3: for (int t = bid; t < 1024; t += nblk) p3_tile(p, l, t, smem); break;
    case 4: for (int it = bid; it < NTOK / 32; it += nblk) p4_batch(p, l, it, smem); break;
    case 5: { const int mtot = moe_total_mtiles(p.counts + l * 16), nt = ((mtot + 7) >> 3) * 32; for (int t = bid; t < nt; t += nblk) p5_tile(p, l, t, mtot, smem); } break;
    case 6: p6_phase(p, l, bid, nblk, smem); break;
    case 7: {
      { const int nw = nblk * 4; int tok = bid * 4 + (threadIdx.x >> 6);
        for (; tok + 3 * nw < NTOK; tok += 4 * nw) p7_tokens<4>(p, l, tok, nw);
        for (; tok < NTOK; tok += nw) p7_tokens<1>(p, l, tok, nw); }
      if (l < 3) for (int it = bid; it < NCONV_ITEMS; it += nblk) conv_item(p, l + 1, it, smem);
    } break;
  }
}

template <int PH>
__global__ void __launch_bounds__(256, 2) phase_kernel(Params p, int l) {
  __shared__ __attribute__((aligned(16))) unsigned char smem[SMEM_BYTES];
  run_phase(p, PH, l, blockIdx.x, gridDim.x, smem, (float*)smem);
}

#if MEGA
__global__ void __launch_bounds__(256, 2) mega_kernel(Params p) {
  __shared__ __attribute__((aligned(16))) unsigned char smem[SMEM_BYTES];
  __shared__ uint4 xb_words;
  float* sbias = (float*)smem;
  cg::grid_group grid = cg::this_grid();
  const int bid = blockIdx.x, nblk = gridDim.x;
  if (threadIdx.x == 0) xb_words = make_uint4(0u, 0u, 0u, 0u);
  __syncthreads();
  XcdBarrier xb = xcd_barrier_post(p.bar, (volatile unsigned*)&xb_words);
  run_phase(p, 0, 0, bid, nblk, smem, sbias);
  if (p.never) grid.sync();
  xcd_barrier(xb);
#pragma unroll 1
  for (int l = 0; l < 4; ++l) {
#pragma unroll 1
    for (int ph = 1; ph <= 7; ++ph) {
      run_phase(p, ph, l, bid, nblk, smem, sbias);
#if DUP_PH
      if (ph == DUP_PH) { xcd_barrier(xb); run_phase(p, ph, l, bid, nblk, smem, sbias); }
#endif
      if (!(l == 3 && ph == 7)) xcd_barrier(xb);
    }
  }
}
#endif

extern "C" void kernel_launch(void* const* d_in, const int* in_sizes, int n_in, void* d_out, int out_size, void* d_ws,
                              size_t ws_size, hipStream_t stream) {
  Params p{};
  p.x = (const float*)d_in[0]; p.w_in = (const float*)d_in[1]; p.w_out = (const float*)d_in[2]; p.rel_bias = (const float*)d_in[3];
  p.sgu_ln_g = (const float*)d_in[4]; p.sgu_ln_b = (const float*)d_in[5]; p.sgu_w = (const float*)d_in[6]; p.sgu_b = (const float*)d_in[7];
  p.mix_g = (const float*)d_in[8]; p.ln1_g = (const float*)d_in[9]; p.ln1_b = (const float*)d_in[10];
  p.rg_w = (const float*)d_in[11]; p.rg_b = (const float*)d_in[12]; p.re_w = (const float*)d_in[13]; p.re_b = (const float*)d_in[14];
  p.w_gate = (const float*)d_in[15]; p.w_up = (const float*)d_in[16]; p.w_down = (const float*)d_in[17];
  p.ln2_g = (const float*)d_in[18]; p.ln2_b = (const float*)d_in[19];
  p.out = (float*)d_out;
  unsigned char* w = (unsigned char*)d_ws;
  size_t o = 0;
  auto take = [&](size_t bytes) { unsigned char* r = w + o; o += (bytes + 255) & ~(size_t)255; return r; };
  p.Wt_in = (bf16_t*)take((size_t)2560 * 1024 * 2);
  p.Wt_out = (bf16_t*)take((size_t)1024 * 1024 * 2);
  p.Wgu = (bf16_t*)take((size_t)16 * 512 * 1024 * 2);
  p.Wdn = (bf16_t*)take((size_t)16 * 1024 * 256 * 2);
  p.Wsgu = (bf16_t*)take((size_t)8 * 128 * 128 * 2);
  p.xb = (bf16_t*)take((size_t)NTOK * 1024 * 2);
  p.x1 = (float*)take((size_t)NTOK * 1024 * 4);
  unsigned char* r1 = take((size_t)NTOK * 2560 * 2);
  p.qk = (bf16_t*)r1;
  p.vT = (bf16_t*)(r1 + (size_t)NTOK * 1024 * 2);
  p.ub = (bf16_t*)(r1 + (size_t)NTOK * 1536 * 2);
  p.vnT = (bf16_t*)(r1 + (size_t)NTOK * 2048 * 2);
  p.y = (bf16_t*)r1;
  p.hb = (bf16_t*)r1;
  unsigned char* r2 = take((size_t)NTOK * 1024 * 2);
  p.mixed = (bf16_t*)r2;
  p.act = (bf16_t*)r2;
  p.ssq = (float*)take((size_t)NTOK * 16 * 4);
  p.wlist = (float*)take((size_t)16 * NTOK * 4);
  p.list = (int*)take((size_t)16 * NTOK * 4);
  p.tokinfo = (int*)take((size_t)NTOK * 4 * 4);
  p.counts = (int*)take(256);
  p.Wr_eh = (bf16_t*)take(16384 * 2); p.Wr_el = (bf16_t*)take(16384 * 2);
  p.Wr_gh = (bf16_t*)take(16384 * 2); p.Wr_gl = (bf16_t*)take(16384 * 2);
  p.bar = (unsigned*)take(XCD_BAR_WORDS * 4);
#if MEGA
  static int grid_blocks = 0;
  if (!grid_blocks) {
    int dev = 0, cus = 0, per_cu = 0;
    hipGetDevice(&dev);
    hipDeviceGetAttribute(&cus, hipDeviceAttributeMultiprocessorCount, dev);
    hipOccupancyMaxActiveBlocksPerMultiprocessor(&per_cu, mega_kernel, 256, 0);
    if (per_cu > 2) per_cu = 2;
    grid_blocks = cus * per_cu;
  }
  (void)hipMemsetAsync(p.bar, 0, XCD_BAR_WORDS * 4, stream);
  void* args[] = {&p};
  hipError_t e = hipLaunchCooperativeKernel((void*)mega_kernel, dim3(grid_blocks), dim3(256), args, 0, stream);
  if (e != hipSuccess) fprintf(stderr, "cooperative launch failed: %s (grid %d)\n", hipGetErrorString(e), grid_blocks);
#else
  const int G = 512;
  phase_kernel<0><<<G, 256, 0, stream>>>(p, 0);
  for (int l = 0; l < 4; ++l) {
    phase_kernel<1><<<G, 256, 0, stream>>>(p, l);
    phase_kernel<2><<<G, 256, 0, stream>>>(p, l);
    phase_kernel<3><<<G, 256, 0, stream>>>(p, l);
    phase_kernel<4><<<G, 256, 0, stream>>>(p, l);
    phase_kernel<5><<<G, 256, 0, stream>>>(p, l);
    phase_kernel<6><<<G, 256, 0, stream>>>(p, l);
    phase_kernel<7><<<G, 256, 0, stream>>>(p, l);
  }
#endif
}
```

```cpp
#include <hip/hip_runtime.h>
#include <hip/hip_cooperative_groups.h>
#include <stdint.h>
#include <cstdio>
namespace cg = cooperative_groups;

#ifndef MEGA
#define MEGA 1
#endif
#define DUP_PH 0

typedef unsigned short bf16_t;
typedef short bf16x8 __attribute__((ext_vector_type(8)));
typedef float f32x4 __attribute__((ext_vector_type(4)));
typedef unsigned u32x4 __attribute__((ext_vector_type(4)));
typedef unsigned u32x2 __attribute__((ext_vector_type(2)));

#define NTOK 16384
#define LN_EPS 1e-5f
#define ALPHA 1.681792830507429f
#define NCONV_ITEMS 1009
#define SMEM_BYTES 69632

struct Params {
  const float *x, *w_in, *w_out, *rel_bias, *sgu_ln_g, *sgu_ln_b, *sgu_w, *sgu_b, *mix_g, *ln1_g, *ln1_b,
      *rg_w, *rg_b, *re_w, *re_b, *w_gate, *w_up, *w_down, *ln2_g, *ln2_b;
  float* out;
  bf16_t *Wt_in, *Wt_out, *Wgu, *Wdn, *Wsgu, *xb, *qk, *vT, *ub, *vnT, *mixed, *act, *y, *hb;
  float *x1, *ssq, *wlist;
  bf16_t *Wr_eh, *Wr_el, *Wr_gh, *Wr_gl;
  int *counts, *list, *tokinfo;
  unsigned* bar;
  int never;
  int pad_;
};

__device__ __forceinline__ unsigned cvt_pk_bf16(float lo, float hi) {
  unsigned r; asm("v_cvt_pk_bf16_f32 %0, %1, %2" : "=v"(r) : "v"(lo), "v"(hi)); return r;
}
__device__ __forceinline__ void store_bf16x4(bf16_t* p, float a, float b, float c, float d) {
  u32x2 v; v.x = cvt_pk_bf16(a, b); v.y = cvt_pk_bf16(c, d); *(u32x2*)p = v;
}
__device__ __forceinline__ float gelu_tanh(float x) {
  const float t = x * (-2.302208198f + -0.102943249f * (x * x));
  return x * __builtin_amdgcn_rcpf(1.0f + __builtin_amdgcn_exp2f(t));
}
__device__ __forceinline__ int otid() { int t = threadIdx.x; asm volatile("" : "+v"(t)); return t; }
__device__ __forceinline__ float silu(float x) { return x * __builtin_amdgcn_rcpf(1.0f + __builtin_amdgcn_exp2f(-1.442695041f * x)); }
template <int CTRL>
__device__ __forceinline__ float dpp_mov(float v) {
  return __builtin_bit_cast(float, __builtin_amdgcn_update_dpp(0, __builtin_bit_cast(int, v), CTRL, 0xf, 0xf, true));
}
__device__ __forceinline__ float row16_sum(float v) {
  v += dpp_mov<0xB1>(v); v += dpp_mov<0x4E>(v); v += dpp_mov<0x141>(v); v += dpp_mov<0x140>(v); return v;
}
__device__ __forceinline__ float wave_sum(float v) {
  v = row16_sum(v); v += __shfl_xor(v, 16); v += __shfl_xor(v, 32); return v;
}

struct NoMid { __device__ __forceinline__ void operator()(f32x4 (&)[4][4]) const {} };
struct MidScale {
  float s[4];
  __device__ __forceinline__ void operator()(f32x4 (&acc)[4][4]) const {
#pragma unroll
    for (int i = 0; i < 4; ++i)
#pragma unroll
      for (int j = 0; j < 4; ++j) acc[i][j] *= s[i];
  }
};

#define GLDS16(gptr, lptr) __builtin_amdgcn_global_load_lds((const unsigned*)(gptr), (__attribute__((address_space(3))) unsigned*)(lptr), 16, 0, 0)

__device__ __forceinline__ void gemm_issue0(unsigned char* smem, const bf16_t* pa0, const bf16_t* pa1, const bf16_t* pa2,
                                            const bf16_t* pa3, const bf16_t* pb0, const bf16_t* pb1, const bf16_t* pb2,
                                            const bf16_t* pb3) {
  const int tid = otid(), wid = tid >> 6, srow = tid >> 3;
  const int lch = ((tid & 7) ^ ((srow >> 1) & 7)) * 8 - (tid & 7) * 8;
  unsigned char* d = smem + __builtin_amdgcn_readfirstlane(wid) * 1024;
  GLDS16(pa0 + lch, d); GLDS16(pa1 + lch, d + 4096); GLDS16(pa2 + lch, d + 8192); GLDS16(pa3 + lch, d + 12288);
  GLDS16(pb0 + lch, d + 16384); GLDS16(pb1 + lch, d + 20480); GLDS16(pb2 + lch, d + 24576); GLDS16(pb3 + lch, d + 28672);
}

template <bool PRE = false, class Mid>
__device__ __forceinline__ void gemm_main(unsigned char* smem, const bf16_t* pa0, const bf16_t* pa1, const bf16_t* pa2,
                                          const bf16_t* pa3, const bf16_t* pb0, const bf16_t* pb1, const bf16_t* pb2,
                                          const bf16_t* pb3, int nk, int kmid, bool swapped, f32x4 (&acc)[4][4],
                                          const Mid& mid) {
  const int tid = otid(), lane = tid & 63, wid = tid >> 6, wr = wid >> 1, wc = wid & 1;
  const int srow = tid >> 3;
  const int lch = ((tid & 7) ^ ((srow >> 1) & 7)) * 8 - (tid & 7) * 8;
  pa0 += lch; pa1 += lch; pa2 += lch; pa3 += lch; pb0 += lch; pb1 += lch; pb2 += lch; pb3 += lch;
  const int soff = __builtin_amdgcn_readfirstlane(wid) * 1024;
  const int qi = lane & 15, g = lane >> 4, s = qi >> 1;
  const int aside = swapped ? 16384 : 0, bside = swapped ? 0 : 16384;
  const int offA0 = aside + (wr * 64 + qi) * 128 + (((0 + g) ^ s) << 4);
  const int offA1 = aside + (wr * 64 + qi) * 128 + (((4 + g) ^ s) << 4);
  const int offB0 = bside + (wc * 64 + qi) * 128 + (((0 + g) ^ s) << 4);
  const int offB1 = bside + (wc * 64 + qi) * 128 + (((4 + g) ^ s) << 4);
  if (!PRE) {
    unsigned char* d = smem + soff;
    GLDS16(pa0, d); GLDS16(pa1, d + 4096); GLDS16(pa2, d + 8192); GLDS16(pa3, d + 12288);
    GLDS16(pb0, d + 16384); GLDS16(pb1, d + 20480); GLDS16(pb2, d + 24576); GLDS16(pb3, d + 28672);
  }
  asm volatile("s_waitcnt vmcnt(0)" ::: "memory");
  __syncthreads();
  for (int kt = 0; kt < nk; ++kt) {
    unsigned char* buf = smem + ((kt & 1) << 15);
    if (kt + 1 < nk) {
      const int ko = (kt + 1) * 64;
      unsigned char* d = smem + (((kt + 1) & 1) << 15) + soff;
      GLDS16(pa0 + ko, d); GLDS16(pa1 + ko, d + 4096); GLDS16(pa2 + ko, d + 8192); GLDS16(pa3 + ko, d + 12288);
      GLDS16(pb0 + ko, d + 16384); GLDS16(pb1 + ko, d + 20480); GLDS16(pb2 + ko, d + 24576); GLDS16(pb3 + ko, d + 28672);
    }
    if (kt == kmid) mid(acc);
    {
      bf16x8 af0[4], bf0[4], af1[4], bf1[4];
#pragma unroll
      for (int i = 0; i < 4; ++i) af0[i] = *(const bf16x8*)(buf + offA0 + i * 2048);
#pragma unroll
      for (int j = 0; j < 4; ++j) bf0[j] = *(const bf16x8*)(buf + offB0 + j * 2048);
#pragma unroll
      for (int i = 0; i < 4; ++i) af1[i] = *(const bf16x8*)(buf + offA1 + i * 2048);
#pragma unroll
      for (int j = 0; j < 4; ++j) bf1[j] = *(const bf16x8*)(buf + offB1 + j * 2048);
      asm volatile("s_waitcnt lgkmcnt(8)" ::: "memory");
      __builtin_amdgcn_s_setprio(1);
#pragma unroll
      for (int i = 0; i < 4; ++i)
#pragma unroll
        for (int j = 0; j < 4; ++j) acc[i][j] = __builtin_amdgcn_mfma_f32_16x16x32_bf16(bf0[j], af0[i], acc[i][j], 0, 0, 0);
      asm volatile("s_waitcnt lgkmcnt(0)" ::: "memory");
#pragma unroll
      for (int i = 0; i < 4; ++i)
#pragma unroll
        for (int j = 0; j < 4; ++j) acc[i][j] = __builtin_amdgcn_mfma_f32_16x16x32_bf16(bf1[j], af1[i], acc[i][j], 0, 0, 0);
      __builtin_amdgcn_s_setprio(0);
    }
    asm volatile("s_waitcnt vmcnt(0)" ::: "memory");
    __syncthreads();
  }
}

#define ZERO_ACC(acc)                                   \
  _Pragma("unroll") for (int i_ = 0; i_ < 4; ++i_)      \
  _Pragma("unroll") for (int j_ = 0; j_ < 4; ++j_) acc[i_][j_] = (f32x4){0.f, 0.f, 0.f, 0.f};

__device__ void conv_x(const Params& p, int bid, int nblk) {
  const size_t n8 = (size_t)NTOK * 1024 / 8;
#pragma unroll 4
  for (size_t i = (size_t)bid * 256 + threadIdx.x; i < n8; i += (size_t)nblk * 256) {
    const float4 a = *(const float4*)(p.x + i * 8), b = *(const float4*)(p.x + i * 8 + 4);
    u32x4 v; v.x = cvt_pk_bf16(a.x, a.y); v.y = cvt_pk_bf16(a.z, a.w); v.z = cvt_pk_bf16(b.x, b.y); v.w = cvt_pk_bf16(b.z, b.w);
    *(u32x4*)(p.xb + i * 8) = v;
  }
}

__device__ void tconv_tile(float* tile, const float* src, int src_ld, const float* kscale, bf16_t* dst, int dst_ld, int rstep) {
  const int t = otid();
  {
    const int k0 = t >> 6, n4 = (t & 63) * 4;
    float4 v[16];
#pragma unroll
    for (int i = 0; i < 16; ++i) v[i] = *(const float4*)(src + (size_t)(k0 + 4 * i) * src_ld + n4);
    if (kscale) {
#pragma unroll
      for (int i = 0; i < 16; ++i) { const float sc = kscale[k0 + 4 * i]; v[i].x *= sc; v[i].y *= sc; v[i].z *= sc; v[i].w *= sc; }
    }
#pragma unroll
    for (int i = 0; i < 16; ++i) *(float4*)(tile + (k0 + 4 * i) * 260 + n4) = v[i];
  }
  __syncthreads();
  {
    const int n = t;
    bf16_t* o = dst + (size_t)((n >> 4) * rstep + (n & 15)) * dst_ld;
#pragma unroll
    for (int c = 0; c < 8; ++c) {
      float f[8];
#pragma unroll
      for (int q = 0; q < 8; ++q) f[q] = tile[(c * 8 + q) * 260 + n];
      u32x4 v0;
      v0.x = cvt_pk_bf16(f[0], f[1]); v0.y = cvt_pk_bf16(f[2], f[3]); v0.z = cvt_pk_bf16(f[4], f[5]); v0.w = cvt_pk_bf16(f[6], f[7]);
      *(u32x4*)(o + c * 8) = v0;
    }
  }
  __syncthreads();
}

__device__ void conv_item(const Params& p, int l, int it, unsigned char* smem) {
  float* tile = (float*)smem;
  if (it < 160) {
    const int kt = it / 10, ntile = it % 10;
    tconv_tile(tile, p.w_in + (size_t)l * 1024 * 2560 + (size_t)kt * 64 * 2560 + ntile * 256, 2560, nullptr,
               p.Wt_in + (size_t)ntile * 256 * 1024 + kt * 64, 1024, 16);
  } else if (it < 224) {
    const int r = it - 160, kt = r >> 2, ntile = r & 3;
    tconv_tile(tile, p.w_out + (size_t)l * 1024 * 1024 + (size_t)kt * 64 * 1024 + ntile * 256, 1024, p.mix_g + l * 1024 + kt * 64,
               p.Wt_out + (size_t)ntile * 256 * 1024 + kt * 64, 1024, 16);
  } else if (it < 736) {
    const int r0 = it - 224, e = r0 >> 5, r = r0 & 31, which = r >> 4, kt = r & 15;
    const float* src = (which ? p.w_up : p.w_gate) + (size_t)(l * 16 + e) * 1024 * 256 + (size_t)kt * 64 * 256;
    tconv_tile(tile, src, 256, nullptr, p.Wgu + (size_t)e * 512 * 1024 + (size_t)(which * 16) * 1024 + kt * 64, 1024, 32);
  } else if (it < 992) {
    const int r0 = it - 736, e = r0 >> 4, r = r0 & 15, kt = r >> 2, ntile = r & 3;
    tconv_tile(tile, p.w_down + (size_t)(l * 16 + e) * 256 * 1024 + (size_t)kt * 64 * 1024 + ntile * 256, 1024, nullptr,
               p.Wdn + (size_t)e * 1024 * 256 + (size_t)ntile * 256 * 256 + kt * 64, 256, 16);
  } else if (it == 1008) {
    for (int i = threadIdx.x; i < 16384; i += 256) {
      const int jj = i & 7, j = (i >> 3) & 15, g = (i >> 7) & 3, kb = i >> 9;
      const int k = 32 * kb + 8 * g + jj;
      const float we = p.re_w[(size_t)(l * 1024 + k) * 16 + j];
      const float wg = (j < 4) ? p.rg_w[(size_t)(l * 1024 + k) * 4 + j] : 0.0f;
      const unsigned eh = cvt_pk_bf16(we, 0.f) & 0xffffu, gh = cvt_pk_bf16(wg, 0.f) & 0xffffu;
      const unsigned el = cvt_pk_bf16(we - __uint_as_float(eh << 16), 0.f) & 0xffffu;
      const unsigned gl = cvt_pk_bf16(wg - __uint_as_float(gh << 16), 0.f) & 0xffffu;
      p.Wr_eh[i] = (bf16_t)eh; p.Wr_el[i] = (bf16_t)el; p.Wr_gh[i] = (bf16_t)gh; p.Wr_gl[i] = (bf16_t)gl;
    }
  } else {
    const int j = it - 992;
    const float* src = p.sgu_w + (size_t)l * 131072 + (size_t)j * 8192 + threadIdx.x * 32;
    bf16_t* dst = p.Wsgu + (size_t)j * 8192 + threadIdx.x * 32;
#pragma unroll
    for (int q = 0; q < 4; ++q) {
      const float4 a = *(const float4*)(src + q * 8), b = *(const float4*)(src + q * 8 + 4);
      u32x4 v; v.x = cvt_pk_bf16(a.x, a.y); v.y = cvt_pk_bf16(a.z, a.w); v.z = cvt_pk_bf16(b.x, b.y); v.w = cvt_pk_bf16(b.z, b.w);
      *(u32x4*)(dst + q * 8) = v;
    }
  }
}

__device__ __forceinline__ void p1_decode(int t, int& mt, int& nt) {
  const int x_ = t & 7, j_ = t >> 3, rd_ = j_ >> 6, lb_ = j_ & 63;
  mt = (rd_ < 4) ? (x_ * 16 + (rd_ & 1) * 8 + (lb_ & 7)) : (x_ * 16 + (lb_ & 15));
  nt = (rd_ < 4) ? ((rd_ >> 1) * 8 + (lb_ >> 3)) : (16 + (lb_ >> 4));
}
__device__ __forceinline__ void p1_epilogue(const Params& p, int l, int mt, int nt, f32x4 (&acc)[4][4]) {
  const int type = nt >> 2;
  const bool swapped = (type == 2) || (type == 4);
  const int tid = otid(), lane = tid & 63, wid = tid >> 6, wr = wid >> 1, wc = wid & 1;
  const int qi = lane & 15, g = lane >> 4;
  if (!swapped) {
#pragma unroll
    for (int i = 0; i < 4; ++i) {
      const int m = mt * 128 + wr * 64 + i * 16 + qi;
#pragma unroll
      for (int j = 0; j < 4; ++j) {
        const int n = nt * 128 + wc * 64 + j * 16 + 4 * g;
        f32x4 v = acc[i][j];
        if (type == 0) v *= 0.125f;
        if (type == 3) { v[0] = gelu_tanh(v[0]); v[1] = gelu_tanh(v[1]); v[2] = gelu_tanh(v[2]); v[3] = gelu_tanh(v[3]); }
        bf16_t* dst = (type == 3) ? (p.ub + (size_t)m * 512 + (n - 1536)) : (p.qk + (size_t)m * 1024 + n);
        store_bf16x4(dst, v[0], v[1], v[2], v[3]);
      }
    }
  } else {
    const int bidx = (mt * 128) >> 12, tokbase = (mt * 128) & 4095;
    bf16_t* dstb = (type == 2) ? p.vT : p.vnT;
    const int fbase = (type == 2) ? 1024 : 2048;
    if (type == 4) {
#pragma unroll
      for (int i = 0; i < 4; ++i)
#pragma unroll
        for (int j = 0; j < 4; ++j)
#pragma unroll
          for (int r = 0; r < 4; ++r) acc[i][j][r] = gelu_tanh(acc[i][j][r]);
      float gam[4], bet[4];
#pragma unroll
      for (int i = 0; i < 4; ++i) {
        const int f = nt * 128 + wr * 64 + i * 16 + qi - 2048;
        gam[i] = p.sgu_ln_g[l * 512 + f]; bet[i] = p.sgu_ln_b[l * 512 + f];
      }
#pragma unroll
      for (int j = 0; j < 4; ++j)
#pragma unroll
        for (int r = 0; r < 4; ++r) {
          float s1 = acc[0][j][r] + acc[1][j][r] + acc[2][j][r] + acc[3][j][r];
          s1 = row16_sum(s1);
          const float mu = s1 * (1.0f / 64.0f);
          float s2 = 0.f;
#pragma unroll
          for (int i = 0; i < 4; ++i) { const float d = acc[i][j][r] - mu; s2 += d * d; }
          s2 = row16_sum(s2);
          const float rstd = rsqrtf(s2 * (1.0f / 64.0f) + LN_EPS);
#pragma unroll
          for (int i = 0; i < 4; ++i) acc[i][j][r] = (acc[i][j][r] - mu) * rstd * gam[i] + bet[i];
        }
    }
#pragma unroll
    for (int i = 0; i < 4; ++i) {
      const int f = nt * 128 + wr * 64 + i * 16 + qi - fbase;
#pragma unroll
      for (int j = 0; j < 4; ++j) {
        const int tok = tokbase + wc * 64 + j * 16 + 4 * g;
        store_bf16x4(dstb + ((size_t)(bidx * 512 + f)) * 4096 + tok, acc[i][j][0], acc[i][j][1], acc[i][j][2], acc[i][j][3]);
      }
    }
  }
}


__device__ void p1_phase(const Params& p, int l, int bid, int nblk, unsigned char* smem) {
  const int tid0 = otid();
  int t = bid, mt = 0, nt = 0;
  const bf16_t* A = nullptr; const bf16_t* B = nullptr;
  if (t < 2560) {
    p1_decode(t, mt, nt);
    A = p.xb + (size_t)(mt * 128 + (tid0 >> 3)) * 1024 + (tid0 & 7) * 8;
    B = p.Wt_in + (size_t)(nt * 128 + (tid0 >> 3)) * 1024 + (tid0 & 7) * 8;
    __syncthreads();
    gemm_issue0(smem, A, A + 32 * 1024, A + 64 * 1024, A + 96 * 1024, B, B + 32 * 1024, B + 64 * 1024, B + 96 * 1024);
  }
  while (t < 2560) {
    const int type = nt >> 2;
    const bool swapped = (type == 2) || (type == 4);
    f32x4 acc[4][4];
    ZERO_ACC(acc);
    gemm_main<true>(smem, A, A + 32 * 1024, A + 64 * 1024, A + 96 * 1024, B, B + 32 * 1024, B + 64 * 1024, B + 96 * 1024, 16, -1, swapped, acc, NoMid());
    const int tn = t + nblk;
    int mtn = mt, ntn = nt;
    if (tn < 2560) {
      p1_decode(tn, mtn, ntn);
      const int tid = otid();
      A = p.xb + (size_t)(mtn * 128 + (tid >> 3)) * 1024 + (tid & 7) * 8;
      B = p.Wt_in + (size_t)(ntn * 128 + (tid >> 3)) * 1024 + (tid & 7) * 8;
      gemm_issue0(smem, A, A + 32 * 1024, A + 64 * 1024, A + 96 * 1024, B, B + 32 * 1024, B + 64 * 1024, B + 96 * 1024);
    }
    p1_epilogue(p, l, mt, nt, acc);
    mt = mtn; nt = ntn; t = tn;
  }
}

__device__ void attn_phase(const Params& p, int l, int bid, int nblk, unsigned char* smem) {
  const int tid = otid(), lane = tid & 63, w = tid >> 6, qi = lane & 15, g = lane >> 4;
  unsigned char* Kb = smem;
  unsigned char* Vb = smem + 32768;
  float* sbias = (float*)(smem + 32768 + 33792);
  const int c0 = (w == 0) ? 0 : (w == 1) ? 8 : (w == 2) ? 24 : 32;
  const int cq = 16 * w + qi, cs = min(max(cq - 8, 0), 48);
  const int krow = tid >> 3, kch = tid & 7;
  const int ksoff = krow * 128 + ((kch ^ ((krow >> 1) & 7)) << 4);
  const int vd = tid >> 5, vc = tid & 31;
  const int vsoff = vd * 528 + vc * 16;
  u32x4 st[8], st2[8];
#define ATT_ISSUE_K(it_)                                                                                              \
  do {                                                                                                                \
    const int h_ = (it_) & 7, br_ = (it_) >> 3, r_ = br_ & 63, b_ = br_ >> 6, rs_ = min(max(r_ - 4, 0), 56);          \
    const bf16_t* kg_ = p.qk + ((size_t)b_ * 4096 + rs_ * 64 + krow) * 1024 + 512 + h_ * 64 + kch * 8;                \
    _Pragma("unroll") for (int i = 0; i < 8; ++i) st[i] = *(const u32x4*)(kg_ + (size_t)(32 * i) * 1024);            \
    _Pragma("unroll") for (int i = 0; i < 8; ++i) st2[i] = *(const u32x4*)(kg_ + (size_t)(256 + 32 * i) * 1024);     \
  } while (0)
  int it = bid;
  if (it < 2048) ATT_ISSUE_K(it);
  while (it < 2048) {
    const int h = it & 7, br = it >> 3, r = br & 63, b = br >> 6;
    const int rs = min(max(r - 4, 0), 56);
    const size_t tokq = (size_t)b * 4096 + r * 64 + cq;
    const bf16_t* vg = p.vT + ((size_t)(b * 512 + h * 64 + vd)) * 4096 + rs * 64 + vc * 8;
    const float rb0 = p.rel_bias[(size_t)(l * 8 + h) * 465 + tid];
    const float rb1 = p.rel_bias[(size_t)(l * 8 + h) * 465 + min(tid + 256, 464)];
    bf16x8 qf0 = *(const bf16x8*)(p.qk + tokq * 1024 + h * 64 + g * 8);
    bf16x8 qf1 = *(const bf16x8*)(p.qk + tokq * 1024 + h * 64 + 32 + g * 8);
    __syncthreads();
    sbias[tid] = rb0;
    if (tid + 256 < 465) sbias[tid + 256] = rb1;
#pragma unroll
    for (int i = 0; i < 8; ++i) *(u32x4*)(Kb + ksoff + i * 4096) = st[i];
#pragma unroll
    for (int i = 0; i < 8; ++i) st[i] = *(const u32x4*)(vg + (size_t)(8 * i) * 4096);
    __syncthreads();
    f32x4 s[8][2];
#pragma unroll
    for (int jh = 0; jh < 2; ++jh) {
#pragma unroll
      for (int jj = 0; jj < 4; ++jj)
#pragma unroll
        for (int ch = 0; ch < 2; ++ch) {
          const int kl = jj * 64 + c0 + 16 * ch + qi;
          const int sw = (kl >> 1) & 7;
          const bf16x8 kf0 = *(const bf16x8*)(Kb + kl * 128 + (((0 + g) ^ sw) << 4));
          const bf16x8 kf1 = *(const bf16x8*)(Kb + kl * 128 + (((4 + g) ^ sw) << 4));
          f32x4 a = {0.f, 0.f, 0.f, 0.f};
          a = __builtin_amdgcn_mfma_f32_16x16x32_bf16(kf0, qf0, a, 0, 0, 0);
          a = __builtin_amdgcn_mfma_f32_16x16x32_bf16(kf1, qf1, a, 0, 0, 0);
          s[jh * 4 + jj][ch] = a;
        }
      if (jh == 0) {
        __syncthreads();
#pragma unroll
        for (int i = 0; i < 8; ++i) *(u32x4*)(Kb + ksoff + i * 4096) = st2[i];
#pragma unroll
        for (int i = 0; i < 8; ++i) st2[i] = *(const u32x4*)(vg + (size_t)(8 * i) * 4096 + 256);
        __syncthreads();
      }
    }
#pragma unroll
    for (int i = 0; i < 8; ++i) *(u32x4*)(Vb + vsoff + i * 8 * 528) = st[i];
    float mx = -1e30f;
#pragma unroll
    for (int j = 0; j < 8; ++j)
#pragma unroll
      for (int ch = 0; ch < 2; ++ch)
#pragma unroll
        for (int rg = 0; rg < 4; ++rg) {
          const int kc = c0 + 16 * ch + 4 * g + rg;
          const bool valid = (kc >= cs) && (kc < cs + 16);
          const int bidx = valid ? ((rs + j - r + 7) * 31 + (kc - cq) + 15) : 0;
          const float v = valid ? (s[j][ch][rg] + sbias[bidx]) : -1e30f;
          s[j][ch][rg] = v;
          mx = fmaxf(mx, v);
        }
    mx = fmaxf(mx, __shfl_xor(mx, 16)); mx = fmaxf(mx, __shfl_xor(mx, 32));
    float sum = 0.f;
#pragma unroll
    for (int j = 0; j < 8; ++j)
#pragma unroll
      for (int ch = 0; ch < 2; ++ch)
#pragma unroll
        for (int rg = 0; rg < 4; ++rg) { const float e = __expf(s[j][ch][rg] - mx); s[j][ch][rg] = e; sum += e; }
    sum += __shfl_xor(sum, 16); sum += __shfl_xor(sum, 32);
    const float inv = 1.0f / sum;
    bf16x8 pf[8];
#pragma unroll
    for (int j = 0; j < 8; ++j) {
      u32x4 pw;
      pw.x = cvt_pk_bf16(s[j][0][0], s[j][0][1]); pw.y = cvt_pk_bf16(s[j][0][2], s[j][0][3]);
      pw.z = cvt_pk_bf16(s[j][1][0], s[j][1][1]); pw.w = cvt_pk_bf16(s[j][1][2], s[j][1][3]);
      pf[j] = __builtin_bit_cast(bf16x8, pw);
    }
    f32x4 o[4];
#pragma unroll
    for (int dt = 0; dt < 4; ++dt) o[dt] = (f32x4){0.f, 0.f, 0.f, 0.f};
    const int itn = it + nblk;
    __syncthreads();
#pragma unroll
    for (int jh = 0; jh < 2; ++jh) {
#pragma unroll
      for (int jj = 0; jj < 4; ++jj)
#pragma unroll
        for (int dt = 0; dt < 4; ++dt) {
          const unsigned char* vp = Vb + (dt * 16 + qi) * 528 + (jj * 64 + c0 + 4 * g) * 2;
          const u32x2 lo = *(const u32x2*)vp, hi = *(const u32x2*)(vp + 32);
          u32x4 vw; vw.x = lo.x; vw.y = lo.y; vw.z = hi.x; vw.w = hi.y;
          o[dt] = __builtin_amdgcn_mfma_f32_16x16x32_bf16(__builtin_bit_cast(bf16x8, vw), pf[jh * 4 + jj], o[dt], 0, 0, 0);
        }
      if (jh == 0) {
        __syncthreads();
#pragma unroll
        for (int i = 0; i < 8; ++i) *(u32x4*)(Vb + vsoff + i * 8 * 528) = st2[i];
        if (itn < 2048) ATT_ISSUE_K(itn);
        __syncthreads();
      }
    }
    float sq = 0.f;
#pragma unroll
    for (int dt = 0; dt < 4; ++dt) {
      o[dt] *= inv;
      sq += o[dt][0] * o[dt][0] + o[dt][1] * o[dt][1] + o[dt][2] * o[dt][2] + o[dt][3] * o[dt][3];
      store_bf16x4(p.mixed + tokq * 1024 + h * 64 + dt * 16 + 4 * g, o[dt][0], o[dt][1], o[dt][2], o[dt][3]);
    }
    sq += __shfl_xor(sq, 16); sq += __shfl_xor(sq, 32);
    if (g == 0) p.ssq[tokq * 16 + h] = sq;
    it = itn;
  }
#undef ATT_ISSUE_K
}

__device__ void sgu_item(const Params& p, int l, int it, unsigned char* smem) {
  const int grp = it & 7, bc = it >> 3, chunk = bc & 31, b = bc >> 5;
  const int tid = otid(), lane = tid & 63, w = tid >> 6, qi = lane & 15, g = lane >> 4;
  const int p0 = 32 * w;
  const int wbase = __builtin_amdgcn_readfirstlane(w) * 1024;
  const int lc = ((tid & 15) ^ ((tid >> 4) & 15)) << 3;
  const bf16_t* wsrc = p.Wsgu + ((size_t)(grp * 128 + (tid >> 4))) * 128 + lc;
  const bf16_t* vsrc = p.vnT + ((size_t)(b * 512 + grp * 64 + (tid >> 4))) * 4096 + chunk * 128 + lc;
  __syncthreads();
#pragma unroll
  for (int i = 0; i < 8; ++i) GLDS16(wsrc + (size_t)(16 * i) * 128, smem + i * 4096 + wbase);
#pragma unroll
  for (int i = 0; i < 4; ++i) GLDS16(vsrc + (size_t)(16 * i) * 4096, smem + 32768 + i * 4096 + wbase);
  asm volatile("s_waitcnt vmcnt(0)" ::: "memory");
  __syncthreads();
  f32x4 acc[2][4];
#pragma unroll
  for (int mt = 0; mt < 2; ++mt)
#pragma unroll
    for (int nt = 0; nt < 4; ++nt) acc[mt][nt] = (f32x4){0.f, 0.f, 0.f, 0.f};
#pragma unroll
  for (int ks = 0; ks < 4; ++ks) {
    const int co = ((ks * 4 + g) ^ qi) << 4;
    bf16x8 wf[2], vf[4];
#pragma unroll
    for (int mt = 0; mt < 2; ++mt) wf[mt] = *(const bf16x8*)(smem + (p0 + 16 * mt + qi) * 256 + co);
#pragma unroll
    for (int nt = 0; nt < 4; ++nt) vf[nt] = *(const bf16x8*)(smem + 32768 + (16 * nt + qi) * 256 + co);
#pragma unroll
    for (int mt = 0; mt < 2; ++mt)
#pragma unroll
      for (int nt = 0; nt < 4; ++nt) acc[mt][nt] = __builtin_amdgcn_mfma_f32_16x16x32_bf16(vf[nt], wf[mt], acc[mt][nt], 0, 0, 0);
  }
#pragma unroll
  for (int mt = 0; mt < 2; ++mt) {
    const int pp = p0 + 16 * mt + qi;
    const size_t tok = (size_t)b * 4096 + chunk * 128 + pp;
    const float bias = p.sgu_b[(size_t)(l * 8 + grp) * 128 + pp];
    float sq = 0.f;
#pragma unroll
    for (int nt = 0; nt < 4; ++nt) {
      const int d = 16 * nt + 4 * g;
      const u32x2 uu = *(const u32x2*)(p.ub + tok * 512 + grp * 64 + d);
      const float u0 = __uint_as_float(uu.x << 16), u1 = __uint_as_float(uu.x & 0xffff0000u);
      const float u2 = __uint_as_float(uu.y << 16), u3 = __uint_as_float(uu.y & 0xffff0000u);
      const float v0 = u0 * (acc[mt][nt][0] + bias), v1 = u1 * (acc[mt][nt][1] + bias);
      const float v2 = u2 * (acc[mt][nt][2] + bias), v3 = u3 * (acc[mt][nt][3] + bias);
      sq += v0 * v0 + v1 * v1 + v2 * v2 + v3 * v3;
      store_bf16x4(p.mixed + tok * 1024 + 512 + grp * 64 + d, v0, v1, v2, v3);
    }
    sq += __shfl_xor(sq, 16); sq += __shfl_xor(sq, 32);
    if (g == 0) p.ssq[tok * 16 + 8 + grp] = sq;
  }
}

__device__ void p3_tile(const Params& p, int l, int t, unsigned char* smem) {
  const int x_ = t & 7, j_ = t >> 3, rd_ = j_ >> 6, lb_ = j_ & 63;
  const int mt = x_ * 16 + rd_ * 8 + (lb_ & 7), nt = lb_ >> 3;
  const int tid = otid(), lane = tid & 63, wid = tid >> 6, wr = wid >> 1, wc = wid & 1;
  const int srow = tid >> 3, sch = tid & 7, qi = lane & 15, g = lane >> 4;
  const bf16_t* A = p.mixed + (size_t)(mt * 128 + srow) * 1024 + sch * 8;
  const bf16_t* B = p.Wt_out + (size_t)(nt * 128 + srow) * 1024 + sch * 8;
  MidScale mid; float rss[4];
#pragma unroll
  for (int i = 0; i < 4; ++i) {
    const int m = mt * 128 + wr * 64 + i * 16 + qi;
    const float4 a0 = *(const float4*)(p.ssq + (size_t)m * 16), a1 = *(const float4*)(p.ssq + (size_t)m * 16 + 4);
    const float4 b0 = *(const float4*)(p.ssq + (size_t)m * 16 + 8), b1 = *(const float4*)(p.ssq + (size_t)m * 16 + 12);
    const float sa = (a0.x + a0.y + a0.z + a0.w) + (a1.x + a1.y + a1.z + a1.w);
    const float sb = (b0.x + b0.y + b0.z + b0.w) + (b1.x + b1.y + b1.z + b1.w);
    const float ra = rsqrtf(sa * (1.0f / 512.0f) + LN_EPS), rb = rsqrtf(sb * (1.0f / 512.0f) + LN_EPS);
    mid.s[i] = ra / rb; rss[i] = rb;
  }
  f32x4 acc[4][4];
  ZERO_ACC(acc);
  gemm_main(smem, A, A + 32 * 1024, A + 64 * 1024, A + 96 * 1024, B, B + 32 * 1024, B + 64 * 1024, B + 96 * 1024, 16, 8, false, acc, mid);
#pragma unroll
  for (int i = 0; i < 4; ++i) {
    const int m = mt * 128 + wr * 64 + i * 16 + qi;
#pragma unroll
    for (int j = 0; j < 4; ++j) {
      const int n = nt * 128 + wc * 64 + j * 16 + 4 * g;
      const u32x2 xr = *(const u32x2*)(p.xb + (size_t)m * 1024 + n);
      const float o0 = ALPHA * __uint_as_float(xr.x << 16) + acc[i][j][0] * rss[i];
      const float o1 = ALPHA * __uint_as_float(xr.x & 0xffff0000u) + acc[i][j][1] * rss[i];
      const float o2 = ALPHA * __uint_as_float(xr.y << 16) + acc[i][j][2] * rss[i];
      const float o3 = ALPHA * __uint_as_float(xr.y & 0xffff0000u) + acc[i][j][3] * rss[i];
      store_bf16x4(p.hb + (size_t)m * 1024 + n, o0, o1, o2, o3);
    }
  }
}

__device__ void p4_batch(const Params& p, int l, int batch, unsigned char* smem) {
  const int tid = otid(), lane = tid & 63, w = tid >> 6;
  int* scnt = (int*)smem;
  int* sbase = scnt + 16;
  __syncthreads();
  if (tid < 16) scnt[tid] = 0;
  __syncthreads();
  const int tokw = batch * 32 + w * 8;
  {
    float4 gm[4], bt[4];
#pragma unroll
    for (int q = 0; q < 4; ++q) {
      gm[q] = *(const float4*)(p.ln1_g + l * 1024 + q * 256 + lane * 4);
      bt[q] = *(const float4*)(p.ln1_b + l * 1024 + q * 256 + lane * 4);
    }
#pragma unroll 4
    for (int t = 0; t < 8; ++t) {
      float* xr = p.x1 + (size_t)(tokw + t) * 1024 + lane * 4;
      const bf16_t* hr = p.hb + (size_t)(tokw + t) * 1024 + lane * 4;
      float4 v[4];
#pragma unroll
      for (int q = 0; q < 4; ++q) {
        const u32x2 hh = *(const u32x2*)(hr + q * 256);
        v[q].x = __uint_as_float(hh.x << 16); v[q].y = __uint_as_float(hh.x & 0xffff0000u);
        v[q].z = __uint_as_float(hh.y << 16); v[q].w = __uint_as_float(hh.y & 0xffff0000u);
      }
      float s1 = 0.f;
#pragma unroll
      for (int q = 0; q < 4; ++q) s1 += (v[q].x + v[q].y) + (v[q].z + v[q].w);
      const float mu = wave_sum(s1) * (1.0f / 1024.0f);
      float s2 = 0.f;
#pragma unroll
      for (int q = 0; q < 4; ++q) {
        const float d0 = v[q].x - mu, d1 = v[q].y - mu, d2 = v[q].z - mu, d3 = v[q].w - mu;
        s2 += (d0 * d0 + d1 * d1) + (d2 * d2 + d3 * d3);
      }
      const float rstd = rsqrtf(wave_sum(s2) * (1.0f / 1024.0f) + LN_EPS);
#pragma unroll
      for (int q = 0; q < 4; ++q) {
        float4 o;
        o.x = (v[q].x - mu) * rstd * gm[q].x + bt[q].x; o.y = (v[q].y - mu) * rstd * gm[q].y + bt[q].y;
        o.z = (v[q].z - mu) * rstd * gm[q].z + bt[q].z; o.w = (v[q].w - mu) * rstd * gm[q].w + bt[q].w;
        *(float4*)(xr + q * 256) = o;
        store_bf16x4(p.xb + (size_t)(tokw + t) * 1024 + q * 256 + lane * 4, o.x, o.y, o.z, o.w);
      }
    }
  }
  asm volatile("s_waitcnt vmcnt(0)" ::: "memory");
  __syncthreads();
  const int j = lane & 15, g = lane >> 4;
  float* part = (float*)(smem + 1024);
  {
    const float* xr0 = p.x1 + (size_t)(batch * 32 + j) * 1024 + 256 * w + 8 * g;
    const float* xr1 = xr0 + 16 * 1024;
    const size_t wof = ((size_t)(8 * w * 4 + g) * 16 + j) * 8;
    f32x4 De0 = {0.f, 0.f, 0.f, 0.f}, Dg0 = De0, De1 = De0, Dg1 = De0;
#pragma unroll 2
    for (int kb = 0; kb < 8; ++kb) {
      const float4 xa0 = *(const float4*)(xr0 + kb * 32), xc0 = *(const float4*)(xr0 + kb * 32 + 4);
      const float4 xa1 = *(const float4*)(xr1 + kb * 32), xc1 = *(const float4*)(xr1 + kb * 32 + 4);
      const bf16x8 weh = *(const bf16x8*)(p.Wr_eh + wof + kb * 512), wel = *(const bf16x8*)(p.Wr_el + wof + kb * 512);
      const bf16x8 wgh = *(const bf16x8*)(p.Wr_gh + wof + kb * 512), wgl = *(const bf16x8*)(p.Wr_gl + wof + kb * 512);
      u32x4 h, lo;
      h.x = cvt_pk_bf16(xa0.x, xa0.y); h.y = cvt_pk_bf16(xa0.z, xa0.w); h.z = cvt_pk_bf16(xc0.x, xc0.y); h.w = cvt_pk_bf16(xc0.z, xc0.w);
      lo.x = cvt_pk_bf16(xa0.x - __uint_as_float(h.x << 16), xa0.y - __uint_as_float(h.x & 0xffff0000u));
      lo.y = cvt_pk_bf16(xa0.z - __uint_as_float(h.y << 16), xa0.w - __uint_as_float(h.y & 0xffff0000u));
      lo.z = cvt_pk_bf16(xc0.x - __uint_as_float(h.z << 16), xc0.y - __uint_as_float(h.z & 0xffff0000u));
      lo.w = cvt_pk_bf16(xc0.z - __uint_as_float(h.w << 16), xc0.w - __uint_as_float(h.w & 0xffff0000u));
      bf16x8 xh = __builtin_bit_cast(bf16x8, h), xl = __builtin_bit_cast(bf16x8, lo);
      De0 = __builtin_amdgcn_mfma_f32_16x16x32_bf16(weh, xh, De0, 0, 0, 0);
      Dg0 = __builtin_amdgcn_mfma_f32_16x16x32_bf16(wgh, xh, Dg0, 0, 0, 0);
      De0 = __builtin_amdgcn_mfma_f32_16x16x32_bf16(weh, xl, De0, 0, 0, 0);
      Dg0 = __builtin_amdgcn_mfma_f32_16x16x32_bf16(wgh, xl, Dg0, 0, 0, 0);
      De0 = __builtin_amdgcn_mfma_f32_16x16x32_bf16(wel, xh, De0, 0, 0, 0);
      Dg0 = __builtin_amdgcn_mfma_f32_16x16x32_bf16(wgl, xh, Dg0, 0, 0, 0);
      h.x = cvt_pk_bf16(xa1.x, xa1.y); h.y = cvt_pk_bf16(xa1.z, xa1.w); h.z = cvt_pk_bf16(xc1.x, xc1.y); h.w = cvt_pk_bf16(xc1.z, xc1.w);
      lo.x = cvt_pk_bf16(xa1.x - __uint_as_float(h.x << 16), xa1.y - __uint_as_float(h.x & 0xffff0000u));
      lo.y = cvt_pk_bf16(xa1.z - __uint_as_float(h.y << 16), xa1.w - __uint_as_float(h.y & 0xffff0000u));
      lo.z = cvt_pk_bf16(xc1.x - __uint_as_float(h.z << 16), xc1.y - __uint_as_float(h.z & 0xffff0000u));
      lo.w = cvt_pk_bf16(xc1.z - __uint_as_float(h.w << 16), xc1.w - __uint_as_float(h.w & 0xffff0000u));
      xh = __builtin_bit_cast(bf16x8, h); xl = __builtin_bit_cast(bf16x8, lo);
      De1 = __builtin_amdgcn_mfma_f32_16x16x32_bf16(weh, xh, De1, 0, 0, 0);
      Dg1 = __builtin_amdgcn_mfma_f32_16x16x32_bf16(wgh, xh, Dg1, 0, 0, 0);
      De1 = __builtin_amdgcn_mfma_f32_16x16x32_bf16(weh, xl, De1, 0, 0, 0);
      Dg1 = __builtin_amdgcn_mfma_f32_16x16x32_bf16(wgh, xl, Dg1, 0, 0, 0);
      De1 = __builtin_amdgcn_mfma_f32_16x16x32_bf16(wel, xh, De1, 0, 0, 0);
      Dg1 = __builtin_amdgcn_mfma_f32_16x16x32_bf16(wgl, xh, Dg1, 0, 0, 0);
    }
    float* pw = part + ((size_t)(w * 2) * 64 + lane) * 8;
    *(f32x4*)(pw) = De0; *(f32x4*)(pw + 4) = Dg0;
    *(f32x4*)(pw + 512) = De1; *(f32x4*)(pw + 516) = Dg1;
  }
  __syncthreads();
  const int tok = tokw + (j & 7);
  f32x4 De = {0.f, 0.f, 0.f, 0.f}, Dg = {0.f, 0.f, 0.f, 0.f};
  {
    const int ln = g * 16 + (w & 1) * 8 + (j & 7), tl = w >> 1;
#pragma unroll
    for (int ww = 0; ww < 4; ++ww) {
      const float* pr = part + ((size_t)(ww * 2 + tl) * 64 + ln) * 8;
      De += *(const f32x4*)(pr); Dg += *(const f32x4*)(pr + 4);
    }
  }
  float gl[4];
#pragma unroll
  for (int k = 0; k < 4; ++k) gl[k] = __shfl(Dg[k], j) + p.rg_b[l * 4 + k];
  int gs = 0; float gmax = gl[0];
#pragma unroll
  for (int k = 1; k < 4; ++k) { const bool bb = gl[k] > gmax; gmax = bb ? gl[k] : gmax; gs = bb ? k : gs; }
  float psum = 0.f;
#pragma unroll
  for (int k = 0; k < 4; ++k) psum += __expf(gl[k] - gmax);
  const float gate = 1.0f / psum;
  float es[4];
#pragma unroll
  for (int k = 0; k < 4; ++k) es[k] = De[k] + p.re_b[l * 16 + 4 * g + k];
  int i0 = 0; float v0 = es[0];
#pragma unroll
  for (int k = 1; k < 4; ++k) { const bool bb = es[k] > v0; v0 = bb ? es[k] : v0; i0 = bb ? k : i0; }
  int i1 = 0; float v1 = -3.0e38f;
#pragma unroll
  for (int k = 0; k < 4; ++k) { const bool bb = (k != i0) && (es[k] > v1); v1 = bb ? es[k] : v1; i1 = bb ? k : i1; }
  const float ex = __expf(v1 - v0);
  const float tw0 = 1.0f / (1.0f + ex), tw1 = ex / (1.0f + ex);
  const bool commit = (g == gs) && (j < 8);
  const int e0 = gs * 4 + i0, e1 = gs * 4 + i1;
  int lp0 = 0, lp1 = 0;
  if (commit) { lp0 = atomicAdd(&scnt[e0], 1); lp1 = atomicAdd(&scnt[e1], 1); }
  __syncthreads();
  if (tid < 16) sbase[tid] = atomicAdd(p.counts + l * 16 + tid, scnt[tid]);
  __syncthreads();
  if (commit) {
    const int pos0 = sbase[e0] + lp0, pos1 = sbase[e1] + lp1;
    p.list[e0 * NTOK + pos0] = tok; p.wlist[e0 * NTOK + pos0] = gate * tw0;
    p.list[e1 * NTOK + pos1] = tok; p.wlist[e1 * NTOK + pos1] = gate * tw1;
    int4 ti; ti.x = e0; ti.y = pos0; ti.z = e1; ti.w = pos1;
    *(int4*)(p.tokinfo + (size_t)tok * 4) = ti;
  }
}

__device__ __forceinline__ int moe_total_mtiles(const int* cnts) {
  int tot = 0;
#pragma unroll
  for (int e = 0; e < 16; ++e) tot += (cnts[e] + 127) >> 7;
  return tot;
}
__device__ __forceinline__ void moe_find(const int* cnts, int mi, int& e_out, int& ml, int& off, int& cnt) {
  int rem = mi, o = 0; e_out = 0; ml = 0; off = 0; cnt = 1;
  bool found = false;
#pragma unroll
  for (int e = 0; e < 16; ++e) {
    const int c = cnts[e], mtl = (c + 127) >> 7;
    if (!found && rem < mtl) { found = true; e_out = e; ml = rem; off = o; cnt = c; }
    rem -= mtl; o += c;
  }
}

__device__ void p5_tile(const Params& p, int l, int t, int mtot, unsigned char* smem) {
  const int mi = (t >> 5) * 8 + (t & 7), nt = (t >> 3) & 3;
  if (mi >= mtot) return;
  int e, ml, off, cnt;
  moe_find(p.counts + l * 16, mi, e, ml, off, cnt);
  const int tid = otid(), lane = tid & 63, wid = tid >> 6, wr = wid >> 1, wc = wid & 1;
  const int srow = tid >> 3, sch = tid & 7, qi = lane & 15, g = lane >> 4;
  const bf16_t* pa[4];
#pragma unroll
  for (int i = 0; i < 4; ++i) {
    const int ridx = min(ml * 128 + srow + 32 * i, cnt - 1);
    const int tok = p.list[e * NTOK + ridx];
    pa[i] = p.xb + (size_t)tok * 1024 + sch * 8;
  }
  const bf16_t* B = p.Wgu + ((size_t)e * 512 + nt * 128 + srow) * 1024 + sch * 8;
  f32x4 acc[4][4];
  ZERO_ACC(acc);
  gemm_main(smem, pa[0], pa[1], pa[2], pa[3], B, B + 32 * 1024, B + 64 * 1024, B + 96 * 1024, 16, -1, false, acc, NoMid());
#pragma unroll
  for (int i = 0; i < 4; ++i) {
    const int rloc = ml * 128 + wr * 64 + i * 16 + qi;
    if (rloc < cnt) {
      const size_t slot = (size_t)off + rloc;
#pragma unroll
      for (int jp = 0; jp < 2; ++jp) {
        const f32x4 ga = acc[i][2 * jp], up = acc[i][2 * jp + 1];
        const int col = 64 * nt + 32 * wc + 16 * jp + 4 * g;
        store_bf16x4(p.act + slot * 256 + col, silu(ga[0]) * up[0], silu(ga[1]) * up[1], silu(ga[2]) * up[2], silu(ga[3]) * up[3]);
      }
    }
  }
}

struct P6Tile { int e, ml, off, cnt, nt; const bf16_t* pa0; const bf16_t* pa1; const bf16_t* pa2; const bf16_t* pa3; const bf16_t* B; };
__device__ __forceinline__ int p6_next(int t, int ntot, int mtot, int nblk) {
  while (t < ntot && ((t >> 6) * 8 + (t & 7)) >= mtot) t += nblk;
  return t;
}
__device__ __forceinline__ void p6_setup(const Params& p, int l, int t, P6Tile& T) {
  const int mi = (t >> 6) * 8 + (t & 7);
  T.nt = (t >> 3) & 7;
  moe_find(p.counts + l * 16, mi, T.e, T.ml, T.off, T.cnt);
  const int tid = otid(), srow = tid >> 3, sch = tid & 7;
  const bf16_t* base = p.act + (size_t)T.off * 256 + sch * 8;
  T.pa0 = base + (size_t)min(T.ml * 128 + srow, T.cnt - 1) * 256;
  T.pa1 = base + (size_t)min(T.ml * 128 + srow + 32, T.cnt - 1) * 256;
  T.pa2 = base + (size_t)min(T.ml * 128 + srow + 64, T.cnt - 1) * 256;
  T.pa3 = base + (size_t)min(T.ml * 128 + srow + 96, T.cnt - 1) * 256;
  T.B = p.Wdn + ((size_t)T.e * 1024 + T.nt * 128 + srow) * 256 + sch * 8;
}
__device__ void p6_phase(const Params& p, int l, int bid, int nblk, unsigned char* smem) {
  const int mtot = moe_total_mtiles(p.counts + l * 16), ntot = ((mtot + 7) >> 3) * 64;
  P6Tile cur, nxt;
  int t = p6_next(bid, ntot, mtot, nblk);
  if (t < ntot) {
    p6_setup(p, l, t, cur);
    __syncthreads();
    gemm_issue0(smem, cur.pa0, cur.pa1, cur.pa2, cur.pa3, cur.B, cur.B + 32 * 256, cur.B + 64 * 256, cur.B + 96 * 256);
  }
  while (t < ntot) {
    f32x4 acc[4][4];
    ZERO_ACC(acc);
    gemm_main<true>(smem, cur.pa0, cur.pa1, cur.pa2, cur.pa3, cur.B, cur.B + 32 * 256, cur.B + 64 * 256, cur.B + 96 * 256, 4, -1, false, acc, NoMid());
    const int tn = p6_next(t + nblk, ntot, mtot, nblk);
    nxt = cur;
    if (tn < ntot) {
      p6_setup(p, l, tn, nxt);
      gemm_issue0(smem, nxt.pa0, nxt.pa1, nxt.pa2, nxt.pa3, nxt.B, nxt.B + 32 * 256, nxt.B + 64 * 256, nxt.B + 96 * 256);
    }
    {
      const int tid = otid(), lane = tid & 63, wid = tid >> 6, wr = wid >> 1, wc = wid & 1, qi = lane & 15, g = lane >> 4;
#pragma unroll
      for (int i = 0; i < 4; ++i) {
        const int rloc = cur.ml * 128 + wr * 64 + i * 16 + qi;
        if (rloc < cur.cnt) {
          const float wgt = p.wlist[cur.e * NTOK + rloc];
          const size_t slot = (size_t)cur.off + rloc;
#pragma unroll
          for (int j = 0; j < 4; ++j) {
            const int n = cur.nt * 128 + wc * 64 + j * 16 + 4 * g;
            store_bf16x4(p.y + slot * 1024 + n, acc[i][j][0] * wgt, acc[i][j][1] * wgt, acc[i][j][2] * wgt, acc[i][j][3] * wgt);
          }
        }
      }
    }
    cur = nxt; t = tn;
  }
}

template <int NT>
__device__ __forceinline__ void p7_tokens(const Params& p, int l, int tok0, int tstride) {
  const int lane = otid() & 63;
  int4 ti[NT];
#pragma unroll
  for (int u = 0; u < NT; ++u) ti[u] = *(const int4*)(p.tokinfo + (size_t)(tok0 + u * tstride) * 4);
  int off0[NT], off1[NT];
#pragma unroll
  for (int u = 0; u < NT; ++u) { off0[u] = 0; off1[u] = 0; }
#pragma unroll
  for (int e = 0; e < 16; ++e) {
    const int c = p.counts[l * 16 + e];
#pragma unroll
    for (int u = 0; u < NT; ++u) { if (e < ti[u].x) off0[u] += c; if (e < ti[u].z) off1[u] += c; }
  }
  float4 xr[NT][4]; u32x2 ya[NT][4], yb[NT][4];
#pragma unroll
  for (int u = 0; u < NT; ++u) {
    const int tok = tok0 + u * tstride;
    const size_t s0 = (size_t)off0[u] + ti[u].y, s1 = (size_t)off1[u] + ti[u].w;
#pragma unroll
    for (int q = 0; q < 4; ++q) {
      const int c = q * 256 + lane * 4;
      xr[u][q] = *(const float4*)(p.x1 + (size_t)tok * 1024 + c);
      ya[u][q] = *(const u32x2*)(p.y + s0 * 1024 + c);
      yb[u][q] = *(const u32x2*)(p.y + s1 * 1024 + c);
    }
  }
  float4 gg[4], bb[4];
#pragma unroll
  for (int q = 0; q < 4; ++q) {
    gg[q] = *(const float4*)(p.ln2_g + l * 1024 + q * 256 + lane * 4);
    bb[q] = *(const float4*)(p.ln2_b + l * 1024 + q * 256 + lane * 4);
  }
#pragma unroll
  for (int u = 0; u < NT; ++u) {
    const int tok = tok0 + u * tstride;
    float hv[16];
#pragma unroll
    for (int q = 0; q < 4; ++q) {
      hv[q * 4 + 0] = ALPHA * xr[u][q].x + (__uint_as_float(ya[u][q].x << 16) + __uint_as_float(yb[u][q].x << 16));
      hv[q * 4 + 1] = ALPHA * xr[u][q].y + (__uint_as_float(ya[u][q].x & 0xffff0000u) + __uint_as_float(yb[u][q].x & 0xffff0000u));
      hv[q * 4 + 2] = ALPHA * xr[u][q].z + (__uint_as_float(ya[u][q].y << 16) + __uint_as_float(yb[u][q].y << 16));
      hv[q * 4 + 3] = ALPHA * xr[u][q].w + (__uint_as_float(ya[u][q].y & 0xffff0000u) + __uint_as_float(yb[u][q].y & 0xffff0000u));
    }
    float s1s = 0.f;
#pragma unroll
    for (int c = 0; c < 16; ++c) s1s += hv[c];
    const float mu = wave_sum(s1s) * (1.0f / 1024.0f);
    float s2 = 0.f;
#pragma unroll
    for (int c = 0; c < 16; ++c) { const float d = hv[c] - mu; s2 += d * d; }
    const float rstd = rsqrtf(wave_sum(s2) * (1.0f / 1024.0f) + LN_EPS);
#pragma unroll
    for (int q = 0; q < 4; ++q) {
      const int c = q * 256 + lane * 4;
      float4 o;
      o.x = (hv[q * 4 + 0] - mu) * rstd * gg[q].x + bb[q].x; o.y = (hv[q * 4 + 1] - mu) * rstd * gg[q].y + bb[q].y;
      o.z = (hv[q * 4 + 2] - mu) * rstd * gg[q].z + bb[q].z; o.w = (hv[q * 4 + 3] - mu) * rstd * gg[q].w + bb[q].w;
      if (l == 3) *(float4*)(p.out + (size_t)tok * 1024 + c) = o;
      else store_bf16x4(p.xb + (size_t)tok * 1024 + c, o.x, o.y, o.z, o.w);
    }
  }
}

#define XB_TMO      128
#define XB_XCNT(j)  (256  + 64 * (j))
#define XB_XSUB(j)  (1280 + 64 * (j))
#define XB_XGEN(j)  (2304 + 64 * (j))
#define XB_TOP      3328
#define XB_TOPGEN   3392
#define XCD_BAR_WORDS 3456
#define XB_SPIN_CAP (1u << 22)
__device__ __forceinline__ unsigned xb_ld(unsigned* p) { return __hip_atomic_load(p, __ATOMIC_RELAXED, __HIP_MEMORY_SCOPE_AGENT); }
__device__ __forceinline__ unsigned xb_add(unsigned* p, unsigned v) { return __hip_atomic_fetch_add(p, v, __ATOMIC_RELAXED, __HIP_MEMORY_SCOPE_AGENT); }
__device__ __forceinline__ unsigned xb_xcc_id() { return (unsigned)__builtin_amdgcn_s_getreg((3 << 11) | 20) & 0xFu; }
#define XB_SPIN(cond, bar) do { unsigned _sp = 0; while (cond) { __builtin_amdgcn_s_sleep(1); \
    if ((++_sp & 255u) == 0u) { if (xb_ld(&(bar)[XB_TMO])) break; if (_sp > XB_SPIN_CAP) { atomicAdd(&(bar)[XB_TMO], 1u); break; } } } } while (0)
struct XcdBarrier { unsigned* bar; unsigned x; volatile unsigned* st; };
__device__ __forceinline__ XcdBarrier xcd_barrier_post(unsigned* bar, volatile unsigned* st) {
  XcdBarrier b; b.bar = bar; b.x = xb_xcc_id(); b.st = st;
  if (threadIdx.x == 0) (void)xb_add(&bar[XB_XCNT(b.x)], 1u);
  return b;
}
__device__ __forceinline__ void xcd_barrier_complete(unsigned* bar, unsigned x, unsigned& nloc, unsigned& nx) {
  const unsigned G = gridDim.x;
  unsigned sum, cnt, mine, sp = 0u;
  for (;;) {
    sum = 0u; cnt = 0u; mine = 0u;
#pragma unroll
    for (unsigned j = 0; j < 16; ++j) { const unsigned c = xb_ld(&bar[XB_XCNT(j)]); sum += c; cnt += (c > 0u) ? 1u : 0u; mine = (j == x) ? c : mine; }
    if (sum == G) break;
    __builtin_amdgcn_s_sleep(1);
    if ((++sp & 255u) == 0u) { if (xb_ld(&bar[XB_TMO])) break; if (sp > XB_SPIN_CAP) { atomicAdd(&bar[XB_TMO], 1u); break; } }
  }
  nloc = mine > 0u ? mine : 1u; nx = cnt > 0u ? cnt : 1u;
}
__device__ __forceinline__ void xcd_barrier(const XcdBarrier& b) {
  asm volatile("s_waitcnt vmcnt(0)" ::: "memory");
  __syncthreads();
  if (threadIdx.x == 0) {
    unsigned* bar = b.bar;
    __builtin_amdgcn_s_waitcnt(0);
    unsigned nloc = b.st[0], nx = b.st[1];
    if (nloc == 0u) { xcd_barrier_complete(bar, b.x, nloc, nx); b.st[0] = nloc; b.st[1] = nx; }
    const unsigned old = xb_add(&bar[XB_XSUB(b.x)], 1u);
    const unsigned gen = old / nloc;
    if (old + 1u == (gen + 1u) * nloc) {
      __builtin_amdgcn_fence(__ATOMIC_RELEASE, "agent");
      asm volatile("s_waitcnt vmcnt(0)" ::: "memory");
      const unsigned og = xb_add(&bar[XB_TOP], 1u);
      const unsigned tg = og / nx;
      if (og + 1u == (tg + 1u) * nx) xb_add(&bar[XB_TOPGEN], 1u);
      else XB_SPIN(xb_ld(&bar[XB_TOPGEN]) == tg, bar);
      __builtin_amdgcn_fence(__ATOMIC_ACQUIRE, "agent");
      xb_add(&bar[XB_XGEN(b.x)], 1u);
      asm volatile("s_waitcnt vmcnt(0)" ::: "memory");
    } else {
      XB_SPIN(xb_ld(&bar[XB_XGEN(b.x)]) == gen, bar);
      __builtin_amdgcn_fence(__ATOMIC_ACQUIRE, "agent");
      asm volatile("s_waitcnt vmcnt(0)" ::: "memory");
    }
  }
  __syncthreads();
}

__device__ __forceinline__ void run_phase(const Params& p, int ph, int l, int bid, int nblk, unsigned char* smem, float* sbias) {
  switch (ph) {
    case 0: {
      if (bid == 0 && threadIdx.x < 64) p.counts[threadIdx.x] = 0;
      conv_x(p, bid, nblk);
      for (int it = bid; it < NCONV_ITEMS; it += nblk) conv_item(p, 0, it, smem);
    } break;
    case 1: p1_phase(p, l, bid, nblk, smem); break;
    case 2:
      attn_phase(p, l, bid, nblk, smem);
      for (int it = bid; it < 1024; it += nblk) sgu_item(p, l, it, smem);
      break;
    case 3: for (int t = bid; t < 1024; t += nblk) p3_tile(p, l, t, smem); break;
    case 4: for (int it = bid; it < NTOK / 32; it += nblk) p4_batch(p, l, it, smem); break;
    case 5: { const int mtot = moe_total_mtiles(p.counts + l * 16), nt = ((mtot + 7) >> 3) * 32; for (int t = bid; t < nt; t += nblk) p5_tile(p, l, t, mtot, smem); } break;
    case 6: p6_phase(p, l, bid, nblk, smem); break;
    case 7: {
      { const int nw = nblk * 4; int tok = bid * 4 + (threadIdx.x >> 6);
        for (; tok + 3 * nw < NTOK; tok += 4 * nw) p7_tokens<4>(p, l, tok, nw);
        for (; tok < NTOK; tok += nw) p7_tokens<1>(p, l, tok, nw); }
      if (l < 3) for (int it = bid; it < NCONV_ITEMS; it += nblk) conv_item(p, l + 1, it, smem);
    } break;
  }
}

template <int PH>
__global__ void __launch_bounds__(256, 2) phase_kernel(Params p, int l) {
  __shared__ __attribute__((aligned(16))) unsigned char smem[SMEM_BYTES];
  run_phase(p, PH, l, blockIdx.x, gridDim.x, smem, (float*)smem);
}

#if MEGA
__global__ void __launch_bounds__(256, 2) mega_kernel(Params p) {
  __shared__ __attribute__((aligned(16))) unsigned char smem[SMEM_BYTES];
  __shared__ uint4 xb_words;
  float* sbias = (float*)smem;
  cg::grid_group grid = cg::this_grid();
  const int bid = blockIdx.x, nblk = gridDim.x;
  if (threadIdx.x == 0) xb_words = make_uint4(0u, 0u, 0u, 0u);
  __syncthreads();
  XcdBarrier xb = xcd_barrier_post(p.bar, (volatile unsigned*)&xb_words);
  run_phase(p, 0, 0, bid, nblk, smem, sbias);
  if (p.never) grid.sync();
  xcd_barrier(xb);
#pragma unroll 1
  for (int l = 0; l < 4; ++l) {
#pragma unroll 1
    for (int ph = 1; ph <= 7; ++ph) {
      run_phase(p, ph, l, bid, nblk, smem, sbias);
#if DUP_PH
      if (ph == DUP_PH) { xcd_barrier(xb); run_phase(p, ph, l, bid, nblk, smem, sbias); }
#endif
      if (!(l == 3 && ph == 7)) xcd_barrier(xb);
    }
  }
}
#endif

extern "C" void kernel_launch(void* const* d_in, const int* in_sizes, int n_in, void* d_out, int out_size, void* d_ws,
                              size_t ws_size, hipStream_t stream) {
  Params p{};
  p.x = (const float*)d_in[0]; p.w_in = (const float*)d_in[1]; p.w_out = (const float*)d_in[2]; p.rel_bias = (const float*)d_in[3];
  p.sgu_ln_g = (const float*)d_in[4]; p.sgu_ln_b = (const float*)d_in[5]; p.sgu_w = (const float*)d_in[6]; p.sgu_b = (const float*)d_in[7];
  p.mix_g = (const float*)d_in[8]; p.ln1_g = (const float*)d_in[9]; p.ln1_b = (const float*)d_in[10];
  p.rg_w = (const float*)d_in[11]; p.rg_b = (const float*)d_in[12]; p.re_w = (const float*)d_in[13]; p.re_b = (const float*)d_in[14];
  p.w_gate = (const float*)d_in[15]; p.w_up = (const float*)d_in[16]; p.w_down = (const float*)d_in[17];
  p.ln2_g = (const float*)d_in[18]; p.ln2_b = (const float*)d_in[19];
  p.out = (float*)d_out;
  unsigned char* w = (unsigned char*)d_ws;
  size_t o = 0;
  auto take = [&](size_t bytes) { unsigned char* r = w + o; o += (bytes + 255) & ~(size_t)255; return r; };
  p.Wt_in = (bf16_t*)take((size_t)2560 * 1024 * 2);
  p.Wt_out = (bf16_t*)take((size_t)1024 * 1024 * 2);
  p.Wgu = (bf16_t*)take((size_t)16 * 512 * 1024 * 2);
  p.Wdn = (bf16_t*)take((size_t)16 * 1024 * 256 * 2);
  p.Wsgu = (bf16_t*)take((size_t)8 * 128 * 128 * 2);
  p.xb = (bf16_t*)take((size_t)NTOK * 1024 * 2);
  p.x1 = (float*)take((size_t)NTOK * 1024 * 4);
  unsigned char* r1 = take((size_t)NTOK * 2560 * 2);
  p.qk = (bf16_t*)r1;
  p.vT = (bf16_t*)(r1 + (size_t)NTOK * 1024 * 2);
  p.ub = (bf16_t*)(r1 + (size_t)NTOK * 1536 * 2);
  p.vnT = (bf16_t*)(r1 + (size_t)NTOK * 2048 * 2);
  p.y = (bf16_t*)r1;
  p.hb = (bf16_t*)r1;
  unsigned char* r2 = take((size_t)NTOK * 1024 * 2);
  p.mixed = (bf16_t*)r2;
  p.act = (bf16_t*)r2;
  p.ssq = (float*)take((size_t)NTOK * 16 * 4);
  p.wlist = (float*)take((size_t)16 * NTOK * 4);
  p.list = (int*)take((size_t)16 * NTOK * 4);
  p.tokinfo = (int*)take((size_t)NTOK * 4 * 4);
  p.counts = (int*)take(256);
  p.Wr_eh = (bf16_t*)take(16384 * 2); p.Wr_el = (bf16_t*)take(16384 * 2);
  p.Wr_gh = (bf16_t*)take(16384 * 2); p.Wr_gl = (bf16_t*)take(16384 * 2);
  p.bar = (unsigned*)take(XCD_BAR_WORDS * 4);
#if MEGA
  static int grid_blocks = 0;
  if (!grid_blocks) {
    int dev = 0, cus = 0, per_cu = 0;
    hipGetDevice(&dev);
    hipDeviceGetAttribute(&cus, hipDeviceAttributeMultiprocessorCount, dev);
    hipOccupancyMaxActiveBlocksPerMultiprocessor(&per_cu, mega_kernel, 256, 0);
    if (per_cu > 2) per_cu = 2;
    grid_blocks = cus * per_cu;
  }
  (void)hipMemsetAsync(p.bar, 0, XCD_BAR_WORDS * 4, stream);
  void* args[] = {&p};
  hipError_t e = hipLaunchCooperativeKernel((void*)mega_kernel, dim3(grid_blocks), dim3(256), args, 0, stream);
  if (e != hipSuccess) fprintf(stderr, "cooperative launch failed: %s (grid %d)\n", hipGetErrorString(e), grid_blocks);
#else
  const int G = 512;
  phase_kernel<0><<<G, 256, 0, stream>>>(p, 0);
  for (int l = 0; l < 4; ++l) {
    phase_kernel<1><<<G, 256, 0, stream>>>(p, l);
    phase_kernel<2><<<G, 256, 0, stream>>>(p, l);
    phase_kernel<3><<<G, 256, 0, stream>>>(p, l);
    phase_kernel<4><<<G, 256, 0, stream>>>(p, l);
    phase_kernel<5><<<G, 256, 0, stream>>>(p, l);
    phase_kernel<6><<<G, 256, 0, stream>>>(p, l);
    phase_kernel<7><<<G, 256, 0, stream>>>(p, l);
  }
#endif
}
```

```cpp
#include <hip/hip_runtime.h>
#include <hip/hip_cooperative_groups.h>
#include <stdint.h>
#include <cstdio>
namespace cg = cooperative_groups;

#ifndef MEGA
#define MEGA 1
#endif
#define DUP_PH 0

typedef unsigned short bf16_t;
typedef short bf16x8 __attribute__((ext_vector_type(8)));
typedef float f32x4 __attribute__((ext_vector_type(4)));
typedef unsigned u32x4 __attribute__((ext_vector_type(4)));
typedef unsigned u32x2 __attribute__((ext_vector_type(2)));

#define NTOK 16384
#define LN_EPS 1e-5f
#define ALPHA 1.681792830507429f
#define NCONV_ITEMS 1009
#define SMEM_BYTES 69632

struct Params {
  const float *x, *w_in, *w_out, *rel_bias, *sgu_ln_g, *sgu_ln_b, *sgu_w, *sgu_b, *mix_g, *ln1_g, *ln1_b,
      *rg_w, *rg_b, *re_w, *re_b, *w_gate, *w_up, *w_down, *ln2_g, *ln2_b;
  float* out;
  bf16_t *Wt_in, *Wt_out, *Wgu, *Wdn, *Wsgu, *xb, *qk, *vT, *ub, *vnT, *mixed, *act, *y, *hb;
  float *x1, *ssq, *wlist;
  bf16_t *Wr_eh, *Wr_el, *Wr_gh, *Wr_gl;
  int *counts, *list, *tokinfo;
  unsigned* bar;
  int never;
  int pad_;
};

__device__ __forceinline__ unsigned cvt_pk_bf16(float lo, float hi) {
  unsigned r; asm("v_cvt_pk_bf16_f32 %0, %1, %2" : "=v"(r) : "v"(lo), "v"(hi)); return r;
}
__device__ __forceinline__ void store_bf16x4(bf16_t* p, float a, float b, float c, float d) {
  u32x2 v; v.x = cvt_pk_bf16(a, b); v.y = cvt_pk_bf16(c, d); *(u32x2*)p = v;
}
__device__ __forceinline__ float gelu_tanh(float x) {
  const float t = x * (-2.302208198f + -0.102943249f * (x * x));
  return x * __builtin_amdgcn_rcpf(1.0f + __builtin_amdgcn_exp2f(t));
}
__device__ __forceinline__ int otid() { int t = threadIdx.x; asm volatile("" : "+v"(t)); return t; }
__device__ __forceinline__ float silu(float x) { return x * __builtin_amdgcn_rcpf(1.0f + __builtin_amdgcn_exp2f(-1.442695041f * x)); }
template <int CTRL>
__device__ __forceinline__ float dpp_mov(float v) {
  return __builtin_bit_cast(float, __builtin_amdgcn_update_dpp(0, __builtin_bit_cast(int, v), CTRL, 0xf, 0xf, true));
}
__device__ __forceinline__ float row16_sum(float v) {
  v += dpp_mov<0xB1>(v); v += dpp_mov<0x4E>(v); v += dpp_mov<0x141>(v); v += dpp_mov<0x140>(v); return v;
}
__device__ __forceinline__ float wave_sum(float v) {
  v = row16_sum(v); v += __shfl_xor(v, 16); v += __shfl_xor(v, 32); return v;
}

struct NoMid { __device__ __forceinline__ void operator()(f32x4 (&)[4][4]) const {} };
struct MidScale {
  float s[4];
  __device__ __forceinline__ void operator()(f32x4 (&acc)[4][4]) const {
#pragma unroll
    for (int i = 0; i < 4; ++i)
#pragma unroll
      for (int j = 0; j < 4; ++j) acc[i][j] *= s[i];
  }
};

#define GLDS16(gptr, lptr) __builtin_amdgcn_global_load_lds((const unsigned*)(gptr), (__attribute__((address_space(3))) unsigned*)(lptr), 16, 0, 0)

__device__ __forceinline__ void gemm_issue0(unsigned char* smem, const bf16_t* pa0, const bf16_t* pa1, const bf16_t* pa2,
                                            const bf16_t* pa3, const bf16_t* pb0, const bf16_t* pb1, const bf16_t* pb2,
                                            const bf16_t* pb3) {
  const int tid = otid(), wid = tid >> 6, srow = tid >> 3;
  const int lch = ((tid & 7) ^ ((srow >> 1) & 7)) * 8 - (tid & 7) * 8;
  unsigned char* d = smem + __builtin_amdgcn_readfirstlane(wid) * 1024;
  GLDS16(pa0 + lch, d); GLDS16(pa1 + lch, d + 4096); GLDS16(pa2 + lch, d + 8192); GLDS16(pa3 + lch, d + 12288);
  GLDS16(pb0 + lch, d + 16384); GLDS16(pb1 + lch, d + 20480); GLDS16(pb2 + lch, d + 24576); GLDS16(pb3 + lch, d + 28672);
}

template <bool PRE = false, class Mid>
__device__ __forceinline__ void gemm_main(unsigned char* smem, const bf16_t* pa0, const bf16_t* pa1, const bf16_t* pa2,
                                          const bf16_t* pa3, const bf16_t* pb0, const bf16_t* pb1, const bf16_t* pb2,
                                          const bf16_t* pb3, int nk, int kmid, bool swapped, f32x4 (&acc)[4][4],
                                          const Mid& mid) {
  const int tid = otid(), lane = tid & 63, wid = tid >> 6, wr = wid >> 1, wc = wid & 1;
  const int srow = tid >> 3;
  const int lch = ((tid & 7) ^ ((srow >> 1) & 7)) * 8 - (tid & 7) * 8;
  pa0 += lch; pa1 += lch; pa2 += lch; pa3 += lch; pb0 += lch; pb1 += lch; pb2 += lch; pb3 += lch;
  const int soff = __builtin_amdgcn_readfirstlane(wid) * 1024;
  const int qi = lane & 15, g = lane >> 4, s = qi >> 1;
  const int aside = swapped ? 16384 : 0, bside = swapped ? 0 : 16384;
  const int offA0 = aside + (wr * 64 + qi) * 128 + (((0 + g) ^ s) << 4);
  const int offA1 = aside + (wr * 64 + qi) * 128 + (((4 + g) ^ s) << 4);
  const int offB0 = bside + (wc * 64 + qi) * 128 + (((0 + g) ^ s) << 4);
  const int offB1 = bside + (wc * 64 + qi) * 128 + (((4 + g) ^ s) << 4);
  if (!PRE) {
    unsigned char* d = smem + soff;
    GLDS16(pa0, d); GLDS16(pa1, d + 4096); GLDS16(pa2, d + 8192); GLDS16(pa3, d + 12288);
    GLDS16(pb0, d + 16384); GLDS16(pb1, d + 20480); GLDS16(pb2, d + 24576); GLDS16(pb3, d + 28672);
  }
  asm volatile("s_waitcnt vmcnt(0)" ::: "memory");
  __syncthreads();
  for (int kt = 0; kt < nk; ++kt) {
    unsigned char* buf = smem + ((kt & 1) << 15);
    if (kt + 1 < nk) {
      const int ko = (kt + 1) * 64;
      unsigned char* d = smem + (((kt + 1) & 1) << 15) + soff;
      GLDS16(pa0 + ko, d); GLDS16(pa1 + ko, d + 4096); GLDS16(pa2 + ko, d + 8192); GLDS16(pa3 + ko, d + 12288);
      GLDS16(pb0 + ko, d + 16384); GLDS16(pb1 + ko, d + 20480); GLDS16(pb2 + ko, d + 24576); GLDS16(pb3 + ko, d + 28672);
    }
    if (kt == kmid) mid(acc);
    {
      bf16x8 af0[4], bf0[4], af1[4], bf1[4];
#pragma unroll
      for (int i = 0; i < 4; ++i) af0[i] = *(const bf16x8*)(buf + offA0 + i * 2048);
#pragma unroll
      for (int j = 0; j < 4; ++j) bf0[j] = *(const bf16x8*)(buf + offB0 + j * 2048);
#pragma unroll
      for (int i = 0; i < 4; ++i) af1[i] = *(const bf16x8*)(buf + offA1 + i * 2048);
#pragma unroll
      for (int j = 0; j < 4; ++j) bf1[j] = *(const bf16x8*)(buf + offB1 + j * 2048);
      asm volatile("s_waitcnt lgkmcnt(8)" ::: "memory");
      __builtin_amdgcn_s_setprio(1);
#pragma unroll
      for (int i = 0; i < 4; ++i)
#pragma unroll
        for (int j = 0; j < 4; ++j) acc[i][j] = __builtin_amdgcn_mfma_f32_16x16x32_bf16(bf0[j], af0[i], acc[i][j], 0, 0, 0);
      asm volatile("s_waitcnt lgkmcnt(0)" ::: "memory");
#pragma unroll
      for (int i = 0; i < 4; ++i)
#pragma unroll
        for (int j = 0; j < 4; ++j) acc[i][j] = __builtin_amdgcn_mfma_f32_16x16x32_bf16(bf1[j], af1[i], acc[i][j], 0, 0, 0);
      __builtin_amdgcn_s_setprio(0);
    }
    asm volatile("s_waitcnt vmcnt(0)" ::: "memory");
    __syncthreads();
  }
}

#define ZERO_ACC(acc)                                   \
  _Pragma("unroll") for (int i_ = 0; i_ < 4; ++i_)      \
  _Pragma("unroll") for (int j_ = 0; j_ < 4; ++j_) acc[i_][j_] = (f32x4){0.f, 0.f, 0.f, 0.f};

__device__ void conv_x(const Params& p, int bid, int nblk) {
  const size_t n8 = (size_t)NTOK * 1024 / 8;
#pragma unroll 4
  for (size_t i = (size_t)bid * 256 + threadIdx.x; i < n8; i += (size_t)nblk * 256) {
    const f32x4 a_ = __builtin_nontemporal_load((const f32x4*)(p.x + i * 8)), b_ = __builtin_nontemporal_load((const f32x4*)(p.x + i * 8 + 4));
    float4 a, b; a.x = a_[0]; a.y = a_[1]; a.z = a_[2]; a.w = a_[3]; b.x = b_[0]; b.y = b_[1]; b.z = b_[2]; b.w = b_[3];
    u32x4 v; v.x = cvt_pk_bf16(a.x, a.y); v.y = cvt_pk_bf16(a.z, a.w); v.z = cvt_pk_bf16(b.x, b.y); v.w = cvt_pk_bf16(b.z, b.w);
    *(u32x4*)(p.xb + i * 8) = v;
  }
}

__device__ void tconv_tile(float* tile, const float* src, int src_ld, const float* kscale, bf16_t* dst, int dst_ld, int rstep) {
  const int t = otid();
  {
    const int k0 = t >> 6, n4 = (t & 63) * 4;
    float4 v[16];
#pragma unroll
    for (int i = 0; i < 16; ++i) {
      const f32x4 tv = __builtin_nontemporal_load((const f32x4*)(src + (size_t)(k0 + 4 * i) * src_ld + n4));
      v[i].x = tv[0]; v[i].y = tv[1]; v[i].z = tv[2]; v[i].w = tv[3];
    }
    if (kscale) {
#pragma unroll
      for (int i = 0; i < 16; ++i) { const float sc = kscale[k0 + 4 * i]; v[i].x *= sc; v[i].y *= sc; v[i].z *= sc; v[i].w *= sc; }
    }
#pragma unroll
    for (int i = 0; i < 16; ++i) *(float4*)(tile + (k0 + 4 * i) * 260 + n4) = v[i];
  }
  __syncthreads();
  {
    const int n = t;
    bf16_t* o = dst + (size_t)((n >> 4) * rstep + (n & 15)) * dst_ld;
#pragma unroll
    for (int c = 0; c < 8; ++c) {
      float f[8];
#pragma unroll
      for (int q = 0; q < 8; ++q) f[q] = tile[(c * 8 + q) * 260 + n];
      u32x4 v0;
      v0.x = cvt_pk_bf16(f[0], f[1]); v0.y = cvt_pk_bf16(f[2], f[3]); v0.z = cvt_pk_bf16(f[4], f[5]); v0.w = cvt_pk_bf16(f[6], f[7]);
      *(u32x4*)(o + c * 8) = v0;
    }
  }
  __syncthreads();
}

__device__ void conv_item(const Params& p, int l, int it, unsigned char* smem) {
  float* tile = (float*)smem;
  if (it < 160) {
    const int kt = it / 10, ntile = it % 10;
    tconv_tile(tile, p.w_in + (size_t)l * 1024 * 2560 + (size_t)kt * 64 * 2560 + ntile * 256, 2560, nullptr,
               p.Wt_in + (size_t)ntile * 256 * 1024 + kt * 64, 1024, 16);
  } else if (it < 224) {
    const int r = it - 160, kt = r >> 2, ntile = r & 3;
    tconv_tile(tile, p.w_out + (size_t)l * 1024 * 1024 + (size_t)kt * 64 * 1024 + ntile * 256, 1024, p.mix_g + l * 1024 + kt * 64,
               p.Wt_out + (size_t)ntile * 256 * 1024 + kt * 64, 1024, 16);
  } else if (it < 736) {
    const int r0 = it - 224, e = r0 >> 5, r = r0 & 31, which = r >> 4, kt = r & 15;
    const float* src = (which ? p.w_up : p.w_gate) + (size_t)(l * 16 + e) * 1024 * 256 + (size_t)kt * 64 * 256;
    tconv_tile(tile, src, 256, nullptr, p.Wgu + (size_t)e * 512 * 1024 + (size_t)(which * 16) * 1024 + kt * 64, 1024, 32);
  } else if (it < 992) {
    const int r0 = it - 736, e = r0 >> 4, r = r0 & 15, kt = r >> 2, ntile = r & 3;
    tconv_tile(tile, p.w_down + (size_t)(l * 16 + e) * 256 * 1024 + (size_t)kt * 64 * 1024 + ntile * 256, 1024, nullptr,
               p.Wdn + (size_t)e * 1024 * 256 + (size_t)ntile * 256 * 256 + kt * 64, 256, 16);
  } else if (it == 1008) {
    for (int i = threadIdx.x; i < 16384; i += 256) {
      const int jj = i & 7, j = (i >> 3) & 15, g = (i >> 7) & 3, kb = i >> 9;
      const int k = 32 * kb + 8 * g + jj;
      const float we = p.re_w[(size_t)(l * 1024 + k) * 16 + j];
      const float wg = (j < 4) ? p.rg_w[(size_t)(l * 1024 + k) * 4 + j] : 0.0f;
      const unsigned eh = cvt_pk_bf16(we, 0.f) & 0xffffu, gh = cvt_pk_bf16(wg, 0.f) & 0xffffu;
      const unsigned el = cvt_pk_bf16(we - __uint_as_float(eh << 16), 0.f) & 0xffffu;
      const unsigned gl = cvt_pk_bf16(wg - __uint_as_float(gh << 16), 0.f) & 0xffffu;
      p.Wr_eh[i] = (bf16_t)eh; p.Wr_el[i] = (bf16_t)el; p.Wr_gh[i] = (bf16_t)gh; p.Wr_gl[i] = (bf16_t)gl;
    }
  } else {
    const int j = it - 992;
    const float* src = p.sgu_w + (size_t)l * 131072 + (size_t)j * 8192 + threadIdx.x * 32;
    bf16_t* dst = p.Wsgu + (size_t)j * 8192 + threadIdx.x * 32;
#pragma unroll
    for (int q = 0; q < 4; ++q) {
      const float4 a = *(const float4*)(src + q * 8), b = *(const float4*)(src + q * 8 + 4);
      u32x4 v; v.x = cvt_pk_bf16(a.x, a.y); v.y = cvt_pk_bf16(a.z, a.w); v.z = cvt_pk_bf16(b.x, b.y); v.w = cvt_pk_bf16(b.z, b.w);
      *(u32x4*)(dst + q * 8) = v;
    }
  }
}

__device__ __forceinline__ void p1_decode(int t, int& mt, int& nt) {
  const int x_ = t & 7, j_ = t >> 3, rd_ = j_ >> 6, lb_ = j_ & 63;
  mt = (rd_ < 4) ? (x_ * 16 + (rd_ & 1) * 8 + (lb_ & 7)) : (x_ * 16 + (lb_ & 15));
  nt = (rd_ < 4) ? ((rd_ >> 1) * 8 + (lb_ >> 3)) : (16 + (lb_ >> 4));
}
__device__ __forceinline__ void p1_epilogue(const Params& p, int l, int mt, int nt, f32x4 (&acc)[4][4]) {
  const int type = nt >> 2;
  const bool swapped = (type == 2) || (type == 4);
  const int tid = otid(), lane = tid & 63, wid = tid >> 6, wr = wid >> 1, wc = wid & 1;
  const int qi = lane & 15, g = lane >> 4;
  if (!swapped) {
#pragma unroll
    for (int i = 0; i < 4; ++i) {
      const int m = mt * 128 + wr * 64 + i * 16 + qi;
#pragma unroll
      for (int j = 0; j < 4; ++j) {
        const int n = nt * 128 + wc * 64 + j * 16 + 4 * g;
        f32x4 v = acc[i][j];
        if (type == 0) v *= 0.125f;
        if (type == 3) { v[0] = gelu_tanh(v[0]); v[1] = gelu_tanh(v[1]); v[2] = gelu_tanh(v[2]); v[3] = gelu_tanh(v[3]); }
        bf16_t* dst = (type == 3) ? (p.ub + (size_t)m * 512 + (n - 1536)) : (p.qk + (size_t)m * 1024 + n);
        store_bf16x4(dst, v[0], v[1], v[2], v[3]);
      }
    }
  } else {
    const int bidx = (mt * 128) >> 12, tokbase = (mt * 128) & 4095;
    bf16_t* dstb = (type == 2) ? p.vT : p.vnT;
    const int fbase = (type == 2) ? 1024 : 2048;
    if (type == 4) {
#pragma unroll
      for (int i = 0; i < 4; ++i)
#pragma unroll
        for (int j = 0; j < 4; ++j)
#pragma unroll
          for (int r = 0; r < 4; ++r) acc[i][j][r] = gelu_tanh(acc[i][j][r]);
      float gam[4], bet[4];
#pragma unroll
      for (int i = 0; i < 4; ++i) {
        const int f = nt * 128 + wr * 64 + i * 16 + qi - 2048;
        gam[i] = p.sgu_ln_g[l * 512 + f]; bet[i] = p.sgu_ln_b[l * 512 + f];
      }
#pragma unroll
      for (int j = 0; j < 4; ++j)
#pragma unroll
        for (int r = 0; r < 4; ++r) {
          float s1 = acc[0][j][r] + acc[1][j][r] + acc[2][j][r] + acc[3][j][r];
          s1 = row16_sum(s1);
          const float mu = s1 * (1.0f / 64.0f);
          float s2 = 0.f;
#pragma unroll
          for (int i = 0; i < 4; ++i) { const float d = acc[i][j][r] - mu; s2 += d * d; }
          s2 = row16_sum(s2);
          const float rstd = rsqrtf(s2 * (1.0f / 64.0f) + LN_EPS);
#pragma unroll
          for (int i = 0; i < 4; ++i) acc[i][j][r] = (acc[i][j][r] - mu) * rstd * gam[i] + bet[i];
        }
    }
#pragma unroll
    for (int i = 0; i < 4; ++i) {
      const int f = nt * 128 + wr * 64 + i * 16 + qi - fbase;
#pragma unroll
      for (int j = 0; j < 4; ++j) {
        const int tok = tokbase + wc * 64 + j * 16 + 4 * g;
        store_bf16x4(dstb + ((size_t)(bidx * 512 + f)) * 4096 + tok, acc[i][j][0], acc[i][j][1], acc[i][j][2], acc[i][j][3]);
      }
    }
  }
}


__device__ void p1_phase(const Params& p, int l, int bid, int nblk, unsigned char* smem) {
  const int tid0 = otid();
  int t = bid, mt = 0, nt = 0;
  const bf16_t* A = nullptr; const bf16_t* B = nullptr;
  if (t < 2560) {
    p1_decode(t, mt, nt);
    A = p.xb + (size_t)(mt * 128 + (tid0 >> 3)) * 1024 + (tid0 & 7) * 8;
    B = p.Wt_in + (size_t)(nt * 128 + (tid0 >> 3)) * 1024 + (tid0 & 7) * 8;
    __syncthreads();
    gemm_issue0(smem, A, A + 32 * 1024, A + 64 * 1024, A + 96 * 1024, B, B + 32 * 1024, B + 64 * 1024, B + 96 * 1024);
  }
  while (t < 2560) {
    const int type = nt >> 2;
    const bool swapped = (type == 2) || (type == 4);
    f32x4 acc[4][4];
    ZERO_ACC(acc);
    gemm_main<true>(smem, A, A + 32 * 1024, A + 64 * 1024, A + 96 * 1024, B, B + 32 * 1024, B + 64 * 1024, B + 96 * 1024, 16, -1, swapped, acc, NoMid());
    const int tn = t + nblk;
    int mtn = mt, ntn = nt;
    if (tn < 2560) {
      p1_decode(tn, mtn, ntn);
      const int tid = otid();
      A = p.xb + (size_t)(mtn * 128 + (tid >> 3)) * 1024 + (tid & 7) * 8;
      B = p.Wt_in + (size_t)(ntn * 128 + (tid >> 3)) * 1024 + (tid & 7) * 8;
      gemm_issue0(smem, A, A + 32 * 1024, A + 64 * 1024, A + 96 * 1024, B, B + 32 * 1024, B + 64 * 1024, B + 96 * 1024);
    }
    p1_epilogue(p, l, mt, nt, acc);
    mt = mtn; nt = ntn; t = tn;
  }
}

__device__ void attn_phase(const Params& p, int l, int bid, int nblk, unsigned char* smem) {
  const int tid = otid(), lane = tid & 63, w = tid >> 6, qi = lane & 15, g = lane >> 4;
  unsigned char* Kb = smem;
  unsigned char* Vb = smem + 32768;
  float* sbias = (float*)(smem + 32768 + 33792);
  const int c0 = (w == 0) ? 0 : (w == 1) ? 8 : (w == 2) ? 24 : 32;
  const int cq = 16 * w + qi, cs = min(max(cq - 8, 0), 48);
  const int krow = tid >> 3, kch = tid & 7;
  const int ksoff = krow * 128 + ((kch ^ ((krow >> 1) & 7)) << 4);
  const int vd = tid >> 5, vc = tid & 31;
  const int vsoff = vd * 528 + vc * 16;
  u32x4 st[8], st2[8];
#define ATT_ISSUE_K(it_)                                                                                              \
  do {                                                                                                                \
    const int h_ = (it_) & 7, br_ = (it_) >> 3, r_ = br_ & 63, b_ = br_ >> 6, rs_ = min(max(r_ - 4, 0), 56);          \
    const bf16_t* kg_ = p.qk + ((size_t)b_ * 4096 + rs_ * 64 + krow) * 1024 + 512 + h_ * 64 + kch * 8;                \
    _Pragma("unroll") for (int i = 0; i < 8; ++i) st[i] = *(const u32x4*)(kg_ + (size_t)(32 * i) * 1024);            \
    _Pragma("unroll") for (int i = 0; i < 8; ++i) st2[i] = *(const u32x4*)(kg_ + (size_t)(256 + 32 * i) * 1024);     \
  } while (0)
  int it = bid;
  if (it < 2048) ATT_ISSUE_K(it);
  while (it < 2048) {
    const int h = it & 7, br = it >> 3, r = br & 63, b = br >> 6;
    const int rs = min(max(r - 4, 0), 56);
    const size_t tokq = (size_t)b * 4096 + r * 64 + cq;
    const bf16_t* vg = p.vT + ((size_t)(b * 512 + h * 64 + vd)) * 4096 + rs * 64 + vc * 8;
    const float rb0 = p.rel_bias[(size_t)(l * 8 + h) * 465 + tid];
    const float rb1 = p.rel_bias[(size_t)(l * 8 + h) * 465 + min(tid + 256, 464)];
    bf16x8 qf0 = *(const bf16x8*)(p.qk + tokq * 1024 + h * 64 + g * 8);
    bf16x8 qf1 = *(const bf16x8*)(p.qk + tokq * 1024 + h * 64 + 32 + g * 8);
    __syncthreads();
    sbias[tid] = rb0;
    if (tid + 256 < 465) sbias[tid + 256] = rb1;
#pragma unroll
    for (int i = 0; i < 8; ++i) *(u32x4*)(Kb + ksoff + i * 4096) = st[i];
#pragma unroll
    for (int i = 0; i < 8; ++i) st[i] = *(const u32x4*)(vg + (size_t)(8 * i) * 4096);
    __syncthreads();
    f32x4 s[8][2];
#pragma unroll
    for (int jh = 0; jh < 2; ++jh) {
#pragma unroll
      for (int jj = 0; jj < 4; ++jj)
#pragma unroll
        for (int ch = 0; ch < 2; ++ch) {
          const int kl = jj * 64 + c0 + 16 * ch + qi;
          const int sw = (kl >> 1) & 7;
          const bf16x8 kf0 = *(const bf16x8*)(Kb + kl * 128 + (((0 + g) ^ sw) << 4));
          const bf16x8 kf1 = *(const bf16x8*)(Kb + kl * 128 + (((4 + g) ^ sw) << 4));
          f32x4 a = {0.f, 0.f, 0.f, 0.f};
          a = __builtin_amdgcn_mfma_f32_16x16x32_bf16(kf0, qf0, a, 0, 0, 0);
          a = __builtin_amdgcn_mfma_f32_16x16x32_bf16(kf1, qf1, a, 0, 0, 0);
          s[jh * 4 + jj][ch] = a;
        }
      if (jh == 0) {
        __syncthreads();
#pragma unroll
        for (int i = 0; i < 8; ++i) *(u32x4*)(Kb + ksoff + i * 4096) = st2[i];
#pragma unroll
        for (int i = 0; i < 8; ++i) st2[i] = *(const u32x4*)(vg + (size_t)(8 * i) * 4096 + 256);
        __syncthreads();
      }
    }
#pragma unroll
    for (int i = 0; i < 8; ++i) *(u32x4*)(Vb + vsoff + i * 8 * 528) = st[i];
    float mx = -1e30f;
#pragma unroll
    for (int j = 0; j < 8; ++j)
#pragma unroll
      for (int ch = 0; ch < 2; ++ch)
#pragma unroll
        for (int rg = 0; rg < 4; ++rg) {
          const int kc = c0 + 16 * ch + 4 * g + rg;
          const bool valid = (kc >= cs) && (kc < cs + 16);
          const int bidx = valid ? ((rs + j - r + 7) * 31 + (kc - cq) + 15) : 0;
          const float v = valid ? (s[j][ch][rg] + sbias[bidx]) : -1e30f;
          s[j][ch][rg] = v;
          mx = fmaxf(mx, v);
        }
    mx = fmaxf(mx, __shfl_xor(mx, 16)); mx = fmaxf(mx, __shfl_xor(mx, 32));
    float sum = 0.f;
#pragma unroll
    for (int j = 0; j < 8; ++j)
#pragma unroll
      for (int ch = 0; ch < 2; ++ch)
#pragma unroll
        for (int rg = 0; rg < 4; ++rg) { const float e = __expf(s[j][ch][rg] - mx); s[j][ch][rg] = e; sum += e; }
    sum += __shfl_xor(sum, 16); sum += __shfl_xor(sum, 32);
    const float inv = 1.0f / sum;
    bf16x8 pf[8];
#pragma unroll
    for (int j = 0; j < 8; ++j) {
      u32x4 pw;
      pw.x = cvt_pk_bf16(s[j][0][0], s[j][0][1]); pw.y = cvt_pk_bf16(s[j][0][2], s[j][0][3]);
      pw.z = cvt_pk_bf16(s[j][1][0], s[j][1][1]); pw.w = cvt_pk_bf16(s[j][1][2], s[j][1][3]);
      pf[j] = __builtin_bit_cast(bf16x8, pw);
    }
    f32x4 o[4];
#pragma unroll
    for (int dt = 0; dt < 4; ++dt) o[dt] = (f32x4){0.f, 0.f, 0.f, 0.f};
    const int itn = it + nblk;
    __syncthreads();
#pragma unroll
    for (int jh = 0; jh < 2; ++jh) {
#pragma unroll
      for (int jj = 0; jj < 4; ++jj)
#pragma unroll
        for (int dt = 0; dt < 4; ++dt) {
          const unsigned char* vp = Vb + (dt * 16 + qi) * 528 + (jj * 64 + c0 + 4 * g) * 2;
          const u32x2 lo = *(const u32x2*)vp, hi = *(const u32x2*)(vp + 32);
          u32x4 vw; vw.x = lo.x; vw.y = lo.y; vw.z = hi.x; vw.w = hi.y;
          o[dt] = __builtin_amdgcn_mfma_f32_16x16x32_bf16(__builtin_bit_cast(bf16x8, vw), pf[jh * 4 + jj], o[dt], 0, 0, 0);
        }
      if (jh == 0) {
        __syncthreads();
#pragma unroll
        for (int i = 0; i < 8; ++i) *(u32x4*)(Vb + vsoff + i * 8 * 528) = st2[i];
        if (itn < 2048) ATT_ISSUE_K(itn);
        __syncthreads();
      }
    }
    float sq = 0.f;
#pragma unroll
    for (int dt = 0; dt < 4; ++dt) {
      o[dt] *= inv;
      sq += o[dt][0] * o[dt][0] + o[dt][1] * o[dt][1] + o[dt][2] * o[dt][2] + o[dt][3] * o[dt][3];
      store_bf16x4(p.mixed + tokq * 1024 + h * 64 + dt * 16 + 4 * g, o[dt][0], o[dt][1], o[dt][2], o[dt][3]);
    }
    sq += __shfl_xor(sq, 16); sq += __shfl_xor(sq, 32);
    if (g == 0) p.ssq[tokq * 16 + h] = sq;
    it = itn;
  }
#undef ATT_ISSUE_K
}

__device__ void sgu_item(const Params& p, int l, int it, unsigned char* smem) {
  const int grp = it & 7, bc = it >> 3, chunk = bc & 31, b = bc >> 5;
  const int tid = otid(), lane = tid & 63, w = tid >> 6, qi = lane & 15, g = lane >> 4;
  const int p0 = 32 * w;
  const int wbase = __builtin_amdgcn_readfirstlane(w) * 1024;
  const int lc = ((tid & 15) ^ ((tid >> 4) & 15)) << 3;
  const bf16_t* wsrc = p.Wsgu + ((size_t)(grp * 128 + (tid >> 4))) * 128 + lc;
  const bf16_t* vsrc = p.vnT + ((size_t)(b * 512 + grp * 64 + (tid >> 4))) * 4096 + chunk * 128 + lc;
  __syncthreads();
#pragma unroll
  for (int i = 0; i < 8; ++i) GLDS16(wsrc + (size_t)(16 * i) * 128, smem + i * 4096 + wbase);
#pragma unroll
  for (int i = 0; i < 4; ++i) GLDS16(vsrc + (size_t)(16 * i) * 4096, smem + 32768 + i * 4096 + wbase);
  asm volatile("s_waitcnt vmcnt(0)" ::: "memory");
  __syncthreads();
  f32x4 acc[2][4];
#pragma unroll
  for (int mt = 0; mt < 2; ++mt)
#pragma unroll
    for (int nt = 0; nt < 4; ++nt) acc[mt][nt] = (f32x4){0.f, 0.f, 0.f, 0.f};
#pragma unroll
  for (int ks = 0; ks < 4; ++ks) {
    const int co = ((ks * 4 + g) ^ qi) << 4;
    bf16x8 wf[2], vf[4];
#pragma unroll
    for (int mt = 0; mt < 2; ++mt) wf[mt] = *(const bf16x8*)(smem + (p0 + 16 * mt + qi) * 256 + co);
#pragma unroll
    for (int nt = 0; nt < 4; ++nt) vf[nt] = *(const bf16x8*)(smem + 32768 + (16 * nt + qi) * 256 + co);
#pragma unroll
    for (int mt = 0; mt < 2; ++mt)
#pragma unroll
      for (int nt = 0; nt < 4; ++nt) acc[mt][nt] = __builtin_amdgcn_mfma_f32_16x16x32_bf16(vf[nt], wf[mt], acc[mt][nt], 0, 0, 0);
  }
#pragma unroll
  for (int mt = 0; mt < 2; ++mt) {
    const int pp = p0 + 16 * mt + qi;
    const size_t tok = (size_t)b * 4096 + chunk * 128 + pp;
    const float bias = p.sgu_b[(size_t)(l * 8 + grp) * 128 + pp];
    float sq = 0.f;
#pragma unroll
    for (int nt = 0; nt < 4; ++nt) {
      const int d = 16 * nt + 4 * g;
      const u32x2 uu = *(const u32x2*)(p.ub + tok * 512 + grp * 64 + d);
      const float u0 = __uint_as_float(uu.x << 16), u1 = __uint_as_float(uu.x & 0xffff0000u);
      const float u2 = __uint_as_float(uu.y << 16), u3 = __uint_as_float(uu.y & 0xffff0000u);
      const float v0 = u0 * (acc[mt][nt][0] + bias), v1 = u1 * (acc[mt][nt][1] + bias);
      const float v2 = u2 * (acc[mt][nt][2] + bias), v3 = u3 * (acc[mt][nt][3] + bias);
      sq += v0 * v0 + v1 * v1 + v2 * v2 + v3 * v3;
      store_bf16x4(p.mixed + tok * 1024 + 512 + grp * 64 + d, v0, v1, v2, v3);
    }
    sq += __shfl_xor(sq, 16); sq += __shfl_xor(sq, 32);
    if (g == 0) p.ssq[tok * 16 + 8 + grp] = sq;
  }
}

__device__ void p3_tile(const Params& p, int l, int t, unsigned char* smem) {
  const int x_ = t & 7, j_ = t >> 3, rd_ = j_ >> 6, lb_ = j_ & 63;
  const int mt = x_ * 16 + rd_ * 8 + (lb_ & 7), nt = lb_ >> 3;
  const int tid = otid(), lane = tid & 63, wid = tid >> 6, wr = wid >> 1, wc = wid & 1;
  const int srow = tid >> 3, sch = tid & 7, qi = lane & 15, g = lane >> 4;
  const bf16_t* A = p.mixed + (size_t)(mt * 128 + srow) * 1024 + sch * 8;
  const bf16_t* B = p.Wt_out + (size_t)(nt * 128 + srow) * 1024 + sch * 8;
  MidScale mid; float rss[4];
#pragma unroll
  for (int i = 0; i < 4; ++i) {
    const int m = mt * 128 + wr * 64 + i * 16 + qi;
    const float4 a0 = *(const float4*)(p.ssq + (size_t)m * 16), a1 = *(const float4*)(p.ssq + (size_t)m * 16 + 4);
    const float4 b0 = *(const float4*)(p.ssq + (size_t)m * 16 + 8), b1 = *(const float4*)(p.ssq + (size_t)m * 16 + 12);
    const float sa = (a0.x + a0.y + a0.z + a0.w) + (a1.x + a1.y + a1.z + a1.w);
    const float sb = (b0.x + b0.y + b0.z + b0.w) + (b1.x + b1.y + b1.z + b1.w);
    const float ra = rsqrtf(sa * (1.0f / 512.0f) + LN_EPS), rb = rsqrtf(sb * (1.0f / 512.0f) + LN_EPS);
    mid.s[i] = ra / rb; rss[i] = rb;
  }
  f32x4 acc[4][4];
  ZERO_ACC(acc);
  gemm_main(smem, A, A + 32 * 1024, A + 64 * 1024, A + 96 * 1024, B, B + 32 * 1024, B + 64 * 1024, B + 96 * 1024, 16, 8, false, acc, mid);
#pragma unroll
  for (int i = 0; i < 4; ++i) {
    const int m = mt * 128 + wr * 64 + i * 16 + qi;
#pragma unroll
    for (int j = 0; j < 4; ++j) {
      const int n = nt * 128 + wc * 64 + j * 16 + 4 * g;
      const u32x2 xr = *(const u32x2*)(p.xb + (size_t)m * 1024 + n);
      const float o0 = ALPHA * __uint_as_float(xr.x << 16) + acc[i][j][0] * rss[i];
      const float o1 = ALPHA * __uint_as_float(xr.x & 0xffff0000u) + acc[i][j][1] * rss[i];
      const float o2 = ALPHA * __uint_as_float(xr.y << 16) + acc[i][j][2] * rss[i];
      const float o3 = ALPHA * __uint_as_float(xr.y & 0xffff0000u) + acc[i][j][3] * rss[i];
      store_bf16x4(p.hb + (size_t)m * 1024 + n, o0, o1, o2, o3);
    }
  }
}

__device__ void p4_batch(const Params& p, int l, int batch, unsigned char* smem) {
  const int tid = otid(), lane = tid & 63, w = tid >> 6;
  int* scnt = (int*)smem;
  int* sbase = scnt + 16;
  __syncthreads();
  if (tid < 16) scnt[tid] = 0;
  __syncthreads();
  const int tokw = batch * 32 + w * 8;
  {
    float4 gm[4], bt[4];
#pragma unroll
    for (int q = 0; q < 4; ++q) {
      gm[q] = *(const float4*)(p.ln1_g + l * 1024 + q * 256 + lane * 4);
      bt[q] = *(const float4*)(p.ln1_b + l * 1024 + q * 256 + lane * 4);
    }
#pragma unroll 4
    for (int t = 0; t < 8; ++t) {
      float* xr = p.x1 + (size_t)(tokw + t) * 1024 + lane * 4;
      const bf16_t* hr = p.hb + (size_t)(tokw + t) * 1024 + lane * 4;
      float4 v[4];
#pragma unroll
      for (int q = 0; q < 4; ++q) {
        const u32x2 hh = *(const u32x2*)(hr + q * 256);
        v[q].x = __uint_as_float(hh.x << 16); v[q].y = __uint_as_float(hh.x & 0xffff0000u);
        v[q].z = __uint_as_float(hh.y << 16); v[q].w = __uint_as_float(hh.y & 0xffff0000u);
      }
      float s1 = 0.f;
#pragma unroll
      for (int q = 0; q < 4; ++q) s1 += (v[q].x + v[q].y) + (v[q].z + v[q].w);
      const float mu = wave_sum(s1) * (1.0f / 1024.0f);
      float s2 = 0.f;
#pragma unroll
      for (int q = 0; q < 4; ++q) {
        const float d0 = v[q].x - mu, d1 = v[q].y - mu, d2 = v[q].z - mu, d3 = v[q].w - mu;
        s2 += (d0 * d0 + d1 * d1) + (d2 * d2 + d3 * d3);
      }
      const float rstd = rsqrtf(wave_sum(s2) * (1.0f / 1024.0f) + LN_EPS);
#pragma unroll
      for (int q = 0; q < 4; ++q) {
        float4 o;
        o.x = (v[q].x - mu) * rstd * gm[q].x + bt[q].x; o.y = (v[q].y - mu) * rstd * gm[q].y + bt[q].y;
        o.z = (v[q].z - mu) * rstd * gm[q].z + bt[q].z; o.w = (v[q].w - mu) * rstd * gm[q].w + bt[q].w;
        *(float4*)(xr + q * 256) = o;
        store_bf16x4(p.xb + (size_t)(tokw + t) * 1024 + q * 256 + lane * 4, o.x, o.y, o.z, o.w);
      }
    }
  }
  asm volatile("s_waitcnt vmcnt(0)" ::: "memory");
  __syncthreads();
  const int j = lane & 15, g = lane >> 4;
  float* part = (float*)(smem + 1024);
  {
    const float* xr0 = p.x1 + (size_t)(batch * 32 + j) * 1024 + 256 * w + 8 * g;
    const float* xr1 = xr0 + 16 * 1024;
    const size_t wof = ((size_t)(8 * w * 4 + g) * 16 + j) * 8;
    f32x4 De0 = {0.f, 0.f, 0.f, 0.f}, Dg0 = De0, De1 = De0, Dg1 = De0;
#pragma unroll 2
    for (int kb = 0; kb < 8; ++kb) {
      const float4 xa0 = *(const float4*)(xr0 + kb * 32), xc0 = *(const float4*)(xr0 + kb * 32 + 4);
      const float4 xa1 = *(const float4*)(xr1 + kb * 32), xc1 = *(const float4*)(xr1 + kb * 32 + 4);
      const bf16x8 weh = *(const bf16x8*)(p.Wr_eh + wof + kb * 512), wel = *(const bf16x8*)(p.Wr_el + wof + kb * 512);
      const bf16x8 wgh = *(const bf16x8*)(p.Wr_gh + wof + kb * 512), wgl = *(const bf16x8*)(p.Wr_gl + wof + kb * 512);
      u32x4 h, lo;
      h.x = cvt_pk_bf16(xa0.x, xa0.y); h.y = cvt_pk_bf16(xa0.z, xa0.w); h.z = cvt_pk_bf16(xc0.x, xc0.y); h.w = cvt_pk_bf16(xc0.z, xc0.w);
      lo.x = cvt_pk_bf16(xa0.x - __uint_as_float(h.x << 16), xa0.y - __uint_as_float(h.x & 0xffff0000u));
      lo.y = cvt_pk_bf16(xa0.z - __uint_as_float(h.y << 16), xa0.w - __uint_as_float(h.y & 0xffff0000u));
      lo.z = cvt_pk_bf16(xc0.x - __uint_as_float(h.z << 16), xc0.y - __uint_as_float(h.z & 0xffff0000u));
      lo.w = cvt_pk_bf16(xc0.z - __uint_as_float(h.w << 16), xc0.w - __uint_as_float(h.w & 0xffff0000u));
      bf16x8 xh = __builtin_bit_cast(bf16x8, h), xl = __builtin_bit_cast(bf16x8, lo);
      De0 = __builtin_amdgcn_mfma_f32_16x16x32_bf16(weh, xh, De0, 0, 0, 0);
      Dg0 = __builtin_amdgcn_mfma_f32_16x16x32_bf16(wgh, xh, Dg0, 0, 0, 0);
      De0 = __builtin_amdgcn_mfma_f32_16x16x32_bf16(weh, xl, De0, 0, 0, 0);
      Dg0 = __builtin_amdgcn_mfma_f32_16x16x32_bf16(wgh, xl, Dg0, 0, 0, 0);
      De0 = __builtin_amdgcn_mfma_f32_16x16x32_bf16(wel, xh, De0, 0, 0, 0);
      Dg0 = __builtin_amdgcn_mfma_f32_16x16x32_bf16(wgl, xh, Dg0, 0, 0, 0);
      h.x = cvt_pk_bf16(xa1.x, xa1.y); h.y = cvt_pk_bf16(xa1.z, xa1.w); h.z = cvt_pk_bf16(xc1.x, xc1.y); h.w = cvt_pk_bf16(xc1.z, xc1.w);
      lo.x = cvt_pk_bf16(xa1.x - __uint_as_float(h.x << 16), xa1.y - __uint_as_float(h.x & 0xffff0000u));
      lo.y = cvt_pk_bf16(xa1.z - __uint_as_float(h.y << 16), xa1.w - __uint_as_float(h.y & 0xffff0000u));
      lo.z = cvt_pk_bf16(xc1.x - __uint_as_float(h.z << 16), xc1.y - __uint_as_float(h.z & 0xffff0000u));
      lo.w = cvt_pk_bf16(xc1.z - __uint_as_float(h.w << 16), xc1.w - __uint_as_float(h.w & 0xffff0000u));
      xh = __builtin_bit_cast(bf16x8, h); xl = __builtin_bit_cast(bf16x8, lo);
      De1 = __builtin_amdgcn_mfma_f32_16x16x32_bf16(weh, xh, De1, 0, 0, 0);
      Dg1 = __builtin_amdgcn_mfma_f32_16x16x32_bf16(wgh, xh, Dg1, 0, 0, 0);
      De1 = __builtin_amdgcn_mfma_f32_16x16x32_bf16(weh, xl, De1, 0, 0, 0);
      Dg1 = __builtin_amdgcn_mfma_f32_16x16x32_bf16(wgh, xl, Dg1, 0, 0, 0);
      De1 = __builtin_amdgcn_mfma_f32_16x16x32_bf16(wel, xh, De1, 0, 0, 0);
      Dg1 = __builtin_amdgcn_mfma_f32_16x16x32_bf16(wgl, xh, Dg1, 0, 0, 0);
    }
    float* pw = part + ((size_t)(w * 2) * 64 + lane) * 8;
    *(f32x4*)(pw) = De0; *(f32x4*)(pw + 4) = Dg0;
    *(f32x4*)(pw + 512) = De1; *(f32x4*)(pw + 516) = Dg1;
  }
  __syncthreads();
  const int tok = tokw + (j & 7);
  f32x4 De = {0.f, 0.f, 0.f, 0.f}, Dg = {0.f, 0.f, 0.f, 0.f};
  {
    const int ln = g * 16 + (w & 1) * 8 + (j & 7), tl = w >> 1;
#pragma unroll
    for (int ww = 0; ww < 4; ++ww) {
      const float* pr = part + ((size_t)(ww * 2 + tl) * 64 + ln) * 8;
      De += *(const f32x4*)(pr); Dg += *(const f32x4*)(pr + 4);
    }
  }
  float gl[4];
#pragma unroll
  for (int k = 0; k < 4; ++k) gl[k] = __shfl(Dg[k], j) + p.rg_b[l * 4 + k];
  int gs = 0; float gmax = gl[0];
#pragma unroll
  for (int k = 1; k < 4; ++k) { const bool bb = gl[k] > gmax; gmax = bb ? gl[k] : gmax; gs = bb ? k : gs; }
  float psum = 0.f;
#pragma unroll
  for (int k = 0; k < 4; ++k) psum += __expf(gl[k] - gmax);
  const float gate = 1.0f / psum;
  float es[4];
#pragma unroll
  for (int k = 0; k < 4; ++k) es[k] = De[k] + p.re_b[l * 16 + 4 * g + k];
  int i0 = 0; float v0 = es[0];
#pragma unroll
  for (int k = 1; k < 4; ++k) { const bool bb = es[k] > v0; v0 = bb ? es[k] : v0; i0 = bb ? k : i0; }
  int i1 = 0; float v1 = -3.0e38f;
#pragma unroll
  for (int k = 0; k < 4; ++k) { const bool bb = (k != i0) && (es[k] > v1); v1 = bb ? es[k] : v1; i1 = bb ? k : i1; }
  const float ex = __expf(v1 - v0);
  const float tw0 = 1.0f / (1.0f + ex), tw1 = ex / (1.0f + ex);
  const bool commit = (g == gs) && (j < 8);
  const int e0 = gs * 4 + i0, e1 = gs * 4 + i1;
  int lp0 = 0, lp1 = 0;
  if (commit) { lp0 = atomicAdd(&scnt[e0], 1); lp1 = atomicAdd(&scnt[e1], 1); }
  __syncthreads();
  if (tid < 16) sbase[tid] = atomicAdd(p.counts + l * 16 + tid, scnt[tid]);
  __syncthreads();
  if (commit) {
    const int pos0 = sbase[e0] + lp0, pos1 = sbase[e1] + lp1;
    p.list[e0 * NTOK + pos0] = tok; p.wlist[e0 * NTOK + pos0] = gate * tw0;
    p.list[e1 * NTOK + pos1] = tok; p.wlist[e1 * NTOK + pos1] = gate * tw1;
    int4 ti; ti.x = e0; ti.y = pos0; ti.z = e1; ti.w = pos1;
    *(int4*)(p.tokinfo + (size_t)tok * 4) = ti;
  }
}

__device__ __forceinline__ int moe_total_mtiles(const int* cnts) {
  int tot = 0;
#pragma unroll
  for (int e = 0; e < 16; ++e) tot += (cnts[e] + 127) >> 7;
  return tot;
}
__device__ __forceinline__ void moe_find(const int* cnts, int mi, int& e_out, int& ml, int& off, int& cnt) {
  int rem = mi, o = 0; e_out = 0; ml = 0; off = 0; cnt = 1;
  bool found = false;
#pragma unroll
  for (int e = 0; e < 16; ++e) {
    const int c = cnts[e], mtl = (c + 127) >> 7;
    if (!found && rem < mtl) { found = true; e_out = e; ml = rem; off = o; cnt = c; }
    rem -= mtl; o += c;
  }
}

__device__ void p5_tile(const Params& p, int l, int t, int mtot, unsigned char* smem) {
  const int mi = (t >> 5) * 8 + (t & 7), nt = (t >> 3) & 3;
  if (mi >= mtot) return;
  int e, ml, off, cnt;
  moe_find(p.counts + l * 16, mi, e, ml, off, cnt);
  const int tid = otid(), lane = tid & 63, wid = tid >> 6, wr = wid >> 1, wc = wid & 1;
  const int srow = tid >> 3, sch = tid & 7, qi = lane & 15, g = lane >> 4;
  const bf16_t* pa[4];
#pragma unroll
  for (int i = 0; i < 4; ++i) {
    const int ridx = min(ml * 128 + srow + 32 * i, cnt - 1);
    const int tok = p.list[e * NTOK + ridx];
    pa[i] = p.xb + (size_t)tok * 1024 + sch * 8;
  }
  const bf16_t* B = p.Wgu + ((size_t)e * 512 + nt * 128 + srow) * 1024 + sch * 8;
  f32x4 acc[4][4];
  ZERO_ACC(acc);
  gemm_main(smem, pa[0], pa[1], pa[2], pa[3], B, B + 32 * 1024, B + 64 * 1024, B + 96 * 1024, 16, -1, false, acc, NoMid());
#pragma unroll
  for (int i = 0; i < 4; ++i) {
    const int rloc = ml * 128 + wr * 64 + i * 16 + qi;
    if (rloc < cnt) {
      const size_t slot = (size_t)off + rloc;
#pragma unroll
      for (int jp = 0; jp < 2; ++jp) {
        const f32x4 ga = acc[i][2 * jp], up = acc[i][2 * jp + 1];
        const int col = 64 * nt + 32 * wc + 16 * jp + 4 * g;
        store_bf16x4(p.act + slot * 256 + col, silu(ga[0]) * up[0], silu(ga[1]) * up[1], silu(ga[2]) * up[2], silu(ga[3]) * up[3]);
      }
    }
  }
}

struct P6Tile { int e, ml, off, cnt, nt; const bf16_t* pa0; const bf16_t* pa1; const bf16_t* pa2; const bf16_t* pa3; const bf16_t* B; };
__device__ __forceinline__ int p6_next(int t, int ntot, int mtot, int nblk) {
  while (t < ntot && ((t >> 6) * 8 + (t & 7)) >= mtot) t += nblk;
  return t;
}
__device__ __forceinline__ void p6_setup(const Params& p, int l, int t, P6Tile& T) {
  const int mi = (t >> 6) * 8 + (t & 7);
  T.nt = (t >> 3) & 7;
  moe_find(p.counts + l * 16, mi, T.e, T.ml, T.off, T.cnt);
  const int tid = otid(), srow = tid >> 3, sch = tid & 7;
  const bf16_t* base = p.act + (size_t)T.off * 256 + sch * 8;
  T.pa0 = base + (size_t)min(T.ml * 128 + srow, T.cnt - 1) * 256;
  T.pa1 = base + (size_t)min(T.ml * 128 + srow + 32, T.cnt - 1) * 256;
  T.pa2 = base + (size_t)min(T.ml * 128 + srow + 64, T.cnt - 1) * 256;
  T.pa3 = base + (size_t)min(T.ml * 128 + srow + 96, T.cnt - 1) * 256;
  T.B = p.Wdn + ((size_t)T.e * 1024 + T.nt * 128 + srow) * 256 + sch * 8;
}
__device__ void p6_phase(const Params& p, int l, int bid, int nblk, unsigned char* smem) {
  const int mtot = moe_total_mtiles(p.counts + l * 16), ntot = ((mtot + 7) >> 3) * 64;
  P6Tile cur, nxt;
  int t = p6_next(bid, ntot, mtot, nblk);
  if (t < ntot) {
    p6_setup(p, l, t, cur);
    __syncthreads();
    gemm_issue0(smem, cur.pa0, cur.pa1, cur.pa2, cur.pa3, cur.B, cur.B + 32 * 256, cur.B + 64 * 256, cur.B + 96 * 256);
  }
  while (t < ntot) {
    f32x4 acc[4][4];
    ZERO_ACC(acc);
    gemm_main<true>(smem, cur.pa0, cur.pa1, cur.pa2, cur.pa3, cur.B, cur.B + 32 * 256, cur.B + 64 * 256, cur.B + 96 * 256, 4, -1, false, acc, NoMid());
    const int tn = p6_next(t + nblk, ntot, mtot, nblk);
    nxt = cur;
    if (tn < ntot) {
      p6_setup(p, l, tn, nxt);
      gemm_issue0(smem, nxt.pa0, nxt.pa1, nxt.pa2, nxt.pa3, nxt.B, nxt.B + 32 * 256, nxt.B + 64 * 256, nxt.B + 96 * 256);
    }
    {
      const int tid = otid(), lane = tid & 63, wid = tid >> 6, wr = wid >> 1, wc = wid & 1, qi = lane & 15, g = lane >> 4;
#pragma unroll
      for (int i = 0; i < 4; ++i) {
        const int rloc = cur.ml * 128 + wr * 64 + i * 16 + qi;
        if (rloc < cur.cnt) {
          const float wgt = p.wlist[cur.e * NTOK + rloc];
          const size_t slot = (size_t)cur.off + rloc;
#pragma unroll
          for (int j = 0; j < 4; ++j) {
            const int n = cur.nt * 128 + wc * 64 + j * 16 + 4 * g;
            store_bf16x4(p.y + slot * 1024 + n, acc[i][j][0] * wgt, acc[i][j][1] * wgt, acc[i][j][2] * wgt, acc[i][j][3] * wgt);
          }
        }
      }
    }
    cur = nxt; t = tn;
  }
}

template <int NT>
__device__ __forceinline__ void p7_tokens(const Params& p, int l, int tok0, int tstride) {
  const int lane = otid() & 63;
  int4 ti[NT];
#pragma unroll
  for (int u = 0; u < NT; ++u) ti[u] = *(const int4*)(p.tokinfo + (size_t)(tok0 + u * tstride) * 4);
  int off0[NT], off1[NT];
#pragma unroll
  for (int u = 0; u < NT; ++u) { off0[u] = 0; off1[u] = 0; }
#pragma unroll
  for (int e = 0; e < 16; ++e) {
    const int c = p.counts[l * 16 + e];
#pragma unroll
    for (int u = 0; u < NT; ++u) { if (e < ti[u].x) off0[u] += c; if (e < ti[u].z) off1[u] += c; }
  }
  float4 xr[NT][4]; u32x2 ya[NT][4], yb[NT][4];
#pragma unroll
  for (int u = 0; u < NT; ++u) {
    const int tok = tok0 + u * tstride;
    const size_t s0 = (size_t)off0[u] + ti[u].y, s1 = (size_t)off1[u] + ti[u].w;
#pragma unroll
    for (int q = 0; q < 4; ++q) {
      const int c = q * 256 + lane * 4;
      xr[u][q] = *(const float4*)(p.x1 + (size_t)tok * 1024 + c);
      ya[u][q] = *(const u32x2*)(p.y + s0 * 1024 + c);
      yb[u][q] = *(const u32x2*)(p.y + s1 * 1024 + c);
    }
  }
  float4 gg[4], bb[4];
#pragma unroll
  for (int q = 0; q < 4; ++q) {
    gg[q] = *(const float4*)(p.ln2_g + l * 1024 + q * 256 + lane * 4);
    bb[q] = *(const float4*)(p.ln2_b + l * 1024 + q * 256 + lane * 4);
  }
#pragma unroll
  for (int u = 0; u < NT; ++u) {
    const int tok = tok0 + u * tstride;
    float hv[16];
#pragma unroll
    for (int q = 0; q < 4; ++q) {
      hv[q * 4 + 0] = ALPHA * xr[u][q].x + (__uint_as_float(ya[u][q].x << 16) + __uint_as_float(yb[u][q].x << 16));
      hv[q * 4 + 1] = ALPHA * xr[u][q].y + (__uint_as_float(ya[u][q].x & 0xffff0000u) + __uint_as_float(yb[u][q].x & 0xffff0000u));
      hv[q * 4 + 2] = ALPHA * xr[u][q].z + (__uint_as_float(ya[u][q].y << 16) + __uint_as_float(yb[u][q].y << 16));
      hv[q * 4 + 3] = ALPHA * xr[u][q].w + (__uint_as_float(ya[u][q].y & 0xffff0000u) + __uint_as_float(yb[u][q].y & 0xffff0000u));
    }
    float s1s = 0.f;
#pragma unroll
    for (int c = 0; c < 16; ++c) s1s += hv[c];
    const float mu = wave_sum(s1s) * (1.0f / 1024.0f);
    float s2 = 0.f;
#pragma unroll
    for (int c = 0; c < 16; ++c) { const float d = hv[c] - mu; s2 += d * d; }
    const float rstd = rsqrtf(wave_sum(s2) * (1.0f / 1024.0f) + LN_EPS);
#pragma unroll
    for (int q = 0; q < 4; ++q) {
      const int c = q * 256 + lane * 4;
      float4 o;
      o.x = (hv[q * 4 + 0] - mu) * rstd * gg[q].x + bb[q].x; o.y = (hv[q * 4 + 1] - mu) * rstd * gg[q].y + bb[q].y;
      o.z = (hv[q * 4 + 2] - mu) * rstd * gg[q].z + bb[q].z; o.w = (hv[q * 4 + 3] - mu) * rstd * gg[q].w + bb[q].w;
      if (l == 3) *(float4*)(p.out + (size_t)tok * 1024 + c) = o;
      else store_bf16x4(p.xb + (size_t)tok * 1024 + c, o.x, o.y, o.z, o.w);
    }
  }
}

#define XB_TMO      128
#define XB_XCNT(j)  (256  + 64 * (j))
#define XB_XSUB(j)  (1280 + 64 * (j))
#define XB_XGEN(j)  (2304 + 64 * (j))
#define XB_TOP      3328
#define XB_TOPGEN   3392
#define XCD_BAR_WORDS 3456
#define XB_SPIN_CAP (1u << 22)
__device__ __forceinline__ unsigned xb_ld(unsigned* p) { return __hip_atomic_load(p, __ATOMIC_RELAXED, __HIP_MEMORY_SCOPE_AGENT); }
__device__ __forceinline__ unsigned xb_add(unsigned* p, unsigned v) { return __hip_atomic_fetch_add(p, v, __ATOMIC_RELAXED, __HIP_MEMORY_SCOPE_AGENT); }
__device__ __forceinline__ unsigned xb_xcc_id() { return (unsigned)__builtin_amdgcn_s_getreg((3 << 11) | 20) & 0xFu; }
#define XB_SPIN(cond, bar) do { unsigned _sp = 0; while (cond) { __builtin_amdgcn_s_sleep(1); \
    if ((++_sp & 255u) == 0u) { if (xb_ld(&(bar)[XB_TMO])) break; if (_sp > XB_SPIN_CAP) { atomicAdd(&(bar)[XB_TMO], 1u); break; } } } } while (0)
struct XcdBarrier { unsigned* bar; unsigned x; volatile unsigned* st; };
__device__ __forceinline__ XcdBarrier xcd_barrier_post(unsigned* bar, volatile unsigned* st) {
  XcdBarrier b; b.bar = bar; b.x = xb_xcc_id(); b.st = st;
  if (threadIdx.x == 0) (void)xb_add(&bar[XB_XCNT(b.x)], 1u);
  return b;
}
__device__ __forceinline__ void xcd_barrier_complete(unsigned* bar, unsigned x, unsigned& nloc, unsigned& nx) {
  const unsigned G = gridDim.x;
  unsigned sum, cnt, mine, sp = 0u;
  for (;;) {
    sum = 0u; cnt = 0u; mine = 0u;
#pragma unroll
    for (unsigned j = 0; j < 16; ++j) { const unsigned c = xb_ld(&bar[XB_XCNT(j)]); sum += c; cnt += (c > 0u) ? 1u : 0u; mine = (j == x) ? c : mine; }
    if (sum == G) break;
    __builtin_amdgcn_s_sleep(1);
    if ((++sp & 255u) == 0u) { if (xb_ld(&bar[XB_TMO])) break; if (sp > XB_SPIN_CAP) { atomicAdd(&bar[XB_TMO], 1u); break; } }
  }
  nloc = mine > 0u ? mine : 1u; nx = cnt > 0u ? cnt : 1u;
}
__device__ __forceinline__ void xcd_barrier(const XcdBarrier& b) {
  asm volatile("s_waitcnt vmcnt(0)" ::: "memory");
  __syncthreads();
  if (threadIdx.x == 0) {
    unsigned* bar = b.bar;
    __builtin_amdgcn_s_waitcnt(0);
    unsigned nloc = b.st[0], nx = b.st[1];
    if (nloc == 0u) { xcd_barrier_complete(bar, b.x, nloc, nx); b.st[0] = nloc; b.st[1] = nx; }
    const unsigned old = xb_add(&bar[XB_XSUB(b.x)], 1u);
    const unsigned gen = old / nloc;
    if (old + 1u == (gen + 1u) * nloc) {
      __builtin_amdgcn_fence(__ATOMIC_RELEASE, "agent");
      asm volatile("s_waitcnt vmcnt(0)" ::: "memory");
      const unsigned og = xb_add(&bar[XB_TOP], 1u);
      const unsigned tg = og / nx;
      if (og + 1u == (tg + 1u) * nx) xb_add(&bar[XB_TOPGEN], 1u);
      else XB_SPIN(xb_ld(&bar[XB_TOPGEN]) == tg, bar);
      __builtin_amdgcn_fence(__ATOMIC_ACQUIRE, "agent");
      xb_add(&bar[XB_XGEN(b.x)], 1u);
      asm volatile("s_waitcnt vmcnt(0)" ::: "memory");
    } else {
      XB_SPIN(xb_ld(&bar[XB_XGEN(b.x)]) == gen, bar);
      __builtin_amdgcn_fence(__ATOMIC_ACQUIRE, "agent");
      asm volatile("s_waitcnt vmcnt(0)" ::: "memory");
    }
  }
  __syncthreads();
}

__device__ __forceinline__ void run_phase(const Params& p, int ph, int l, int bid, int nblk, unsigned char* smem, float* sbias) {
  switch (ph) {
    case 0: {
      if (bid == 0 && threadIdx.x < 64) p.counts[threadIdx.x] = 0;
      conv_x(p, bid, nblk);
      for (int it = bid; it < NCONV_ITEMS; it += nblk) conv_item(p, 0, it, smem);
    } break;
    case 1: p1_phase(p, l, bid, nblk, smem); break;
    case 2:
      attn_phase(p, l, bid, nblk, smem);
      for (int it = bid; it < 1024; it += nblk) sgu_item(p, l, it, smem);
      break;
    case 3: for (int t = bid; t < 1024; t += nblk) p3_tile(p, l, t, smem); break;
    case 4: for (int it = bid; it < NTOK / 32; it += nblk) p4_batch(p, l, it, smem); break;
    case 5: { const int mtot = moe_total_mtiles(p.counts + l * 16), nt = ((mtot + 7) >> 3) * 32; for (int t = bid; t < nt; t += nblk) p5_tile(p, l, t, mtot, smem); } break;
    case 6: p6_phase(p, l, bid, nblk, smem); break;
    case 7: {
      { const int nw = nblk * 4; int tok = bid * 4 + (threadIdx.x >> 6);
        for (; tok + 3 * nw < NTOK; tok += 4 * nw) p7_tokens<4>(p, l, tok, nw);
        for (; tok < NTOK; tok += nw) p7_tokens<1>(p, l, tok, nw); }
      if (l < 3) for (int it = bid; it < NCONV_ITEMS; it += nblk) conv_item(p, l + 1, it, smem);
    } break;
  }
}

template <int PH>
__global__ void __launch_bounds__(256, 2) phase_kernel(Params p, int l) {
  __shared__ __attribute__((aligned(16))) unsigned char smem[SMEM_BYTES];
  run_phase(p, PH, l, blockIdx.x, gridDim.x, smem, (float*)smem);
}

#if MEGA
__global__ void __launch_bounds__(256, 2) mega_kernel(Params p) {
  __shared__ __attribute__((aligned(16))) unsigned char smem[SMEM_BYTES];
  __shared__ uint4 xb_words;
  float* sbias = (float*)smem;
  cg::grid_group grid = cg::this_grid();
  const int bid = blockIdx.x, nblk = gridDim.x;
  if (threadIdx.x == 0) xb_words = make_uint4(0u, 0u, 0u, 0u);
  __syncthreads();
  XcdBarrier xb = xcd_barrier_post(p.bar, (volatile unsigned*)&xb_words);
  run_phase(p, 0, 0, bid, nblk, smem, sbias);
  if (p.never) grid.sync();
  xcd_barrier(xb);
#pragma unroll 1
  for (int l = 0; l < 4; ++l) {
#pragma unroll 1
    for (int ph = 1; ph <= 7; ++ph) {
      run_phase(p, ph, l, bid, nblk, smem, sbias);
#if DUP_PH
      if (ph == DUP_PH) { xcd_barrier(xb); run_phase(p, ph, l, bid, nblk, smem, sbias); }
#endif
      if (!(l == 3 && ph == 7)) xcd_barrier(xb);
    }
  }
}
#endif

extern "C" void kernel_launch(void* const* d_in, const int* in_sizes, int n_in, void* d_out, int out_size, void* d_ws,
                              size_t ws_size, hipStream_t stream) {
  Params p{};
  p.x = (const float*)d_in[0]; p.w_in = (const float*)d_in[1]; p.w_out = (const float*)d_in[2]; p.rel_bias = (const float*)d_in[3];
  p.sgu_ln_g = (const float*)d_in[4]; p.sgu_ln_b = (const float*)d_in[5]; p.sgu_w = (const float*)d_in[6]; p.sgu_b = (const float*)d_in[7];
  p.mix_g = (const float*)d_in[8]; p.ln1_g = (const float*)d_in[9]; p.ln1_b = (const float*)d_in[10];
  p.rg_w = (const float*)d_in[11]; p.rg_b = (const float*)d_in[12]; p.re_w = (const float*)d_in[13]; p.re_b = (const float*)d_in[14];
  p.w_gate = (const float*)d_in[15]; p.w_up = (const float*)d_in[16]; p.w_down = (const float*)d_in[17];
  p.ln2_g = (const float*)d_in[18]; p.ln2_b = (const float*)d_in[19];
  p.out = (float*)d_out;
  unsigned char* w = (unsigned char*)d_ws;
  size_t o = 0;
  auto take = [&](size_t bytes) { unsigned char* r = w + o; o += (bytes + 255) & ~(size_t)255; return r; };
  p.Wt_in = (bf16_t*)take((size_t)2560 * 1024 * 2);
  p.Wt_out = (bf16_t*)take((size_t)1024 * 1024 * 2);
  p.Wgu = (bf16_t*)take((size_t)16 * 512 * 1024 * 2);
  p.Wdn = (bf16_t*)take((size_t)16 * 1024 * 256 * 2);
  p.Wsgu = (bf16_t*)take((size_t)8 * 128 * 128 * 2);
  p.xb = (bf16_t*)take((size_t)NTOK * 1024 * 2);
  p.x1 = (float*)take((size_t)NTOK * 1024 * 4);
  unsigned char* r1 = take((size_t)NTOK * 2560 * 2);
  p.qk = (bf16_t*)r1;
  p.vT = (bf16_t*)(r1 + (size_t)NTOK * 1024 * 2);
  p.ub = (bf16_t*)(r1 + (size_t)NTOK * 1536 * 2);
  p.vnT = (bf16_t*)(r1 + (size_t)NTOK * 2048 * 2);
  p.y = (bf16_t*)r1;
  p.hb = (bf16_t*)r1;
  unsigned char* r2 = take((size_t)NTOK * 1024 * 2);
  p.mixed = (bf16_t*)r2;
  p.act = (bf16_t*)r2;
  p.ssq = (float*)take((size_t)NTOK * 16 * 4);
  p.wlist = (float*)take((size_t)16 * NTOK * 4);
  p.list = (int*)take((size_t)16 * NTOK * 4);
  p.tokinfo = (int*)take((size_t)NTOK * 4 * 4);
  p.counts = (int*)take(256);
  p.Wr_eh = (bf16_t*)take(16384 * 2); p.Wr_el = (bf16_t*)take(16384 * 2);
  p.Wr_gh = (bf16_t*)take(16384 * 2); p.Wr_gl = (bf16_t*)take(16384 * 2);
  p.bar = (unsigned*)take(XCD_BAR_WORDS * 4);
#if MEGA
  static int grid_blocks = 0;
  if (!grid_blocks) {
    int dev = 0, cus = 0, per_cu = 0;
    hipGetDevice(&dev);
    hipDeviceGetAttribute(&cus, hipDeviceAttributeMultiprocessorCount, dev);
    hipOccupancyMaxActiveBlocksPerMultiprocessor(&per_cu, mega_kernel, 256, 0);
    if (per_cu > 2) per_cu = 2;
    grid_blocks = cus * per_cu;
  }
  (void)hipMemsetAsync(p.bar, 0, XCD_BAR_WORDS * 4, stream);
  void* args[] = {&p};
  hipError_t e = hipLaunchCooperativeKernel((void*)mega_kernel, dim3(grid_blocks), dim3(256), args, 0, stream);
  if (e != hipSuccess) fprintf(stderr, "cooperative launch failed: %s (grid %d)\n", hipGetErrorString(e), grid_blocks);
#else
  const int G = 512;
  phase_kernel<0><<<G, 256, 0, stream>>>(p, 0);
  for (int l = 0; l < 4; ++l) {
    phase_kernel<1><<<G, 256, 0, stream>>>(p, l);
    phase_kernel<2><<<G, 256, 0, stream>>>(p, l);
    phase_kernel<3><<<G, 256, 0, stream>>>(p, l);
    phase_kernel<4><<<G, 256, 0, stream>>>(p, l);
    phase_kernel<5><<<G, 256, 0, stream>>>(p, l);
    phase_kernel<6><<<G, 256, 0, stream>>>(p, l);
    phase_kernel<7><<<G, 256, 0, stream>>>(p, l);
  }
#endif
}
```

```cpp
#include <hip/hip_runtime.h>
#include <hip/hip_cooperative_groups.h>
#include <stdint.h>
#include <cstdio>
namespace cg = cooperative_groups;

#ifndef MEGA
#define MEGA 1
#endif
#define DUP_PH 0

typedef unsigned short bf16_t;
typedef short bf16x8 __attribute__((ext_vector_type(8)));
typedef float f32x4 __attribute__((ext_vector_type(4)));
typedef unsigned u32x4 __attribute__((ext_vector_type(4)));
typedef unsigned u32x2 __attribute__((ext_vector_type(2)));

#define NTOK 16384
#define LN_EPS 1e-5f
#define ALPHA 1.681792830507429f
#define NCONV_ITEMS 1009
#define SMEM_BYTES 69632

struct Params {
  const float *x, *w_in, *w_out, *rel_bias, *sgu_ln_g, *sgu_ln_b, *sgu_w, *sgu_b, *mix_g, *ln1_g, *ln1_b,
      *rg_w, *rg_b, *re_w, *re_b, *w_gate, *w_up, *w_down, *ln2_g, *ln2_b;
  float* out;
  bf16_t *Wt_in, *Wt_out, *Wgu, *Wdn, *Wsgu, *xb, *qk, *vT, *ub, *vnT, *mixed, *act, *y, *hb;
  float *x1, *ssq, *wlist;
  bf16_t *Wr_eh, *Wr_el, *Wr_gh, *Wr_gl;
  bf16_t* x1lo;
  int *counts, *list, *tokinfo;
  unsigned* bar;
  int never;
  int pad_;
};

__device__ __forceinline__ unsigned cvt_pk_bf16(float lo, float hi) {
  unsigned r; asm("v_cvt_pk_bf16_f32 %0, %1, %2" : "=v"(r) : "v"(lo), "v"(hi)); return r;
}
__device__ __forceinline__ void store_bf16x4(bf16_t* p, float a, float b, float c, float d) {
  u32x2 v; v.x = cvt_pk_bf16(a, b); v.y = cvt_pk_bf16(c, d); *(u32x2*)p = v;
}
__device__ __forceinline__ float gelu_tanh(float x) {
  const float t = x * (-2.302208198f + -0.102943249f * (x * x));
  return x * __builtin_amdgcn_rcpf(1.0f + __builtin_amdgcn_exp2f(t));
}
__device__ __forceinline__ int otid() { int t = threadIdx.x; asm volatile("" : "+v"(t)); return t; }
__device__ __forceinline__ float silu(float x) { return x * __builtin_amdgcn_rcpf(1.0f + __builtin_amdgcn_exp2f(-1.442695041f * x)); }
template <int CTRL>
__device__ __forceinline__ float dpp_mov(float v) {
  return __builtin_bit_cast(float, __builtin_amdgcn_update_dpp(0, __builtin_bit_cast(int, v), CTRL, 0xf, 0xf, true));
}
__device__ __forceinline__ float row16_sum(float v) {
  v += dpp_mov<0xB1>(v); v += dpp_mov<0x4E>(v); v += dpp_mov<0x141>(v); v += dpp_mov<0x140>(v); return v;
}
__device__ __forceinline__ float wave_sum(float v) {
  v = row16_sum(v); v += __shfl_xor(v, 16); v += __shfl_xor(v, 32); return v;
}

struct NoMid { __device__ __forceinline__ void operator()(f32x4 (&)[4][4]) const {} };
struct MidScale {
  float s[4];
  __device__ __forceinline__ void operator()(f32x4 (&acc)[4][4]) const {
#pragma unroll
    for (int i = 0; i < 4; ++i)
#pragma unroll
      for (int j = 0; j < 4; ++j) acc[i][j] *= s[i];
  }
};

#define GLDS16(gptr, lptr) __builtin_amdgcn_global_load_lds((const unsigned*)(gptr), (__attribute__((address_space(3))) unsigned*)(lptr), 16, 0, 0)

__device__ __forceinline__ void gemm_issue0(unsigned char* smem, const bf16_t* pa0, const bf16_t* pa1, const bf16_t* pa2,
                                            const bf16_t* pa3, const bf16_t* pb0, const bf16_t* pb1, const bf16_t* pb2,
                                            const bf16_t* pb3) {
  const int tid = otid(), wid = tid >> 6, srow = tid >> 3;
  const int lch = ((tid & 7) ^ ((srow >> 1) & 7)) * 8 - (tid & 7) * 8;
  unsigned char* d = smem + __builtin_amdgcn_readfirstlane(wid) * 1024;
  GLDS16(pa0 + lch, d); GLDS16(pa1 + lch, d + 4096); GLDS16(pa2 + lch, d + 8192); GLDS16(pa3 + lch, d + 12288);
  GLDS16(pb0 + lch, d + 16384); GLDS16(pb1 + lch, d + 20480); GLDS16(pb2 + lch, d + 24576); GLDS16(pb3 + lch, d + 28672);
}

template <bool PRE = false, class Mid>
__device__ __forceinline__ void gemm_main(unsigned char* smem, const bf16_t* pa0, const bf16_t* pa1, const bf16_t* pa2,
                                          const bf16_t* pa3, const bf16_t* pb0, const bf16_t* pb1, const bf16_t* pb2,
                                          const bf16_t* pb3, int nk, int kmid, bool swapped, f32x4 (&acc)[4][4],
                                          const Mid& mid) {
  const int tid = otid(), lane = tid & 63, wid = tid >> 6, wr = wid >> 1, wc = wid & 1;
  const int srow = tid >> 3;
  const int lch = ((tid & 7) ^ ((srow >> 1) & 7)) * 8 - (tid & 7) * 8;
  pa0 += lch; pa1 += lch; pa2 += lch; pa3 += lch; pb0 += lch; pb1 += lch; pb2 += lch; pb3 += lch;
  const int soff = __builtin_amdgcn_readfirstlane(wid) * 1024;
  const int qi = lane & 15, g = lane >> 4, s = qi >> 1;
  const int aside = swapped ? 16384 : 0, bside = swapped ? 0 : 16384;
  const int offA0 = aside + (wr * 64 + qi) * 128 + (((0 + g) ^ s) << 4);
  const int offA1 = aside + (wr * 64 + qi) * 128 + (((4 + g) ^ s) << 4);
  const int offB0 = bside + (wc * 64 + qi) * 128 + (((0 + g) ^ s) << 4);
  const int offB1 = bside + (wc * 64 + qi) * 128 + (((4 + g) ^ s) << 4);
  if (!PRE) {
    unsigned char* d = smem + soff;
    GLDS16(pa0, d); GLDS16(pa1, d + 4096); GLDS16(pa2, d + 8192); GLDS16(pa3, d + 12288);
    GLDS16(pb0, d + 16384); GLDS16(pb1, d + 20480); GLDS16(pb2, d + 24576); GLDS16(pb3, d + 28672);
  }
  asm volatile("s_waitcnt vmcnt(0)" ::: "memory");
  __syncthreads();
  for (int kt = 0; kt < nk; ++kt) {
    unsigned char* buf = smem + ((kt & 1) << 15);
    if (kt + 1 < nk) {
      const int ko = (kt + 1) * 64;
      unsigned char* d = smem + (((kt + 1) & 1) << 15) + soff;
      GLDS16(pa0 + ko, d); GLDS16(pa1 + ko, d + 4096); GLDS16(pa2 + ko, d + 8192); GLDS16(pa3 + ko, d + 12288);
      GLDS16(pb0 + ko, d + 16384); GLDS16(pb1 + ko, d + 20480); GLDS16(pb2 + ko, d + 24576); GLDS16(pb3 + ko, d + 28672);
    }
    if (kt == kmid) mid(acc);
    {
      bf16x8 af0[4], bf0[4], af1[4], bf1[4];
#pragma unroll
      for (int i = 0; i < 4; ++i) af0[i] = *(const bf16x8*)(buf + offA0 + i * 2048);
#pragma unroll
      for (int j = 0; j < 4; ++j) bf0[j] = *(const bf16x8*)(buf + offB0 + j * 2048);
#pragma unroll
      for (int i = 0; i < 4; ++i) af1[i] = *(const bf16x8*)(buf + offA1 + i * 2048);
#pragma unroll
      for (int j = 0; j < 4; ++j) bf1[j] = *(const bf16x8*)(buf + offB1 + j * 2048);
      asm volatile("s_waitcnt lgkmcnt(8)" ::: "memory");
      __builtin_amdgcn_s_setprio(1);
#pragma unroll
      for (int i = 0; i < 4; ++i)
#pragma unroll
        for (int j = 0; j < 4; ++j) acc[i][j] = __builtin_amdgcn_mfma_f32_16x16x32_bf16(bf0[j], af0[i], acc[i][j], 0, 0, 0);
      asm volatile("s_waitcnt lgkmcnt(0)" ::: "memory");
#pragma unroll
      for (int i = 0; i < 4; ++i)
#pragma unroll
        for (int j = 0; j < 4; ++j) acc[i][j] = __builtin_amdgcn_mfma_f32_16x16x32_bf16(bf1[j], af1[i], acc[i][j], 0, 0, 0);
      __builtin_amdgcn_s_setprio(0);
    }
    asm volatile("s_waitcnt vmcnt(0)" ::: "memory");
    __syncthreads();
  }
}

#define ZERO_ACC(acc)                                   \
  _Pragma("unroll") for (int i_ = 0; i_ < 4; ++i_)      \
  _Pragma("unroll") for (int j_ = 0; j_ < 4; ++j_) acc[i_][j_] = (f32x4){0.f, 0.f, 0.f, 0.f};

__device__ void conv_x(const Params& p, int bid, int nblk) {
  const size_t n8 = (size_t)NTOK * 1024 / 8;
#pragma unroll 4
  for (size_t i = (size_t)bid * 256 + threadIdx.x; i < n8; i += (size_t)nblk * 256) {
    const f32x4 a_ = __builtin_nontemporal_load((const f32x4*)(p.x + i * 8)), b_ = __builtin_nontemporal_load((const f32x4*)(p.x + i * 8 + 4));
    float4 a, b; a.x = a_[0]; a.y = a_[1]; a.z = a_[2]; a.w = a_[3]; b.x = b_[0]; b.y = b_[1]; b.z = b_[2]; b.w = b_[3];
    u32x4 v; v.x = cvt_pk_bf16(a.x, a.y); v.y = cvt_pk_bf16(a.z, a.w); v.z = cvt_pk_bf16(b.x, b.y); v.w = cvt_pk_bf16(b.z, b.w);
    *(u32x4*)(p.xb + i * 8) = v;
  }
}

__device__ void tconv_tile(float* tile, const float* src, int src_ld, const float* kscale, bf16_t* dst, int dst_ld, int rstep) {
  const int t = otid();
  {
    const int k0 = t >> 6, n4 = (t & 63) * 4;
    float4 v[16];
#pragma unroll
    for (int i = 0; i < 16; ++i) {
      const f32x4 tv = __builtin_nontemporal_load((const f32x4*)(src + (size_t)(k0 + 4 * i) * src_ld + n4));
      v[i].x = tv[0]; v[i].y = tv[1]; v[i].z = tv[2]; v[i].w = tv[3];
    }
    if (kscale) {
#pragma unroll
      for (int i = 0; i < 16; ++i) { const float sc = kscale[k0 + 4 * i]; v[i].x *= sc; v[i].y *= sc; v[i].z *= sc; v[i].w *= sc; }
    }
#pragma unroll
    for (int i = 0; i < 16; ++i) *(float4*)(tile + (k0 + 4 * i) * 260 + n4) = v[i];
  }
  __syncthreads();
  {
    const int n = t;
    bf16_t* o = dst + (size_t)((n >> 4) * rstep + (n & 15)) * dst_ld;
#pragma unroll
    for (int c = 0; c < 8; ++c) {
      float f[8];
#pragma unroll
      for (int q = 0; q < 8; ++q) f[q] = tile[(c * 8 + q) * 260 + n];
      u32x4 v0;
      v0.x = cvt_pk_bf16(f[0], f[1]); v0.y = cvt_pk_bf16(f[2], f[3]); v0.z = cvt_pk_bf16(f[4], f[5]); v0.w = cvt_pk_bf16(f[6], f[7]);
      *(u32x4*)(o + c * 8) = v0;
    }
  }
  __syncthreads();
}

__device__ void conv_item(const Params& p, int l, int it, unsigned char* smem) {
  float* tile = (float*)smem;
  if (it < 160) {
    const int kt = it / 10, ntile = it % 10;
    tconv_tile(tile, p.w_in + (size_t)l * 1024 * 2560 + (size_t)kt * 64 * 2560 + ntile * 256, 2560, nullptr,
               p.Wt_in + (size_t)ntile * 256 * 1024 + kt * 64, 1024, 16);
  } else if (it < 224) {
    const int r = it - 160, kt = r >> 2, ntile = r & 3;
    tconv_tile(tile, p.w_out + (size_t)l * 1024 * 1024 + (size_t)kt * 64 * 1024 + ntile * 256, 1024, p.mix_g + l * 1024 + kt * 64,
               p.Wt_out + (size_t)ntile * 256 * 1024 + kt * 64, 1024, 16);
  } else if (it < 736) {
    const int r0 = it - 224, e = r0 >> 5, r = r0 & 31, which = r >> 4, kt = r & 15;
    const float* src = (which ? p.w_up : p.w_gate) + (size_t)(l * 16 + e) * 1024 * 256 + (size_t)kt * 64 * 256;
    tconv_tile(tile, src, 256, nullptr, p.Wgu + (size_t)e * 512 * 1024 + (size_t)(which * 16) * 1024 + kt * 64, 1024, 32);
  } else if (it < 992) {
    const int r0 = it - 736, e = r0 >> 4, r = r0 & 15, kt = r >> 2, ntile = r & 3;
    tconv_tile(tile, p.w_down + (size_t)(l * 16 + e) * 256 * 1024 + (size_t)kt * 64 * 1024 + ntile * 256, 1024, nullptr,
               p.Wdn + (size_t)e * 1024 * 256 + (size_t)ntile * 256 * 256 + kt * 64, 256, 16);
  } else if (it == 1008) {
    for (int i = threadIdx.x; i < 16384; i += 256) {
      const int jj = i & 7, j = (i >> 3) & 15, g = (i >> 7) & 3, kb = i >> 9;
      const int k = 32 * kb + 8 * g + jj;
      const float we = p.re_w[(size_t)(l * 1024 + k) * 16 + j];
      const float wg = (j < 4) ? p.rg_w[(size_t)(l * 1024 + k) * 4 + j] : 0.0f;
      const unsigned eh = cvt_pk_bf16(we, 0.f) & 0xffffu, gh = cvt_pk_bf16(wg, 0.f) & 0xffffu;
      const unsigned el = cvt_pk_bf16(we - __uint_as_float(eh << 16), 0.f) & 0xffffu;
      const unsigned gl = cvt_pk_bf16(wg - __uint_as_float(gh << 16), 0.f) & 0xffffu;
      p.Wr_eh[i] = (bf16_t)eh; p.Wr_el[i] = (bf16_t)el; p.Wr_gh[i] = (bf16_t)gh; p.Wr_gl[i] = (bf16_t)gl;
    }
  } else {
    const int j = it - 992;
    const float* src = p.sgu_w + (size_t)l * 131072 + (size_t)j * 8192 + threadIdx.x * 32;
    bf16_t* dst = p.Wsgu + (size_t)j * 8192 + threadIdx.x * 32;
#pragma unroll
    for (int q = 0; q < 4; ++q) {
      const float4 a = *(const float4*)(src + q * 8), b = *(const float4*)(src + q * 8 + 4);
      u32x4 v; v.x = cvt_pk_bf16(a.x, a.y); v.y = cvt_pk_bf16(a.z, a.w); v.z = cvt_pk_bf16(b.x, b.y); v.w = cvt_pk_bf16(b.z, b.w);
      *(u32x4*)(dst + q * 8) = v;
    }
  }
}

__device__ __forceinline__ void p1_decode(int t, int& mt, int& nt) {
  const int x_ = t & 7, j_ = t >> 3, rd_ = j_ >> 6, lb_ = j_ & 63;
  mt = (rd_ < 4) ? (x_ * 16 + (rd_ & 1) * 8 + (lb_ & 7)) : (x_ * 16 + (lb_ & 15));
  nt = (rd_ < 4) ? ((rd_ >> 1) * 8 + (lb_ >> 3)) : (16 + (lb_ >> 4));
}
__device__ __forceinline__ void p1_epilogue(const Params& p, int l, int mt, int nt, f32x4 (&acc)[4][4]) {
  const int type = nt >> 2;
  const bool swapped = (type == 2) || (type == 4);
  const int tid = otid(), lane = tid & 63, wid = tid >> 6, wr = wid >> 1, wc = wid & 1;
  const int qi = lane & 15, g = lane >> 4;
  if (!swapped) {
#pragma unroll
    for (int i = 0; i < 4; ++i) {
      const int m = mt * 128 + wr * 64 + i * 16 + qi;
#pragma unroll
      for (int j = 0; j < 4; ++j) {
        const int n = nt * 128 + wc * 64 + j * 16 + 4 * g;
        f32x4 v = acc[i][j];
        if (type == 0) v *= 0.125f;
        if (type == 3) { v[0] = gelu_tanh(v[0]); v[1] = gelu_tanh(v[1]); v[2] = gelu_tanh(v[2]); v[3] = gelu_tanh(v[3]); }
        bf16_t* dst = (type == 3) ? (p.ub + (size_t)m * 512 + (n - 1536)) : (p.qk + (size_t)m * 1024 + n);
        store_bf16x4(dst, v[0], v[1], v[2], v[3]);
      }
    }
  } else {
    const int bidx = (mt * 128) >> 12, tokbase = (mt * 128) & 4095;
    bf16_t* dstb = (type == 2) ? p.vT : p.vnT;
    const int fbase = (type == 2) ? 1024 : 2048;
    if (type == 4) {
#pragma unroll
      for (int i = 0; i < 4; ++i)
#pragma unroll
        for (int j = 0; j < 4; ++j)
#pragma unroll
          for (int r = 0; r < 4; ++r) acc[i][j][r] = gelu_tanh(acc[i][j][r]);
      float gam[4], bet[4];
#pragma unroll
      for (int i = 0; i < 4; ++i) {
        const int f = nt * 128 + wr * 64 + i * 16 + qi - 2048;
        gam[i] = p.sgu_ln_g[l * 512 + f]; bet[i] = p.sgu_ln_b[l * 512 + f];
      }
#pragma unroll
      for (int j = 0; j < 4; ++j)
#pragma unroll
        for (int r = 0; r < 4; ++r) {
          float s1 = acc[0][j][r] + acc[1][j][r] + acc[2][j][r] + acc[3][j][r];
          s1 = row16_sum(s1);
          const float mu = s1 * (1.0f / 64.0f);
          float s2 = 0.f;
#pragma unroll
          for (int i = 0; i < 4; ++i) { const float d = acc[i][j][r] - mu; s2 += d * d; }
          s2 = row16_sum(s2);
          const float rstd = rsqrtf(s2 * (1.0f / 64.0f) + LN_EPS);
#pragma unroll
          for (int i = 0; i < 4; ++i) acc[i][j][r] = (acc[i][j][r] - mu) * rstd * gam[i] + bet[i];
        }
    }
#pragma unroll
    for (int i = 0; i < 4; ++i) {
      const int f = nt * 128 + wr * 64 + i * 16 + qi - fbase;
#pragma unroll
      for (int j = 0; j < 4; ++j) {
        const int tok = tokbase + wc * 64 + j * 16 + 4 * g;
        store_bf16x4(dstb + ((size_t)(bidx * 512 + f)) * 4096 + tok, acc[i][j][0], acc[i][j][1], acc[i][j][2], acc[i][j][3]);
      }
    }
  }
}


__device__ void p1_phase(const Params& p, int l, int bid, int nblk, unsigned char* smem) {
  const int tid0 = otid();
  int t = bid, mt = 0, nt = 0;
  const bf16_t* A = nullptr; const bf16_t* B = nullptr;
  if (t < 2560) {
    p1_decode(t, mt, nt);
    A = p.xb + (size_t)(mt * 128 + (tid0 >> 3)) * 1024 + (tid0 & 7) * 8;
    B = p.Wt_in + (size_t)(nt * 128 + (tid0 >> 3)) * 1024 + (tid0 & 7) * 8;
    __syncthreads();
    gemm_issue0(smem, A, A + 32 * 1024, A + 64 * 1024, A + 96 * 1024, B, B + 32 * 1024, B + 64 * 1024, B + 96 * 1024);
  }
  while (t < 2560) {
    const int type = nt >> 2;
    const bool swapped = (type == 2) || (type == 4);
    f32x4 acc[4][4];
    ZERO_ACC(acc);
    gemm_main<true>(smem, A, A + 32 * 1024, A + 64 * 1024, A + 96 * 1024, B, B + 32 * 1024, B + 64 * 1024, B + 96 * 1024, 16, -1, swapped, acc, NoMid());
    const int tn = t + nblk;
    int mtn = mt, ntn = nt;
    if (tn < 2560) {
      p1_decode(tn, mtn, ntn);
      const int tid = otid();
      A = p.xb + (size_t)(mtn * 128 + (tid >> 3)) * 1024 + (tid & 7) * 8;
      B = p.Wt_in + (size_t)(ntn * 128 + (tid >> 3)) * 1024 + (tid & 7) * 8;
      gemm_issue0(smem, A, A + 32 * 1024, A + 64 * 1024, A + 96 * 1024, B, B + 32 * 1024, B + 64 * 1024, B + 96 * 1024);
    }
    p1_epilogue(p, l, mt, nt, acc);
    mt = mtn; nt = ntn; t = tn;
  }
}

__device__ void attn_phase(const Params& p, int l, int bid, int nblk, unsigned char* smem) {
  const int tid = otid(), lane = tid & 63, w = tid >> 6, qi = lane & 15, g = lane >> 4;
  unsigned char* Kb = smem;
  unsigned char* Vb = smem + 32768;
  float* sbias = (float*)(smem + 32768 + 33792);
  const int c0 = (w == 0) ? 0 : (w == 1) ? 8 : (w == 2) ? 24 : 32;
  const int cq = 16 * w + qi, cs = min(max(cq - 8, 0), 48);
  const int krow = tid >> 3, kch = tid & 7;
  const int ksoff = krow * 128 + ((kch ^ ((krow >> 1) & 7)) << 4);
  const int vd = tid >> 5, vc = tid & 31;
  const int vsoff = vd * 528 + vc * 16;
  u32x4 st[8], st2[8];
#define ATT_ISSUE_K(it_)                                                                                              \
  do {                                                                                                                \
    const int h_ = (it_) & 7, br_ = (it_) >> 3, r_ = br_ & 63, b_ = br_ >> 6, rs_ = min(max(r_ - 4, 0), 56);          \
    const bf16_t* kg_ = p.qk + ((size_t)b_ * 4096 + rs_ * 64 + krow) * 1024 + 512 + h_ * 64 + kch * 8;                \
    _Pragma("unroll") for (int i = 0; i < 8; ++i) st[i] = *(const u32x4*)(kg_ + (size_t)(32 * i) * 1024);            \
    _Pragma("unroll") for (int i = 0; i < 8; ++i) st2[i] = *(const u32x4*)(kg_ + (size_t)(256 + 32 * i) * 1024);     \
  } while (0)
  int it = bid;
  if (it < 2048) ATT_ISSUE_K(it);
  while (it < 2048) {
    const int h = it & 7, br = it >> 3, r = br & 63, b = br >> 6;
    const int rs = min(max(r - 4, 0), 56);
    const size_t tokq = (size_t)b * 4096 + r * 64 + cq;
    const bf16_t* vg = p.vT + ((size_t)(b * 512 + h * 64 + vd)) * 4096 + rs * 64 + vc * 8;
    const float rb0 = p.rel_bias[(size_t)(l * 8 + h) * 465 + tid];
    const float rb1 = p.rel_bias[(size_t)(l * 8 + h) * 465 + min(tid + 256, 464)];
    bf16x8 qf0 = *(const bf16x8*)(p.qk + tokq * 1024 + h * 64 + g * 8);
    bf16x8 qf1 = *(const bf16x8*)(p.qk + tokq * 1024 + h * 64 + 32 + g * 8);
    __syncthreads();
    sbias[tid] = rb0;
    if (tid + 256 < 465) sbias[tid + 256] = rb1;
#pragma unroll
    for (int i = 0; i < 8; ++i) *(u32x4*)(Kb + ksoff + i * 4096) = st[i];
#pragma unroll
    for (int i = 0; i < 8; ++i) st[i] = *(const u32x4*)(vg + (size_t)(8 * i) * 4096);
    __syncthreads();
    f32x4 s[8][2];
#pragma unroll
    for (int jh = 0; jh < 2; ++jh) {
#pragma unroll
      for (int jj = 0; jj < 4; ++jj)
#pragma unroll
        for (int ch = 0; ch < 2; ++ch) {
          const int kl = jj * 64 + c0 + 16 * ch + qi;
          const int sw = (kl >> 1) & 7;
          const bf16x8 kf0 = *(const bf16x8*)(Kb + kl * 128 + (((0 + g) ^ sw) << 4));
          const bf16x8 kf1 = *(const bf16x8*)(Kb + kl * 128 + (((4 + g) ^ sw) << 4));
          f32x4 a = {0.f, 0.f, 0.f, 0.f};
          a = __builtin_amdgcn_mfma_f32_16x16x32_bf16(kf0, qf0, a, 0, 0, 0);
          a = __builtin_amdgcn_mfma_f32_16x16x32_bf16(kf1, qf1, a, 0, 0, 0);
          s[jh * 4 + jj][ch] = a;
        }
      if (jh == 0) {
        __syncthreads();
#pragma unroll
        for (int i = 0; i < 8; ++i) *(u32x4*)(Kb + ksoff + i * 4096) = st2[i];
#pragma unroll
        for (int i = 0; i < 8; ++i) st2[i] = *(const u32x4*)(vg + (size_t)(8 * i) * 4096 + 256);
        __syncthreads();
      }
    }
#pragma unroll
    for (int i = 0; i < 8; ++i) *(u32x4*)(Vb + vsoff + i * 8 * 528) = st[i];
    float mx = -1e30f;
#pragma unroll
    for (int j = 0; j < 8; ++j)
#pragma unroll
      for (int ch = 0; ch < 2; ++ch)
#pragma unroll
        for (int rg = 0; rg < 4; ++rg) {
          const int kc = c0 + 16 * ch + 4 * g + rg;
          const bool valid = (kc >= cs) && (kc < cs + 16);
          const int bidx = valid ? ((rs + j - r + 7) * 31 + (kc - cq) + 15) : 0;
          const float v = valid ? (s[j][ch][rg] + sbias[bidx]) : -1e30f;
          s[j][ch][rg] = v;
          mx = fmaxf(mx, v);
        }
    mx = fmaxf(mx, __shfl_xor(mx, 16)); mx = fmaxf(mx, __shfl_xor(mx, 32));
    float sum = 0.f;
#pragma unroll
    for (int j = 0; j < 8; ++j)
#pragma unroll
      for (int ch = 0; ch < 2; ++ch)
#pragma unroll
        for (int rg = 0; rg < 4; ++rg) { const float e = __expf(s[j][ch][rg] - mx); s[j][ch][rg] = e; sum += e; }
    sum += __shfl_xor(sum, 16); sum += __shfl_xor(sum, 32);
    const float inv = 1.0f / sum;
    bf16x8 pf[8];
#pragma unroll
    for (int j = 0; j < 8; ++j) {
      u32x4 pw;
      pw.x = cvt_pk_bf16(s[j][0][0], s[j][0][1]); pw.y = cvt_pk_bf16(s[j][0][2], s[j][0][3]);
      pw.z = cvt_pk_bf16(s[j][1][0], s[j][1][1]); pw.w = cvt_pk_bf16(s[j][1][2], s[j][1][3]);
      pf[j] = __builtin_bit_cast(bf16x8, pw);
    }
    f32x4 o[4];
#pragma unroll
    for (int dt = 0; dt < 4; ++dt) o[dt] = (f32x4){0.f, 0.f, 0.f, 0.f};
    const int itn = it + nblk;
    __syncthreads();
#pragma unroll
    for (int jh = 0; jh < 2; ++jh) {
#pragma unroll
      for (int jj = 0; jj < 4; ++jj)
#pragma unroll
        for (int dt = 0; dt < 4; ++dt) {
          const unsigned char* vp = Vb + (dt * 16 + qi) * 528 + (jj * 64 + c0 + 4 * g) * 2;
          const u32x2 lo = *(const u32x2*)vp, hi = *(const u32x2*)(vp + 32);
          u32x4 vw; vw.x = lo.x; vw.y = lo.y; vw.z = hi.x; vw.w = hi.y;
          o[dt] = __builtin_amdgcn_mfma_f32_16x16x32_bf16(__builtin_bit_cast(bf16x8, vw), pf[jh * 4 + jj], o[dt], 0, 0, 0);
        }
      if (jh == 0) {
        __syncthreads();
#pragma unroll
        for (int i = 0; i < 8; ++i) *(u32x4*)(Vb + vsoff + i * 8 * 528) = st2[i];
        if (itn < 2048) ATT_ISSUE_K(itn);
        __syncthreads();
      }
    }
    float sq = 0.f;
#pragma unroll
    for (int dt = 0; dt < 4; ++dt) {
      o[dt] *= inv;
      sq += o[dt][0] * o[dt][0] + o[dt][1] * o[dt][1] + o[dt][2] * o[dt][2] + o[dt][3] * o[dt][3];
      store_bf16x4(p.mixed + tokq * 1024 + h * 64 + dt * 16 + 4 * g, o[dt][0], o[dt][1], o[dt][2], o[dt][3]);
    }
    sq += __shfl_xor(sq, 16); sq += __shfl_xor(sq, 32);
    if (g == 0) p.ssq[tokq * 16 + h] = sq;
    it = itn;
  }
#undef ATT_ISSUE_K
}

__device__ void sgu_item(const Params& p, int l, int it, unsigned char* smem) {
  const int grp = it & 7, bc = it >> 3, chunk = bc & 31, b = bc >> 5;
  const int tid = otid(), lane = tid & 63, w = tid >> 6, qi = lane & 15, g = lane >> 4;
  const int p0 = 32 * w;
  const int wbase = __builtin_amdgcn_readfirstlane(w) * 1024;
  const int lc = ((tid & 15) ^ ((tid >> 4) & 15)) << 3;
  const bf16_t* wsrc = p.Wsgu + ((size_t)(grp * 128 + (tid >> 4))) * 128 + lc;
  const bf16_t* vsrc = p.vnT + ((size_t)(b * 512 + grp * 64 + (tid >> 4))) * 4096 + chunk * 128 + lc;
  __syncthreads();
#pragma unroll
  for (int i = 0; i < 8; ++i) GLDS16(wsrc + (size_t)(16 * i) * 128, smem + i * 4096 + wbase);
#pragma unroll
  for (int i = 0; i < 4; ++i) GLDS16(vsrc + (size_t)(16 * i) * 4096, smem + 32768 + i * 4096 + wbase);
  asm volatile("s_waitcnt vmcnt(0)" ::: "memory");
  __syncthreads();
  f32x4 acc[2][4];
#pragma unroll
  for (int mt = 0; mt < 2; ++mt)
#pragma unroll
    for (int nt = 0; nt < 4; ++nt) acc[mt][nt] = (f32x4){0.f, 0.f, 0.f, 0.f};
#pragma unroll
  for (int ks = 0; ks < 4; ++ks) {
    const int co = ((ks * 4 + g) ^ qi) << 4;
    bf16x8 wf[2], vf[4];
#pragma unroll
    for (int mt = 0; mt < 2; ++mt) wf[mt] = *(const bf16x8*)(smem + (p0 + 16 * mt + qi) * 256 + co);
#pragma unroll
    for (int nt = 0; nt < 4; ++nt) vf[nt] = *(const bf16x8*)(smem + 32768 + (16 * nt + qi) * 256 + co);
#pragma unroll
    for (int mt = 0; mt < 2; ++mt)
#pragma unroll
      for (int nt = 0; nt < 4; ++nt) acc[mt][nt] = __builtin_amdgcn_mfma_f32_16x16x32_bf16(vf[nt], wf[mt], acc[mt][nt], 0, 0, 0);
  }
#pragma unroll
  for (int mt = 0; mt < 2; ++mt) {
    const int pp = p0 + 16 * mt + qi;
    const size_t tok = (size_t)b * 4096 + chunk * 128 + pp;
    const float bias = p.sgu_b[(size_t)(l * 8 + grp) * 128 + pp];
    float sq = 0.f;
#pragma unroll
    for (int nt = 0; nt < 4; ++nt) {
      const int d = 16 * nt + 4 * g;
      const u32x2 uu = *(const u32x2*)(p.ub + tok * 512 + grp * 64 + d);
      const float u0 = __uint_as_float(uu.x << 16), u1 = __uint_as_float(uu.x & 0xffff0000u);
      const float u2 = __uint_as_float(uu.y << 16), u3 = __uint_as_float(uu.y & 0xffff0000u);
      const float v0 = u0 * (acc[mt][nt][0] + bias), v1 = u1 * (acc[mt][nt][1] + bias);
      const float v2 = u2 * (acc[mt][nt][2] + bias), v3 = u3 * (acc[mt][nt][3] + bias);
      sq += v0 * v0 + v1 * v1 + v2 * v2 + v3 * v3;
      store_bf16x4(p.mixed + tok * 1024 + 512 + grp * 64 + d, v0, v1, v2, v3);
    }
    sq += __shfl_xor(sq, 16); sq += __shfl_xor(sq, 32);
    if (g == 0) p.ssq[tok * 16 + 8 + grp] = sq;
  }
}

__device__ void p3_tile(const Params& p, int l, int t, unsigned char* smem) {
  const int x_ = t & 7, j_ = t >> 3, rd_ = j_ >> 6, lb_ = j_ & 63;
  const int mt = x_ * 16 + rd_ * 8 + (lb_ & 7), nt = lb_ >> 3;
  const int tid = otid(), lane = tid & 63, wid = tid >> 6, wr = wid >> 1, wc = wid & 1;
  const int srow = tid >> 3, sch = tid & 7, qi = lane & 15, g = lane >> 4;
  const bf16_t* A = p.mixed + (size_t)(mt * 128 + srow) * 1024 + sch * 8;
  const bf16_t* B = p.Wt_out + (size_t)(nt * 128 + srow) * 1024 + sch * 8;
  MidScale mid; float rss[4];
#pragma unroll
  for (int i = 0; i < 4; ++i) {
    const int m = mt * 128 + wr * 64 + i * 16 + qi;
    const float4 a0 = *(const float4*)(p.ssq + (size_t)m * 16), a1 = *(const float4*)(p.ssq + (size_t)m * 16 + 4);
    const float4 b0 = *(const float4*)(p.ssq + (size_t)m * 16 + 8), b1 = *(const float4*)(p.ssq + (size_t)m * 16 + 12);
    const float sa = (a0.x + a0.y + a0.z + a0.w) + (a1.x + a1.y + a1.z + a1.w);
    const float sb = (b0.x + b0.y + b0.z + b0.w) + (b1.x + b1.y + b1.z + b1.w);
    const float ra = rsqrtf(sa * (1.0f / 512.0f) + LN_EPS), rb = rsqrtf(sb * (1.0f / 512.0f) + LN_EPS);
    mid.s[i] = ra / rb; rss[i] = rb;
  }
  f32x4 acc[4][4];
  ZERO_ACC(acc);
  gemm_main(smem, A, A + 32 * 1024, A + 64 * 1024, A + 96 * 1024, B, B + 32 * 1024, B + 64 * 1024, B + 96 * 1024, 16, 8, false, acc, mid);
#pragma unroll
  for (int i = 0; i < 4; ++i) {
    const int m = mt * 128 + wr * 64 + i * 16 + qi;
#pragma unroll
    for (int j = 0; j < 4; ++j) {
      const int n = nt * 128 + wc * 64 + j * 16 + 4 * g;
      const u32x2 xr = *(const u32x2*)(p.xb + (size_t)m * 1024 + n);
      const float o0 = ALPHA * __uint_as_float(xr.x << 16) + acc[i][j][0] * rss[i];
      const float o1 = ALPHA * __uint_as_float(xr.x & 0xffff0000u) + acc[i][j][1] * rss[i];
      const float o2 = ALPHA * __uint_as_float(xr.y << 16) + acc[i][j][2] * rss[i];
      const float o3 = ALPHA * __uint_as_float(xr.y & 0xffff0000u) + acc[i][j][3] * rss[i];
      store_bf16x4(p.hb + (size_t)m * 1024 + n, o0, o1, o2, o3);
    }
  }
}

__device__ void p4_batch(const Params& p, int l, int batch, unsigned char* smem) {
  const int tid = otid(), lane = tid & 63, w = tid >> 6;
  int* scnt = (int*)smem;
  int* sbase = scnt + 16;
  __syncthreads();
  if (tid < 16) scnt[tid] = 0;
  __syncthreads();
  const int tokw = batch * 32 + w * 8;
  {
    float4 gm[4], bt[4];
#pragma unroll
    for (int q = 0; q < 4; ++q) {
      gm[q] = *(const float4*)(p.ln1_g + l * 1024 + q * 256 + lane * 4);
      bt[q] = *(const float4*)(p.ln1_b + l * 1024 + q * 256 + lane * 4);
    }
#pragma unroll 4
    for (int t = 0; t < 8; ++t) {
      const bf16_t* hr = p.hb + (size_t)(tokw + t) * 1024 + lane * 4;
      float4 v[4];
#pragma unroll
      for (int q = 0; q < 4; ++q) {
        const u32x2 hh = *(const u32x2*)(hr + q * 256);
        v[q].x = __uint_as_float(hh.x << 16); v[q].y = __uint_as_float(hh.x & 0xffff0000u);
        v[q].z = __uint_as_float(hh.y << 16); v[q].w = __uint_as_float(hh.y & 0xffff0000u);
      }
      float s1 = 0.f;
#pragma unroll
      for (int q = 0; q < 4; ++q) s1 += (v[q].x + v[q].y) + (v[q].z + v[q].w);
      const float mu = wave_sum(s1) * (1.0f / 1024.0f);
      float s2 = 0.f;
#pragma unroll
      for (int q = 0; q < 4; ++q) {
        const float d0 = v[q].x - mu, d1 = v[q].y - mu, d2 = v[q].z - mu, d3 = v[q].w - mu;
        s2 += (d0 * d0 + d1 * d1) + (d2 * d2 + d3 * d3);
      }
      const float rstd = rsqrtf(wave_sum(s2) * (1.0f / 1024.0f) + LN_EPS);
#pragma unroll
      for (int q = 0; q < 4; ++q) {
        float4 o;
        o.x = (v[q].x - mu) * rstd * gm[q].x + bt[q].x; o.y = (v[q].y - mu) * rstd * gm[q].y + bt[q].y;
        o.z = (v[q].z - mu) * rstd * gm[q].z + bt[q].z; o.w = (v[q].w - mu) * rstd * gm[q].w + bt[q].w;
        u32x2 hi; hi.x = cvt_pk_bf16(o.x, o.y); hi.y = cvt_pk_bf16(o.z, o.w);
        *(u32x2*)(p.xb + (size_t)(tokw + t) * 1024 + q * 256 + lane * 4) = hi;
        store_bf16x4(p.x1lo + (size_t)(tokw + t) * 1024 + q * 256 + lane * 4, o.x - __uint_as_float(hi.x << 16), o.y - __uint_as_float(hi.x & 0xffff0000u),
                     o.z - __uint_as_float(hi.y << 16), o.w - __uint_as_float(hi.y & 0xffff0000u));
      }
    }
  }
  asm volatile("s_waitcnt vmcnt(0)" ::: "memory");
  __syncthreads();
  const int j = lane & 15, g = lane >> 4;
  float* part = (float*)(smem + 1024);
  {
    const size_t xo0 = (size_t)(batch * 32 + j) * 1024 + 256 * w + 8 * g, xo1 = xo0 + 16 * 1024;
    const size_t wof = ((size_t)(8 * w * 4 + g) * 16 + j) * 8;
    f32x4 De0 = {0.f, 0.f, 0.f, 0.f}, Dg0 = De0, De1 = De0, Dg1 = De0;
#pragma unroll 2
    for (int kb = 0; kb < 8; ++kb) {
      const bf16x8 xh0 = *(const bf16x8*)(p.xb + xo0 + kb * 32), xl0 = *(const bf16x8*)(p.x1lo + xo0 + kb * 32);
      const bf16x8 xh1 = *(const bf16x8*)(p.xb + xo1 + kb * 32), xl1 = *(const bf16x8*)(p.x1lo + xo1 + kb * 32);
      const bf16x8 weh = *(const bf16x8*)(p.Wr_eh + wof + kb * 512), wel = *(const bf16x8*)(p.Wr_el + wof + kb * 512);
      const bf16x8 wgh = *(const bf16x8*)(p.Wr_gh + wof + kb * 512), wgl = *(const bf16x8*)(p.Wr_gl + wof + kb * 512);
      De0 = __builtin_amdgcn_mfma_f32_16x16x32_bf16(weh, xh0, De0, 0, 0, 0);
      Dg0 = __builtin_amdgcn_mfma_f32_16x16x32_bf16(wgh, xh0, Dg0, 0, 0, 0);
      De0 = __builtin_amdgcn_mfma_f32_16x16x32_bf16(weh, xl0, De0, 0, 0, 0);
      Dg0 = __builtin_amdgcn_mfma_f32_16x16x32_bf16(wgh, xl0, Dg0, 0, 0, 0);
      De0 = __builtin_amdgcn_mfma_f32_16x16x32_bf16(wel, xh0, De0, 0, 0, 0);
      Dg0 = __builtin_amdgcn_mfma_f32_16x16x32_bf16(wgl, xh0, Dg0, 0, 0, 0);
      De1 = __builtin_amdgcn_mfma_f32_16x16x32_bf16(weh, xh1, De1, 0, 0, 0);
      Dg1 = __builtin_amdgcn_mfma_f32_16x16x32_bf16(wgh, xh1, Dg1, 0, 0, 0);
      De1 = __builtin_amdgcn_mfma_f32_16x16x32_bf16(weh, xl1, De1, 0, 0, 0);
      Dg1 = __builtin_amdgcn_mfma_f32_16x16x32_bf16(wgh, xl1, Dg1, 0, 0, 0);
      De1 = __builtin_amdgcn_mfma_f32_16x16x32_bf16(wel, xh1, De1, 0, 0, 0);
      Dg1 = __builtin_amdgcn_mfma_f32_16x16x32_bf16(wgl, xh1, Dg1, 0, 0, 0);
    }
    float* pw = part + ((size_t)(w * 2) * 64 + lane) * 8;
    *(f32x4*)(pw) = De0; *(f32x4*)(pw + 4) = Dg0;
    *(f32x4*)(pw + 512) = De1; *(f32x4*)(pw + 516) = Dg1;
  }
  __syncthreads();
  const int tok = tokw + (j & 7);
  f32x4 De = {0.f, 0.f, 0.f, 0.f}, Dg = {0.f, 0.f, 0.f, 0.f};
  {
    const int ln = g * 16 + (w & 1) * 8 + (j & 7), tl = w >> 1;
#pragma unroll
    for (int ww = 0; ww < 4; ++ww) {
      const float* pr = part + ((size_t)(ww * 2 + tl) * 64 + ln) * 8;
      De += *(const f32x4*)(pr); Dg += *(const f32x4*)(pr + 4);
    }
  }
  float gl[4];
#pragma unroll
  for (int k = 0; k < 4; ++k) gl[k] = __shfl(Dg[k], j) + p.rg_b[l * 4 + k];
  int gs = 0; float gmax = gl[0];
#pragma unroll
  for (int k = 1; k < 4; ++k) { const bool bb = gl[k] > gmax; gmax = bb ? gl[k] : gmax; gs = bb ? k : gs; }
  float psum = 0.f;
#pragma unroll
  for (int k = 0; k < 4; ++k) psum += __expf(gl[k] - gmax);
  const float gate = 1.0f / psum;
  float es[4];
#pragma unroll
  for (int k = 0; k < 4; ++k) es[k] = De[k] + p.re_b[l * 16 + 4 * g + k];
  int i0 = 0; float v0 = es[0];
#pragma unroll
  for (int k = 1; k < 4; ++k) { const bool bb = es[k] > v0; v0 = bb ? es[k] : v0; i0 = bb ? k : i0; }
  int i1 = 0; float v1 = -3.0e38f;
#pragma unroll
  for (int k = 0; k < 4; ++k) { const bool bb = (k != i0) && (es[k] > v1); v1 = bb ? es[k] : v1; i1 = bb ? k : i1; }
  const float ex = __expf(v1 - v0);
  const float tw0 = 1.0f / (1.0f + ex), tw1 = ex / (1.0f + ex);
  const bool commit = (g == gs) && (j < 8);
  const int e0 = gs * 4 + i0, e1 = gs * 4 + i1;
  int lp0 = 0, lp1 = 0;
  if (commit) { lp0 = atomicAdd(&scnt[e0], 1); lp1 = atomicAdd(&scnt[e1], 1); }
  __syncthreads();
  if (tid < 16) sbase[tid] = atomicAdd(p.counts + l * 16 + tid, scnt[tid]);
  __syncthreads();
  if (commit) {
    const int pos0 = sbase[e0] + lp0, pos1 = sbase[e1] + lp1;
    p.list[e0 * NTOK + pos0] = tok; p.wlist[e0 * NTOK + pos0] = gate * tw0;
    p.list[e1 * NTOK + pos1] = tok; p.wlist[e1 * NTOK + pos1] = gate * tw1;
    int4 ti; ti.x = e0; ti.y = pos0; ti.z = e1; ti.w = pos1;
    *(int4*)(p.tokinfo + (size_t)tok * 4) = ti;
  }
}

__device__ __forceinline__ int moe_total_mtiles(const int* cnts) {
  int tot = 0;
#pragma unroll
  for (int e = 0; e < 16; ++e) tot += (cnts[e] + 127) >> 7;
  return tot;
}
__device__ __forceinline__ void moe_find(const int* cnts, int mi, int& e_out, int& ml, int& off, int& cnt) {
  int rem = mi, o = 0; e_out = 0; ml = 0; off = 0; cnt = 1;
  bool found = false;
#pragma unroll
  for (int e = 0; e < 16; ++e) {
    const int c = cnts[e], mtl = (c + 127) >> 7;
    if (!found && rem < mtl) { found = true; e_out = e; ml = rem; off = o; cnt = c; }
    rem -= mtl; o += c;
  }
}

__device__ void p5_tile(const Params& p, int l, int t, int mtot, unsigned char* smem) {
  const int mi = (t >> 5) * 8 + (t & 7), nt = (t >> 3) & 3;
  if (mi >= mtot) return;
  int e, ml, off, cnt;
  moe_find(p.counts + l * 16, mi, e, ml, off, cnt);
  const int tid = otid(), lane = tid & 63, wid = tid >> 6, wr = wid >> 1, wc = wid & 1;
  const int srow = tid >> 3, sch = tid & 7, qi = lane & 15, g = lane >> 4;
  const bf16_t* pa[4];
#pragma unroll
  for (int i = 0; i < 4; ++i) {
    const int ridx = min(ml * 128 + srow + 32 * i, cnt - 1);
    const int tok = p.list[e * NTOK + ridx];
    pa[i] = p.xb + (size_t)tok * 1024 + sch * 8;
  }
  const bf16_t* B = p.Wgu + ((size_t)e * 512 + nt * 128 + srow) * 1024 + sch * 8;
  f32x4 acc[4][4];
  ZERO_ACC(acc);
  gemm_main(smem, pa[0], pa[1], pa[2], pa[3], B, B + 32 * 1024, B + 64 * 1024, B + 96 * 1024, 16, -1, false, acc, NoMid());
#pragma unroll
  for (int i = 0; i < 4; ++i) {
    const int rloc = ml * 128 + wr * 64 + i * 16 + qi;
    if (rloc < cnt) {
      const size_t slot = (size_t)off + rloc;
#pragma unroll
      for (int jp = 0; jp < 2; ++jp) {
        const f32x4 ga = acc[i][2 * jp], up = acc[i][2 * jp + 1];
        const int col = 64 * nt + 32 * wc + 16 * jp + 4 * g;
        store_bf16x4(p.act + slot * 256 + col, silu(ga[0]) * up[0], silu(ga[1]) * up[1], silu(ga[2]) * up[2], silu(ga[3]) * up[3]);
      }
    }
  }
}

struct P6Tile { int e, ml, off, cnt, nt; const bf16_t* pa0; const bf16_t* pa1; const bf16_t* pa2; const bf16_t* pa3; const bf16_t* B; };
__device__ __forceinline__ int p6_next(int t, int ntot, int mtot, int nblk) {
  while (t < ntot && ((t >> 6) * 8 + (t & 7)) >= mtot) t += nblk;
  return t;
}
__device__ __forceinline__ void p6_setup(const Params& p, int l, int t, P6Tile& T) {
  const int mi = (t >> 6) * 8 + (t & 7);
  T.nt = (t >> 3) & 7;
  moe_find(p.counts + l * 16, mi, T.e, T.ml, T.off, T.cnt);
  const int tid = otid(), srow = tid >> 3, sch = tid & 7;
  const bf16_t* base = p.act + (size_t)T.off * 256 + sch * 8;
  T.pa0 = base + (size_t)min(T.ml * 128 + srow, T.cnt - 1) * 256;
  T.pa1 = base + (size_t)min(T.ml * 128 + srow + 32, T.cnt - 1) * 256;
  T.pa2 = base + (size_t)min(T.ml * 128 + srow + 64, T.cnt - 1) * 256;
  T.pa3 = base + (size_t)min(T.ml * 128 + srow + 96, T.cnt - 1) * 256;
  T.B = p.Wdn + ((size_t)T.e * 1024 + T.nt * 128 + srow) * 256 + sch * 8;
}
__device__ void p6_phase(const Params& p, int l, int bid, int nblk, unsigned char* smem) {
  const int mtot = moe_total_mtiles(p.counts + l * 16), ntot = ((mtot + 7) >> 3) * 64;
  P6Tile cur, nxt;
  int t = p6_next(bid, ntot, mtot, nblk);
  if (t < ntot) {
    p6_setup(p, l, t, cur);
    __syncthreads();
    gemm_issue0(smem, cur.pa0, cur.pa1, cur.pa2, cur.pa3, cur.B, cur.B + 32 * 256, cur.B + 64 * 256, cur.B + 96 * 256);
  }
  while (t < ntot) {
    f32x4 acc[4][4];
    ZERO_ACC(acc);
    gemm_main<true>(smem, cur.pa0, cur.pa1, cur.pa2, cur.pa3, cur.B, cur.B + 32 * 256, cur.B + 64 * 256, cur.B + 96 * 256, 4, -1, false, acc, NoMid());
    const int tn = p6_next(t + nblk, ntot, mtot, nblk);
    nxt = cur;
    if (tn < ntot) {
      p6_setup(p, l, tn, nxt);
      gemm_issue0(smem, nxt.pa0, nxt.pa1, nxt.pa2, nxt.pa3, nxt.B, nxt.B + 32 * 256, nxt.B + 64 * 256, nxt.B + 96 * 256);
    }
    {
      const int tid = otid(), lane = tid & 63, wid = tid >> 6, wr = wid >> 1, wc = wid & 1, qi = lane & 15, g = lane >> 4;
#pragma unroll
      for (int i = 0; i < 4; ++i) {
        const int rloc = cur.ml * 128 + wr * 64 + i * 16 + qi;
        if (rloc < cur.cnt) {
          const float wgt = p.wlist[cur.e * NTOK + rloc];
          const size_t slot = (size_t)cur.off + rloc;
#pragma unroll
          for (int j = 0; j < 4; ++j) {
            const int n = cur.nt * 128 + wc * 64 + j * 16 + 4 * g;
            store_bf16x4(p.y + slot * 1024 + n, acc[i][j][0] * wgt, acc[i][j][1] * wgt, acc[i][j][2] * wgt, acc[i][j][3] * wgt);
          }
        }
      }
    }
    cur = nxt; t = tn;
  }
}

template <int NT>
__device__ __forceinline__ void p7_tokens(const Params& p, int l, int tok0, int tstride) {
  const int lane = otid() & 63;
  int4 ti[NT];
#pragma unroll
  for (int u = 0; u < NT; ++u) ti[u] = *(const int4*)(p.tokinfo + (size_t)(tok0 + u * tstride) * 4);
  int off0[NT], off1[NT];
#pragma unroll
  for (int u = 0; u < NT; ++u) { off0[u] = 0; off1[u] = 0; }
#pragma unroll
  for (int e = 0; e < 16; ++e) {
    const int c = p.counts[l * 16 + e];
#pragma unroll
    for (int u = 0; u < NT; ++u) { if (e < ti[u].x) off0[u] += c; if (e < ti[u].z) off1[u] += c; }
  }
  float4 xr[NT][4]; u32x2 ya[NT][4], yb[NT][4];
#pragma unroll
  for (int u = 0; u < NT; ++u) {
    const int tok = tok0 + u * tstride;
    const size_t s0 = (size_t)off0[u] + ti[u].y, s1 = (size_t)off1[u] + ti[u].w;
#pragma unroll
    for (int q = 0; q < 4; ++q) {
      const int c = q * 256 + lane * 4;
      { const u32x2 xh_ = *(const u32x2*)(p.xb + (size_t)tok * 1024 + c), xl_ = *(const u32x2*)(p.x1lo + (size_t)tok * 1024 + c);
        xr[u][q].x = __uint_as_float(xh_.x << 16) + __uint_as_float(xl_.x << 16);
        xr[u][q].y = __uint_as_float(xh_.x & 0xffff0000u) + __uint_as_float(xl_.x & 0xffff0000u);
        xr[u][q].z = __uint_as_float(xh_.y << 16) + __uint_as_float(xl_.y << 16);
        xr[u][q].w = __uint_as_float(xh_.y & 0xffff0000u) + __uint_as_float(xl_.y & 0xffff0000u); }
      ya[u][q] = *(const u32x2*)(p.y + s0 * 1024 + c);
      yb[u][q] = *(const u32x2*)(p.y + s1 * 1024 + c);
    }
  }
  float4 gg[4], bb[4];
#pragma unroll
  for (int q = 0; q < 4; ++q) {
    gg[q] = *(const float4*)(p.ln2_g + l * 1024 + q * 256 + lane * 4);
    bb[q] = *(const float4*)(p.ln2_b + l * 1024 + q * 256 + lane * 4);
  }
#pragma unroll
  for (int u = 0; u < NT; ++u) {
    const int tok = tok0 + u * tstride;
    float hv[16];
#pragma unroll
    for (int q = 0; q < 4; ++q) {
      hv[q * 4 + 0] = ALPHA * xr[u][q].x + (__uint_as_float(ya[u][q].x << 16) + __uint_as_float(yb[u][q].x << 16));
      hv[q * 4 + 1] = ALPHA * xr[u][q].y + (__uint_as_float(ya[u][q].x & 0xffff0000u) + __uint_as_float(yb[u][q].x & 0xffff0000u));
      hv[q * 4 + 2] = ALPHA * xr[u][q].z + (__uint_as_float(ya[u][q].y << 16) + __uint_as_float(yb[u][q].y << 16));
      hv[q * 4 + 3] = ALPHA * xr[u][q].w + (__uint_as_float(ya[u][q].y & 0xffff0000u) + __uint_as_float(yb[u][q].y & 0xffff0000u));
    }
    float s1s = 0.f;
#pragma unroll
    for (int c = 0; c < 16; ++c) s1s += hv[c];
    const float mu = wave_sum(s1s) * (1.0f / 1024.0f);
    float s2 = 0.f;
#pragma unroll
    for (int c = 0; c < 16; ++c) { const float d = hv[c] - mu; s2 += d * d; }
    const float rstd = rsqrtf(wave_sum(s2) * (1.0f / 1024.0f) + LN_EPS);
#pragma unroll
    for (int q = 0; q < 4; ++q) {
      const int c = q * 256 + lane * 4;
      float4 o;
      o.x = (hv[q * 4 + 0] - mu) * rstd * gg[q].x + bb[q].x; o.y = (hv[q * 4 + 1] - mu) * rstd * gg[q].y + bb[q].y;
      o.z = (hv[q * 4 + 2] - mu) * rstd * gg[q].z + bb[q].z; o.w = (hv[q * 4 + 3] - mu) * rstd * gg[q].w + bb[q].w;
      if (l == 3) *(float4*)(p.out + (size_t)tok * 1024 + c) = o;
      else store_bf16x4(p.xb + (size_t)tok * 1024 + c, o.x, o.y, o.z, o.w);
    }
  }
}

#define XB_TMO      128
#define XB_XCNT(j)  (256  + 64 * (j))
#define XB_XSUB(j)  (1280 + 64 * (j))
#define XB_XGEN(j)  (2304 + 64 * (j))
#define XB_TOP      3328
#define XB_TOPGEN   3392
#define XCD_BAR_WORDS 3456
#define XB_SPIN_CAP (1u << 22)
__device__ __forceinline__ unsigned xb_ld(unsigned* p) { return __hip_atomic_load(p, __ATOMIC_RELAXED, __HIP_MEMORY_SCOPE_AGENT); }
__device__ __forceinline__ unsigned xb_add(unsigned* p, unsigned v) { return __hip_atomic_fetch_add(p, v, __ATOMIC_RELAXED, __HIP_MEMORY_SCOPE_AGENT); }
__device__ __forceinline__ unsigned xb_xcc_id() { return (unsigned)__builtin_amdgcn_s_getreg((3 << 11) | 20) & 0xFu; }
#define XB_SPIN(cond, bar) do { unsigned _sp = 0; while (cond) { __builtin_amdgcn_s_sleep(1); \
    if ((++_sp & 255u) == 0u) { if (xb_ld(&(bar)[XB_TMO])) break; if (_sp > XB_SPIN_CAP) { atomicAdd(&(bar)[XB_TMO], 1u); break; } } } } while (0)
struct XcdBarrier { unsigned* bar; unsigned x; volatile unsigned* st; };
__device__ __forceinline__ XcdBarrier xcd_barrier_post(unsigned* bar, volatile unsigned* st) {
  XcdBarrier b; b.bar = bar; b.x = xb_xcc_id(); b.st = st;
  if (threadIdx.x == 0) (void)xb_add(&bar[XB_XCNT(b.x)], 1u);
  return b;
}
__device__ __forceinline__ void xcd_barrier_complete(unsigned* bar, unsigned x, unsigned& nloc, unsigned& nx) {
  const unsigned G = gridDim.x;
  unsigned sum, cnt, mine, sp = 0u;
  for (;;) {
    sum = 0u; cnt = 0u; mine = 0u;
#pragma unroll
    for (unsigned j = 0; j < 16; ++j) { const unsigned c = xb_ld(&bar[XB_XCNT(j)]); sum += c; cnt += (c > 0u) ? 1u : 0u; mine = (j == x) ? c : mine; }
    if (sum == G) break;
    __builtin_amdgcn_s_sleep(1);
    if ((++sp & 255u) == 0u) { if (xb_ld(&bar[XB_TMO])) break; if (sp > XB_SPIN_CAP) { atomicAdd(&bar[XB_TMO], 1u); break; } }
  }
  nloc = mine > 0u ? mine : 1u; nx = cnt > 0u ? cnt : 1u;
}
__device__ __forceinline__ void xcd_barrier(const XcdBarrier& b) {
  asm volatile("s_waitcnt vmcnt(0)" ::: "memory");
  __syncthreads();
  if (threadIdx.x == 0) {
    unsigned* bar = b.bar;
    __builtin_amdgcn_s_waitcnt(0);
    unsigned nloc = b.st[0], nx = b.st[1];
    if (nloc == 0u) { xcd_barrier_complete(bar, b.x, nloc, nx); b.st[0] = nloc; b.st[1] = nx; }
    const unsigned old = xb_add(&bar[XB_XSUB(b.x)], 1u);
    const unsigned gen = old / nloc;
    if (old + 1u == (gen + 1u) * nloc) {
      __builtin_amdgcn_fence(__ATOMIC_RELEASE, "agent");
      asm volatile("s_waitcnt vmcnt(0)" ::: "memory");
      const unsigned og = xb_add(&bar[XB_TOP], 1u);
      const unsigned tg = og / nx;
      if (og + 1u == (tg + 1u) * nx) xb_add(&bar[XB_TOPGEN], 1u);
      else XB_SPIN(xb_ld(&bar[XB_TOPGEN]) == tg, bar);
      __builtin_amdgcn_fence(__ATOMIC_ACQUIRE, "agent");
      xb_add(&bar[XB_XGEN(b.x)], 1u);
      asm volatile("s_waitcnt vmcnt(0)" ::: "memory");
    } else {
      XB_SPIN(xb_ld(&bar[XB_XGEN(b.x)]) == gen, bar);
      __builtin_amdgcn_fence(__ATOMIC_ACQUIRE, "agent");
      asm volatile("s_waitcnt vmcnt(0)" ::: "memory");
    }
  }
  __syncthreads();
}

__device__ __forceinline__ void run_phase(const Params& p, int ph, int l, int bid, int nblk, unsigned char* smem, float* sbias) {
  switch (ph) {
    case 0: {
      if (bid == 0 && threadIdx.x < 64) p.counts[threadIdx.x] = 0;
      conv_x(p, bid, nblk);
      for (int it = bid; it < NCONV_ITEMS; it += nblk) conv_item(p, 0, it, smem);
    } break;
    case 1: p1_phase(p, l, bid, nblk, smem); break;
    case 2:
      attn_phase(p, l, bid, nblk, smem);
      for (int it = bid; it < 1024; it += nblk) sgu_item(p, l, it, smem);
      break;
    case 3: for (int t = bid; t < 1024; t += nblk) p3_tile(p, l, t, smem); break;
    case 4: for (int it = bid; it < NTOK / 32; it += nblk) p4_batch(p, l, it, smem); break;
    case 5: { const int mtot = moe_total_mtiles(p.counts + l * 16), nt = ((mtot + 7) >> 3) * 32; for (int t = bid; t < nt; t += nblk) p5_tile(p, l, t, mtot, smem); } break;
    case 6: p6_phase(p, l, bid, nblk, smem); break;
    case 7: {
      { const int nw = nblk * 4; int tok = bid * 4 + (threadIdx.x >> 6);
        for (; tok + 3 * nw < NTOK; tok += 4 * nw) p7_tokens<4>(p, l, tok, nw);
        for (; tok < NTOK; tok += nw) p7_tokens<1>(p, l, tok, nw); }
      if (l < 3) for (int it = bid; it < NCONV_ITEMS; it += nblk) conv_item(p, l + 1, it, smem);
    } break;
  }
}

template <int PH>
__global__ void __launch_bounds__(256, 2) phase_kernel(Params p, int l) {
  __shared__ __attribute__((aligned(16))) unsigned char smem[SMEM_BYTES];
  run_phase(p, PH, l, blockIdx.x, gridDim.x, smem, (float*)smem);
}

#if MEGA
__global__ void __launch_bounds__(256, 2) mega_kernel(Params p) {
  __shared__ __attribute__((aligned(16))) unsigned char smem[SMEM_BYTES];
  __shared__ uint4 xb_words;
  float* sbias = (float*)smem;
  cg::grid_group grid = cg::this_grid();
  const int bid = blockIdx.x, nblk = gridDim.x;
  if (threadIdx.x == 0) xb_words = make_uint4(0u, 0u, 0u, 0u);
  __syncthreads();
  XcdBarrier xb = xcd_barrier_post(p.bar, (volatile unsigned*)&xb_words);
  run_phase(p, 0, 0, bid, nblk, smem, sbias);
  if (p.never) grid.sync();
  xcd_barrier(xb);
#pragma unroll 1
  for (int l = 0; l < 4; ++l) {
#pragma unroll 1
    for (int ph = 1; ph <= 7; ++ph) {
      run_phase(p, ph, l, bid, nblk, smem, sbias);
#if DUP_PH
      if (ph == DUP_PH) { xcd_barrier(xb); run_phase(p, ph, l, bid, nblk, smem, sbias); }
#endif
      if (!(l == 3 && ph == 7)) xcd_barrier(xb);
    }
  }
}
#endif

extern "C" void kernel_launch(void* const* d_in, const int* in_sizes, int n_in, void* d_out, int out_size, void* d_ws,
                              size_t ws_size, hipStream_t stream) {
  Params p{};
  p.x = (const float*)d_in[0]; p.w_in = (const float*)d_in[1]; p.w_out = (const float*)d_in[2]; p.rel_bias = (const float*)d_in[3];
  p.sgu_ln_g = (const float*)d_in[4]; p.sgu_ln_b = (const float*)d_in[5]; p.sgu_w = (const float*)d_in[6]; p.sgu_b = (const float*)d_in[7];
  p.mix_g = (const float*)d_in[8]; p.ln1_g = (const float*)d_in[9]; p.ln1_b = (const float*)d_in[10];
  p.rg_w = (const float*)d_in[11]; p.rg_b = (const float*)d_in[12]; p.re_w = (const float*)d_in[13]; p.re_b = (const float*)d_in[14];
  p.w_gate = (const float*)d_in[15]; p.w_up = (const float*)d_in[16]; p.w_down = (const float*)d_in[17];
  p.ln2_g = (const float*)d_in[18]; p.ln2_b = (const float*)d_in[19];
  p.out = (float*)d_out;
  unsigned char* w = (unsigned char*)d_ws;
  size_t o = 0;
  auto take = [&](size_t bytes) { unsigned char* r = w + o; o += (bytes + 255) & ~(size_t)255; return r; };
  p.Wt_in = (bf16_t*)take((size_t)2560 * 1024 * 2);
  p.Wt_out = (bf16_t*)take((size_t)1024 * 1024 * 2);
  p.Wgu = (bf16_t*)take((size_t)16 * 512 * 1024 * 2);
  p.Wdn = (bf16_t*)take((size_t)16 * 1024 * 256 * 2);
  p.Wsgu = (bf16_t*)take((size_t)8 * 128 * 128 * 2);
  p.xb = (bf16_t*)take((size_t)NTOK * 1024 * 2);
  p.x1 = (float*)take((size_t)NTOK * 1024 * 4);
  p.x1lo = (bf16_t*)p.x1;
  unsigned char* r1 = take((size_t)NTOK * 2560 * 2);
  p.qk = (bf16_t*)r1;
  p.vT = (bf16_t*)(r1 + (size_t)NTOK * 1024 * 2);
  p.ub = (bf16_t*)(r1 + (size_t)NTOK * 1536 * 2);
  p.vnT = (bf16_t*)(r1 + (size_t)NTOK * 2048 * 2);
  p.y = (bf16_t*)r1;
  p.hb = (bf16_t*)r1;
  unsigned char* r2 = take((size_t)NTOK * 1024 * 2);
  p.mixed = (bf16_t*)r2;
  p.act = (bf16_t*)r2;
  p.ssq = (float*)take((size_t)NTOK * 16 * 4);
  p.wlist = (float*)take((size_t)16 * NTOK * 4);
  p.list = (int*)take((size_t)16 * NTOK * 4);
  p.tokinfo = (int*)take((size_t)NTOK * 4 * 4);
  p.counts = (int*)take(256);
  p.Wr_eh = (bf16_t*)take(16384 * 2); p.Wr_el = (bf16_t*)take(16384 * 2);
  p.Wr_gh = (bf16_t*)take(16384 * 2); p.Wr_gl = (bf16_t*)take(16384 * 2);
  p.bar = (unsigned*)take(XCD_BAR_WORDS * 4);
#if MEGA
  static int grid_blocks = 0;
  if (!grid_blocks) {
    int dev = 0, cus = 0, per_cu = 0;
    hipGetDevice(&dev);
    hipDeviceGetAttribute(&cus, hipDeviceAttributeMultiprocessorCount, dev);
    hipOccupancyMaxActiveBlocksPerMultiprocessor(&per_cu, mega_kernel, 256, 0);
    if (per_cu > 2) per_cu = 2;
    grid_blocks = cus * per_cu;
  }
  (void)hipMemsetAsync(p.bar, 0, XCD_BAR_WORDS * 4, stream);
  void* args[] = {&p};
  hipError_t e = hipLaunchCooperativeKernel((void*)mega_kernel, dim3(grid_blocks), dim3(256), args, 0, stream);
  if (e != hipSuccess) fprintf(stderr, "cooperative launch failed: %s (grid %d)\n", hipGetErrorString(e), grid_blocks);
#else
  const int G = 512;
  phase_kernel<0><<<G, 256, 0, stream>>>(p, 0);
  for (int l = 0; l < 4; ++l) {
    phase_kernel<1><<<G, 256, 0, stream>>>(p, l);
    phase_kernel<2><<<G, 256, 0, stream>>>(p, l);
    phase_kernel<3><<<G, 256, 0, stream>>>(p, l);
    phase_kernel<4><<<G, 256, 0, stream>>>(p, l);
    phase_kernel<5><<<G, 256, 0, stream>>>(p, l);
    phase_kernel<6><<<G, 256, 0, stream>>>(p, l);
    phase_kernel<7><<<G, 256, 0, stream>>>(p, l);
  }
#endif
}
```

```cpp
#include <hip/hip_runtime.h>
#include <hip/hip_cooperative_groups.h>
#include <stdint.h>
#include <cstdio>
namespace cg = cooperative_groups;

#ifndef MEGA
#define MEGA 1
#endif
#define DUP_PH 0

typedef unsigned short bf16_t;
typedef short bf16x8 __attribute__((ext_vector_type(8)));
typedef float f32x4 __attribute__((ext_vector_type(4)));
typedef unsigned u32x4 __attribute__((ext_vector_type(4)));
typedef unsigned u32x2 __attribute__((ext_vector_type(2)));

#define NTOK 16384
#define LN_EPS 1e-5f
#define ALPHA 1.681792830507429f
#define NCONV_ITEMS 1024
#define SMEM_BYTES 69632

struct Params {
  const float *x, *w_in, *w_out, *rel_bias, *sgu_ln_g, *sgu_ln_b, *sgu_w, *sgu_b, *mix_g, *ln1_g, *ln1_b,
      *rg_w, *rg_b, *re_w, *re_b, *w_gate, *w_up, *w_down, *ln2_g, *ln2_b;
  float* out;
  bf16_t *Wt_in, *Wt_out, *Wgu, *Wdn, *Wsgu, *xb, *qk, *vT, *ub, *vnT, *mixed, *act, *y, *hb;
  float *x1, *ssq, *wlist;
  bf16_t *Wr_eh, *Wr_el, *Wr_gh, *Wr_gl;
  bf16_t* x1lo;
  int *counts, *list, *tokinfo;
  unsigned* bar;
  int never;
  int pad_;
};

__device__ __forceinline__ unsigned cvt_pk_bf16(float lo, float hi) {
  unsigned r; asm("v_cvt_pk_bf16_f32 %0, %1, %2" : "=v"(r) : "v"(lo), "v"(hi)); return r;
}
__device__ __forceinline__ void store_bf16x4(bf16_t* p, float a, float b, float c, float d) {
  u32x2 v; v.x = cvt_pk_bf16(a, b); v.y = cvt_pk_bf16(c, d); *(u32x2*)p = v;
}
__device__ __forceinline__ float gelu_tanh(float x) {
  const float t = x * (-2.302208198f + -0.102943249f * (x * x));
  return x * __builtin_amdgcn_rcpf(1.0f + __builtin_amdgcn_exp2f(t));
}
__device__ __forceinline__ int otid() { int t = threadIdx.x; asm volatile("" : "+v"(t)); return t; }
__device__ __forceinline__ float silu(float x) { return x * __builtin_amdgcn_rcpf(1.0f + __builtin_amdgcn_exp2f(-1.442695041f * x)); }
template <int CTRL>
__device__ __forceinline__ float dpp_mov(float v) {
  return __builtin_bit_cast(float, __builtin_amdgcn_update_dpp(0, __builtin_bit_cast(int, v), CTRL, 0xf, 0xf, true));
}
__device__ __forceinline__ float row16_sum(float v) {
  v += dpp_mov<0xB1>(v); v += dpp_mov<0x4E>(v); v += dpp_mov<0x141>(v); v += dpp_mov<0x140>(v); return v;
}
__device__ __forceinline__ float wave_sum(float v) {
  v = row16_sum(v); v += __shfl_xor(v, 16); v += __shfl_xor(v, 32); return v;
}

struct NoMid { __device__ __forceinline__ void operator()(f32x4 (&)[4][4]) const {} };
struct MidScale {
  float s[4];
  __device__ __forceinline__ void operator()(f32x4 (&acc)[4][4]) const {
#pragma unroll
    for (int i = 0; i < 4; ++i)
#pragma unroll
      for (int j = 0; j < 4; ++j) acc[i][j] *= s[i];
  }
};

#define GLDS16(gptr, lptr) __builtin_amdgcn_global_load_lds((const unsigned*)(gptr), (__attribute__((address_space(3))) unsigned*)(lptr), 16, 0, 0)

__device__ __forceinline__ void gemm_issue0(unsigned char* smem, const bf16_t* pa0, const bf16_t* pa1, const bf16_t* pa2,
                                            const bf16_t* pa3, const bf16_t* pb0, const bf16_t* pb1, const bf16_t* pb2,
                                            const bf16_t* pb3) {
  const int tid = otid(), wid = tid >> 6, srow = tid >> 3;
  const int lch = ((tid & 7) ^ ((srow >> 1) & 7)) * 8 - (tid & 7) * 8;
  unsigned char* d = smem + __builtin_amdgcn_readfirstlane(wid) * 1024;
  GLDS16(pa0 + lch, d); GLDS16(pa1 + lch, d + 4096); GLDS16(pa2 + lch, d + 8192); GLDS16(pa3 + lch, d + 12288);
  GLDS16(pb0 + lch, d + 16384); GLDS16(pb1 + lch, d + 20480); GLDS16(pb2 + lch, d + 24576); GLDS16(pb3 + lch, d + 28672);
}

template <bool PRE = false, class Mid>
__device__ __forceinline__ void gemm_main(unsigned char* smem, const bf16_t* pa0, const bf16_t* pa1, const bf16_t* pa2,
                                          const bf16_t* pa3, const bf16_t* pb0, const bf16_t* pb1, const bf16_t* pb2,
                                          const bf16_t* pb3, int nk, int kmid, bool swapped, f32x4 (&acc)[4][4],
                                          const Mid& mid) {
  const int tid = otid(), lane = tid & 63, wid = tid >> 6, wr = wid >> 1, wc = wid & 1;
  const int srow = tid >> 3;
  const int lch = ((tid & 7) ^ ((srow >> 1) & 7)) * 8 - (tid & 7) * 8;
  pa0 += lch; pa1 += lch; pa2 += lch; pa3 += lch; pb0 += lch; pb1 += lch; pb2 += lch; pb3 += lch;
  const int soff = __builtin_amdgcn_readfirstlane(wid) * 1024;
  const int qi = lane & 15, g = lane >> 4, s = qi >> 1;
  const int aside = swapped ? 16384 : 0, bside = swapped ? 0 : 16384;
  const int offA0 = aside + (wr * 64 + qi) * 128 + (((0 + g) ^ s) << 4);
  const int offA1 = aside + (wr * 64 + qi) * 128 + (((4 + g) ^ s) << 4);
  const int offB0 = bside + (wc * 64 + qi) * 128 + (((0 + g) ^ s) << 4);
  const int offB1 = bside + (wc * 64 + qi) * 128 + (((4 + g) ^ s) << 4);
  if (!PRE) {
    unsigned char* d = smem + soff;
    GLDS16(pa0, d); GLDS16(pa1, d + 4096); GLDS16(pa2, d + 8192); GLDS16(pa3, d + 12288);
    GLDS16(pb0, d + 16384); GLDS16(pb1, d + 20480); GLDS16(pb2, d + 24576); GLDS16(pb3, d + 28672);
  }
  asm volatile("s_waitcnt vmcnt(0)" ::: "memory");
  __syncthreads();
  for (int kt = 0; kt < nk; ++kt) {
    unsigned char* buf = smem + ((kt & 1) << 15);
    if (kt + 1 < nk) {
      const int ko = (kt + 1) * 64;
      unsigned char* d = smem + (((kt + 1) & 1) << 15) + soff;
      GLDS16(pa0 + ko, d); GLDS16(pa1 + ko, d + 4096); GLDS16(pa2 + ko, d + 8192); GLDS16(pa3 + ko, d + 12288);
      GLDS16(pb0 + ko, d + 16384); GLDS16(pb1 + ko, d + 20480); GLDS16(pb2 + ko, d + 24576); GLDS16(pb3 + ko, d + 28672);
    }
    if (kt == kmid) mid(acc);
    {
      bf16x8 af0[4], bf0[4], af1[4], bf1[4];
#pragma unroll
      for (int i = 0; i < 4; ++i) af0[i] = *(const bf16x8*)(buf + offA0 + i * 2048);
#pragma unroll
      for (int j = 0; j < 4; ++j) bf0[j] = *(const bf16x8*)(buf + offB0 + j * 2048);
#pragma unroll
      for (int i = 0; i < 4; ++i) af1[i] = *(const bf16x8*)(buf + offA1 + i * 2048);
#pragma unroll
      for (int j = 0; j < 4; ++j) bf1[j] = *(const bf16x8*)(buf + offB1 + j * 2048);
      asm volatile("s_waitcnt lgkmcnt(8)" ::: "memory");
      __builtin_amdgcn_s_setprio(1);
#pragma unroll
      for (int i = 0; i < 4; ++i)
#pragma unroll
        for (int j = 0; j < 4; ++j) acc[i][j] = __builtin_amdgcn_mfma_f32_16x16x32_bf16(bf0[j], af0[i], acc[i][j], 0, 0, 0);
      asm volatile("s_waitcnt lgkmcnt(0)" ::: "memory");
#pragma unroll
      for (int i = 0; i < 4; ++i)
#pragma unroll
        for (int j = 0; j < 4; ++j) acc[i][j] = __builtin_amdgcn_mfma_f32_16x16x32_bf16(bf1[j], af1[i], acc[i][j], 0, 0, 0);
      __builtin_amdgcn_s_setprio(0);
    }
    asm volatile("s_waitcnt vmcnt(0)" ::: "memory");
    __syncthreads();
  }
}

#define ZERO_ACC(acc)                                   \
  _Pragma("unroll") for (int i_ = 0; i_ < 4; ++i_)      \
  _Pragma("unroll") for (int j_ = 0; j_ < 4; ++j_) acc[i_][j_] = (f32x4){0.f, 0.f, 0.f, 0.f};

__device__ void conv_x(const Params& p, int bid, int nblk) {
  const size_t n8 = (size_t)NTOK * 1024 / 8;
#pragma unroll 4
  for (size_t i = (size_t)bid * 256 + threadIdx.x; i < n8; i += (size_t)nblk * 256) {
    const f32x4 a_ = __builtin_nontemporal_load((const f32x4*)(p.x + i * 8)), b_ = __builtin_nontemporal_load((const f32x4*)(p.x + i * 8 + 4));
    float4 a, b; a.x = a_[0]; a.y = a_[1]; a.z = a_[2]; a.w = a_[3]; b.x = b_[0]; b.y = b_[1]; b.z = b_[2]; b.w = b_[3];
    u32x4 v; v.x = cvt_pk_bf16(a.x, a.y); v.y = cvt_pk_bf16(a.z, a.w); v.z = cvt_pk_bf16(b.x, b.y); v.w = cvt_pk_bf16(b.z, b.w);
    *(u32x4*)(p.xb + i * 8) = v;
  }
}

__device__ void tconv_tile(float* tile, const float* src, int src_ld, const float* kscale, bf16_t* dst, int dst_ld, int rstep) {
  const int t = otid();
  {
    const int k0 = t >> 6, n4 = (t & 63) * 4;
    float4 v[16];
#pragma unroll
    for (int i = 0; i < 16; ++i) {
      const f32x4 tv = __builtin_nontemporal_load((const f32x4*)(src + (size_t)(k0 + 4 * i) * src_ld + n4));
      v[i].x = tv[0]; v[i].y = tv[1]; v[i].z = tv[2]; v[i].w = tv[3];
    }
    if (kscale) {
#pragma unroll
      for (int i = 0; i < 16; ++i) { const float sc = kscale[k0 + 4 * i]; v[i].x *= sc; v[i].y *= sc; v[i].z *= sc; v[i].w *= sc; }
    }
#pragma unroll
    for (int i = 0; i < 16; ++i) *(float4*)(tile + (k0 + 4 * i) * 260 + n4) = v[i];
  }
  __syncthreads();
  {
    const int n = t;
    bf16_t* o = dst + (size_t)((n >> 4) * rstep + (n & 15)) * dst_ld;
#pragma unroll
    for (int c = 0; c < 8; ++c) {
      float f[8];
#pragma unroll
      for (int q = 0; q < 8; ++q) f[q] = tile[(c * 8 + q) * 260 + n];
      u32x4 v0;
      v0.x = cvt_pk_bf16(f[0], f[1]); v0.y = cvt_pk_bf16(f[2], f[3]); v0.z = cvt_pk_bf16(f[4], f[5]); v0.w = cvt_pk_bf16(f[6], f[7]);
      *(u32x4*)(o + c * 8) = v0;
    }
  }
  __syncthreads();
}

__device__ void conv_item(const Params& p, int l, int it, unsigned char* smem) {
  float* tile = (float*)smem;
  if (it < 160) {
    const int kt = it / 10, ntile = it % 10;
    tconv_tile(tile, p.w_in + (size_t)l * 1024 * 2560 + (size_t)kt * 64 * 2560 + ntile * 256, 2560, nullptr,
               p.Wt_in + (size_t)ntile * 256 * 1024 + kt * 64, 1024, 16);
  } else if (it < 224) {
    const int r = it - 160, kt = r >> 2, ntile = r & 3;
    tconv_tile(tile, p.w_out + (size_t)l * 1024 * 1024 + (size_t)kt * 64 * 1024 + ntile * 256, 1024, p.mix_g + l * 1024 + kt * 64,
               p.Wt_out + (size_t)ntile * 256 * 1024 + kt * 64, 1024, 16);
  } else if (it < 736) {
    const int r0 = it - 224, e = r0 >> 5, r = r0 & 31, which = r >> 4, kt = r & 15;
    const float* src = (which ? p.w_up : p.w_gate) + (size_t)(l * 16 + e) * 1024 * 256 + (size_t)kt * 64 * 256;
    tconv_tile(tile, src, 256, nullptr, p.Wgu + (size_t)e * 512 * 1024 + (size_t)(which * 16) * 1024 + kt * 64, 1024, 32);
  } else if (it < 992) {
    const int r0 = it - 736, e = r0 >> 4, r = r0 & 15, kt = r >> 2, ntile = r & 3;
    tconv_tile(tile, p.w_down + (size_t)(l * 16 + e) * 256 * 1024 + (size_t)kt * 64 * 1024 + ntile * 256, 1024, nullptr,
               p.Wdn + (size_t)e * 1024 * 256 + (size_t)ntile * 256 * 256 + kt * 64, 256, 16);
  } else if (it >= 1008) {
    const int r = it - 1008;
#pragma unroll
    for (int q = 0; q < 4; ++q) {
      const int idx = q * 256 + (threadIdx.x & 255);
      const int j = idx & 15, k = r * 64 + (idx >> 4);
      const int kb = k >> 5, g = (k >> 3) & 3, jj = k & 7;
      const int i = ((kb * 4 + g) * 16 + j) * 8 + jj;
      const float we = p.re_w[(size_t)(l * 1024 + k) * 16 + j];
      const float wg = (j < 4) ? p.rg_w[(size_t)(l * 1024 + k) * 4 + j] : 0.0f;
      const unsigned eh = cvt_pk_bf16(we, 0.f) & 0xffffu, gh = cvt_pk_bf16(wg, 0.f) & 0xffffu;
      const unsigned el = cvt_pk_bf16(we - __uint_as_float(eh << 16), 0.f) & 0xffffu;
      const unsigned gl = cvt_pk_bf16(wg - __uint_as_float(gh << 16), 0.f) & 0xffffu;
      p.Wr_eh[i] = (bf16_t)eh; p.Wr_el[i] = (bf16_t)el; p.Wr_gh[i] = (bf16_t)gh; p.Wr_gl[i] = (bf16_t)gl;
    }
  } else {
    const int j = it - 992;
    const float* src = p.sgu_w + (size_t)l * 131072 + (size_t)j * 8192 + threadIdx.x * 32;
    bf16_t* dst = p.Wsgu + (size_t)j * 8192 + threadIdx.x * 32;
#pragma unroll
    for (int q = 0; q < 4; ++q) {
      const float4 a = *(const float4*)(src + q * 8), b = *(const float4*)(src + q * 8 + 4);
      u32x4 v; v.x = cvt_pk_bf16(a.x, a.y); v.y = cvt_pk_bf16(a.z, a.w); v.z = cvt_pk_bf16(b.x, b.y); v.w = cvt_pk_bf16(b.z, b.w);
      *(u32x4*)(dst + q * 8) = v;
    }
  }
}

__device__ __forceinline__ void p1_decode(int t, int& mt, int& nt) {
  const int x_ = t & 7, j_ = t >> 3, rd_ = j_ >> 6, lb_ = j_ & 63;
  mt = (rd_ < 4) ? (x_ * 16 + (rd_ & 1) * 8 + (lb_ & 7)) : (x_ * 16 + (lb_ & 15));
  nt = (rd_ < 4) ? ((rd_ >> 1) * 8 + (lb_ >> 3)) : (16 + (lb_ >> 4));
}
__device__ __forceinline__ void p1_epilogue(const Params& p, int l, int mt, int nt, f32x4 (&acc)[4][4]) {
  const int type = nt >> 2;
  const bool swapped = (type == 2) || (type == 4);
  const int tid = otid(), lane = tid & 63, wid = tid >> 6, wr = wid >> 1, wc = wid & 1;
  const int qi = lane & 15, g = lane >> 4;
  if (!swapped) {
#pragma unroll
    for (int i = 0; i < 4; ++i) {
      const int m = mt * 128 + wr * 64 + i * 16 + qi;
#pragma unroll
      for (int j = 0; j < 4; ++j) {
        const int n = nt * 128 + wc * 64 + j * 16 + 4 * g;
        f32x4 v = acc[i][j];
        if (type == 0) v *= 0.125f;
        if (type == 3) { v[0] = gelu_tanh(v[0]); v[1] = gelu_tanh(v[1]); v[2] = gelu_tanh(v[2]); v[3] = gelu_tanh(v[3]); }
        bf16_t* dst = (type == 3) ? (p.ub + (size_t)m * 512 + (n - 1536)) : (p.qk + (size_t)m * 1024 + n);
        store_bf16x4(dst, v[0], v[1], v[2], v[3]);
      }
    }
  } else {
    const int bidx = (mt * 128) >> 12, tokbase = (mt * 128) & 4095;
    bf16_t* dstb = (type == 2) ? p.vT : p.vnT;
    const int fbase = (type == 2) ? 1024 : 2048;
    if (type == 4) {
#pragma unroll
      for (int i = 0; i < 4; ++i)
#pragma unroll
        for (int j = 0; j < 4; ++j)
#pragma unroll
          for (int r = 0; r < 4; ++r) acc[i][j][r] = gelu_tanh(acc[i][j][r]);
      float gam[4], bet[4];
#pragma unroll
      for (int i = 0; i < 4; ++i) {
        const int f = nt * 128 + wr * 64 + i * 16 + qi - 2048;
        gam[i] = p.sgu_ln_g[l * 512 + f]; bet[i] = p.sgu_ln_b[l * 512 + f];
      }
#pragma unroll
      for (int j = 0; j < 4; ++j)
#pragma unroll
        for (int r = 0; r < 4; ++r) {
          float s1 = acc[0][j][r] + acc[1][j][r] + acc[2][j][r] + acc[3][j][r];
          s1 = row16_sum(s1);
          const float mu = s1 * (1.0f / 64.0f);
          float s2 = 0.f;
#pragma unroll
          for (int i = 0; i < 4; ++i) { const float d = acc[i][j][r] - mu; s2 += d * d; }
          s2 = row16_sum(s2);
          const float rstd = rsqrtf(s2 * (1.0f / 64.0f) + LN_EPS);
#pragma unroll
          for (int i = 0; i < 4; ++i) acc[i][j][r] = (acc[i][j][r] - mu) * rstd * gam[i] + bet[i];
        }
    }
#pragma unroll
    for (int i = 0; i < 4; ++i) {
      const int f = nt * 128 + wr * 64 + i * 16 + qi - fbase;
#pragma unroll
      for (int j = 0; j < 4; ++j) {
        const int tok = tokbase + wc * 64 + j * 16 + 4 * g;
        store_bf16x4(dstb + ((size_t)(bidx * 512 + f)) * 4096 + tok, acc[i][j][0], acc[i][j][1], acc[i][j][2], acc[i][j][3]);
      }
    }
  }
}


__device__ void p1_phase(const Params& p, int l, int bid, int nblk, unsigned char* smem) {
  const int tid0 = otid();
  int t = bid, mt = 0, nt = 0;
  const bf16_t* A = nullptr; const bf16_t* B = nullptr;
  if (t < 2560) {
    p1_decode(t, mt, nt);
    A = p.xb + (size_t)(mt * 128 + (tid0 >> 3)) * 1024 + (tid0 & 7) * 8;
    B = p.Wt_in + (size_t)(nt * 128 + (tid0 >> 3)) * 1024 + (tid0 & 7) * 8;
    __syncthreads();
    gemm_issue0(smem, A, A + 32 * 1024, A + 64 * 1024, A + 96 * 1024, B, B + 32 * 1024, B + 64 * 1024, B + 96 * 1024);
  }
  while (t < 2560) {
    const int type = nt >> 2;
    const bool swapped = (type == 2) || (type == 4);
    f32x4 acc[4][4];
    ZERO_ACC(acc);
    gemm_main<true>(smem, A, A + 32 * 1024, A + 64 * 1024, A + 96 * 1024, B, B + 32 * 1024, B + 64 * 1024, B + 96 * 1024, 16, -1, swapped, acc, NoMid());
    const int tn = t + nblk;
    int mtn = mt, ntn = nt;
    if (tn < 2560) {
      p1_decode(tn, mtn, ntn);
      const int tid = otid();
      A = p.xb + (size_t)(mtn * 128 + (tid >> 3)) * 1024 + (tid & 7) * 8;
      B = p.Wt_in + (size_t)(ntn * 128 + (tid >> 3)) * 1024 + (tid & 7) * 8;
      gemm_issue0(smem, A, A + 32 * 1024, A + 64 * 1024, A + 96 * 1024, B, B + 32 * 1024, B + 64 * 1024, B + 96 * 1024);
    }
    p1_epilogue(p, l, mt, nt, acc);
    mt = mtn; nt = ntn; t = tn;
  }
}

__device__ void attn_phase(const Params& p, int l, int bid, int nblk, unsigned char* smem) {
  const int tid = otid(), lane = tid & 63, w = tid >> 6, qi = lane & 15, g = lane >> 4;
  unsigned char* Kb = smem;
  unsigned char* Vb = smem + 32768;
  float* sbias = (float*)(smem + 32768 + 33792);
  const int c0 = (w == 0) ? 0 : (w == 1) ? 8 : (w == 2) ? 24 : 32;
  const int cq = 16 * w + qi, cs = min(max(cq - 8, 0), 48);
  const int krow = tid >> 3, kch = tid & 7;
  const int ksoff = krow * 128 + ((kch ^ ((krow >> 1) & 7)) << 4);
  const int vd = tid >> 5, vc = tid & 31;
  const int vsoff = vd * 528 + vc * 16;
  u32x4 st[8], st2[8];
#define ATT_ISSUE_K(it_)                                                                                              \
  do {                                                                                                                \
    const int h_ = (it_) & 7, br_ = (it_) >> 3, r_ = br_ & 63, b_ = br_ >> 6, rs_ = min(max(r_ - 4, 0), 56);          \
    const bf16_t* kg_ = p.qk + ((size_t)b_ * 4096 + rs_ * 64 + krow) * 1024 + 512 + h_ * 64 + kch * 8;                \
    _Pragma("unroll") for (int i = 0; i < 8; ++i) st[i] = *(const u32x4*)(kg_ + (size_t)(32 * i) * 1024);            \
    _Pragma("unroll") for (int i = 0; i < 8; ++i) st2[i] = *(const u32x4*)(kg_ + (size_t)(256 + 32 * i) * 1024);     \
  } while (0)
  int it = bid;
  if (it < 2048) ATT_ISSUE_K(it);
  while (it < 2048) {
    const int h = it & 7, br = it >> 3, r = br & 63, b = br >> 6;
    const int rs = min(max(r - 4, 0), 56);
    const size_t tokq = (size_t)b * 4096 + r * 64 + cq;
    const bf16_t* vg = p.vT + ((size_t)(b * 512 + h * 64 + vd)) * 4096 + rs * 64 + vc * 8;
    const float rb0 = p.rel_bias[(size_t)(l * 8 + h) * 465 + tid];
    const float rb1 = p.rel_bias[(size_t)(l * 8 + h) * 465 + min(tid + 256, 464)];
    bf16x8 qf0 = *(const bf16x8*)(p.qk + tokq * 1024 + h * 64 + g * 8);
    bf16x8 qf1 = *(const bf16x8*)(p.qk + tokq * 1024 + h * 64 + 32 + g * 8);
    __syncthreads();
    sbias[tid] = rb0;
    if (tid + 256 < 465) sbias[tid + 256] = rb1;
#pragma unroll
    for (int i = 0; i < 8; ++i) *(u32x4*)(Kb + ksoff + i * 4096) = st[i];
#pragma unroll
    for (int i = 0; i < 8; ++i) st[i] = *(const u32x4*)(vg + (size_t)(8 * i) * 4096);
    __syncthreads();
    f32x4 s[8][2];
#pragma unroll
    for (int jh = 0; jh < 2; ++jh) {
#pragma unroll
      for (int jj = 0; jj < 4; ++jj)
#pragma unroll
        for (int ch = 0; ch < 2; ++ch) {
          const int kl = jj * 64 + c0 + 16 * ch + qi;
          const int sw = (kl >> 1) & 7;
          const bf16x8 kf0 = *(const bf16x8*)(Kb + kl * 128 + (((0 + g) ^ sw) << 4));
          const bf16x8 kf1 = *(const bf16x8*)(Kb + kl * 128 + (((4 + g) ^ sw) << 4));
          f32x4 a = {0.f, 0.f, 0.f, 0.f};
          a = __builtin_amdgcn_mfma_f32_16x16x32_bf16(kf0, qf0, a, 0, 0, 0);
          a = __builtin_amdgcn_mfma_f32_16x16x32_bf16(kf1, qf1, a, 0, 0, 0);
          s[jh * 4 + jj][ch] = a;
        }
      if (jh == 0) {
        __syncthreads();
#pragma unroll
        for (int i = 0; i < 8; ++i) *(u32x4*)(Kb + ksoff + i * 4096) = st2[i];
#pragma unroll
        for (int i = 0; i < 8; ++i) st2[i] = *(const u32x4*)(vg + (size_t)(8 * i) * 4096 + 256);
        __syncthreads();
      }
    }
#pragma unroll
    for (int i = 0; i < 8; ++i) *(u32x4*)(Vb + vsoff + i * 8 * 528) = st[i];
    float mx = -1e30f;
#pragma unroll
    for (int j = 0; j < 8; ++j)
#pragma unroll
      for (int ch = 0; ch < 2; ++ch)
#pragma unroll
        for (int rg = 0; rg < 4; ++rg) {
          const int kc = c0 + 16 * ch + 4 * g + rg;
          const bool valid = (kc >= cs) && (kc < cs + 16);
          const int bidx = valid ? ((rs + j - r + 7) * 31 + (kc - cq) + 15) : 0;
          const float v = valid ? (s[j][ch][rg] + sbias[bidx]) : -1e30f;
          s[j][ch][rg] = v;
          mx = fmaxf(mx, v);
        }
    mx = fmaxf(mx, __shfl_xor(mx, 16)); mx = fmaxf(mx, __shfl_xor(mx, 32));
    float sum = 0.f;
#pragma unroll
    for (int j = 0; j < 8; ++j)
#pragma unroll
      for (int ch = 0; ch < 2; ++ch)
#pragma unroll
        for (int rg = 0; rg < 4; ++rg) { const float e = __expf(s[j][ch][rg] - mx); s[j][ch][rg] = e; sum += e; }
    sum += __shfl_xor(sum, 16); sum += __shfl_xor(sum, 32);
    const float inv = 1.0f / sum;
    bf16x8 pf[8];
#pragma unroll
    for (int j = 0; j < 8; ++j) {
      u32x4 pw;
      pw.x = cvt_pk_bf16(s[j][0][0], s[j][0][1]); pw.y = cvt_pk_bf16(s[j][0][2], s[j][0][3]);
      pw.z = cvt_pk_bf16(s[j][1][0], s[j][1][1]); pw.w = cvt_pk_bf16(s[j][1][2], s[j][1][3]);
      pf[j] = __builtin_bit_cast(bf16x8, pw);
    }
    f32x4 o[4];
#pragma unroll
    for (int dt = 0; dt < 4; ++dt) o[dt] = (f32x4){0.f, 0.f, 0.f, 0.f};
    const int itn = it + nblk;
    __syncthreads();
#pragma unroll
    for (int jh = 0; jh < 2; ++jh) {
#pragma unroll
      for (int jj = 0; jj < 4; ++jj)
#pragma unroll
        for (int dt = 0; dt < 4; ++dt) {
          const unsigned char* vp = Vb + (dt * 16 + qi) * 528 + (jj * 64 + c0 + 4 * g) * 2;
          const u32x2 lo = *(const u32x2*)vp, hi = *(const u32x2*)(vp + 32);
          u32x4 vw; vw.x = lo.x; vw.y = lo.y; vw.z = hi.x; vw.w = hi.y;
          o[dt] = __builtin_amdgcn_mfma_f32_16x16x32_bf16(__builtin_bit_cast(bf16x8, vw), pf[jh * 4 + jj], o[dt], 0, 0, 0);
        }
      if (jh == 0) {
        __syncthreads();
#pragma unroll
        for (int i = 0; i < 8; ++i) *(u32x4*)(Vb + vsoff + i * 8 * 528) = st2[i];
        if (itn < 2048) ATT_ISSUE_K(itn);
        __syncthreads();
      }
    }
    float sq = 0.f;
#pragma unroll
    for (int dt = 0; dt < 4; ++dt) {
      o[dt] *= inv;
      sq += o[dt][0] * o[dt][0] + o[dt][1] * o[dt][1] + o[dt][2] * o[dt][2] + o[dt][3] * o[dt][3];
      store_bf16x4(p.mixed + tokq * 1024 + h * 64 + dt * 16 + 4 * g, o[dt][0], o[dt][1], o[dt][2], o[dt][3]);
    }
    sq += __shfl_xor(sq, 16); sq += __shfl_xor(sq, 32);
    if (g == 0) p.ssq[tokq * 16 + h] = sq;
    it = itn;
  }
#undef ATT_ISSUE_K
}

__device__ void sgu_item(const Params& p, int l, int it, unsigned char* smem) {
  const int grp = it & 7, bc = it >> 3, chunk = bc & 31, b = bc >> 5;
  const int tid = otid(), lane = tid & 63, w = tid >> 6, qi = lane & 15, g = lane >> 4;
  const int p0 = 32 * w;
  const int wbase = __builtin_amdgcn_readfirstlane(w) * 1024;
  const int lc = ((tid & 15) ^ ((tid >> 4) & 15)) << 3;
  const bf16_t* wsrc = p.Wsgu + ((size_t)(grp * 128 + (tid >> 4))) * 128 + lc;
  const bf16_t* vsrc = p.vnT + ((size_t)(b * 512 + grp * 64 + (tid >> 4))) * 4096 + chunk * 128 + lc;
  __syncthreads();
#pragma unroll
  for (int i = 0; i < 8; ++i) GLDS16(wsrc + (size_t)(16 * i) * 128, smem + i * 4096 + wbase);
#pragma unroll
  for (int i = 0; i < 4; ++i) GLDS16(vsrc + (size_t)(16 * i) * 4096, smem + 32768 + i * 4096 + wbase);
  asm volatile("s_waitcnt vmcnt(0)" ::: "memory");
  __syncthreads();
  f32x4 acc[2][4];
#pragma unroll
  for (int mt = 0; mt < 2; ++mt)
#pragma unroll
    for (int nt = 0; nt < 4; ++nt) acc[mt][nt] = (f32x4){0.f, 0.f, 0.f, 0.f};
#pragma unroll
  for (int ks = 0; ks < 4; ++ks) {
    const int co = ((ks * 4 + g) ^ qi) << 4;
    bf16x8 wf[2], vf[4];
#pragma unroll
    for (int mt = 0; mt < 2; ++mt) wf[mt] = *(const bf16x8*)(smem + (p0 + 16 * mt + qi) * 256 + co);
#pragma unroll
    for (int nt = 0; nt < 4; ++nt) vf[nt] = *(const bf16x8*)(smem + 32768 + (16 * nt + qi) * 256 + co);
#pragma unroll
    for (int mt = 0; mt < 2; ++mt)
#pragma unroll
      for (int nt = 0; nt < 4; ++nt) acc[mt][nt] = __builtin_amdgcn_mfma_f32_16x16x32_bf16(vf[nt], wf[mt], acc[mt][nt], 0, 0, 0);
  }
#pragma unroll
  for (int mt = 0; mt < 2; ++mt) {
    const int pp = p0 + 16 * mt + qi;
    const size_t tok = (size_t)b * 4096 + chunk * 128 + pp;
    const float bias = p.sgu_b[(size_t)(l * 8 + grp) * 128 + pp];
    float sq = 0.f;
#pragma unroll
    for (int nt = 0; nt < 4; ++nt) {
      const int d = 16 * nt + 4 * g;
      const u32x2 uu = *(const u32x2*)(p.ub + tok * 512 + grp * 64 + d);
      const float u0 = __uint_as_float(uu.x << 16), u1 = __uint_as_float(uu.x & 0xffff0000u);
      const float u2 = __uint_as_float(uu.y << 16), u3 = __uint_as_float(uu.y & 0xffff0000u);
      const float v0 = u0 * (acc[mt][nt][0] + bias), v1 = u1 * (acc[mt][nt][1] + bias);
      const float v2 = u2 * (acc[mt][nt][2] + bias), v3 = u3 * (acc[mt][nt][3] + bias);
      sq += v0 * v0 + v1 * v1 + v2 * v2 + v3 * v3;
      store_bf16x4(p.mixed + tok * 1024 + 512 + grp * 64 + d, v0, v1, v2, v3);
    }
    sq += __shfl_xor(sq, 16); sq += __shfl_xor(sq, 32);
    if (g == 0) p.ssq[tok * 16 + 8 + grp] = sq;
  }
}

__device__ void p3_tile(const Params& p, int l, int t, unsigned char* smem) {
  const int x_ = t & 7, j_ = t >> 3, rd_ = j_ >> 6, lb_ = j_ & 63;
  const int mt = x_ * 16 + rd_ * 8 + (lb_ & 7), nt = lb_ >> 3;
  const int tid = otid(), lane = tid & 63, wid = tid >> 6, wr = wid >> 1, wc = wid & 1;
  const int srow = tid >> 3, sch = tid & 7, qi = lane & 15, g = lane >> 4;
  const bf16_t* A = p.mixed + (size_t)(mt * 128 + srow) * 1024 + sch * 8;
  const bf16_t* B = p.Wt_out + (size_t)(nt * 128 + srow) * 1024 + sch * 8;
  MidScale mid; float rss[4];
#pragma unroll
  for (int i = 0; i < 4; ++i) {
    const int m = mt * 128 + wr * 64 + i * 16 + qi;
    const float4 a0 = *(const float4*)(p.ssq + (size_t)m * 16), a1 = *(const float4*)(p.ssq + (size_t)m * 16 + 4);
    const float4 b0 = *(const float4*)(p.ssq + (size_t)m * 16 + 8), b1 = *(const float4*)(p.ssq + (size_t)m * 16 + 12);
    const float sa = (a0.x + a0.y + a0.z + a0.w) + (a1.x + a1.y + a1.z + a1.w);
    const float sb = (b0.x + b0.y + b0.z + b0.w) + (b1.x + b1.y + b1.z + b1.w);
    const float ra = rsqrtf(sa * (1.0f / 512.0f) + LN_EPS), rb = rsqrtf(sb * (1.0f / 512.0f) + LN_EPS);
    mid.s[i] = ra / rb; rss[i] = rb;
  }
  f32x4 acc[4][4];
  ZERO_ACC(acc);
  gemm_main(smem, A, A + 32 * 1024, A + 64 * 1024, A + 96 * 1024, B, B + 32 * 1024, B + 64 * 1024, B + 96 * 1024, 16, 8, false, acc, mid);
#pragma unroll
  for (int i = 0; i < 4; ++i) {
    const int m = mt * 128 + wr * 64 + i * 16 + qi;
#pragma unroll
    for (int j = 0; j < 4; ++j) {
      const int n = nt * 128 + wc * 64 + j * 16 + 4 * g;
      const u32x2 xr = *(const u32x2*)(p.xb + (size_t)m * 1024 + n);
      const float o0 = ALPHA * __uint_as_float(xr.x << 16) + acc[i][j][0] * rss[i];
      const float o1 = ALPHA * __uint_as_float(xr.x & 0xffff0000u) + acc[i][j][1] * rss[i];
      const float o2 = ALPHA * __uint_as_float(xr.y << 16) + acc[i][j][2] * rss[i];
      const float o3 = ALPHA * __uint_as_float(xr.y & 0xffff0000u) + acc[i][j][3] * rss[i];
      store_bf16x4(p.hb + (size_t)m * 1024 + n, o0, o1, o2, o3);
    }
  }
}

__device__ void p4_batch(const Params& p, int l, int batch, unsigned char* smem) {
  const int tid = otid(), lane = tid & 63, w = tid >> 6;
  int* scnt = (int*)smem;
  int* sbase = scnt + 16;
  __syncthreads();
  if (tid < 16) scnt[tid] = 0;
  __syncthreads();
  const int tokw = batch * 32 + w * 8;
  {
    float4 gm[4], bt[4];
#pragma unroll
    for (int q = 0; q < 4; ++q) {
      gm[q] = *(const float4*)(p.ln1_g + l * 1024 + q * 256 + lane * 4);
      bt[q] = *(const float4*)(p.ln1_b + l * 1024 + q * 256 + lane * 4);
    }
#pragma unroll 4
    for (int t = 0; t < 8; ++t) {
      const bf16_t* hr = p.hb + (size_t)(tokw + t) * 1024 + lane * 4;
      float4 v[4];
#pragma unroll
      for (int q = 0; q < 4; ++q) {
        const u32x2 hh = *(const u32x2*)(hr + q * 256);
        v[q].x = __uint_as_float(hh.x << 16); v[q].y = __uint_as_float(hh.x & 0xffff0000u);
        v[q].z = __uint_as_float(hh.y << 16); v[q].w = __uint_as_float(hh.y & 0xffff0000u);
      }
      float s1 = 0.f;
#pragma unroll
      for (int q = 0; q < 4; ++q) s1 += (v[q].x + v[q].y) + (v[q].z + v[q].w);
      const float mu = wave_sum(s1) * (1.0f / 1024.0f);
      float s2 = 0.f;
#pragma unroll
      for (int q = 0; q < 4; ++q) {
        const float d0 = v[q].x - mu, d1 = v[q].y - mu, d2 = v[q].z - mu, d3 = v[q].w - mu;
        s2 += (d0 * d0 + d1 * d1) + (d2 * d2 + d3 * d3);
      }
      const float rstd = rsqrtf(wave_sum(s2) * (1.0f / 1024.0f) + LN_EPS);
#pragma unroll
      for (int q = 0; q < 4; ++q) {
        float4 o;
        o.x = (v[q].x - mu) * rstd * gm[q].x + bt[q].x; o.y = (v[q].y - mu) * rstd * gm[q].y + bt[q].y;
        o.z = (v[q].z - mu) * rstd * gm[q].z + bt[q].z; o.w = (v[q].w - mu) * rstd * gm[q].w + bt[q].w;
        u32x2 hi; hi.x = cvt_pk_bf16(o.x, o.y); hi.y = cvt_pk_bf16(o.z, o.w);
        *(u32x2*)(p.xb + (size_t)(tokw + t) * 1024 + q * 256 + lane * 4) = hi;
        store_bf16x4(p.x1lo + (size_t)(tokw + t) * 1024 + q * 256 + lane * 4, o.x - __uint_as_float(hi.x << 16), o.y - __uint_as_float(hi.x & 0xffff0000u),
                     o.z - __uint_as_float(hi.y << 16), o.w - __uint_as_float(hi.y & 0xffff0000u));
      }
    }
  }
  asm volatile("s_waitcnt vmcnt(0)" ::: "memory");
  __syncthreads();
  const int j = lane & 15, g = lane >> 4;
  float* part = (float*)(smem + 1024);
  {
    const size_t xo0 = (size_t)(batch * 32 + j) * 1024 + 256 * w + 8 * g, xo1 = xo0 + 16 * 1024;
    const size_t wof = ((size_t)(8 * w * 4 + g) * 16 + j) * 8;
    f32x4 De0 = {0.f, 0.f, 0.f, 0.f}, Dg0 = De0, De1 = De0, Dg1 = De0;
#pragma unroll 2
    for (int kb = 0; kb < 8; ++kb) {
      const bf16x8 xh0 = *(const bf16x8*)(p.xb + xo0 + kb * 32), xl0 = *(const bf16x8*)(p.x1lo + xo0 + kb * 32);
      const bf16x8 xh1 = *(const bf16x8*)(p.xb + xo1 + kb * 32), xl1 = *(const bf16x8*)(p.x1lo + xo1 + kb * 32);
      const bf16x8 weh = *(const bf16x8*)(p.Wr_eh + wof + kb * 512), wel = *(const bf16x8*)(p.Wr_el + wof + kb * 512);
      const bf16x8 wgh = *(const bf16x8*)(p.Wr_gh + wof + kb * 512), wgl = *(const bf16x8*)(p.Wr_gl + wof + kb * 512);
      De0 = __builtin_amdgcn_mfma_f32_16x16x32_bf16(weh, xh0, De0, 0, 0, 0);
      Dg0 = __builtin_amdgcn_mfma_f32_16x16x32_bf16(wgh, xh0, Dg0, 0, 0, 0);
      De0 = __builtin_amdgcn_mfma_f32_16x16x32_bf16(weh, xl0, De0, 0, 0, 0);
      Dg0 = __builtin_amdgcn_mfma_f32_16x16x32_bf16(wgh, xl0, Dg0, 0, 0, 0);
      De0 = __builtin_amdgcn_mfma_f32_16x16x32_bf16(wel, xh0, De0, 0, 0, 0);
      Dg0 = __builtin_amdgcn_mfma_f32_16x16x32_bf16(wgl, xh0, Dg0, 0, 0, 0);
      De1 = __builtin_amdgcn_mfma_f32_16x16x32_bf16(weh, xh1, De1, 0, 0, 0);
      Dg1 = __builtin_amdgcn_mfma_f32_16x16x32_bf16(wgh, xh1, Dg1, 0, 0, 0);
      De1 = __builtin_amdgcn_mfma_f32_16x16x32_bf16(weh, xl1, De1, 0, 0, 0);
      Dg1 = __builtin_amdgcn_mfma_f32_16x16x32_bf16(wgh, xl1, Dg1, 0, 0, 0);
      De1 = __builtin_amdgcn_mfma_f32_16x16x32_bf16(wel, xh1, De1, 0, 0, 0);
      Dg1 = __builtin_amdgcn_mfma_f32_16x16x32_bf16(wgl, xh1, Dg1, 0, 0, 0);
    }
    float* pw = part + ((size_t)(w * 2) * 64 + lane) * 8;
    *(f32x4*)(pw) = De0; *(f32x4*)(pw + 4) = Dg0;
    *(f32x4*)(pw + 512) = De1; *(f32x4*)(pw + 516) = Dg1;
  }
  __syncthreads();
  const int tok = tokw + (j & 7);
  f32x4 De = {0.f, 0.f, 0.f, 0.f}, Dg = {0.f, 0.f, 0.f, 0.f};
  {
    const int ln = g * 16 + (w & 1) * 8 + (j & 7), tl = w >> 1;
#pragma unroll
    for (int ww = 0; ww < 4; ++ww) {
      const float* pr = part + ((size_t)(ww * 2 + tl) * 64 + ln) * 8;
      De += *(const f32x4*)(pr); Dg += *(const f32x4*)(pr + 4);
    }
  }
  float gl[4];
#pragma unroll
  for (int k = 0; k < 4; ++k) gl[k] = __shfl(Dg[k], j) + p.rg_b[l * 4 + k];
  int gs = 0; float gmax = gl[0];
#pragma unroll
  for (int k = 1; k < 4; ++k) { const bool bb = gl[k] > gmax; gmax = bb ? gl[k] : gmax; gs = bb ? k : gs; }
  float psum = 0.f;
#pragma unroll
  for (int k = 0; k < 4; ++k) psum += __expf(gl[k] - gmax);
  const float gate = 1.0f / psum;
  float es[4];
#pragma unroll
  for (int k = 0; k < 4; ++k) es[k] = De[k] + p.re_b[l * 16 + 4 * g + k];
  int i0 = 0; float v0 = es[0];
#pragma unroll
  for (int k = 1; k < 4; ++k) { const bool bb = es[k] > v0; v0 = bb ? es[k] : v0; i0 = bb ? k : i0; }
  int i1 = 0; float v1 = -3.0e38f;
#pragma unroll
  for (int k = 0; k < 4; ++k) { const bool bb = (k != i0) && (es[k] > v1); v1 = bb ? es[k] : v1; i1 = bb ? k : i1; }
  const float ex = __expf(v1 - v0);
  const float tw0 = 1.0f / (1.0f + ex), tw1 = ex / (1.0f + ex);
  const bool commit = (g == gs) && (j < 8);
  const int e0 = gs * 4 + i0, e1 = gs * 4 + i1;
  int lp0 = 0, lp1 = 0;
  if (commit) { lp0 = atomicAdd(&scnt[e0], 1); lp1 = atomicAdd(&scnt[e1], 1); }
  __syncthreads();
  if (tid < 16) sbase[tid] = atomicAdd(p.counts + l * 16 + tid, scnt[tid]);
  __syncthreads();
  if (commit) {
    const int pos0 = sbase[e0] + lp0, pos1 = sbase[e1] + lp1;
    p.list[e0 * NTOK + pos0] = tok; p.wlist[e0 * NTOK + pos0] = gate * tw0;
    p.list[e1 * NTOK + pos1] = tok; p.wlist[e1 * NTOK + pos1] = gate * tw1;
    int4 ti; ti.x = e0; ti.y = pos0; ti.z = e1; ti.w = pos1;
    *(int4*)(p.tokinfo + (size_t)tok * 4) = ti;
  }
}

__device__ __forceinline__ int moe_total_mtiles(const int* cnts) {
  int tot = 0;
#pragma unroll
  for (int e = 0; e < 16; ++e) tot += (cnts[e] + 127) >> 7;
  return tot;
}
__device__ __forceinline__ void moe_find(const int* cnts, int mi, int& e_out, int& ml, int& off, int& cnt) {
  int rem = mi, o = 0; e_out = 0; ml = 0; off = 0; cnt = 1;
  bool found = false;
#pragma unroll
  for (int e = 0; e < 16; ++e) {
    const int c = cnts[e], mtl = (c + 127) >> 7;
    if (!found && rem < mtl) { found = true; e_out = e; ml = rem; off = o; cnt = c; }
    rem -= mtl; o += c;
  }
}

__device__ void p5_tile(const Params& p, int l, int t, int mtot, unsigned char* smem) {
  const int mi = (t >> 5) * 8 + (t & 7), nt = (t >> 3) & 3;
  if (mi >= mtot) return;
  int e, ml, off, cnt;
  moe_find(p.counts + l * 16, mi, e, ml, off, cnt);
  const int tid = otid(), lane = tid & 63, wid = tid >> 6, wr = wid >> 1, wc = wid & 1;
  const int srow = tid >> 3, sch = tid & 7, qi = lane & 15, g = lane >> 4;
  const bf16_t* pa[4];
#pragma unroll
  for (int i = 0; i < 4; ++i) {
    const int ridx = min(ml * 128 + srow + 32 * i, cnt - 1);
    const int tok = p.list[e * NTOK + ridx];
    pa[i] = p.xb + (size_t)tok * 1024 + sch * 8;
  }
  const bf16_t* B = p.Wgu + ((size_t)e * 512 + nt * 128 + srow) * 1024 + sch * 8;
  f32x4 acc[4][4];
  ZERO_ACC(acc);
  gemm_main(smem, pa[0], pa[1], pa[2], pa[3], B, B + 32 * 1024, B + 64 * 1024, B + 96 * 1024, 16, -1, false, acc, NoMid());
#pragma unroll
  for (int i = 0; i < 4; ++i) {
    const int rloc = ml * 128 + wr * 64 + i * 16 + qi;
    if (rloc < cnt) {
      const size_t slot = (size_t)off + rloc;
#pragma unroll
      for (int jp = 0; jp < 2; ++jp) {
        const f32x4 ga = acc[i][2 * jp], up = acc[i][2 * jp + 1];
        const int col = 64 * nt + 32 * wc + 16 * jp + 4 * g;
        store_bf16x4(p.act + slot * 256 + col, silu(ga[0]) * up[0], silu(ga[1]) * up[1], silu(ga[2]) * up[2], silu(ga[3]) * up[3]);
      }
    }
  }
}

struct P6Tile { int e, ml, off, cnt, nt; const bf16_t* pa0; const bf16_t* pa1; const bf16_t* pa2; const bf16_t* pa3; const bf16_t* B; };
__device__ __forceinline__ int p6_next(int t, int ntot, int mtot, int nblk) {
  while (t < ntot && ((t >> 6) * 8 + (t & 7)) >= mtot) t += nblk;
  return t;
}
__device__ __forceinline__ void p6_setup(const Params& p, int l, int t, P6Tile& T) {
  const int mi = (t >> 6) * 8 + (t & 7);
  T.nt = (t >> 3) & 7;
  moe_find(p.counts + l * 16, mi, T.e, T.ml, T.off, T.cnt);
  const int tid = otid(), srow = tid >> 3, sch = tid & 7;
  const bf16_t* base = p.act + (size_t)T.off * 256 + sch * 8;
  T.pa0 = base + (size_t)min(T.ml * 128 + srow, T.cnt - 1) * 256;
  T.pa1 = base + (size_t)min(T.ml * 128 + srow + 32, T.cnt - 1) * 256;
  T.pa2 = base + (size_t)min(T.ml * 128 + srow + 64, T.cnt - 1) * 256;
  T.pa3 = base + (size_t)min(T.ml * 128 + srow + 96, T.cnt - 1) * 256;
  T.B = p.Wdn + ((size_t)T.e * 1024 + T.nt * 128 + srow) * 256 + sch * 8;
}
__device__ void p6_phase(const Params& p, int l, int bid, int nblk, unsigned char* smem) {
  const int mtot = moe_total_mtiles(p.counts + l * 16), ntot = ((mtot + 7) >> 3) * 64;
  P6Tile cur, nxt;
  int t = p6_next(bid, ntot, mtot, nblk);
  if (t < ntot) {
    p6_setup(p, l, t, cur);
    __syncthreads();
    gemm_issue0(smem, cur.pa0, cur.pa1, cur.pa2, cur.pa3, cur.B, cur.B + 32 * 256, cur.B + 64 * 256, cur.B + 96 * 256);
  }
  while (t < ntot) {
    f32x4 acc[4][4];
    ZERO_ACC(acc);
    gemm_main<true>(smem, cur.pa0, cur.pa1, cur.pa2, cur.pa3, cur.B, cur.B + 32 * 256, cur.B + 64 * 256, cur.B + 96 * 256, 4, -1, false, acc, NoMid());
    const int tn = p6_next(t + nblk, ntot, mtot, nblk);
    nxt = cur;
    if (tn < ntot) {
      p6_setup(p, l, tn, nxt);
      gemm_issue0(smem, nxt.pa0, nxt.pa1, nxt.pa2, nxt.pa3, nxt.B, nxt.B + 32 * 256, nxt.B + 64 * 256, nxt.B + 96 * 256);
    }
    {
      const int tid = otid(), lane = tid & 63, wid = tid >> 6, wr = wid >> 1, wc = wid & 1, qi = lane & 15, g = lane >> 4;
#pragma unroll
      for (int i = 0; i < 4; ++i) {
        const int rloc = cur.ml * 128 + wr * 64 + i * 16 + qi;
        if (rloc < cur.cnt) {
          const float wgt = p.wlist[cur.e * NTOK + rloc];
          const size_t slot = (size_t)cur.off + rloc;
#pragma unroll
          for (int j = 0; j < 4; ++j) {
            const int n = cur.nt * 128 + wc * 64 + j * 16 + 4 * g;
            store_bf16x4(p.y + slot * 1024 + n, acc[i][j][0] * wgt, acc[i][j][1] * wgt, acc[i][j][2] * wgt, acc[i][j][3] * wgt);
          }
        }
      }
    }
    cur = nxt; t = tn;
  }
}

template <int NT>
__device__ __forceinline__ void p7_tokens(const Params& p, int l, int tok0, int tstride) {
  const int lane = otid() & 63;
  int4 ti[NT];
#pragma unroll
  for (int u = 0; u < NT; ++u) ti[u] = *(const int4*)(p.tokinfo + (size_t)(tok0 + u * tstride) * 4);
  int off0[NT], off1[NT];
#pragma unroll
  for (int u = 0; u < NT; ++u) { off0[u] = 0; off1[u] = 0; }
#pragma unroll
  for (int e = 0; e < 16; ++e) {
    const int c = p.counts[l * 16 + e];
#pragma unroll
    for (int u = 0; u < NT; ++u) { if (e < ti[u].x) off0[u] += c; if (e < ti[u].z) off1[u] += c; }
  }
  float4 xr[NT][4]; u32x2 ya[NT][4], yb[NT][4];
#pragma unroll
  for (int u = 0; u < NT; ++u) {
    const int tok = tok0 + u * tstride;
    const size_t s0 = (size_t)off0[u] + ti[u].y, s1 = (size_t)off1[u] + ti[u].w;
#pragma unroll
    for (int q = 0; q < 4; ++q) {
      const int c = q * 256 + lane * 4;
      { const u32x2 xh_ = *(const u32x2*)(p.xb + (size_t)tok * 1024 + c), xl_ = *(const u32x2*)(p.x1lo + (size_t)tok * 1024 + c);
        xr[u][q].x = __uint_as_float(xh_.x << 16) + __uint_as_float(xl_.x << 16);
        xr[u][q].y = __uint_as_float(xh_.x & 0xffff0000u) + __uint_as_float(xl_.x & 0xffff0000u);
        xr[u][q].z = __uint_as_float(xh_.y << 16) + __uint_as_float(xl_.y << 16);
        xr[u][q].w = __uint_as_float(xh_.y & 0xffff0000u) + __uint_as_float(xl_.y & 0xffff0000u); }
      ya[u][q] = *(const u32x2*)(p.y + s0 * 1024 + c);
      yb[u][q] = *(const u32x2*)(p.y + s1 * 1024 + c);
    }
  }
  float4 gg[4], bb[4];
#pragma unroll
  for (int q = 0; q < 4; ++q) {
    gg[q] = *(const float4*)(p.ln2_g + l * 1024 + q * 256 + lane * 4);
    bb[q] = *(const float4*)(p.ln2_b + l * 1024 + q * 256 + lane * 4);
  }
#pragma unroll
  for (int u = 0; u < NT; ++u) {
    const int tok = tok0 + u * tstride;
    float hv[16];
#pragma unroll
    for (int q = 0; q < 4; ++q) {
      hv[q * 4 + 0] = ALPHA * xr[u][q].x + (__uint_as_float(ya[u][q].x << 16) + __uint_as_float(yb[u][q].x << 16));
      hv[q * 4 + 1] = ALPHA * xr[u][q].y + (__uint_as_float(ya[u][q].x & 0xffff0000u) + __uint_as_float(yb[u][q].x & 0xffff0000u));
      hv[q * 4 + 2] = ALPHA * xr[u][q].z + (__uint_as_float(ya[u][q].y << 16) + __uint_as_float(yb[u][q].y << 16));
      hv[q * 4 + 3] = ALPHA * xr[u][q].w + (__uint_as_float(ya[u][q].y & 0xffff0000u) + __uint_as_float(yb[u][q].y & 0xffff0000u));
    }
    float s1s = 0.f;
#pragma unroll
    for (int c = 0; c < 16; ++c) s1s += hv[c];
    const float mu = wave_sum(s1s) * (1.0f / 1024.0f);
    float s2 = 0.f;
#pragma unroll
    for (int c = 0; c < 16; ++c) { const float d = hv[c] - mu; s2 += d * d; }
    const float rstd = rsqrtf(wave_sum(s2) * (1.0f / 1024.0f) + LN_EPS);
#pragma unroll
    for (int q = 0; q < 4; ++q) {
      const int c = q * 256 + lane * 4;
      float4 o;
      o.x = (hv[q * 4 + 0] - mu) * rstd * gg[q].x + bb[q].x; o.y = (hv[q * 4 + 1] - mu) * rstd * gg[q].y + bb[q].y;
      o.z = (hv[q * 4 + 2] - mu) * rstd * gg[q].z + bb[q].z; o.w = (hv[q * 4 + 3] - mu) * rstd * gg[q].w + bb[q].w;
      if (l == 3) *(float4*)(p.out + (size_t)tok * 1024 + c) = o;
      else store_bf16x4(p.xb + (size_t)tok * 1024 + c, o.x, o.y, o.z, o.w);
    }
  }
}

#define XB_TMO      128
#define XB_XCNT(j)  (256  + 64 * (j))
#define XB_XSUB(j)  (1280 + 64 * (j))
#define XB_XGEN(j)  (2304 + 64 * (j))
#define XB_TOP      3328
#define XB_TOPGEN   3392
#define XCD_BAR_WORDS 3456
#define XB_SPIN_CAP (1u << 22)
__device__ __forceinline__ unsigned xb_ld(unsigned* p) { return __hip_atomic_load(p, __ATOMIC_RELAXED, __HIP_MEMORY_SCOPE_AGENT); }
__device__ __forceinline__ unsigned xb_add(unsigned* p, unsigned v) { return __hip_atomic_fetch_add(p, v, __ATOMIC_RELAXED, __HIP_MEMORY_SCOPE_AGENT); }
__device__ __forceinline__ unsigned xb_xcc_id() { return (unsigned)__builtin_amdgcn_s_getreg((3 << 11) | 20) & 0xFu; }
#define XB_SPIN(cond, bar) do { unsigned _sp = 0; while (cond) { __builtin_amdgcn_s_sleep(1); \
    if ((++_sp & 255u) == 0u) { if (xb_ld(&(bar)[XB_TMO])) break; if (_sp > XB_SPIN_CAP) { atomicAdd(&(bar)[XB_TMO], 1u); break; } } } } while (0)
struct XcdBarrier { unsigned* bar; unsigned x; volatile unsigned* st; };
__device__ __forceinline__ XcdBarrier xcd_barrier_post(unsigned* bar, volatile unsigned* st) {
  XcdBarrier b; b.bar = bar; b.x = xb_xcc_id(); b.st = st;
  if (threadIdx.x == 0) (void)xb_add(&bar[XB_XCNT(b.x)], 1u);
  return b;
}
__device__ __forceinline__ void xcd_barrier_complete(unsigned* bar, unsigned x, unsigned& nloc, unsigned& nx) {
  const unsigned G = gridDim.x;
  unsigned sum, cnt, mine, sp = 0u;
  for (;;) {
    sum = 0u; cnt = 0u; mine = 0u;
#pragma unroll
    for (unsigned j = 0; j < 16; ++j) { const unsigned c = xb_ld(&bar[XB_XCNT(j)]); sum += c; cnt += (c > 0u) ? 1u : 0u; mine = (j == x) ? c : mine; }
    if (sum == G) break;
    __builtin_amdgcn_s_sleep(1);
    if ((++sp & 255u) == 0u) { if (xb_ld(&bar[XB_TMO])) break; if (sp > XB_SPIN_CAP) { atomicAdd(&bar[XB_TMO], 1u); break; } }
  }
  nloc = mine > 0u ? mine : 1u; nx = cnt > 0u ? cnt : 1u;
}
__device__ __forceinline__ void xcd_barrier(const XcdBarrier& b) {
  asm volatile("s_waitcnt vmcnt(0)" ::: "memory");
  __syncthreads();
  if (threadIdx.x == 0) {
    unsigned* bar = b.bar;
    __builtin_amdgcn_s_waitcnt(0);
    unsigned nloc = b.st[0], nx = b.st[1];
    if (nloc == 0u) { xcd_barrier_complete(bar, b.x, nloc, nx); b.st[0] = nloc; b.st[1] = nx; }
    const unsigned old = xb_add(&bar[XB_XSUB(b.x)], 1u);
    const unsigned gen = old / nloc;
    if (old + 1u == (gen + 1u) * nloc) {
      __builtin_amdgcn_fence(__ATOMIC_RELEASE, "agent");
      asm volatile("s_waitcnt vmcnt(0)" ::: "memory");
      const unsigned og = xb_add(&bar[XB_TOP], 1u);
      const unsigned tg = og / nx;
      if (og + 1u == (tg + 1u) * nx) xb_add(&bar[XB_TOPGEN], 1u);
      else XB_SPIN(xb_ld(&bar[XB_TOPGEN]) == tg, bar);
      __builtin_amdgcn_fence(__ATOMIC_ACQUIRE, "agent");
      xb_add(&bar[XB_XGEN(b.x)], 1u);
      asm volatile("s_waitcnt vmcnt(0)" ::: "memory");
    } else {
      XB_SPIN(xb_ld(&bar[XB_XGEN(b.x)]) == gen, bar);
      __builtin_amdgcn_fence(__ATOMIC_ACQUIRE, "agent");
      asm volatile("s_waitcnt vmcnt(0)" ::: "memory");
    }
  }
  __syncthreads();
}

__device__ __forceinline__ void run_phase(const Params& p, int ph, int l, int bid, int nblk, unsigned char* smem, float* sbias) {
  switch (ph) {
    case 0: {
      if (bid == 0 && threadIdx.x < 64) p.counts[threadIdx.x] = 0;
      conv_x(p, bid, nblk);
      for (int it = bid; it < NCONV_ITEMS; it += nblk) conv_item(p, 0, it, smem);
    } break;
    case 1: p1_phase(p, l, bid, nblk, smem); break;
    case 2:
      attn_phase(p, l, bid, nblk, smem);
      for (int it = bid; it < 1024; it += nblk) sgu_item(p, l, it, smem);
      break;
    case 3: for (int t = bid; t < 1024; t += nblk) p3_tile(p, l, t, smem); break;
    case 4: for (int it = bid; it < NTOK / 32; it += nblk) p4_batch(p, l, it, smem); break;
    case 5: { const int mtot = moe_total_mtiles(p.counts + l * 16), nt = ((mtot + 7) >> 3) * 32; for (int t = bid; t < nt; t += nblk) p5_tile(p, l, t, mtot, smem); } break;
    case 6: p6_phase(p, l, bid, nblk, smem); break;
    case 7: {
      { const int nw = nblk * 4; int tok = bid * 4 + (threadIdx.x >> 6);
        for (; tok + 3 * nw < NTOK; tok += 4 * nw) p7_tokens<4>(p, l, tok, nw);
        for (; tok < NTOK; tok += nw) p7_tokens<1>(p, l, tok, nw); }
      if (l < 3) for (int it = bid; it < NCONV_ITEMS; it += nblk) conv_item(p, l + 1, it, smem);
    } break;
  }
}

template <int PH>
__global__ void __launch_bounds__(256, 2) phase_kernel(Params p, int l) {
  __shared__ __attribute__((aligned(16))) unsigned char smem[SMEM_BYTES];
  run_phase(p, PH, l, blockIdx.x, gridDim.x, smem, (float*)smem);
}

#if MEGA
__global__ void __launch_bounds__(256, 2) mega_kernel(Params p) {
  __shared__ __attribute__((aligned(16))) unsigned char smem[SMEM_BYTES];
  __shared__ uint4 xb_words;
  float* sbias = (float*)smem;
  cg::grid_group grid = cg::this_grid();
  const int bid = blockIdx.x, nblk = gridDim.x;
  if (threadIdx.x == 0) xb_words = make_uint4(0u, 0u, 0u, 0u);
  __syncthreads();
  XcdBarrier xb = xcd_barrier_post(p.bar, (volatile unsigned*)&xb_words);
  run_phase(p, 0, 0, bid, nblk, smem, sbias);
  if (p.never) grid.sync();
  xcd_barrier(xb);
#pragma unroll 1
  for (int l = 0; l < 4; ++l) {
#pragma unroll 1
    for (int ph = 1; ph <= 7; ++ph) {
      run_phase(p, ph, l, bid, nblk, smem, sbias);
#if DUP_PH
      if (ph == DUP_PH) { xcd_barrier(xb); run_phase(p, ph, l, bid, nblk, smem, sbias); }
#endif
      if (!(l == 3 && ph == 7)) xcd_barrier(xb);
    }
  }
}
#endif

extern "C" void kernel_launch(void* const* d_in, const int* in_sizes, int n_in, void* d_out, int out_size, void* d_ws,
                              size_t ws_size, hipStream_t stream) {
  Params p{};
  p.x = (const float*)d_in[0]; p.w_in = (const float*)d_in[1]; p.w_out = (const float*)d_in[2]; p.rel_bias = (const float*)d_in[3];
  p.sgu_ln_g = (const float*)d_in[4]; p.sgu_ln_b = (const float*)d_in[5]; p.sgu_w = (const float*)d_in[6]; p.sgu_b = (const float*)d_in[7];
  p.mix_g = (const float*)d_in[8]; p.ln1_g = (const float*)d_in[9]; p.ln1_b = (const float*)d_in[10];
  p.rg_w = (const float*)d_in[11]; p.rg_b = (const float*)d_in[12]; p.re_w = (const float*)d_in[13]; p.re_b = (const float*)d_in[14];
  p.w_gate = (const float*)d_in[15]; p.w_up = (const float*)d_in[16]; p.w_down = (const float*)d_in[17];
  p.ln2_g = (const float*)d_in[18]; p.ln2_b = (const float*)d_in[19];
  p.out = (float*)d_out;
  unsigned char* w = (unsigned char*)d_ws;
  size_t o = 0;
  auto take = [&](size_t bytes) { unsigned char* r = w + o; o += (bytes + 255) & ~(size_t)255; return r; };
  p.Wt_in = (bf16_t*)take((size_t)2560 * 1024 * 2);
  p.Wt_out = (bf16_t*)take((size_t)1024 * 1024 * 2);
  p.Wgu = (bf16_t*)take((size_t)16 * 512 * 1024 * 2);
  p.Wdn = (bf16_t*)take((size_t)16 * 1024 * 256 * 2);
  p.Wsgu = (bf16_t*)take((size_t)8 * 128 * 128 * 2);
  p.xb = (bf16_t*)take((size_t)NTOK * 1024 * 2);
  p.x1 = (float*)take((size_t)NTOK * 1024 * 4);
  p.x1lo = (bf16_t*)p.x1;
  unsigned char* r1 = take((size_t)NTOK * 2560 * 2);
  p.qk = (bf16_t*)r1;
  p.vT = (bf16_t*)(r1 + (size_t)NTOK * 1024 * 2);
  p.ub = (bf16_t*)(r1 + (size_t)NTOK * 1536 * 2);
  p.vnT = (bf16_t*)(r1 + (size_t)NTOK * 2048 * 2);
  p.y = (bf16_t*)r1;
  p.hb = (bf16_t*)r1;
  unsigned char* r2 = take((size_t)NTOK * 1024 * 2);
  p.mixed = (bf16_t*)r2;
  p.act = (bf16_t*)r2;
  p.ssq = (float*)take((size_t)NTOK * 16 * 4);
  p.wlist = (float*)take((size_t)16 * NTOK * 4);
  p.list = (int*)take((size_t)16 * NTOK * 4);
  p.tokinfo = (int*)take((size_t)NTOK * 4 * 4);
  p.counts = (int*)take(256);
  p.Wr_eh = (bf16_t*)take(16384 * 2); p.Wr_el = (bf16_t*)take(16384 * 2);
  p.Wr_gh = (bf16_t*)take(16384 * 2); p.Wr_gl = (bf16_t*)take(16384 * 2);
  p.bar = (unsigned*)take(XCD_BAR_WORDS * 4);
#if MEGA
  static int grid_blocks = 0;
  if (!grid_blocks) {
    int dev = 0, cus = 0, per_cu = 0;
    hipGetDevice(&dev);
    hipDeviceGetAttribute(&cus, hipDeviceAttributeMultiprocessorCount, dev);
    hipOccupancyMaxActiveBlocksPerMultiprocessor(&per_cu, mega_kernel, 256, 0);
    if (per_cu > 2) per_cu = 2;
    grid_blocks = cus * per_cu;
  }
  (void)hipMemsetAsync(p.bar, 0, XCD_BAR_WORDS * 4, stream);
  void* args[] = {&p};
  hipError_t e = hipLaunchCooperativeKernel((void*)mega_kernel, dim3(grid_blocks), dim3(256), args, 0, stream);
  if (e != hipSuccess) fprintf(stderr, "cooperative launch failed: %s (grid %d)\n", hipGetErrorString(e), grid_blocks);
#else
  const int G = 512;
  phase_kernel<0><<<G, 256, 0, stream>>>(p, 0);
  for (int l = 0; l < 4; ++l) {
    phase_kernel<1><<<G, 256, 0, stream>>>(p, l);
    phase_kernel<2><<<G, 256, 0, stream>>>(p, l);
    phase_kernel<3><<<G, 256, 0, stream>>>(p, l);
    phase_kernel<4><<<G, 256, 0, stream>>>(p, l);
    phase_kernel<5><<<G, 256, 0, stream>>>(p, l);
    phase_kernel<6><<<G, 256, 0, stream>>>(p, l);
    phase_kernel<7><<<G, 256, 0, stream>>>(p, l);
  }
#endif
}
```

```cpp
#include <hip/hip_runtime.h>
#include <hip/hip_cooperative_groups.h>
#include <stdint.h>
#include <cstdio>
namespace cg = cooperative_groups;

#ifndef MEGA
#define MEGA 1
#endif
#define DUP_PH 0

typedef unsigned short bf16_t;
typedef short bf16x8 __attribute__((ext_vector_type(8)));
typedef float f32x4 __attribute__((ext_vector_type(4)));
typedef unsigned u32x4 __attribute__((ext_vector_type(4)));
typedef unsigned u32x2 __attribute__((ext_vector_type(2)));

#define NTOK 16384
#define LN_EPS 1e-5f
#define ALPHA 1.681792830507429f
#define NCONV_ITEMS 1024
#define SMEM_BYTES 69632

struct Params {
  const float *x, *w_in, *w_out, *rel_bias, *sgu_ln_g, *sgu_ln_b, *sgu_w, *sgu_b, *mix_g, *ln1_g, *ln1_b,
      *rg_w, *rg_b, *re_w, *re_b, *w_gate, *w_up, *w_down, *ln2_g, *ln2_b;
  float* out;
  bf16_t *Wt_in, *Wt_out, *Wgu, *Wdn, *Wsgu, *xb, *qk, *vT, *ub, *vnT, *mixed, *act, *y, *hb;
  float *x1, *ssq, *wlist;
  bf16_t *Wr_eh, *Wr_el, *Wr_gh, *Wr_gl;
  bf16_t* x1lo;
  int *counts, *list, *tokinfo;
  unsigned* bar;
  int never;
  int pad_;
};

__device__ __forceinline__ unsigned cvt_pk_bf16(float lo, float hi) {
  unsigned r; asm("v_cvt_pk_bf16_f32 %0, %1, %2" : "=v"(r) : "v"(lo), "v"(hi)); return r;
}
__device__ __forceinline__ void store_bf16x4(bf16_t* p, float a, float b, float c, float d) {
  u32x2 v; v.x = cvt_pk_bf16(a, b); v.y = cvt_pk_bf16(c, d); *(u32x2*)p = v;
}
__device__ __forceinline__ float gelu_tanh(float x) {
  const float t = x * (-2.302208198f + -0.102943249f * (x * x));
  return x * __builtin_amdgcn_rcpf(1.0f + __builtin_amdgcn_exp2f(t));
}
__device__ __forceinline__ int otid() { int t = threadIdx.x; asm volatile("" : "+v"(t)); return t; }
__device__ __forceinline__ float silu(float x) { return x * __builtin_amdgcn_rcpf(1.0f + __builtin_amdgcn_exp2f(-1.442695041f * x)); }
template <int CTRL>
__device__ __forceinline__ float dpp_mov(float v) {
  return __builtin_bit_cast(float, __builtin_amdgcn_update_dpp(0, __builtin_bit_cast(int, v), CTRL, 0xf, 0xf, true));
}
__device__ __forceinline__ float row16_sum(float v) {
  v += dpp_mov<0xB1>(v); v += dpp_mov<0x4E>(v); v += dpp_mov<0x141>(v); v += dpp_mov<0x140>(v); return v;
}
__device__ __forceinline__ float wave_sum(float v) {
  v = row16_sum(v); v += __shfl_xor(v, 16); v += __shfl_xor(v, 32); return v;
}

struct NoMid { __device__ __forceinline__ void operator()(f32x4 (&)[4][4]) const {} };
struct MidScale {
  float s[4];
  __device__ __forceinline__ void operator()(f32x4 (&acc)[4][4]) const {
#pragma unroll
    for (int i = 0; i < 4; ++i)
#pragma unroll
      for (int j = 0; j < 4; ++j) acc[i][j] *= s[i];
  }
};

#define GLDS16(gptr, lptr) __builtin_amdgcn_global_load_lds((const unsigned*)(gptr), (__attribute__((address_space(3))) unsigned*)(lptr), 16, 0, 0)

__device__ __forceinline__ void gemm_issue0(unsigned char* smem, const bf16_t* pa0, const bf16_t* pa1, const bf16_t* pa2,
                                            const bf16_t* pa3, const bf16_t* pb0, const bf16_t* pb1, const bf16_t* pb2,
                                            const bf16_t* pb3) {
  const int tid = otid(), wid = tid >> 6, srow = tid >> 3;
  const int lch = ((tid & 7) ^ ((srow >> 1) & 7)) * 8 - (tid & 7) * 8;
  unsigned char* d = smem + __builtin_amdgcn_readfirstlane(wid) * 1024;
  GLDS16(pa0 + lch, d); GLDS16(pa1 + lch, d + 4096); GLDS16(pa2 + lch, d + 8192); GLDS16(pa3 + lch, d + 12288);
  GLDS16(pb0 + lch, d + 16384); GLDS16(pb1 + lch, d + 20480); GLDS16(pb2 + lch, d + 24576); GLDS16(pb3 + lch, d + 28672);
}

template <bool PRE = false, class Mid>
__device__ __forceinline__ void gemm_main(unsigned char* smem, const bf16_t* pa0, const bf16_t* pa1, const bf16_t* pa2,
                                          const bf16_t* pa3, const bf16_t* pb0, const bf16_t* pb1, const bf16_t* pb2,
                                          const bf16_t* pb3, int nk, int kmid, bool swapped, f32x4 (&acc)[4][4],
                                          const Mid& mid) {
  const int tid = otid(), lane = tid & 63, wid = tid >> 6, wr = wid >> 1, wc = wid & 1;
  const int srow = tid >> 3;
  const int lch = ((tid & 7) ^ ((srow >> 1) & 7)) * 8 - (tid & 7) * 8;
  pa0 += lch; pa1 += lch; pa2 += lch; pa3 += lch; pb0 += lch; pb1 += lch; pb2 += lch; pb3 += lch;
  const int soff = __builtin_amdgcn_readfirstlane(wid) * 1024;
  const int qi = lane & 15, g = lane >> 4, s = qi >> 1;
  const int aside = swapped ? 16384 : 0, bside = swapped ? 0 : 16384;
  const int offA0 = aside + (wr * 64 + qi) * 128 + (((0 + g) ^ s) << 4);
  const int offA1 = aside + (wr * 64 + qi) * 128 + (((4 + g) ^ s) << 4);
  const int offB0 = bside + (wc * 64 + qi) * 128 + (((0 + g) ^ s) << 4);
  const int offB1 = bside + (wc * 64 + qi) * 128 + (((4 + g) ^ s) << 4);
  if (!PRE) {
    unsigned char* d = smem + soff;
    GLDS16(pa0, d); GLDS16(pa1, d + 4096); GLDS16(pa2, d + 8192); GLDS16(pa3, d + 12288);
    GLDS16(pb0, d + 16384); GLDS16(pb1, d + 20480); GLDS16(pb2, d + 24576); GLDS16(pb3, d + 28672);
  }
  asm volatile("s_waitcnt vmcnt(0)" ::: "memory");
  __syncthreads();
  for (int kt = 0; kt < nk; ++kt) {
    unsigned char* buf = smem + ((kt & 1) << 15);
    if (kt == kmid) mid(acc);
    {
      bf16x8 af0[4], bf0[4], af1[4], bf1[4];
#pragma unroll
      for (int i = 0; i < 4; ++i) af0[i] = *(const bf16x8*)(buf + offA0 + i * 2048);
#pragma unroll
      for (int j = 0; j < 4; ++j) bf0[j] = *(const bf16x8*)(buf + offB0 + j * 2048);
#pragma unroll
      for (int i = 0; i < 4; ++i) af1[i] = *(const bf16x8*)(buf + offA1 + i * 2048);
#pragma unroll
      for (int j = 0; j < 4; ++j) bf1[j] = *(const bf16x8*)(buf + offB1 + j * 2048);
      if (kt + 1 < nk) {
        const int ko = (kt + 1) * 64;
        unsigned char* d = smem + (((kt + 1) & 1) << 15) + soff;
        GLDS16(pa0 + ko, d); GLDS16(pa1 + ko, d + 4096); GLDS16(pa2 + ko, d + 8192); GLDS16(pa3 + ko, d + 12288);
        GLDS16(pb0 + ko, d + 16384); GLDS16(pb1 + ko, d + 20480); GLDS16(pb2 + ko, d + 24576); GLDS16(pb3 + ko, d + 28672);
      }
      asm volatile("s_waitcnt lgkmcnt(8)" ::: "memory");
      __builtin_amdgcn_s_setprio(1);
#pragma unroll
      for (int i = 0; i < 4; ++i)
#pragma unroll
        for (int j = 0; j < 4; ++j) acc[i][j] = __builtin_amdgcn_mfma_f32_16x16x32_bf16(bf0[j], af0[i], acc[i][j], 0, 0, 0);
      asm volatile("s_waitcnt lgkmcnt(0)" ::: "memory");
#pragma unroll
      for (int i = 0; i < 4; ++i)
#pragma unroll
        for (int j = 0; j < 4; ++j) acc[i][j] = __builtin_amdgcn_mfma_f32_16x16x32_bf16(bf1[j], af1[i], acc[i][j], 0, 0, 0);
      __builtin_amdgcn_s_setprio(0);
    }
    asm volatile("s_waitcnt vmcnt(0)" ::: "memory");
    __syncthreads();
  }
}

#define ZERO_ACC(acc)                                   \
  _Pragma("unroll") for (int i_ = 0; i_ < 4; ++i_)      \
  _Pragma("unroll") for (int j_ = 0; j_ < 4; ++j_) acc[i_][j_] = (f32x4){0.f, 0.f, 0.f, 0.f};

__device__ void conv_x(const Params& p, int bid, int nblk) {
  const size_t n8 = (size_t)NTOK * 1024 / 8;
#pragma unroll 4
  for (size_t i = (size_t)bid * 256 + threadIdx.x; i < n8; i += (size_t)nblk * 256) {
    const f32x4 a_ = __builtin_nontemporal_load((const f32x4*)(p.x + i * 8)), b_ = __builtin_nontemporal_load((const f32x4*)(p.x + i * 8 + 4));
    float4 a, b; a.x = a_[0]; a.y = a_[1]; a.z = a_[2]; a.w = a_[3]; b.x = b_[0]; b.y = b_[1]; b.z = b_[2]; b.w = b_[3];
    u32x4 v; v.x = cvt_pk_bf16(a.x, a.y); v.y = cvt_pk_bf16(a.z, a.w); v.z = cvt_pk_bf16(b.x, b.y); v.w = cvt_pk_bf16(b.z, b.w);
    *(u32x4*)(p.xb + i * 8) = v;
  }
}

__device__ void tconv_tile(float* tile, const float* src, int src_ld, const float* kscale, bf16_t* dst, int dst_ld, int rstep) {
  const int t = otid();
  {
    const int k0 = t >> 6, n4 = (t & 63) * 4;
    float4 v[16];
#pragma unroll
    for (int i = 0; i < 16; ++i) {
      const f32x4 tv = __builtin_nontemporal_load((const f32x4*)(src + (size_t)(k0 + 4 * i) * src_ld + n4));
      v[i].x = tv[0]; v[i].y = tv[1]; v[i].z = tv[2]; v[i].w = tv[3];
    }
    if (kscale) {
#pragma unroll
      for (int i = 0; i < 16; ++i) { const float sc = kscale[k0 + 4 * i]; v[i].x *= sc; v[i].y *= sc; v[i].z *= sc; v[i].w *= sc; }
    }
#pragma unroll
    for (int i = 0; i < 16; ++i) *(float4*)(tile + (k0 + 4 * i) * 260 + n4) = v[i];
  }
  __syncthreads();
  {
    const int n = t;
    bf16_t* o = dst + (size_t)((n >> 4) * rstep + (n & 15)) * dst_ld;
#pragma unroll
    for (int c = 0; c < 8; ++c) {
      float f[8];
#pragma unroll
      for (int q = 0; q < 8; ++q) f[q] = tile[(c * 8 + q) * 260 + n];
      u32x4 v0;
      v0.x = cvt_pk_bf16(f[0], f[1]); v0.y = cvt_pk_bf16(f[2], f[3]); v0.z = cvt_pk_bf16(f[4], f[5]); v0.w = cvt_pk_bf16(f[6], f[7]);
      *(u32x4*)(o + c * 8) = v0;
    }
  }
  __syncthreads();
}

__device__ void conv_item(const Params& p, int l, int it, unsigned char* smem) {
  float* tile = (float*)smem;
  if (it < 160) {
    const int kt = it / 10, ntile = it % 10;
    tconv_tile(tile, p.w_in + (size_t)l * 1024 * 2560 + (size_t)kt * 64 * 2560 + ntile * 256, 2560, nullptr,
               p.Wt_in + (size_t)ntile * 256 * 1024 + kt * 64, 1024, 16);
  } else if (it < 224) {
    const int r = it - 160, kt = r >> 2, ntile = r & 3;
    tconv_tile(tile, p.w_out + (size_t)l * 1024 * 1024 + (size_t)kt * 64 * 1024 + ntile * 256, 1024, p.mix_g + l * 1024 + kt * 64,
               p.Wt_out + (size_t)ntile * 256 * 1024 + kt * 64, 1024, 16);
  } else if (it < 736) {
    const int r0 = it - 224, e = r0 >> 5, r = r0 & 31, which = r >> 4, kt = r & 15;
    const float* src = (which ? p.w_up : p.w_gate) + (size_t)(l * 16 + e) * 1024 * 256 + (size_t)kt * 64 * 256;
    tconv_tile(tile, src, 256, nullptr, p.Wgu + (size_t)e * 512 * 1024 + (size_t)(which * 16) * 1024 + kt * 64, 1024, 32);
  } else if (it < 992) {
    const int r0 = it - 736, e = r0 >> 4, r = r0 & 15, kt = r >> 2, ntile = r & 3;
    tconv_tile(tile, p.w_down + (size_t)(l * 16 + e) * 256 * 1024 + (size_t)kt * 64 * 1024 + ntile * 256, 1024, nullptr,
               p.Wdn + (size_t)e * 1024 * 256 + (size_t)ntile * 256 * 256 + kt * 64, 256, 16);
  } else if (it >= 1008) {
    const int r = it - 1008;
#pragma unroll
    for (int q = 0; q < 4; ++q) {
      const int idx = q * 256 + (threadIdx.x & 255);
      const int j = idx & 15, k = r * 64 + (idx >> 4);
      const int kb = k >> 5, g = (k >> 3) & 3, jj = k & 7;
      const int i = ((kb * 4 + g) * 16 + j) * 8 + jj;
      const float we = p.re_w[(size_t)(l * 1024 + k) * 16 + j];
      const float wg = (j < 4) ? p.rg_w[(size_t)(l * 1024 + k) * 4 + j] : 0.0f;
      const unsigned eh = cvt_pk_bf16(we, 0.f) & 0xffffu, gh = cvt_pk_bf16(wg, 0.f) & 0xffffu;
      const unsigned el = cvt_pk_bf16(we - __uint_as_float(eh << 16), 0.f) & 0xffffu;
      const unsigned gl = cvt_pk_bf16(wg - __uint_as_float(gh << 16), 0.f) & 0xffffu;
      p.Wr_eh[i] = (bf16_t)eh; p.Wr_el[i] = (bf16_t)el; p.Wr_gh[i] = (bf16_t)gh; p.Wr_gl[i] = (bf16_t)gl;
    }
  } else {
    const int j = it - 992;
    const float* src = p.sgu_w + (size_t)l * 131072 + (size_t)j * 8192 + threadIdx.x * 32;
    bf16_t* dst = p.Wsgu + (size_t)j * 8192 + threadIdx.x * 32;
#pragma unroll
    for (int q = 0; q < 4; ++q) {
      const float4 a = *(const float4*)(src + q * 8), b = *(const float4*)(src + q * 8 + 4);
      u32x4 v; v.x = cvt_pk_bf16(a.x, a.y); v.y = cvt_pk_bf16(a.z, a.w); v.z = cvt_pk_bf16(b.x, b.y); v.w = cvt_pk_bf16(b.z, b.w);
      *(u32x4*)(dst + q * 8) = v;
    }
  }
}

__device__ __forceinline__ void p1_decode(int t, int& mt, int& nt) {
  const int x_ = t & 7, j_ = t >> 3, rd_ = j_ >> 6, lb_ = j_ & 63;
  mt = (rd_ < 4) ? (x_ * 16 + (rd_ & 1) * 8 + (lb_ & 7)) : (x_ * 16 + (lb_ & 15));
  nt = (rd_ < 4) ? ((rd_ >> 1) * 8 + (lb_ >> 3)) : (16 + (lb_ >> 4));
}
__device__ __forceinline__ void p1_epilogue(const Params& p, int l, int mt, int nt, f32x4 (&acc)[4][4]) {
  const int type = nt >> 2;
  const bool swapped = (type == 2) || (type == 4);
  const int tid = otid(), lane = tid & 63, wid = tid >> 6, wr = wid >> 1, wc = wid & 1;
  const int qi = lane & 15, g = lane >> 4;
  if (!swapped) {
#pragma unroll
    for (int i = 0; i < 4; ++i) {
      const int m = mt * 128 + wr * 64 + i * 16 + qi;
#pragma unroll
      for (int j = 0; j < 4; ++j) {
        const int n = nt * 128 + wc * 64 + j * 16 + 4 * g;
        f32x4 v = acc[i][j];
        if (type == 0) v *= 0.125f;
        if (type == 3) { v[0] = gelu_tanh(v[0]); v[1] = gelu_tanh(v[1]); v[2] = gelu_tanh(v[2]); v[3] = gelu_tanh(v[3]); }
        bf16_t* dst = (type == 3) ? (p.ub + (size_t)m * 512 + (n - 1536)) : (p.qk + (size_t)m * 1024 + n);
        store_bf16x4(dst, v[0], v[1], v[2], v[3]);
      }
    }
  } else {
    const int bidx = (mt * 128) >> 12, tokbase = (mt * 128) & 4095;
    bf16_t* dstb = (type == 2) ? p.vT : p.vnT;
    const int fbase = (type == 2) ? 1024 : 2048;
    if (type == 4) {
#pragma unroll
      for (int i = 0; i < 4; ++i)
#pragma unroll
        for (int j = 0; j < 4; ++j)
#pragma unroll
          for (int r = 0; r < 4; ++r) acc[i][j][r] = gelu_tanh(acc[i][j][r]);
      float gam[4], bet[4];
#pragma unroll
      for (int i = 0; i < 4; ++i) {
        const int f = nt * 128 + wr * 64 + i * 16 + qi - 2048;
        gam[i] = p.sgu_ln_g[l * 512 + f]; bet[i] = p.sgu_ln_b[l * 512 + f];
      }
#pragma unroll
      for (int j = 0; j < 4; ++j)
#pragma unroll
        for (int r = 0; r < 4; ++r) {
          float s1 = acc[0][j][r] + acc[1][j][r] + acc[2][j][r] + acc[3][j][r];
          s1 = row16_sum(s1);
          const float mu = s1 * (1.0f / 64.0f);
          float s2 = 0.f;
#pragma unroll
          for (int i = 0; i < 4; ++i) { const float d = acc[i][j][r] - mu; s2 += d * d; }
          s2 = row16_sum(s2);
          const float rstd = rsqrtf(s2 * (1.0f / 64.0f) + LN_EPS);
#pragma unroll
          for (int i = 0; i < 4; ++i) acc[i][j][r] = (acc[i][j][r] - mu) * rstd * gam[i] + bet[i];
        }
    }
#pragma unroll
    for (int i = 0; i < 4; ++i) {
      const int f = nt * 128 + wr * 64 + i * 16 + qi - fbase;
#pragma unroll
      for (int j = 0; j < 4; ++j) {
        const int tok = tokbase + wc * 64 + j * 16 + 4 * g;
        store_bf16x4(dstb + ((size_t)(bidx * 512 + f)) * 4096 + tok, acc[i][j][0], acc[i][j][1], acc[i][j][2], acc[i][j][3]);
      }
    }
  }
}


__device__ void p1_phase(const Params& p, int l, int bid, int nblk, unsigned char* smem) {
  const int tid0 = otid();
  int t = bid, mt = 0, nt = 0;
  const bf16_t* A = nullptr; const bf16_t* B = nullptr;
  if (t < 2560) {
    p1_decode(t, mt, nt);
    A = p.xb + (size_t)(mt * 128 + (tid0 >> 3)) * 1024 + (tid0 & 7) * 8;
    B = p.Wt_in + (size_t)(nt * 128 + (tid0 >> 3)) * 1024 + (tid0 & 7) * 8;
    __syncthreads();
    gemm_issue0(smem, A, A + 32 * 1024, A + 64 * 1024, A + 96 * 1024, B, B + 32 * 1024, B + 64 * 1024, B + 96 * 1024);
  }
  while (t < 2560) {
    const int type = nt >> 2;
    const bool swapped = (type == 2) || (type == 4);
    f32x4 acc[4][4];
    ZERO_ACC(acc);
    gemm_main<true>(smem, A, A + 32 * 1024, A + 64 * 1024, A + 96 * 1024, B, B + 32 * 1024, B + 64 * 1024, B + 96 * 1024, 16, -1, swapped, acc, NoMid());
    const int tn = t + nblk;
    int mtn = mt, ntn = nt;
    if (tn < 2560) {
      p1_decode(tn, mtn, ntn);
      const int tid = otid();
      A = p.xb + (size_t)(mtn * 128 + (tid >> 3)) * 1024 + (tid & 7) * 8;
      B = p.Wt_in + (size_t)(ntn * 128 + (tid >> 3)) * 1024 + (tid & 7) * 8;
      gemm_issue0(smem, A, A + 32 * 1024, A + 64 * 1024, A + 96 * 1024, B, B + 32 * 1024, B + 64 * 1024, B + 96 * 1024);
    }
    p1_epilogue(p, l, mt, nt, acc);
    mt = mtn; nt = ntn; t = tn;
  }
}

__device__ void attn_phase(const Params& p, int l, int bid, int nblk, unsigned char* smem) {
  const int tid = otid(), lane = tid & 63, w = tid >> 6, qi = lane & 15, g = lane >> 4;
  unsigned char* Kb = smem;
  unsigned char* Vb = smem + 32768;
  float* sbias = (float*)(smem + 32768 + 33792);
  const int c0 = (w == 0) ? 0 : (w == 1) ? 8 : (w == 2) ? 24 : 32;
  const int cq = 16 * w + qi, cs = min(max(cq - 8, 0), 48);
  const int krow = tid >> 3, kch = tid & 7;
  const int ksoff = krow * 128 + ((kch ^ ((krow >> 1) & 7)) << 4);
  const int vd = tid >> 5, vc = tid & 31;
  const int vsoff = vd * 528 + vc * 16;
  u32x4 st[8], st2[8];
#define ATT_ISSUE_K(it_)                                                                                              \
  do {                                                                                                                \
    const int h_ = (it_) & 7, br_ = (it_) >> 3, r_ = br_ & 63, b_ = br_ >> 6, rs_ = min(max(r_ - 4, 0), 56);          \
    const bf16_t* kg_ = p.qk + ((size_t)b_ * 4096 + rs_ * 64 + krow) * 1024 + 512 + h_ * 64 + kch * 8;                \
    _Pragma("unroll") for (int i = 0; i < 8; ++i) st[i] = *(const u32x4*)(kg_ + (size_t)(32 * i) * 1024);            \
    _Pragma("unroll") for (int i = 0; i < 8; ++i) st2[i] = *(const u32x4*)(kg_ + (size_t)(256 + 32 * i) * 1024);     \
  } while (0)
  int it = bid;
  if (it < 2048) ATT_ISSUE_K(it);
  while (it < 2048) {
    const int h = it & 7, br = it >> 3, r = br & 63, b = br >> 6;
    const int rs = min(max(r - 4, 0), 56);
    const size_t tokq = (size_t)b * 4096 + r * 64 + cq;
    const bf16_t* vg = p.vT + ((size_t)(b * 512 + h * 64 + vd)) * 4096 + rs * 64 + vc * 8;
    const float rb0 = p.rel_bias[(size_t)(l * 8 + h) * 465 + tid];
    const float rb1 = p.rel_bias[(size_t)(l * 8 + h) * 465 + min(tid + 256, 464)];
    bf16x8 qf0 = *(const bf16x8*)(p.qk + tokq * 1024 + h * 64 + g * 8);
    bf16x8 qf1 = *(const bf16x8*)(p.qk + tokq * 1024 + h * 64 + 32 + g * 8);
    __syncthreads();
    sbias[tid] = rb0;
    if (tid + 256 < 465) sbias[tid + 256] = rb1;
#pragma unroll
    for (int i = 0; i < 8; ++i) *(u32x4*)(Kb + ksoff + i * 4096) = st[i];
#pragma unroll
    for (int i = 0; i < 8; ++i) st[i] = *(const u32x4*)(vg + (size_t)(8 * i) * 4096);
    __syncthreads();
    f32x4 s[8][2];
#pragma unroll
    for (int jh = 0; jh < 2; ++jh) {
#pragma unroll
      for (int jj = 0; jj < 4; ++jj)
#pragma unroll
        for (int ch = 0; ch < 2; ++ch) {
          const int kl = jj * 64 + c0 + 16 * ch + qi;
          const int sw = (kl >> 1) & 7;
          const bf16x8 kf0 = *(const bf16x8*)(Kb + kl * 128 + (((0 + g) ^ sw) << 4));
          const bf16x8 kf1 = *(const bf16x8*)(Kb + kl * 128 + (((4 + g) ^ sw) << 4));
          f32x4 a = {0.f, 0.f, 0.f, 0.f};
          a = __builtin_amdgcn_mfma_f32_16x16x32_bf16(kf0, qf0, a, 0, 0, 0);
          a = __builtin_amdgcn_mfma_f32_16x16x32_bf16(kf1, qf1, a, 0, 0, 0);
          s[jh * 4 + jj][ch] = a;
        }
      if (jh == 0) {
        __syncthreads();
#pragma unroll
        for (int i = 0; i < 8; ++i) *(u32x4*)(Kb + ksoff + i * 4096) = st2[i];
#pragma unroll
        for (int i = 0; i < 8; ++i) st2[i] = *(const u32x4*)(vg + (size_t)(8 * i) * 4096 + 256);
        __syncthreads();
      }
    }
#pragma unroll
    for (int i = 0; i < 8; ++i) *(u32x4*)(Vb + vsoff + i * 8 * 528) = st[i];
    float mx = -1e30f;
#pragma unroll
    for (int j = 0; j < 8; ++j)
#pragma unroll
      for (int ch = 0; ch < 2; ++ch)
#pragma unroll
        for (int rg = 0; rg < 4; ++rg) {
          const int kc = c0 + 16 * ch + 4 * g + rg;
          const bool valid = (kc >= cs) && (kc < cs + 16);
          const int bidx = valid ? ((rs + j - r + 7) * 31 + (kc - cq) + 15) : 0;
          const float v = valid ? (s[j][ch][rg] + sbias[bidx]) : -1e30f;
          s[j][ch][rg] = v;
          mx = fmaxf(mx, v);
        }
    mx = fmaxf(mx, __shfl_xor(mx, 16)); mx = fmaxf(mx, __shfl_xor(mx, 32));
    float sum = 0.f;
#pragma unroll
    for (int j = 0; j < 8; ++j)
#pragma unroll
      for (int ch = 0; ch < 2; ++ch)
#pragma unroll
        for (int rg = 0; rg < 4; ++rg) { const float e = __expf(s[j][ch][rg] - mx); s[j][ch][rg] = e; sum += e; }
    sum += __shfl_xor(sum, 16); sum += __shfl_xor(sum, 32);
    const float inv = 1.0f / sum;
    bf16x8 pf[8];
#pragma unroll
    for (int j = 0; j < 8; ++j) {
      u32x4 pw;
      pw.x = cvt_pk_bf16(s[j][0][0], s[j][0][1]); pw.y = cvt_pk_bf16(s[j][0][2], s[j][0][3]);
      pw.z = cvt_pk_bf16(s[j][1][0], s[j][1][1]); pw.w = cvt_pk_bf16(s[j][1][2], s[j][1][3]);
      pf[j] = __builtin_bit_cast(bf16x8, pw);
    }
    f32x4 o[4];
#pragma unroll
    for (int dt = 0; dt < 4; ++dt) o[dt] = (f32x4){0.f, 0.f, 0.f, 0.f};
    const int itn = it + nblk;
    __syncthreads();
#pragma unroll
    for (int jh = 0; jh < 2; ++jh) {
#pragma unroll
      for (int jj = 0; jj < 4; ++jj)
#pragma unroll
        for (int dt = 0; dt < 4; ++dt) {
          const unsigned char* vp = Vb + (dt * 16 + qi) * 528 + (jj * 64 + c0 + 4 * g) * 2;
          const u32x2 lo = *(const u32x2*)vp, hi = *(const u32x2*)(vp + 32);
          u32x4 vw; vw.x = lo.x; vw.y = lo.y; vw.z = hi.x; vw.w = hi.y;
          o[dt] = __builtin_amdgcn_mfma_f32_16x16x32_bf16(__builtin_bit_cast(bf16x8, vw), pf[jh * 4 + jj], o[dt], 0, 0, 0);
        }
      if (jh == 0) {
        __syncthreads();
#pragma unroll
        for (int i = 0; i < 8; ++i) *(u32x4*)(Vb + vsoff + i * 8 * 528) = st2[i];
        if (itn < 2048) ATT_ISSUE_K(itn);
        __syncthreads();
      }
    }
    float sq = 0.f;
#pragma unroll
    for (int dt = 0; dt < 4; ++dt) {
      o[dt] *= inv;
      sq += o[dt][0] * o[dt][0] + o[dt][1] * o[dt][1] + o[dt][2] * o[dt][2] + o[dt][3] * o[dt][3];
      store_bf16x4(p.mixed + tokq * 1024 + h * 64 + dt * 16 + 4 * g, o[dt][0], o[dt][1], o[dt][2], o[dt][3]);
    }
    sq += __shfl_xor(sq, 16); sq += __shfl_xor(sq, 32);
    if (g == 0) p.ssq[tokq * 16 + h] = sq;
    it = itn;
  }
#undef ATT_ISSUE_K
}

__device__ void sgu_item(const Params& p, int l, int it, unsigned char* smem) {
  const int grp = it & 7, bc = it >> 3, chunk = bc & 31, b = bc >> 5;
  const int tid = otid(), lane = tid & 63, w = tid >> 6, qi = lane & 15, g = lane >> 4;
  const int p0 = 32 * w;
  const int wbase = __builtin_amdgcn_readfirstlane(w) * 1024;
  const int lc = ((tid & 15) ^ ((tid >> 4) & 15)) << 3;
  const bf16_t* wsrc = p.Wsgu + ((size_t)(grp * 128 + (tid >> 4))) * 128 + lc;
  const bf16_t* vsrc = p.vnT + ((size_t)(b * 512 + grp * 64 + (tid >> 4))) * 4096 + chunk * 128 + lc;
  __syncthreads();
#pragma unroll
  for (int i = 0; i < 8; ++i) GLDS16(wsrc + (size_t)(16 * i) * 128, smem + i * 4096 + wbase);
#pragma unroll
  for (int i = 0; i < 4; ++i) GLDS16(vsrc + (size_t)(16 * i) * 4096, smem + 32768 + i * 4096 + wbase);
  asm volatile("s_waitcnt vmcnt(0)" ::: "memory");
  __syncthreads();
  f32x4 acc[2][4];
#pragma unroll
  for (int mt = 0; mt < 2; ++mt)
#pragma unroll
    for (int nt = 0; nt < 4; ++nt) acc[mt][nt] = (f32x4){0.f, 0.f, 0.f, 0.f};
#pragma unroll
  for (int ks = 0; ks < 4; ++ks) {
    const int co = ((ks * 4 + g) ^ qi) << 4;
    bf16x8 wf[2], vf[4];
#pragma unroll
    for (int mt = 0; mt < 2; ++mt) wf[mt] = *(const bf16x8*)(smem + (p0 + 16 * mt + qi) * 256 + co);
#pragma unroll
    for (int nt = 0; nt < 4; ++nt) vf[nt] = *(const bf16x8*)(smem + 32768 + (16 * nt + qi) * 256 + co);
#pragma unroll
    for (int mt = 0; mt < 2; ++mt)
#pragma unroll
      for (int nt = 0; nt < 4; ++nt) acc[mt][nt] = __builtin_amdgcn_mfma_f32_16x16x32_bf16(vf[nt], wf[mt], acc[mt][nt], 0, 0, 0);
  }
#pragma unroll
  for (int mt = 0; mt < 2; ++mt) {
    const int pp = p0 + 16 * mt + qi;
    const size_t tok = (size_t)b * 4096 + chunk * 128 + pp;
    const float bias = p.sgu_b[(size_t)(l * 8 + grp) * 128 + pp];
    float sq = 0.f;
#pragma unroll
    for (int nt = 0; nt < 4; ++nt) {
      const int d = 16 * nt + 4 * g;
      const u32x2 uu = *(const u32x2*)(p.ub + tok * 512 + grp * 64 + d);
      const float u0 = __uint_as_float(uu.x << 16), u1 = __uint_as_float(uu.x & 0xffff0000u);
      const float u2 = __uint_as_float(uu.y << 16), u3 = __uint_as_float(uu.y & 0xffff0000u);
      const float v0 = u0 * (acc[mt][nt][0] + bias), v1 = u1 * (acc[mt][nt][1] + bias);
      const float v2 = u2 * (acc[mt][nt][2] + bias), v3 = u3 * (acc[mt][nt][3] + bias);
      sq += v0 * v0 + v1 * v1 + v2 * v2 + v3 * v3;
      store_bf16x4(p.mixed + tok * 1024 + 512 + grp * 64 + d, v0, v1, v2, v3);
    }
    sq += __shfl_xor(sq, 16); sq += __shfl_xor(sq, 32);
    if (g == 0) p.ssq[tok * 16 + 8 + grp] = sq;
  }
}

__device__ void p3_tile(const Params& p, int l, int t, unsigned char* smem) {
  const int x_ = t & 7, j_ = t >> 3, rd_ = j_ >> 6, lb_ = j_ & 63;
  const int mt = x_ * 16 + rd_ * 8 + (lb_ & 7), nt = lb_ >> 3;
  const int tid = otid(), lane = tid & 63, wid = tid >> 6, wr = wid >> 1, wc = wid & 1;
  const int srow = tid >> 3, sch = tid & 7, qi = lane & 15, g = lane >> 4;
  const bf16_t* A = p.mixed + (size_t)(mt * 128 + srow) * 1024 + sch * 8;
  const bf16_t* B = p.Wt_out + (size_t)(nt * 128 + srow) * 1024 + sch * 8;
  MidScale mid; float rss[4];
#pragma unroll
  for (int i = 0; i < 4; ++i) {
    const int m = mt * 128 + wr * 64 + i * 16 + qi;
    const float4 a0 = *(const float4*)(p.ssq + (size_t)m * 16), a1 = *(const float4*)(p.ssq + (size_t)m * 16 + 4);
    const float4 b0 = *(const float4*)(p.ssq + (size_t)m * 16 + 8), b1 = *(const float4*)(p.ssq + (size_t)m * 16 + 12);
    const float sa = (a0.x + a0.y + a0.z + a0.w) + (a1.x + a1.y + a1.z + a1.w);
    const float sb = (b0.x + b0.y + b0.z + b0.w) + (b1.x + b1.y + b1.z + b1.w);
    const float ra = rsqrtf(sa * (1.0f / 512.0f) + LN_EPS), rb = rsqrtf(sb * (1.0f / 512.0f) + LN_EPS);
    mid.s[i] = ra / rb; rss[i] = rb;
  }
  f32x4 acc[4][4];
  ZERO_ACC(acc);
  gemm_main(smem, A, A + 32 * 1024, A + 64 * 1024, A + 96 * 1024, B, B + 32 * 1024, B + 64 * 1024, B + 96 * 1024, 16, 8, false, acc, mid);
#pragma unroll
  for (int i = 0; i < 4; ++i) {
    const int m = mt * 128 + wr * 64 + i * 16 + qi;
#pragma unroll
    for (int j = 0; j < 4; ++j) {
      const int n = nt * 128 + wc * 64 + j * 16 + 4 * g;
      const u32x2 xr = *(const u32x2*)(p.xb + (size_t)m * 1024 + n);
      const float o0 = ALPHA * __uint_as_float(xr.x << 16) + acc[i][j][0] * rss[i];
      const float o1 = ALPHA * __uint_as_float(xr.x & 0xffff0000u) + acc[i][j][1] * rss[i];
      const float o2 = ALPHA * __uint_as_float(xr.y << 16) + acc[i][j][2] * rss[i];
      const float o3 = ALPHA * __uint_as_float(xr.y & 0xffff0000u) + acc[i][j][3] * rss[i];
      store_bf16x4(p.hb + (size_t)m * 1024 + n, o0, o1, o2, o3);
    }
  }
}

__device__ void p4_batch(const Params& p, int l, int batch, unsigned char* smem) {
  const int tid = otid(), lane = tid & 63, w = tid >> 6;
  int* scnt = (int*)smem;
  int* sbase = scnt + 16;
  __syncthreads();
  if (tid < 16) scnt[tid] = 0;
  __syncthreads();
  const int tokw = batch * 32 + w * 8;
  {
    float4 gm[4], bt[4];
#pragma unroll
    for (int q = 0; q < 4; ++q) {
      gm[q] = *(const float4*)(p.ln1_g + l * 1024 + q * 256 + lane * 4);
      bt[q] = *(const float4*)(p.ln1_b + l * 1024 + q * 256 + lane * 4);
    }
#pragma unroll 4
    for (int t = 0; t < 8; ++t) {
      const bf16_t* hr = p.hb + (size_t)(tokw + t) * 1024 + lane * 4;
      float4 v[4];
#pragma unroll
      for (int q = 0; q < 4; ++q) {
        const u32x2 hh = *(const u32x2*)(hr + q * 256);
        v[q].x = __uint_as_float(hh.x << 16); v[q].y = __uint_as_float(hh.x & 0xffff0000u);
        v[q].z = __uint_as_float(hh.y << 16); v[q].w = __uint_as_float(hh.y & 0xffff0000u);
      }
      float s1 = 0.f;
#pragma unroll
      for (int q = 0; q < 4; ++q) s1 += (v[q].x + v[q].y) + (v[q].z + v[q].w);
      const float mu = wave_sum(s1) * (1.0f / 1024.0f);
      float s2 = 0.f;
#pragma unroll
      for (int q = 0; q < 4; ++q) {
        const float d0 = v[q].x - mu, d1 = v[q].y - mu, d2 = v[q].z - mu, d3 = v[q].w - mu;
        s2 += (d0 * d0 + d1 * d1) + (d2 * d2 + d3 * d3);
      }
      const float rstd = rsqrtf(wave_sum(s2) * (1.0f / 1024.0f) + LN_EPS);
#pragma unroll
      for (int q = 0; q < 4; ++q) {
        float4 o;
        o.x = (v[q].x - mu) * rstd * gm[q].x + bt[q].x; o.y = (v[q].y - mu) * rstd * gm[q].y + bt[q].y;
        o.z = (v[q].z - mu) * rstd * gm[q].z + bt[q].z; o.w = (v[q].w - mu) * rstd * gm[q].w + bt[q].w;
        u32x2 hi; hi.x = cvt_pk_bf16(o.x, o.y); hi.y = cvt_pk_bf16(o.z, o.w);
        *(u32x2*)(p.xb + (size_t)(tokw + t) * 1024 + q * 256 + lane * 4) = hi;
        store_bf16x4(p.x1lo + (size_t)(tokw + t) * 1024 + q * 256 + lane * 4, o.x - __uint_as_float(hi.x << 16), o.y - __uint_as_float(hi.x & 0xffff0000u),
                     o.z - __uint_as_float(hi.y << 16), o.w - __uint_as_float(hi.y & 0xffff0000u));
      }
    }
  }
  asm volatile("s_waitcnt vmcnt(0)" ::: "memory");
  __syncthreads();
  const int j = lane & 15, g = lane >> 4;
  float* part = (float*)(smem + 1024);
  {
    const size_t xo0 = (size_t)(batch * 32 + j) * 1024 + 256 * w + 8 * g, xo1 = xo0 + 16 * 1024;
    const size_t wof = ((size_t)(8 * w * 4 + g) * 16 + j) * 8;
    f32x4 De0 = {0.f, 0.f, 0.f, 0.f}, Dg0 = De0, De1 = De0, Dg1 = De0;
#pragma unroll 2
    for (int kb = 0; kb < 8; ++kb) {
      const bf16x8 xh0 = *(const bf16x8*)(p.xb + xo0 + kb * 32), xl0 = *(const bf16x8*)(p.x1lo + xo0 + kb * 32);
      const bf16x8 xh1 = *(const bf16x8*)(p.xb + xo1 + kb * 32), xl1 = *(const bf16x8*)(p.x1lo + xo1 + kb * 32);
      const bf16x8 weh = *(const bf16x8*)(p.Wr_eh + wof + kb * 512), wel = *(const bf16x8*)(p.Wr_el + wof + kb * 512);
      const bf16x8 wgh = *(const bf16x8*)(p.Wr_gh + wof + kb * 512), wgl = *(const bf16x8*)(p.Wr_gl + wof + kb * 512);
      De0 = __builtin_amdgcn_mfma_f32_16x16x32_bf16(weh, xh0, De0, 0, 0, 0);
      Dg0 = __builtin_amdgcn_mfma_f32_16x16x32_bf16(wgh, xh0, Dg0, 0, 0, 0);
      De0 = __builtin_amdgcn_mfma_f32_16x16x32_bf16(weh, xl0, De0, 0, 0, 0);
      Dg0 = __builtin_amdgcn_mfma_f32_16x16x32_bf16(wgh, xl0, Dg0, 0, 0, 0);
      De0 = __builtin_amdgcn_mfma_f32_16x16x32_bf16(wel, xh0, De0, 0, 0, 0);
      Dg0 = __builtin_amdgcn_mfma_f32_16x16x32_bf16(wgl, xh0, Dg0, 0, 0, 0);
      De1 = __builtin_amdgcn_mfma_f32_16x16x32_bf16(weh, xh1, De1, 0, 0, 0);
      Dg1 = __builtin_amdgcn_mfma_f32_16x16x32_bf16(wgh, xh1, Dg1, 0, 0, 0);
      De1 = __builtin_amdgcn_mfma_f32_16x16x32_bf16(weh, xl1, De1, 0, 0, 0);
      Dg1 = __builtin_amdgcn_mfma_f32_16x16x32_bf16(wgh, xl1, Dg1, 0, 0, 0);
      De1 = __builtin_amdgcn_mfma_f32_16x16x32_bf16(wel, xh1, De1, 0, 0, 0);
      Dg1 = __builtin_amdgcn_mfma_f32_16x16x32_bf16(wgl, xh1, Dg1, 0, 0, 0);
    }
    float* pw = part + ((size_t)(w * 2) * 64 + lane) * 8;
    *(f32x4*)(pw) = De0; *(f32x4*)(pw + 4) = Dg0;
    *(f32x4*)(pw + 512) = De1; *(f32x4*)(pw + 516) = Dg1;
  }
  __syncthreads();
  const int tok = tokw + (j & 7);
  f32x4 De = {0.f, 0.f, 0.f, 0.f}, Dg = {0.f, 0.f, 0.f, 0.f};
  {
    const int ln = g * 16 + (w & 1) * 8 + (j & 7), tl = w >> 1;
#pragma unroll
    for (int ww = 0; ww < 4; ++ww) {
      const float* pr = part + ((size_t)(ww * 2 + tl) * 64 + ln) * 8;
      De += *(const f32x4*)(pr); Dg += *(const f32x4*)(pr + 4);
    }
  }
  float gl[4];
#pragma unroll
  for (int k = 0; k < 4; ++k) gl[k] = __shfl(Dg[k], j) + p.rg_b[l * 4 + k];
  int gs = 0; float gmax = gl[0];
#pragma unroll
  for (int k = 1; k < 4; ++k) { const bool bb = gl[k] > gmax; gmax = bb ? gl[k] : gmax; gs = bb ? k : gs; }
  float psum = 0.f;
#pragma unroll
  for (int k = 0; k < 4; ++k) psum += __expf(gl[k] - gmax);
  const float gate = 1.0f / psum;
  float es[4];
#pragma unroll
  for (int k = 0; k < 4; ++k) es[k] = De[k] + p.re_b[l * 16 + 4 * g + k];
  int i0 = 0; float v0 = es[0];
#pragma unroll
  for (int k = 1; k < 4; ++k) { const bool bb = es[k] > v0; v0 = bb ? es[k] : v0; i0 = bb ? k : i0; }
  int i1 = 0; float v1 = -3.0e38f;
#pragma unroll
  for (int k = 0; k < 4; ++k) { const bool bb = (k != i0) && (es[k] > v1); v1 = bb ? es[k] : v1; i1 = bb ? k : i1; }
  const float ex = __expf(v1 - v0);
  const float tw0 = 1.0f / (1.0f + ex), tw1 = ex / (1.0f + ex);
  const bool commit = (g == gs) && (j < 8);
  const int e0 = gs * 4 + i0, e1 = gs * 4 + i1;
  int lp0 = 0, lp1 = 0;
  if (commit) { lp0 = atomicAdd(&scnt[e0], 1); lp1 = atomicAdd(&scnt[e1], 1); }
  __syncthreads();
  if (tid < 16) sbase[tid] = atomicAdd(p.counts + l * 16 + tid, scnt[tid]);
  __syncthreads();
  if (commit) {
    const int pos0 = sbase[e0] + lp0, pos1 = sbase[e1] + lp1;
    p.list[e0 * NTOK + pos0] = tok; p.wlist[e0 * NTOK + pos0] = gate * tw0;
    p.list[e1 * NTOK + pos1] = tok; p.wlist[e1 * NTOK + pos1] = gate * tw1;
    int4 ti; ti.x = e0; ti.y = pos0; ti.z = e1; ti.w = pos1;
    *(int4*)(p.tokinfo + (size_t)tok * 4) = ti;
  }
}

__device__ __forceinline__ int moe_total_mtiles(const int* cnts) {
  int tot = 0;
#pragma unroll
  for (int e = 0; e < 16; ++e) tot += (cnts[e] + 127) >> 7;
  return tot;
}
__device__ __forceinline__ void moe_find(const int* cnts, int mi, int& e_out, int& ml, int& off, int& cnt) {
  int rem = mi, o = 0; e_out = 0; ml = 0; off = 0; cnt = 1;
  bool found = false;
#pragma unroll
  for (int e = 0; e < 16; ++e) {
    const int c = cnts[e], mtl = (c + 127) >> 7;
    if (!found && rem < mtl) { found = true; e_out = e; ml = rem; off = o; cnt = c; }
    rem -= mtl; o += c;
  }
}

__device__ void p5_tile(const Params& p, int l, int t, int mtot, unsigned char* smem) {
  const int mi = (t >> 5) * 8 + (t & 7), nt = (t >> 3) & 3;
  if (mi >= mtot) return;
  int e, ml, off, cnt;
  moe_find(p.counts + l * 16, mi, e, ml, off, cnt);
  const int tid = otid(), lane = tid & 63, wid = tid >> 6, wr = wid >> 1, wc = wid & 1;
  const int srow = tid >> 3, sch = tid & 7, qi = lane & 15, g = lane >> 4;
  const bf16_t* pa[4];
#pragma unroll
  for (int i = 0; i < 4; ++i) {
    const int ridx = min(ml * 128 + srow + 32 * i, cnt - 1);
    const int tok = p.list[e * NTOK + ridx];
    pa[i] = p.xb + (size_t)tok * 1024 + sch * 8;
  }
  const bf16_t* B = p.Wgu + ((size_t)e * 512 + nt * 128 + srow) * 1024 + sch * 8;
  f32x4 acc[4][4];
  ZERO_ACC(acc);
  gemm_main(smem, pa[0], pa[1], pa[2], pa[3], B, B + 32 * 1024, B + 64 * 1024, B + 96 * 1024, 16, -1, false, acc, NoMid());
#pragma unroll
  for (int i = 0; i < 4; ++i) {
    const int rloc = ml * 128 + wr * 64 + i * 16 + qi;
    if (rloc < cnt) {
      const size_t slot = (size_t)off + rloc;
#pragma unroll
      for (int jp = 0; jp < 2; ++jp) {
        const f32x4 ga = acc[i][2 * jp], up = acc[i][2 * jp + 1];
        const int col = 64 * nt + 32 * wc + 16 * jp + 4 * g;
        store_bf16x4(p.act + slot * 256 + col, silu(ga[0]) * up[0], silu(ga[1]) * up[1], silu(ga[2]) * up[2], silu(ga[3]) * up[3]);
      }
    }
  }
}

struct P6Tile { int e, ml, off, cnt, nt; const bf16_t* pa0; const bf16_t* pa1; const bf16_t* pa2; const bf16_t* pa3; const bf16_t* B; };
__device__ __forceinline__ int p6_next(int t, int ntot, int mtot, int nblk) {
  while (t < ntot && ((t >> 6) * 8 + (t & 7)) >= mtot) t += nblk;
  return t;
}
__device__ __forceinline__ void p6_setup(const Params& p, int l, int t, P6Tile& T) {
  const int mi = (t >> 6) * 8 + (t & 7);
  T.nt = (t >> 3) & 7;
  moe_find(p.counts + l * 16, mi, T.e, T.ml, T.off, T.cnt);
  const int tid = otid(), srow = tid >> 3, sch = tid & 7;
  const bf16_t* base = p.act + (size_t)T.off * 256 + sch * 8;
  T.pa0 = base + (size_t)min(T.ml * 128 + srow, T.cnt - 1) * 256;
  T.pa1 = base + (size_t)min(T.ml * 128 + srow + 32, T.cnt - 1) * 256;
  T.pa2 = base + (size_t)min(T.ml * 128 + srow + 64, T.cnt - 1) * 256;
  T.pa3 = base + (size_t)min(T.ml * 128 + srow + 96, T.cnt - 1) * 256;
  T.B = p.Wdn + ((size_t)T.e * 1024 + T.nt * 128 + srow) * 256 + sch * 8;
}
__device__ void p6_phase(const Params& p, int l, int bid, int nblk, unsigned char* smem) {
  const int mtot = moe_total_mtiles(p.counts + l * 16), ntot = ((mtot + 7) >> 3) * 64;
  P6Tile cur, nxt;
  int t = p6_next(bid, ntot, mtot, nblk);
  if (t < ntot) {
    p6_setup(p, l, t, cur);
    __syncthreads();
    gemm_issue0(smem, cur.pa0, cur.pa1, cur.pa2, cur.pa3, cur.B, cur.B + 32 * 256, cur.B + 64 * 256, cur.B + 96 * 256);
  }
  while (t < ntot) {
    f32x4 acc[4][4];
    ZERO_ACC(acc);
    gemm_main<true>(smem, cur.pa0, cur.pa1, cur.pa2, cur.pa3, cur.B, cur.B + 32 * 256, cur.B + 64 * 256, cur.B + 96 * 256, 4, -1, false, acc, NoMid());
    const int tn = p6_next(t + nblk, ntot, mtot, nblk);
    nxt = cur;
    if (tn < ntot) {
      p6_setup(p, l, tn, nxt);
      gemm_issue0(smem, nxt.pa0, nxt.pa1, nxt.pa2, nxt.pa3, nxt.B, nxt.B + 32 * 256, nxt.B + 64 * 256, nxt.B + 96 * 256);
    }
    {
      const int tid = otid(), lane = tid & 63, wid = tid >> 6, wr = wid >> 1, wc = wid & 1, qi = lane & 15, g = lane >> 4;
#pragma unroll
      for (int i = 0; i < 4; ++i) {
        const int rloc = cur.ml * 128 + wr * 64 + i * 16 + qi;
        if (rloc < cur.cnt) {
          const float wgt = p.wlist[cur.e * NTOK + rloc];
          const size_t slot = (size_t)cur.off + rloc;
#pragma unroll
          for (int j = 0; j < 4; ++j) {
            const int n = cur.nt * 128 + wc * 64 + j * 16 + 4 * g;
            store_bf16x4(p.y + slot * 1024 + n, acc[i][j][0] * wgt, acc[i][j][1] * wgt, acc[i][j][2] * wgt, acc[i][j][3] * wgt);
          }
        }
      }
    }
    cur = nxt; t = tn;
  }
}

template <int NT>
__device__ __forceinline__ void p7_tokens(const Params& p, int l, int tok0, int tstride) {
  const int lane = otid() & 63;
  int4 ti[NT];
#pragma unroll
  for (int u = 0; u < NT; ++u) ti[u] = *(const int4*)(p.tokinfo + (size_t)(tok0 + u * tstride) * 4);
  int off0[NT], off1[NT];
#pragma unroll
  for (int u = 0; u < NT; ++u) { off0[u] = 0; off1[u] = 0; }
#pragma unroll
  for (int e = 0; e < 16; ++e) {
    const int c = p.counts[l * 16 + e];
#pragma unroll
    for (int u = 0; u < NT; ++u) { if (e < ti[u].x) off0[u] += c; if (e < ti[u].z) off1[u] += c; }
  }
  float4 xr[NT][4]; u32x2 ya[NT][4], yb[NT][4];
#pragma unroll
  for (int u = 0; u < NT; ++u) {
    const int tok = tok0 + u * tstride;
    const size_t s0 = (size_t)off0[u] + ti[u].y, s1 = (size_t)off1[u] + ti[u].w;
#pragma unroll
    for (int q = 0; q < 4; ++q) {
      const int c = q * 256 + lane * 4;
      { const u32x2 xh_ = *(const u32x2*)(p.xb + (size_t)tok * 1024 + c), xl_ = *(const u32x2*)(p.x1lo + (size_t)tok * 1024 + c);
        xr[u][q].x = __uint_as_float(xh_.x << 16) + __uint_as_float(xl_.x << 16);
        xr[u][q].y = __uint_as_float(xh_.x & 0xffff0000u) + __uint_as_float(xl_.x & 0xffff0000u);
        xr[u][q].z = __uint_as_float(xh_.y << 16) + __uint_as_float(xl_.y << 16);
        xr[u][q].w = __uint_as_float(xh_.y & 0xffff0000u) + __uint_as_float(xl_.y & 0xffff0000u); }
      ya[u][q] = *(const u32x2*)(p.y + s0 * 1024 + c);
      yb[u][q] = *(const u32x2*)(p.y + s1 * 1024 + c);
    }
  }
  float4 gg[4], bb[4];
#pragma unroll
  for (int q = 0; q < 4; ++q) {
    gg[q] = *(const float4*)(p.ln2_g + l * 1024 + q * 256 + lane * 4);
    bb[q] = *(const float4*)(p.ln2_b + l * 1024 + q * 256 + lane * 4);
  }
#pragma unroll
  for (int u = 0; u < NT; ++u) {
    const int tok = tok0 + u * tstride;
    float hv[16];
#pragma unroll
    for (int q = 0; q < 4; ++q) {
      hv[q * 4 + 0] = ALPHA * xr[u][q].x + (__uint_as_float(ya[u][q].x << 16) + __uint_as_float(yb[u][q].x << 16));
      hv[q * 4 + 1] = ALPHA * xr[u][q].y + (__uint_as_float(ya[u][q].x & 0xffff0000u) + __uint_as_float(yb[u][q].x & 0xffff0000u));
      hv[q * 4 + 2] = ALPHA * xr[u][q].z + (__uint_as_float(ya[u][q].y << 16) + __uint_as_float(yb[u][q].y << 16));
      hv[q * 4 + 3] = ALPHA * xr[u][q].w + (__uint_as_float(ya[u][q].y & 0xffff0000u) + __uint_as_float(yb[u][q].y & 0xffff0000u));
    }
    float s1s = 0.f;
#pragma unroll
    for (int c = 0; c < 16; ++c) s1s += hv[c];
    const float mu = wave_sum(s1s) * (1.0f / 1024.0f);
    float s2 = 0.f;
#pragma unroll
    for (int c = 0; c < 16; ++c) { const float d = hv[c] - mu; s2 += d * d; }
    const float rstd = rsqrtf(wave_sum(s2) * (1.0f / 1024.0f) + LN_EPS);
#pragma unroll
    for (int q = 0; q < 4; ++q) {
      const int c = q * 256 + lane * 4;
      float4 o;
      o.x = (hv[q * 4 + 0] - mu) * rstd * gg[q].x + bb[q].x; o.y = (hv[q * 4 + 1] - mu) * rstd * gg[q].y + bb[q].y;
      o.z = (hv[q * 4 + 2] - mu) * rstd * gg[q].z + bb[q].z; o.w = (hv[q * 4 + 3] - mu) * rstd * gg[q].w + bb[q].w;
      if (l == 3) *(float4*)(p.out + (size_t)tok * 1024 + c) = o;
      else store_bf16x4(p.xb + (size_t)tok * 1024 + c, o.x, o.y, o.z, o.w);
    }
  }
}

#define XB_TMO      128
#define XB_XCNT(j)  (256  + 64 * (j))
#define XB_XSUB(j)  (1280 + 64 * (j))
#define XB_XGEN(j)  (2304 + 64 * (j))
#define XB_TOP      3328
#define XB_TOPGEN   3392
#define XCD_BAR_WORDS 3456
#define XB_SPIN_CAP (1u << 22)
__device__ __forceinline__ unsigned xb_ld(unsigned* p) { return __hip_atomic_load(p, __ATOMIC_RELAXED, __HIP_MEMORY_SCOPE_AGENT); }
__device__ __forceinline__ unsigned xb_add(unsigned* p, unsigned v) { return __hip_atomic_fetch_add(p, v, __ATOMIC_RELAXED, __HIP_MEMORY_SCOPE_AGENT); }
__device__ __forceinline__ unsigned xb_xcc_id() { return (unsigned)__builtin_amdgcn_s_getreg((3 << 11) | 20) & 0xFu; }
#define XB_SPIN(cond, bar) do { unsigned _sp = 0; while (cond) { __builtin_amdgcn_s_sleep(1); \
    if ((++_sp & 255u) == 0u) { if (xb_ld(&(bar)[XB_TMO])) break; if (_sp > XB_SPIN_CAP) { atomicAdd(&(bar)[XB_TMO], 1u); break; } } } } while (0)
struct XcdBarrier { unsigned* bar; unsigned x; volatile unsigned* st; };
__device__ __forceinline__ XcdBarrier xcd_barrier_post(unsigned* bar, volatile unsigned* st) {
  XcdBarrier b; b.bar = bar; b.x = xb_xcc_id(); b.st = st;
  if (threadIdx.x == 0) (void)xb_add(&bar[XB_XCNT(b.x)], 1u);
  return b;
}
__device__ __forceinline__ void xcd_barrier_complete(unsigned* bar, unsigned x, unsigned& nloc, unsigned& nx) {
  const unsigned G = gridDim.x;
  unsigned sum, cnt, mine, sp = 0u;
  for (;;) {
    sum = 0u; cnt = 0u; mine = 0u;
#pragma unroll
    for (unsigned j = 0; j < 16; ++j) { const unsigned c = xb_ld(&bar[XB_XCNT(j)]); sum += c; cnt += (c > 0u) ? 1u : 0u; mine = (j == x) ? c : mine; }
    if (sum == G) break;
    __builtin_amdgcn_s_sleep(1);
    if ((++sp & 255u) == 0u) { if (xb_ld(&bar[XB_TMO])) break; if (sp > XB_SPIN_CAP) { atomicAdd(&bar[XB_TMO], 1u); break; } }
  }
  nloc = mine > 0u ? mine : 1u; nx = cnt > 0u ? cnt : 1u;
}
__device__ __forceinline__ void xcd_barrier(const XcdBarrier& b) {
  asm volatile("s_waitcnt vmcnt(0)" ::: "memory");
  __syncthreads();
  if (threadIdx.x == 0) {
    unsigned* bar = b.bar;
    __builtin_amdgcn_s_waitcnt(0);
    unsigned nloc = b.st[0], nx = b.st[1];
    if (nloc == 0u) { xcd_barrier_complete(bar, b.x, nloc, nx); b.st[0] = nloc; b.st[1] = nx; }
    const unsigned old = xb_add(&bar[XB_XSUB(b.x)], 1u);
    const unsigned gen = old / nloc;
    if (old + 1u == (gen + 1u) * nloc) {
      __builtin_amdgcn_fence(__ATOMIC_RELEASE, "agent");
      asm volatile("s_waitcnt vmcnt(0)" ::: "memory");
      const unsigned og = xb_add(&bar[XB_TOP], 1u);
      const unsigned tg = og / nx;
      if (og + 1u == (tg + 1u) * nx) xb_add(&bar[XB_TOPGEN], 1u);
      else XB_SPIN(xb_ld(&bar[XB_TOPGEN]) == tg, bar);
      __builtin_amdgcn_fence(__ATOMIC_ACQUIRE, "agent");
      xb_add(&bar[XB_XGEN(b.x)], 1u);
      asm volatile("s_waitcnt vmcnt(0)" ::: "memory");
    } else {
      XB_SPIN(xb_ld(&bar[XB_XGEN(b.x)]) == gen, bar);
      __builtin_amdgcn_fence(__ATOMIC_ACQUIRE, "agent");
      asm volatile("s_waitcnt vmcnt(0)" ::: "memory");
    }
  }
  __syncthreads();
}

__device__ __forceinline__ void run_phase(const Params& p, int ph, int l, int bid, int nblk, unsigned char* smem, float* sbias) {
  switch (ph) {
    case 0: {
      if (bid == 0 && threadIdx.x < 64) p.counts[threadIdx.x] = 0;
      conv_x(p, bid, nblk);
      for (int it = bid; it < NCONV_ITEMS; it += nblk) conv_item(p, 0, it, smem);
    } break;
    case 1: p1_phase(p, l, bid, nblk, smem); break;
    case 2:
      attn_phase(p, l, bid, nblk, smem);
      for (int it = bid; it < 1024; it += nblk) sgu_item(p, l, it, smem);
      break;
    case 3: for (int t = bid; t < 1024; t += nblk) p3_tile(p, l, t, smem); break;
    case 4: for (int it = bid; it < NTOK / 32; it += nblk) p4_batch(p, l, it, smem); break;
    case 5: { const int mtot = moe_total_mtiles(p.counts + l * 16), nt = ((mtot + 7) >> 3) * 32; for (int t = bid; t < nt; t += nblk) p5_tile(p, l, t, mtot, smem); } break;
    case 6: p6_phase(p, l, bid, nblk, smem); break;
    case 7: {
      { const int nw = nblk * 4; int tok = bid * 4 + (threadIdx.x >> 6);
        for (; tok + 3 * nw < NTOK; tok += 4 * nw) p7_tokens<4>(p, l, tok, nw);
        for (; tok < NTOK; tok += nw) p7_tokens<1>(p, l, tok, nw); }
      if (l < 3) for (int it = bid; it < NCONV_ITEMS; it += nblk) conv_item(p, l + 1, it, smem);
    } break;
  }
}

template <int PH>
__global__ void __launch_bounds__(256, 2) phase_kernel(Params p, int l) {
  __shared__ __attribute__((aligned(16))) unsigned char smem[SMEM_BYTES];
  run_phase(p, PH, l, blockIdx.x, gridDim.x, smem, (float*)smem);
}

#if MEGA
__global__ void __launch_bounds__(256, 2) mega_kernel(Params p) {
  __shared__ __attribute__((aligned(16))) unsigned char smem[SMEM_BYTES];
  __shared__ uint4 xb_words;
  float* sbias = (float*)smem;
  cg::grid_group grid = cg::this_grid();
  const int bid = blockIdx.x, nblk = gridDim.x;
  if (threadIdx.x == 0) xb_words = make_uint4(0u, 0u, 0u, 0u);
  __syncthreads();
  XcdBarrier xb = xcd_barrier_post(p.bar, (volatile unsigned*)&xb_words);
  run_phase(p, 0, 0, bid, nblk, smem, sbias);
  if (p.never) grid.sync();
  xcd_barrier(xb);
#pragma unroll 1
  for (int l = 0; l < 4; ++l) {
#pragma unroll 1
    for (int ph = 1; ph <= 7; ++ph) {
      run_phase(p, ph, l, bid, nblk, smem, sbias);
#if DUP_PH
      if (ph == DUP_PH) { xcd_barrier(xb); run_phase(p, ph, l, bid, nblk, smem, sbias); }
#endif
      if (!(l == 3 && ph == 7)) xcd_barrier(xb);
    }
  }
}
#endif

extern "C" void kernel_launch(void* const* d_in, const int* in_sizes, int n_in, void* d_out, int out_size, void* d_ws,
                              size_t ws_size, hipStream_t stream) {
  Params p{};
  p.x = (const float*)d_in[0]; p.w_in = (const float*)d_in[1]; p.w_out = (const float*)d_in[2]; p.rel_bias = (const float*)d_in[3];
  p.sgu_ln_g = (const float*)d_in[4]; p.sgu_ln_b = (const float*)d_in[5]; p.sgu_w = (const float*)d_in[6]; p.sgu_b = (const float*)d_in[7];
  p.mix_g = (const float*)d_in[8]; p.ln1_g = (const float*)d_in[9]; p.ln1_b = (const float*)d_in[10];
  p.rg_w = (const float*)d_in[11]; p.rg_b = (const float*)d_in[12]; p.re_w = (const float*)d_in[13]; p.re_b = (const float*)d_in[14];
  p.w_gate = (const float*)d_in[15]; p.w_up = (const float*)d_in[16]; p.w_down = (const float*)d_in[17];
  p.ln2_g = (const float*)d_in[18]; p.ln2_b = (const float*)d_in[19];
  p.out = (float*)d_out;
  unsigned char* w = (unsigned char*)d_ws;
  size_t o = 0;
  auto take = [&](size_t bytes) { unsigned char* r = w + o; o += (bytes + 255) & ~(size_t)255; return r; };
  p.Wt_in = (bf16_t*)take((size_t)2560 * 1024 * 2);
  p.Wt_out = (bf16_t*)take((size_t)1024 * 1024 * 2);
  p.Wgu = (bf16_t*)take((size_t)16 * 512 * 1024 * 2);
  p.Wdn = (bf16_t*)take((size_t)16 * 1024 * 256 * 2);
  p.Wsgu = (bf16_t*)take((size_t)8 * 128 * 128 * 2);
  p.xb = (bf16_t*)take((size_t)NTOK * 1024 * 2);
  p.x1 = (float*)take((size_t)NTOK * 1024 * 4);
  p.x1lo = (bf16_t*)p.x1;
  unsigned char* r1 = take((size_t)NTOK * 2560 * 2);
  p.qk = (bf16_t*)r1;
  p.vT = (bf16_t*)(r1 + (size_t)NTOK * 1024 * 2);
  p.ub = (bf16_t*)(r1 + (size_t)NTOK * 1536 * 2);
  p.vnT = (bf16_t*)(r1 + (size_t)NTOK * 2048 * 2);
  p.y = (bf16_t*)r1;
  p.hb = (bf16_t*)r1;
  unsigned char* r2 = take((size_t)NTOK * 1024 * 2);
  p.mixed = (bf16_t*)r2;
  p.act = (bf16_t*)r2;
  p.ssq = (float*)take((size_t)NTOK * 16 * 4);
  p.wlist = (float*)take((size_t)16 * NTOK * 4);
  p.list = (int*)take((size_t)16 * NTOK * 4);
  p.tokinfo = (int*)take((size_t)NTOK * 4 * 4);
  p.counts = (int*)take(256);
  p.Wr_eh = (bf16_t*)take(16384 * 2); p.Wr_el = (bf16_t*)take(16384 * 2);
  p.Wr_gh = (bf16_t*)take(16384 * 2); p.Wr_gl = (bf16_t*)take(16384 * 2);
  p.bar = (unsigned*)take(XCD_BAR_WORDS * 4);
#if MEGA
  static int grid_blocks = 0;
  if (!grid_blocks) {
    int dev = 0, cus = 0, per_cu = 0;
    hipGetDevice(&dev);
    hipDeviceGetAttribute(&cus, hipDeviceAttributeMultiprocessorCount, dev);
    hipOccupancyMaxActiveBlocksPerMultiprocessor(&per_cu, mega_kernel, 256, 0);
    if (per_cu > 2) per_cu = 2;
    grid_blocks = cus * per_cu;
  }
  (void)hipMemsetAsync(p.bar, 0, XCD_BAR_WORDS * 4, stream);
  void* args[] = {&p};
  hipError_t e = hipLaunchCooperativeKernel((void*)mega_kernel, dim3(grid_blocks), dim3(256), args, 0, stream);
  if (e != hipSuccess) fprintf(stderr, "cooperative launch failed: %s (grid %d)\n", hipGetErrorString(e), grid_blocks);
#else
  const int G = 512;
  phase_kernel<0><<<G, 256, 0, stream>>>(p, 0);
  for (int l = 0; l < 4; ++l) {
    phase_kernel<1><<<G, 256, 0, stream>>>(p, l);
    phase_kernel<2><<<G, 256, 0, stream>>>(p, l);
    phase_kernel<3><<<G, 256, 0, stream>>>(p, l);
    phase_kernel<4><<<G, 256, 0, stream>>>(p, l);
    phase_kernel<5><<<G, 256, 0, stream>>>(p, l);
    phase_kernel<6><<<G, 256, 0, stream>>>(p, l);
    phase_kernel<7><<<G, 256, 0, stream>>>(p, l);
  }
#endif
}
```

```cpp
#include <hip/hip_runtime.h>
#include <hip/hip_cooperative_groups.h>
#include <stdint.h>
#include <cstdio>
namespace cg = cooperative_groups;

#ifndef MEGA
#define MEGA 1
#endif
#define DUP_PH 0

typedef unsigned short bf16_t;
typedef short bf16x8 __attribute__((ext_vector_type(8)));
typedef float f32x4 __attribute__((ext_vector_type(4)));
typedef unsigned u32x4 __attribute__((ext_vector_type(4)));
typedef unsigned u32x2 __attribute__((ext_vector_type(2)));

#define NTOK 16384
#define LN_EPS 1e-5f
#define ALPHA 1.681792830507429f
#define NCONV_ITEMS 1024
#define SMEM_BYTES 69632

struct Params {
  const float *x, *w_in, *w_out, *rel_bias, *sgu_ln_g, *sgu_ln_b, *sgu_w, *sgu_b, *mix_g, *ln1_g, *ln1_b,
      *rg_w, *rg_b, *re_w, *re_b, *w_gate, *w_up, *w_down, *ln2_g, *ln2_b;
  float* out;
  bf16_t *Wt_in, *Wt_out, *Wgu, *Wdn, *Wsgu, *xb, *qk, *vT, *ub, *vnT, *mixed, *act, *y, *hb;
  float *x1, *ssq, *wlist;
  bf16_t *Wr_eh, *Wr_el, *Wr_gh, *Wr_gl;
  bf16_t* x1lo;
  int *counts, *list, *tokinfo;
  unsigned* bar;
  int never;
  int pad_;
};

__device__ __forceinline__ unsigned cvt_pk_bf16(float lo, float hi) {
  unsigned r; asm("v_cvt_pk_bf16_f32 %0, %1, %2" : "=v"(r) : "v"(lo), "v"(hi)); return r;
}
__device__ __forceinline__ void store_bf16x4(bf16_t* p, float a, float b, float c, float d) {
  u32x2 v; v.x = cvt_pk_bf16(a, b); v.y = cvt_pk_bf16(c, d); *(u32x2*)p = v;
}
__device__ __forceinline__ float gelu_tanh(float x) {
  const float t = x * (-2.302208198f + -0.102943249f * (x * x));
  return x * __builtin_amdgcn_rcpf(1.0f + __builtin_amdgcn_exp2f(t));
}
__device__ __forceinline__ int otid() { int t = threadIdx.x; asm volatile("" : "+v"(t)); return t; }
__device__ __forceinline__ float silu(float x) { return x * __builtin_amdgcn_rcpf(1.0f + __builtin_amdgcn_exp2f(-1.442695041f * x)); }
template <int CTRL>
__device__ __forceinline__ float dpp_mov(float v) {
  return __builtin_bit_cast(float, __builtin_amdgcn_update_dpp(0, __builtin_bit_cast(int, v), CTRL, 0xf, 0xf, true));
}
__device__ __forceinline__ float row16_sum(float v) {
  v += dpp_mov<0xB1>(v); v += dpp_mov<0x4E>(v); v += dpp_mov<0x141>(v); v += dpp_mov<0x140>(v); return v;
}
__device__ __forceinline__ float wave_sum(float v) {
  v = row16_sum(v); v += __shfl_xor(v, 16); v += __shfl_xor(v, 32); return v;
}

struct NoMid { __device__ __forceinline__ void operator()(f32x4 (&)[4][4]) const {} };
struct MidScale {
  float s[4];
  __device__ __forceinline__ void operator()(f32x4 (&acc)[4][4]) const {
#pragma unroll
    for (int i = 0; i < 4; ++i)
#pragma unroll
      for (int j = 0; j < 4; ++j) acc[i][j] *= s[i];
  }
};

#define GLDS16(gptr, lptr) __builtin_amdgcn_global_load_lds((const unsigned*)(gptr), (__attribute__((address_space(3))) unsigned*)(lptr), 16, 0, 0)

__device__ __forceinline__ void gemm_issue0(unsigned char* smem, const bf16_t* pa0, const bf16_t* pa1, const bf16_t* pa2,
                                            const bf16_t* pa3, const bf16_t* pb0, const bf16_t* pb1, const bf16_t* pb2,
                                            const bf16_t* pb3) {
  const int tid = otid(), wid = tid >> 6, srow = tid >> 3;
  const int lch = ((tid & 7) ^ ((srow >> 1) & 7)) * 8 - (tid & 7) * 8;
  unsigned char* d = smem + __builtin_amdgcn_readfirstlane(wid) * 1024;
  GLDS16(pa0 + lch, d); GLDS16(pa1 + lch, d + 4096); GLDS16(pa2 + lch, d + 8192); GLDS16(pa3 + lch, d + 12288);
  GLDS16(pb0 + lch, d + 16384); GLDS16(pb1 + lch, d + 20480); GLDS16(pb2 + lch, d + 24576); GLDS16(pb3 + lch, d + 28672);
}

template <bool PRE = false, class Mid>
__device__ __forceinline__ void gemm_main(unsigned char* smem, const bf16_t* pa0, const bf16_t* pa1, const bf16_t* pa2,
                                          const bf16_t* pa3, const bf16_t* pb0, const bf16_t* pb1, const bf16_t* pb2,
                                          const bf16_t* pb3, int nk, int kmid, bool swapped, f32x4 (&acc)[4][4],
                                          const Mid& mid) {
  const int tid = otid(), lane = tid & 63, wid = tid >> 6, wr = wid >> 1, wc = wid & 1;
  const int srow = tid >> 3;
  const int lch = ((tid & 7) ^ ((srow >> 1) & 7)) * 8 - (tid & 7) * 8;
  pa0 += lch; pa1 += lch; pa2 += lch; pa3 += lch; pb0 += lch; pb1 += lch; pb2 += lch; pb3 += lch;
  const int soff = __builtin_amdgcn_readfirstlane(wid) * 1024;
  const int qi = lane & 15, g = lane >> 4, s = qi >> 1;
  const int aside = swapped ? 16384 : 0, bside = swapped ? 0 : 16384;
  const int offA0 = aside + (wr * 64 + qi) * 128 + (((0 + g) ^ s) << 4);
  const int offA1 = aside + (wr * 64 + qi) * 128 + (((4 + g) ^ s) << 4);
  const int offB0 = bside + (wc * 64 + qi) * 128 + (((0 + g) ^ s) << 4);
  const int offB1 = bside + (wc * 64 + qi) * 128 + (((4 + g) ^ s) << 4);
  if (!PRE) {
    unsigned char* d = smem + soff;
    GLDS16(pa0, d); GLDS16(pa1, d + 4096); GLDS16(pa2, d + 8192); GLDS16(pa3, d + 12288);
    GLDS16(pb0, d + 16384); GLDS16(pb1, d + 20480); GLDS16(pb2, d + 24576); GLDS16(pb3, d + 28672);
  }
  asm volatile("s_waitcnt vmcnt(0)" ::: "memory");
  __syncthreads();
#pragma unroll 2
  for (int kt = 0; kt < nk; ++kt) {
    unsigned char* buf = smem + ((kt & 1) << 15);
    if (kt == kmid) mid(acc);
    {
      bf16x8 af0[4], bf0[4], af1[4], bf1[4];
#pragma unroll
      for (int i = 0; i < 4; ++i) af0[i] = *(const bf16x8*)(buf + offA0 + i * 2048);
#pragma unroll
      for (int j = 0; j < 4; ++j) bf0[j] = *(const bf16x8*)(buf + offB0 + j * 2048);
#pragma unroll
      for (int i = 0; i < 4; ++i) af1[i] = *(const bf16x8*)(buf + offA1 + i * 2048);
#pragma unroll
      for (int j = 0; j < 4; ++j) bf1[j] = *(const bf16x8*)(buf + offB1 + j * 2048);
      if (kt + 1 < nk) {
        const int ko = (kt + 1) * 64;
        unsigned char* d = smem + (((kt + 1) & 1) << 15) + soff;
        GLDS16(pa0 + ko, d); GLDS16(pa1 + ko, d + 4096); GLDS16(pa2 + ko, d + 8192); GLDS16(pa3 + ko, d + 12288);
        GLDS16(pb0 + ko, d + 16384); GLDS16(pb1 + ko, d + 20480); GLDS16(pb2 + ko, d + 24576); GLDS16(pb3 + ko, d + 28672);
      }
      asm volatile("s_waitcnt lgkmcnt(8)" ::: "memory");
      __builtin_amdgcn_s_setprio(1);
#pragma unroll
      for (int i = 0; i < 4; ++i)
#pragma unroll
        for (int j = 0; j < 4; ++j) acc[i][j] = __builtin_amdgcn_mfma_f32_16x16x32_bf16(bf0[j], af0[i], acc[i][j], 0, 0, 0);
      asm volatile("s_waitcnt lgkmcnt(0)" ::: "memory");
#pragma unroll
      for (int i = 0; i < 4; ++i)
#pragma unroll
        for (int j = 0; j < 4; ++j) acc[i][j] = __builtin_amdgcn_mfma_f32_16x16x32_bf16(bf1[j], af1[i], acc[i][j], 0, 0, 0);
      __builtin_amdgcn_s_setprio(0);
    }
    asm volatile("s_waitcnt vmcnt(0)" ::: "memory");
    __syncthreads();
  }
}

#define ZERO_ACC(acc)                                   \
  _Pragma("unroll") for (int i_ = 0; i_ < 4; ++i_)      \
  _Pragma("unroll") for (int j_ = 0; j_ < 4; ++j_) acc[i_][j_] = (f32x4){0.f, 0.f, 0.f, 0.f};

__device__ void conv_x(const Params& p, int bid, int nblk) {
  const size_t n8 = (size_t)NTOK * 1024 / 8;
#pragma unroll 4
  for (size_t i = (size_t)bid * 256 + threadIdx.x; i < n8; i += (size_t)nblk * 256) {
    const f32x4 a_ = __builtin_nontemporal_load((const f32x4*)(p.x + i * 8)), b_ = __builtin_nontemporal_load((const f32x4*)(p.x + i * 8 + 4));
    float4 a, b; a.x = a_[0]; a.y = a_[1]; a.z = a_[2]; a.w = a_[3]; b.x = b_[0]; b.y = b_[1]; b.z = b_[2]; b.w = b_[3];
    u32x4 v; v.x = cvt_pk_bf16(a.x, a.y); v.y = cvt_pk_bf16(a.z, a.w); v.z = cvt_pk_bf16(b.x, b.y); v.w = cvt_pk_bf16(b.z, b.w);
    *(u32x4*)(p.xb + i * 8) = v;
  }
}

__device__ void tconv_tile(float* tile, const float* src, int src_ld, const float* kscale, bf16_t* dst, int dst_ld, int rstep) {
  const int t = otid();
  {
    const int k0 = t >> 6, n4 = (t & 63) * 4;
    float4 v[16];
#pragma unroll
    for (int i = 0; i < 16; ++i) {
      const f32x4 tv = __builtin_nontemporal_load((const f32x4*)(src + (size_t)(k0 + 4 * i) * src_ld + n4));
      v[i].x = tv[0]; v[i].y = tv[1]; v[i].z = tv[2]; v[i].w = tv[3];
    }
    if (kscale) {
#pragma unroll
      for (int i = 0; i < 16; ++i) { const float sc = kscale[k0 + 4 * i]; v[i].x *= sc; v[i].y *= sc; v[i].z *= sc; v[i].w *= sc; }
    }
#pragma unroll
    for (int i = 0; i < 16; ++i) *(float4*)(tile + (k0 + 4 * i) * 260 + n4) = v[i];
  }
  __syncthreads();
  {
    const int n = t;
    bf16_t* o = dst + (size_t)((n >> 4) * rstep + (n & 15)) * dst_ld;
#pragma unroll
    for (int c = 0; c < 8; ++c) {
      float f[8];
#pragma unroll
      for (int q = 0; q < 8; ++q) f[q] = tile[(c * 8 + q) * 260 + n];
      u32x4 v0;
      v0.x = cvt_pk_bf16(f[0], f[1]); v0.y = cvt_pk_bf16(f[2], f[3]); v0.z = cvt_pk_bf16(f[4], f[5]); v0.w = cvt_pk_bf16(f[6], f[7]);
      *(u32x4*)(o + c * 8) = v0;
    }
  }
  __syncthreads();
}

__device__ void conv_item(const Params& p, int l, int it, unsigned char* smem) {
  float* tile = (float*)smem;
  if (it < 160) {
    const int kt = it / 10, ntile = it % 10;
    tconv_tile(tile, p.w_in + (size_t)l * 1024 * 2560 + (size_t)kt * 64 * 2560 + ntile * 256, 2560, nullptr,
               p.Wt_in + (size_t)ntile * 256 * 1024 + kt * 64, 1024, 16);
  } else if (it < 224) {
    const int r = it - 160, kt = r >> 2, ntile = r & 3;
    tconv_tile(tile, p.w_out + (size_t)l * 1024 * 1024 + (size_t)kt * 64 * 1024 + ntile * 256, 1024, p.mix_g + l * 1024 + kt * 64,
               p.Wt_out + (size_t)ntile * 256 * 1024 + kt * 64, 1024, 16);
  } else if (it < 736) {
    const int r0 = it - 224, e = r0 >> 5, r = r0 & 31, which = r >> 4, kt = r & 15;
    const float* src = (which ? p.w_up : p.w_gate) + (size_t)(l * 16 + e) * 1024 * 256 + (size_t)kt * 64 * 256;
    tconv_tile(tile, src, 256, nullptr, p.Wgu + (size_t)e * 512 * 1024 + (size_t)(which * 16) * 1024 + kt * 64, 1024, 32);
  } else if (it < 992) {
    const int r0 = it - 736, e = r0 >> 4, r = r0 & 15, kt = r >> 2, ntile = r & 3;
    tconv_tile(tile, p.w_down + (size_t)(l * 16 + e) * 256 * 1024 + (size_t)kt * 64 * 1024 + ntile * 256, 1024, nullptr,
               p.Wdn + (size_t)e * 1024 * 256 + (size_t)ntile * 256 * 256 + kt * 64, 256, 16);
  } else if (it >= 1008) {
    const int r = it - 1008;
#pragma unroll
    for (int q = 0; q < 4; ++q) {
      const int idx = q * 256 + (threadIdx.x & 255);
      const int j = idx & 15, k = r * 64 + (idx >> 4);
      const int kb = k >> 5, g = (k >> 3) & 3, jj = k & 7;
      const int i = ((kb * 4 + g) * 16 + j) * 8 + jj;
      const float we = p.re_w[(size_t)(l * 1024 + k) * 16 + j];
      const float wg = (j < 4) ? p.rg_w[(size_t)(l * 1024 + k) * 4 + j] : 0.0f;
      const unsigned eh = cvt_pk_bf16(we, 0.f) & 0xffffu, gh = cvt_pk_bf16(wg, 0.f) & 0xffffu;
      const unsigned el = cvt_pk_bf16(we - __uint_as_float(eh << 16), 0.f) & 0xffffu;
      const unsigned gl = cvt_pk_bf16(wg - __uint_as_float(gh << 16), 0.f) & 0xffffu;
      p.Wr_eh[i] = (bf16_t)eh; p.Wr_el[i] = (bf16_t)el; p.Wr_gh[i] = (bf16_t)gh; p.Wr_gl[i] = (bf16_t)gl;
    }
  } else {
    const int j = it - 992;
    const float* src = p.sgu_w + (size_t)l * 131072 + (size_t)j * 8192 + threadIdx.x * 32;
    bf16_t* dst = p.Wsgu + (size_t)j * 8192 + threadIdx.x * 32;
#pragma unroll
    for (int q = 0; q < 4; ++q) {
      const float4 a = *(const float4*)(src + q * 8), b = *(const float4*)(src + q * 8 + 4);
      u32x4 v; v.x = cvt_pk_bf16(a.x, a.y); v.y = cvt_pk_bf16(a.z, a.w); v.z = cvt_pk_bf16(b.x, b.y); v.w = cvt_pk_bf16(b.z, b.w);
      *(u32x4*)(dst + q * 8) = v;
    }
  }
}

__device__ __forceinline__ void p1_decode(int t, int& mt, int& nt) {
  const int x_ = t & 7, j_ = t >> 3, rd_ = j_ >> 6, lb_ = j_ & 63;
  mt = (rd_ < 4) ? (x_ * 16 + (rd_ & 1) * 8 + (lb_ & 7)) : (x_ * 16 + (lb_ & 15));
  nt = (rd_ < 4) ? ((rd_ >> 1) * 8 + (lb_ >> 3)) : (16 + (lb_ >> 4));
}
__device__ __forceinline__ void p1_epilogue(const Params& p, int l, int mt, int nt, f32x4 (&acc)[4][4]) {
  const int type = nt >> 2;
  const bool swapped = (type == 2) || (type == 4);
  const int tid = otid(), lane = tid & 63, wid = tid >> 6, wr = wid >> 1, wc = wid & 1;
  const int qi = lane & 15, g = lane >> 4;
  if (!swapped) {
#pragma unroll
    for (int i = 0; i < 4; ++i) {
      const int m = mt * 128 + wr * 64 + i * 16 + qi;
#pragma unroll
      for (int j = 0; j < 4; ++j) {
        const int n = nt * 128 + wc * 64 + j * 16 + 4 * g;
        f32x4 v = acc[i][j];
        if (type == 0) v *= 0.125f;
        if (type == 3) { v[0] = gelu_tanh(v[0]); v[1] = gelu_tanh(v[1]); v[2] = gelu_tanh(v[2]); v[3] = gelu_tanh(v[3]); }
        bf16_t* dst = (type == 3) ? (p.ub + (size_t)m * 512 + (n - 1536)) : (p.qk + (size_t)m * 1024 + n);
        store_bf16x4(dst, v[0], v[1], v[2], v[3]);
      }
    }
  } else {
    const int bidx = (mt * 128) >> 12, tokbase = (mt * 128) & 4095;
    bf16_t* dstb = (type == 2) ? p.vT : p.vnT;
    const int fbase = (type == 2) ? 1024 : 2048;
    if (type == 4) {
#pragma unroll
      for (int i = 0; i < 4; ++i)
#pragma unroll
        for (int j = 0; j < 4; ++j)
#pragma unroll
          for (int r = 0; r < 4; ++r) acc[i][j][r] = gelu_tanh(acc[i][j][r]);
      float gam[4], bet[4];
#pragma unroll
      for (int i = 0; i < 4; ++i) {
        const int f = nt * 128 + wr * 64 + i * 16 + qi - 2048;
        gam[i] = p.sgu_ln_g[l * 512 + f]; bet[i] = p.sgu_ln_b[l * 512 + f];
      }
#pragma unroll
      for (int j = 0; j < 4; ++j)
#pragma unroll
        for (int r = 0; r < 4; ++r) {
          float s1 = acc[0][j][r] + acc[1][j][r] + acc[2][j][r] + acc[3][j][r];
          s1 = row16_sum(s1);
          const float mu = s1 * (1.0f / 64.0f);
          float s2 = 0.f;
#pragma unroll
          for (int i = 0; i < 4; ++i) { const float d = acc[i][j][r] - mu; s2 += d * d; }
          s2 = row16_sum(s2);
          const float rstd = rsqrtf(s2 * (1.0f / 64.0f) + LN_EPS);
#pragma unroll
          for (int i = 0; i < 4; ++i) acc[i][j][r] = (acc[i][j][r] - mu) * rstd * gam[i] + bet[i];
        }
    }
#pragma unroll
    for (int i = 0; i < 4; ++i) {
      const int f = nt * 128 + wr * 64 + i * 16 + qi - fbase;
#pragma unroll
      for (int j = 0; j < 4; ++j) {
        const int tok = tokbase + wc * 64 + j * 16 + 4 * g;
        store_bf16x4(dstb + ((size_t)(bidx * 512 + f)) * 4096 + tok, acc[i][j][0], acc[i][j][1], acc[i][j][2], acc[i][j][3]);
      }
    }
  }
}


__device__ void p1_phase(const Params& p, int l, int bid, int nblk, unsigned char* smem) {
  const int tid0 = otid();
  int t = bid, mt = 0, nt = 0;
  const bf16_t* A = nullptr; const bf16_t* B = nullptr;
  if (t < 2560) {
    p1_decode(t, mt, nt);
    A = p.xb + (size_t)(mt * 128 + (tid0 >> 3)) * 1024 + (tid0 & 7) * 8;
    B = p.Wt_in + (size_t)(nt * 128 + (tid0 >> 3)) * 1024 + (tid0 & 7) * 8;
    __syncthreads();
    gemm_issue0(smem, A, A + 32 * 1024, A + 64 * 1024, A + 96 * 1024, B, B + 32 * 1024, B + 64 * 1024, B + 96 * 1024);
  }
  while (t < 2560) {
    const int type = nt >> 2;
    const bool swapped = (type == 2) || (type == 4);
    f32x4 acc[4][4];
    ZERO_ACC(acc);
    gemm_main<true>(smem, A, A + 32 * 1024, A + 64 * 1024, A + 96 * 1024, B, B + 32 * 1024, B + 64 * 1024, B + 96 * 1024, 16, -1, swapped, acc, NoMid());
    const int tn = t + nblk;
    int mtn = mt, ntn = nt;
    if (tn < 2560) {
      p1_decode(tn, mtn, ntn);
      const int tid = otid();
      A = p.xb + (size_t)(mtn * 128 + (tid >> 3)) * 1024 + (tid & 7) * 8;
      B = p.Wt_in + (size_t)(ntn * 128 + (tid >> 3)) * 1024 + (tid & 7) * 8;
      gemm_issue0(smem, A, A + 32 * 1024, A + 64 * 1024, A + 96 * 1024, B, B + 32 * 1024, B + 64 * 1024, B + 96 * 1024);
    }
    p1_epilogue(p, l, mt, nt, acc);
    mt = mtn; nt = ntn; t = tn;
  }
}

__device__ void attn_phase(const Params& p, int l, int bid, int nblk, unsigned char* smem) {
  const int tid = otid(), lane = tid & 63, w = tid >> 6, qi = lane & 15, g = lane >> 4;
  unsigned char* Kb = smem;
  unsigned char* Vb = smem + 32768;
  float* sbias = (float*)(smem + 32768 + 33792);
  const int c0 = (w == 0) ? 0 : (w == 1) ? 8 : (w == 2) ? 24 : 32;
  const int cq = 16 * w + qi, cs = min(max(cq - 8, 0), 48);
  const int krow = tid >> 3, kch = tid & 7;
  const int ksoff = krow * 128 + ((kch ^ ((krow >> 1) & 7)) << 4);
  const int vd = tid >> 5, vc = tid & 31;
  const int vsoff = vd * 528 + vc * 16;
  u32x4 st[8], st2[8];
#define ATT_ISSUE_K(it_)                                                                                              \
  do {                                                                                                                \
    const int h_ = (it_) & 7, br_ = (it_) >> 3, r_ = br_ & 63, b_ = br_ >> 6, rs_ = min(max(r_ - 4, 0), 56);          \
    const bf16_t* kg_ = p.qk + ((size_t)b_ * 4096 + rs_ * 64 + krow) * 1024 + 512 + h_ * 64 + kch * 8;                \
    _Pragma("unroll") for (int i = 0; i < 8; ++i) st[i] = *(const u32x4*)(kg_ + (size_t)(32 * i) * 1024);            \
    _Pragma("unroll") for (int i = 0; i < 8; ++i) st2[i] = *(const u32x4*)(kg_ + (size_t)(256 + 32 * i) * 1024);     \
  } while (0)
  int it = bid;
  if (it < 2048) ATT_ISSUE_K(it);
  while (it < 2048) {
    const int h = it & 7, br = it >> 3, r = br & 63, b = br >> 6;
    const int rs = min(max(r - 4, 0), 56);
    const size_t tokq = (size_t)b * 4096 + r * 64 + cq;
    const bf16_t* vg = p.vT + ((size_t)(b * 512 + h * 64 + vd)) * 4096 + rs * 64 + vc * 8;
    const float rb0 = p.rel_bias[(size_t)(l * 8 + h) * 465 + tid];
    const float rb1 = p.rel_bias[(size_t)(l * 8 + h) * 465 + min(tid + 256, 464)];
    bf16x8 qf0 = *(const bf16x8*)(p.qk + tokq * 1024 + h * 64 + g * 8);
    bf16x8 qf1 = *(const bf16x8*)(p.qk + tokq * 1024 + h * 64 + 32 + g * 8);
    __syncthreads();
    sbias[tid] = rb0;
    if (tid + 256 < 465) sbias[tid + 256] = rb1;
#pragma unroll
    for (int i = 0; i < 8; ++i) *(u32x4*)(Kb + ksoff + i * 4096) = st[i];
#pragma unroll
    for (int i = 0; i < 8; ++i) st[i] = *(const u32x4*)(vg + (size_t)(8 * i) * 4096);
    __syncthreads();
    f32x4 s[8][2];
#pragma unroll
    for (int jh = 0; jh < 2; ++jh) {
#pragma unroll
      for (int jj = 0; jj < 4; ++jj)
#pragma unroll
        for (int ch = 0; ch < 2; ++ch) {
          const int kl = jj * 64 + c0 + 16 * ch + qi;
          const int sw = (kl >> 1) & 7;
          const bf16x8 kf0 = *(const bf16x8*)(Kb + kl * 128 + (((0 + g) ^ sw) << 4));
          const bf16x8 kf1 = *(const bf16x8*)(Kb + kl * 128 + (((4 + g) ^ sw) << 4));
          f32x4 a = {0.f, 0.f, 0.f, 0.f};
          a = __builtin_amdgcn_mfma_f32_16x16x32_bf16(kf0, qf0, a, 0, 0, 0);
          a = __builtin_amdgcn_mfma_f32_16x16x32_bf16(kf1, qf1, a, 0, 0, 0);
          s[jh * 4 + jj][ch] = a;
        }
      if (jh == 0) {
        __syncthreads();
#pragma unroll
        for (int i = 0; i < 8; ++i) *(u32x4*)(Kb + ksoff + i * 4096) = st2[i];
#pragma unroll
        for (int i = 0; i < 8; ++i) st2[i] = *(const u32x4*)(vg + (size_t)(8 * i) * 4096 + 256);
        __syncthreads();
      }
    }
#pragma unroll
    for (int i = 0; i < 8; ++i) *(u32x4*)(Vb + vsoff + i * 8 * 528) = st[i];
    float mx = -1e30f;
#pragma unroll
    for (int j = 0; j < 8; ++j)
#pragma unroll
      for (int ch = 0; ch < 2; ++ch)
#pragma unroll
        for (int rg = 0; rg < 4; ++rg) {
          const int kc = c0 + 16 * ch + 4 * g + rg;
          const bool valid = (kc >= cs) && (kc < cs + 16);
          const int bidx = valid ? ((rs + j - r + 7) * 31 + (kc - cq) + 15) : 0;
          const float v = valid ? (s[j][ch][rg] + sbias[bidx]) : -1e30f;
          s[j][ch][rg] = v;
          mx = fmaxf(mx, v);
        }
    mx = fmaxf(mx, __shfl_xor(mx, 16)); mx = fmaxf(mx, __shfl_xor(mx, 32));
    float sum = 0.f;
#pragma unroll
    for (int j = 0; j < 8; ++j)
#pragma unroll
      for (int ch = 0; ch < 2; ++ch)
#pragma unroll
        for (int rg = 0; rg < 4; ++rg) { const float e = __expf(s[j][ch][rg] - mx); s[j][ch][rg] = e; sum += e; }
    sum += __shfl_xor(sum, 16); sum += __shfl_xor(sum, 32);
    const float inv = 1.0f / sum;
    bf16x8 pf[8];
#pragma unroll
    for (int j = 0; j < 8; ++j) {
      u32x4 pw;
      pw.x = cvt_pk_bf16(s[j][0][0], s[j][0][1]); pw.y = cvt_pk_bf16(s[j][0][2], s[j][0][3]);
      pw.z = cvt_pk_bf16(s[j][1][0], s[j][1][1]); pw.w = cvt_pk_bf16(s[j][1][2], s[j][1][3]);
      pf[j] = __builtin_bit_cast(bf16x8, pw);
    }
    f32x4 o[4];
#pragma unroll
    for (int dt = 0; dt < 4; ++dt) o[dt] = (f32x4){0.f, 0.f, 0.f, 0.f};
    const int itn = it + nblk;
    __syncthreads();
#pragma unroll
    for (int jh = 0; jh < 2; ++jh) {
#pragma unroll
      for (int jj = 0; jj < 4; ++jj)
#pragma unroll
        for (int dt = 0; dt < 4; ++dt) {
          const unsigned char* vp = Vb + (dt * 16 + qi) * 528 + (jj * 64 + c0 + 4 * g) * 2;
          const u32x2 lo = *(const u32x2*)vp, hi = *(const u32x2*)(vp + 32);
          u32x4 vw; vw.x = lo.x; vw.y = lo.y; vw.z = hi.x; vw.w = hi.y;
          o[dt] = __builtin_amdgcn_mfma_f32_16x16x32_bf16(__builtin_bit_cast(bf16x8, vw), pf[jh * 4 + jj], o[dt], 0, 0, 0);
        }
      if (jh == 0) {
        __syncthreads();
#pragma unroll
        for (int i = 0; i < 8; ++i) *(u32x4*)(Vb + vsoff + i * 8 * 528) = st2[i];
        if (itn < 2048) ATT_ISSUE_K(itn);
        __syncthreads();
      }
    }
    float sq = 0.f;
#pragma unroll
    for (int dt = 0; dt < 4; ++dt) {
      o[dt] *= inv;
      sq += o[dt][0] * o[dt][0] + o[dt][1] * o[dt][1] + o[dt][2] * o[dt][2] + o[dt][3] * o[dt][3];
      store_bf16x4(p.mixed + tokq * 1024 + h * 64 + dt * 16 + 4 * g, o[dt][0], o[dt][1], o[dt][2], o[dt][3]);
    }
    sq += __shfl_xor(sq, 16); sq += __shfl_xor(sq, 32);
    if (g == 0) p.ssq[tokq * 16 + h] = sq;
    it = itn;
  }
#undef ATT_ISSUE_K
}

__device__ void sgu_item(const Params& p, int l, int it, unsigned char* smem) {
  const int grp = it & 7, bc = it >> 3, chunk = bc & 31, b = bc >> 5;
  const int tid = otid(), lane = tid & 63, w = tid >> 6, qi = lane & 15, g = lane >> 4;
  const int p0 = 32 * w;
  const int wbase = __builtin_amdgcn_readfirstlane(w) * 1024;
  const int lc = ((tid & 15) ^ ((tid >> 4) & 15)) << 3;
  const bf16_t* wsrc = p.Wsgu + ((size_t)(grp * 128 + (tid >> 4))) * 128 + lc;
  const bf16_t* vsrc = p.vnT + ((size_t)(b * 512 + grp * 64 + (tid >> 4))) * 4096 + chunk * 128 + lc;
  __syncthreads();
#pragma unroll
  for (int i = 0; i < 8; ++i) GLDS16(wsrc + (size_t)(16 * i) * 128, smem + i * 4096 + wbase);
#pragma unroll
  for (int i = 0; i < 4; ++i) GLDS16(vsrc + (size_t)(16 * i) * 4096, smem + 32768 + i * 4096 + wbase);
  asm volatile("s_waitcnt vmcnt(0)" ::: "memory");
  __syncthreads();
  f32x4 acc[2][4];
#pragma unroll
  for (int mt = 0; mt < 2; ++mt)
#pragma unroll
    for (int nt = 0; nt < 4; ++nt) acc[mt][nt] = (f32x4){0.f, 0.f, 0.f, 0.f};
#pragma unroll
  for (int ks = 0; ks < 4; ++ks) {
    const int co = ((ks * 4 + g) ^ qi) << 4;
    bf16x8 wf[2], vf[4];
#pragma unroll
    for (int mt = 0; mt < 2; ++mt) wf[mt] = *(const bf16x8*)(smem + (p0 + 16 * mt + qi) * 256 + co);
#pragma unroll
    for (int nt = 0; nt < 4; ++nt) vf[nt] = *(const bf16x8*)(smem + 32768 + (16 * nt + qi) * 256 + co);
#pragma unroll
    for (int mt = 0; mt < 2; ++mt)
#pragma unroll
      for (int nt = 0; nt < 4; ++nt) acc[mt][nt] = __builtin_amdgcn_mfma_f32_16x16x32_bf16(vf[nt], wf[mt], acc[mt][nt], 0, 0, 0);
  }
#pragma unroll
  for (int mt = 0; mt < 2; ++mt) {
    const int pp = p0 + 16 * mt + qi;
    const size_t tok = (size_t)b * 4096 + chunk * 128 + pp;
    const float bias = p.sgu_b[(size_t)(l * 8 + grp) * 128 + pp];
    float sq = 0.f;
#pragma unroll
    for (int nt = 0; nt < 4; ++nt) {
      const int d = 16 * nt + 4 * g;
      const u32x2 uu = *(const u32x2*)(p.ub + tok * 512 + grp * 64 + d);
      const float u0 = __uint_as_float(uu.x << 16), u1 = __uint_as_float(uu.x & 0xffff0000u);
      const float u2 = __uint_as_float(uu.y << 16), u3 = __uint_as_float(uu.y & 0xffff0000u);
      const float v0 = u0 * (acc[mt][nt][0] + bias), v1 = u1 * (acc[mt][nt][1] + bias);
      const float v2 = u2 * (acc[mt][nt][2] + bias), v3 = u3 * (acc[mt][nt][3] + bias);
      sq += v0 * v0 + v1 * v1 + v2 * v2 + v3 * v3;
      store_bf16x4(p.mixed + tok * 1024 + 512 + grp * 64 + d, v0, v1, v2, v3);
    }
    sq += __shfl_xor(sq, 16); sq += __shfl_xor(sq, 32);
    if (g == 0) p.ssq[tok * 16 + 8 + grp] = sq;
  }
}

__device__ void p3_tile(const Params& p, int l, int t, unsigned char* smem) {
  const int x_ = t & 7, j_ = t >> 3, rd_ = j_ >> 6, lb_ = j_ & 63;
  const int mt = x_ * 16 + rd_ * 8 + (lb_ & 7), nt = lb_ >> 3;
  const int tid = otid(), lane = tid & 63, wid = tid >> 6, wr = wid >> 1, wc = wid & 1;
  const int srow = tid >> 3, sch = tid & 7, qi = lane & 15, g = lane >> 4;
  const bf16_t* A = p.mixed + (size_t)(mt * 128 + srow) * 1024 + sch * 8;
  const bf16_t* B = p.Wt_out + (size_t)(nt * 128 + srow) * 1024 + sch * 8;
  MidScale mid; float rss[4];
#pragma unroll
  for (int i = 0; i < 4; ++i) {
    const int m = mt * 128 + wr * 64 + i * 16 + qi;
    const float4 a0 = *(const float4*)(p.ssq + (size_t)m * 16), a1 = *(const float4*)(p.ssq + (size_t)m * 16 + 4);
    const float4 b0 = *(const float4*)(p.ssq + (size_t)m * 16 + 8), b1 = *(const float4*)(p.ssq + (size_t)m * 16 + 12);
    const float sa = (a0.x + a0.y + a0.z + a0.w) + (a1.x + a1.y + a1.z + a1.w);
    const float sb = (b0.x + b0.y + b0.z + b0.w) + (b1.x + b1.y + b1.z + b1.w);
    const float ra = rsqrtf(sa * (1.0f / 512.0f) + LN_EPS), rb = rsqrtf(sb * (1.0f / 512.0f) + LN_EPS);
    mid.s[i] = ra / rb; rss[i] = rb;
  }
  f32x4 acc[4][4];
  ZERO_ACC(acc);
  gemm_main(smem, A, A + 32 * 1024, A + 64 * 1024, A + 96 * 1024, B, B + 32 * 1024, B + 64 * 1024, B + 96 * 1024, 16, 8, false, acc, mid);
#pragma unroll
  for (int i = 0; i < 4; ++i) {
    const int m = mt * 128 + wr * 64 + i * 16 + qi;
#pragma unroll
    for (int j = 0; j < 4; ++j) {
      const int n = nt * 128 + wc * 64 + j * 16 + 4 * g;
      const u32x2 xr = *(const u32x2*)(p.xb + (size_t)m * 1024 + n);
      const float o0 = ALPHA * __uint_as_float(xr.x << 16) + acc[i][j][0] * rss[i];
      const float o1 = ALPHA * __uint_as_float(xr.x & 0xffff0000u) + acc[i][j][1] * rss[i];
      const float o2 = ALPHA * __uint_as_float(xr.y << 16) + acc[i][j][2] * rss[i];
      const float o3 = ALPHA * __uint_as_float(xr.y & 0xffff0000u) + acc[i][j][3] * rss[i];
      store_bf16x4(p.hb + (size_t)m * 1024 + n, o0, o1, o2, o3);
    }
  }
}

__device__ void p4_batch(const Params& p, int l, int batch, unsigned char* smem) {
  const int tid = otid(), lane = tid & 63, w = tid >> 6;
  int* scnt = (int*)smem;
  int* sbase = scnt + 16;
  __syncthreads();
  if (tid < 16) scnt[tid] = 0;
  __syncthreads();
  const int tokw = batch * 32 + w * 8;
  {
    float4 gm[4], bt[4];
#pragma unroll
    for (int q = 0; q < 4; ++q) {
      gm[q] = *(const float4*)(p.ln1_g + l * 1024 + q * 256 + lane * 4);
      bt[q] = *(const float4*)(p.ln1_b + l * 1024 + q * 256 + lane * 4);
    }
#pragma unroll 4
    for (int t = 0; t < 8; ++t) {
      const bf16_t* hr = p.hb + (size_t)(tokw + t) * 1024 + lane * 4;
      float4 v[4];
#pragma unroll
      for (int q = 0; q < 4; ++q) {
        const u32x2 hh = *(const u32x2*)(hr + q * 256);
        v[q].x = __uint_as_float(hh.x << 16); v[q].y = __uint_as_float(hh.x & 0xffff0000u);
        v[q].z = __uint_as_float(hh.y << 16); v[q].w = __uint_as_float(hh.y & 0xffff0000u);
      }
      float s1 = 0.f;
#pragma unroll
      for (int q = 0; q < 4; ++q) s1 += (v[q].x + v[q].y) + (v[q].z + v[q].w);
      const float mu = wave_sum(s1) * (1.0f / 1024.0f);
      float s2 = 0.f;
#pragma unroll
      for (int q = 0; q < 4; ++q) {
        const float d0 = v[q].x - mu, d1 = v[q].y - mu, d2 = v[q].z - mu, d3 = v[q].w - mu;
        s2 += (d0 * d0 + d1 * d1) + (d2 * d2 + d3 * d3);
      }
      const float rstd = rsqrtf(wave_sum(s2) * (1.0f / 1024.0f) + LN_EPS);
#pragma unroll
      for (int q = 0; q < 4; ++q) {
        float4 o;
        o.x = (v[q].x - mu) * rstd * gm[q].x + bt[q].x; o.y = (v[q].y - mu) * rstd * gm[q].y + bt[q].y;
        o.z = (v[q].z - mu) * rstd * gm[q].z + bt[q].z; o.w = (v[q].w - mu) * rstd * gm[q].w + bt[q].w;
        u32x2 hi; hi.x = cvt_pk_bf16(o.x, o.y); hi.y = cvt_pk_bf16(o.z, o.w);
        *(u32x2*)(p.xb + (size_t)(tokw + t) * 1024 + q * 256 + lane * 4) = hi;
        store_bf16x4(p.x1lo + (size_t)(tokw + t) * 1024 + q * 256 + lane * 4, o.x - __uint_as_float(hi.x << 16), o.y - __uint_as_float(hi.x & 0xffff0000u),
                     o.z - __uint_as_float(hi.y << 16), o.w - __uint_as_float(hi.y & 0xffff0000u));
      }
    }
  }
  asm volatile("s_waitcnt vmcnt(0)" ::: "memory");
  __syncthreads();
  const int j = lane & 15, g = lane >> 4;
  float* part = (float*)(smem + 1024);
  {
    const size_t xo0 = (size_t)(batch * 32 + j) * 1024 + 256 * w + 8 * g, xo1 = xo0 + 16 * 1024;
    const size_t wof = ((size_t)(8 * w * 4 + g) * 16 + j) * 8;
    f32x4 De0 = {0.f, 0.f, 0.f, 0.f}, Dg0 = De0, De1 = De0, Dg1 = De0;
#pragma unroll 2
    for (int kb = 0; kb < 8; ++kb) {
      const bf16x8 xh0 = *(const bf16x8*)(p.xb + xo0 + kb * 32), xl0 = *(const bf16x8*)(p.x1lo + xo0 + kb * 32);
      const bf16x8 xh1 = *(const bf16x8*)(p.xb + xo1 + kb * 32), xl1 = *(const bf16x8*)(p.x1lo + xo1 + kb * 32);
      const bf16x8 weh = *(const bf16x8*)(p.Wr_eh + wof + kb * 512), wel = *(const bf16x8*)(p.Wr_el + wof + kb * 512);
      const bf16x8 wgh = *(const bf16x8*)(p.Wr_gh + wof + kb * 512), wgl = *(const bf16x8*)(p.Wr_gl + wof + kb * 512);
      De0 = __builtin_amdgcn_mfma_f32_16x16x32_bf16(weh, xh0, De0, 0, 0, 0);
      Dg0 = __builtin_amdgcn_mfma_f32_16x16x32_bf16(wgh, xh0, Dg0, 0, 0, 0);
      De0 = __builtin_amdgcn_mfma_f32_16x16x32_bf16(weh, xl0, De0, 0, 0, 0);
      Dg0 = __builtin_amdgcn_mfma_f32_16x16x32_bf16(wgh, xl0, Dg0, 0, 0, 0);
      De0 = __builtin_amdgcn_mfma_f32_16x16x32_bf16(wel, xh0, De0, 0, 0, 0);
      Dg0 = __builtin_amdgcn_mfma_f32_16x16x32_bf16(wgl, xh0, Dg0, 0, 0, 0);
      De1 = __builtin_amdgcn_mfma_f32_16x16x32_bf16(weh, xh1, De1, 0, 0, 0);
      Dg1 = __builtin_amdgcn_mfma_f32_16x16x32_bf16(wgh, xh1, Dg1, 0, 0, 0);
      De1 = __builtin_amdgcn_mfma_f32_16x16x32_bf16(weh, xl1, De1, 0, 0, 0);
      Dg1 = __builtin_amdgcn_mfma_f32_16x16x32_bf16(wgh, xl1, Dg1, 0, 0, 0);
      De1 = __builtin_amdgcn_mfma_f32_16x16x32_bf16(wel, xh1, De1, 0, 0, 0);
      Dg1 = __builtin_amdgcn_mfma_f32_16x16x32_bf16(wgl, xh1, Dg1, 0, 0, 0);
    }
    float* pw = part + ((size_t)(w * 2) * 64 + lane) * 8;
    *(f32x4*)(pw) = De0; *(f32x4*)(pw + 4) = Dg0;
    *(f32x4*)(pw + 512) = De1; *(f32x4*)(pw + 516) = Dg1;
  }
  __syncthreads();
  const int tok = tokw + (j & 7);
  f32x4 De = {0.f, 0.f, 0.f, 0.f}, Dg = {0.f, 0.f, 0.f, 0.f};
  {
    const int ln = g * 16 + (w & 1) * 8 + (j & 7), tl = w >> 1;
#pragma unroll
    for (int ww = 0; ww < 4; ++ww) {
      const float* pr = part + ((size_t)(ww * 2 + tl) * 64 + ln) * 8;
      De += *(const f32x4*)(pr); Dg += *(const f32x4*)(pr + 4);
    }
  }
  float gl[4];
#pragma unroll
  for (int k = 0; k < 4; ++k) gl[k] = __shfl(Dg[k], j) + p.rg_b[l * 4 + k];
  int gs = 0; float gmax = gl[0];
#pragma unroll
  for (int k = 1; k < 4; ++k) { const bool bb = gl[k] > gmax; gmax = bb ? gl[k] : gmax; gs = bb ? k : gs; }
  float psum = 0.f;
#pragma unroll
  for (int k = 0; k < 4; ++k) psum += __expf(gl[k] - gmax);
  const float gate = 1.0f / psum;
  float es[4];
#pragma unroll
  for (int k = 0; k < 4; ++k) es[k] = De[k] + p.re_b[l * 16 + 4 * g + k];
  int i0 = 0; float v0 = es[0];
#pragma unroll
  for (int k = 1; k < 4; ++k) { const bool bb = es[k] > v0; v0 = bb ? es[k] : v0; i0 = bb ? k : i0; }
  int i1 = 0; float v1 = -3.0e38f;
#pragma unroll
  for (int k = 0; k < 4; ++k) { const bool bb = (k != i0) && (es[k] > v1); v1 = bb ? es[k] : v1; i1 = bb ? k : i1; }
  const float ex = __expf(v1 - v0);
  const float tw0 = 1.0f / (1.0f + ex), tw1 = ex / (1.0f + ex);
  const bool commit = (g == gs) && (j < 8);
  const int e0 = gs * 4 + i0, e1 = gs * 4 + i1;
  int lp0 = 0, lp1 = 0;
  if (commit) { lp0 = atomicAdd(&scnt[e0], 1); lp1 = atomicAdd(&scnt[e1], 1); }
  __syncthreads();
  if (tid < 16) sbase[tid] = atomicAdd(p.counts + l * 16 + tid, scnt[tid]);
  __syncthreads();
  if (commit) {
    const int pos0 = sbase[e0] + lp0, pos1 = sbase[e1] + lp1;
    p.list[e0 * NTOK + pos0] = tok; p.wlist[e0 * NTOK + pos0] = gate * tw0;
    p.list[e1 * NTOK + pos1] = tok; p.wlist[e1 * NTOK + pos1] = gate * tw1;
    int4 ti; ti.x = e0; ti.y = pos0; ti.z = e1; ti.w = pos1;
    *(int4*)(p.tokinfo + (size_t)tok * 4) = ti;
  }
}

__device__ __forceinline__ int moe_total_mtiles(const int* cnts) {
  int tot = 0;
#pragma unroll
  for (int e = 0; e < 16; ++e) tot += (cnts[e] + 127) >> 7;
  return tot;
}
__device__ __forceinline__ void moe_find(const int* cnts, int mi, int& e_out, int& ml, int& off, int& cnt) {
  int rem = mi, o = 0; e_out = 0; ml = 0; off = 0; cnt = 1;
  bool found = false;
#pragma unroll
  for (int e = 0; e < 16; ++e) {
    const int c = cnts[e], mtl = (c + 127) >> 7;
    if (!found && rem < mtl) { found = true; e_out = e; ml = rem; off = o; cnt = c; }
    rem -= mtl; o += c;
  }
}

__device__ void p5_tile(const Params& p, int l, int t, int mtot, unsigned char* smem) {
  const int mi = (t >> 5) * 8 + (t & 7), nt = (t >> 3) & 3;
  if (mi >= mtot) return;
  int e, ml, off, cnt;
  moe_find(p.counts + l * 16, mi, e, ml, off, cnt);
  const int tid = otid(), lane = tid & 63, wid = tid >> 6, wr = wid >> 1, wc = wid & 1;
  const int srow = tid >> 3, sch = tid & 7, qi = lane & 15, g = lane >> 4;
  const bf16_t* pa[4];
#pragma unroll
  for (int i = 0; i < 4; ++i) {
    const int ridx = min(ml * 128 + srow + 32 * i, cnt - 1);
    const int tok = p.list[e * NTOK + ridx];
    pa[i] = p.xb + (size_t)tok * 1024 + sch * 8;
  }
  const bf16_t* B = p.Wgu + ((size_t)e * 512 + nt * 128 + srow) * 1024 + sch * 8;
  f32x4 acc[4][4];
  ZERO_ACC(acc);
  gemm_main(smem, pa[0], pa[1], pa[2], pa[3], B, B + 32 * 1024, B + 64 * 1024, B + 96 * 1024, 16, -1, false, acc, NoMid());
#pragma unroll
  for (int i = 0; i < 4; ++i) {
    const int rloc = ml * 128 + wr * 64 + i * 16 + qi;
    if (rloc < cnt) {
      const size_t slot = (size_t)off + rloc;
#pragma unroll
      for (int jp = 0; jp < 2; ++jp) {
        const f32x4 ga = acc[i][2 * jp], up = acc[i][2 * jp + 1];
        const int col = 64 * nt + 32 * wc + 16 * jp + 4 * g;
        store_bf16x4(p.act + slot * 256 + col, silu(ga[0]) * up[0], silu(ga[1]) * up[1], silu(ga[2]) * up[2], silu(ga[3]) * up[3]);
      }
    }
  }
}

struct P6Tile { int e, ml, off, cnt, nt; const bf16_t* pa0; const bf16_t* pa1; const bf16_t* pa2; const bf16_t* pa3; const bf16_t* B; };
__device__ __forceinline__ int p6_next(int t, int ntot, int mtot, int nblk) {
  while (t < ntot && ((t >> 6) * 8 + (t & 7)) >= mtot) t += nblk;
  return t;
}
__device__ __forceinline__ void p6_setup(const Params& p, int l, int t, P6Tile& T) {
  const int mi = (t >> 6) * 8 + (t & 7);
  T.nt = (t >> 3) & 7;
  moe_find(p.counts + l * 16, mi, T.e, T.ml, T.off, T.cnt);
  const int tid = otid(), srow = tid >> 3, sch = tid & 7;
  const bf16_t* base = p.act + (size_t)T.off * 256 + sch * 8;
  T.pa0 = base + (size_t)min(T.ml * 128 + srow, T.cnt - 1) * 256;
  T.pa1 = base + (size_t)min(T.ml * 128 + srow + 32, T.cnt - 1) * 256;
  T.pa2 = base + (size_t)min(T.ml * 128 + srow + 64, T.cnt - 1) * 256;
  T.pa3 = base + (size_t)min(T.ml * 128 + srow + 96, T.cnt - 1) * 256;
  T.B = p.Wdn + ((size_t)T.e * 1024 + T.nt * 128 + srow) * 256 + sch * 8;
}
__device__ void p6_phase(const Params& p, int l, int bid, int nblk, unsigned char* smem) {
  const int mtot = moe_total_mtiles(p.counts + l * 16), ntot = ((mtot + 7) >> 3) * 64;
  P6Tile cur, nxt;
  int t = p6_next(bid, ntot, mtot, nblk);
  if (t < ntot) {
    p6_setup(p, l, t, cur);
    __syncthreads();
    gemm_issue0(smem, cur.pa0, cur.pa1, cur.pa2, cur.pa3, cur.B, cur.B + 32 * 256, cur.B + 64 * 256, cur.B + 96 * 256);
  }
  while (t < ntot) {
    f32x4 acc[4][4];
    ZERO_ACC(acc);
    gemm_main<true>(smem, cur.pa0, cur.pa1, cur.pa2, cur.pa3, cur.B, cur.B + 32 * 256, cur.B + 64 * 256, cur.B + 96 * 256, 4, -1, false, acc, NoMid());
    const int tn = p6_next(t + nblk, ntot, mtot, nblk);
    nxt = cur;
    if (tn < ntot) {
      p6_setup(p, l, tn, nxt);
      gemm_issue0(smem, nxt.pa0, nxt.pa1, nxt.pa2, nxt.pa3, nxt.B, nxt.B + 32 * 256, nxt.B + 64 * 256, nxt.B + 96 * 256);
    }
    {
      const int tid = otid(), lane = tid & 63, wid = tid >> 6, wr = wid >> 1, wc = wid & 1, qi = lane & 15, g = lane >> 4;
#pragma unroll
      for (int i = 0; i < 4; ++i) {
        const int rloc = cur.ml * 128 + wr * 64 + i * 16 + qi;
        if (rloc < cur.cnt) {
          const float wgt = p.wlist[cur.e * NTOK + rloc];
          const size_t slot = (size_t)cur.off + rloc;
#pragma unroll
          for (int j = 0; j < 4; ++j) {
            const int n = cur.nt * 128 + wc * 64 + j * 16 + 4 * g;
            store_bf16x4(p.y + slot * 1024 + n, acc[i][j][0] * wgt, acc[i][j][1] * wgt, acc[i][j][2] * wgt, acc[i][j][3] * wgt);
          }
        }
      }
    }
    cur = nxt; t = tn;
  }
}

template <int NT>
__device__ __forceinline__ void p7_tokens(const Params& p, int l, int tok0, int tstride) {
  const int lane = otid() & 63;
  int4 ti[NT];
#pragma unroll
  for (int u = 0; u < NT; ++u) ti[u] = *(const int4*)(p.tokinfo + (size_t)(tok0 + u * tstride) * 4);
  int off0[NT], off1[NT];
#pragma unroll
  for (int u = 0; u < NT; ++u) { off0[u] = 0; off1[u] = 0; }
#pragma unroll
  for (int e = 0; e < 16; ++e) {
    const int c = p.counts[l * 16 + e];
#pragma unroll
    for (int u = 0; u < NT; ++u) { if (e < ti[u].x) off0[u] += c; if (e < ti[u].z) off1[u] += c; }
  }
  float4 xr[NT][4]; u32x2 ya[NT][4], yb[NT][4];
#pragma unroll
  for (int u = 0; u < NT; ++u) {
    const int tok = tok0 + u * tstride;
    const size_t s0 = (size_t)off0[u] + ti[u].y, s1 = (size_t)off1[u] + ti[u].w;
#pragma unroll
    for (int q = 0; q < 4; ++q) {
      const int c = q * 256 + lane * 4;
      { const u32x2 xh_ = *(const u32x2*)(p.xb + (size_t)tok * 1024 + c), xl_ = *(const u32x2*)(p.x1lo + (size_t)tok * 1024 + c);
        xr[u][q].x = __uint_as_float(xh_.x << 16) + __uint_as_float(xl_.x << 16);
        xr[u][q].y = __uint_as_float(xh_.x & 0xffff0000u) + __uint_as_float(xl_.x & 0xffff0000u);
        xr[u][q].z = __uint_as_float(xh_.y << 16) + __uint_as_float(xl_.y << 16);
        xr[u][q].w = __uint_as_float(xh_.y & 0xffff0000u) + __uint_as_float(xl_.y & 0xffff0000u); }
      ya[u][q] = *(const u32x2*)(p.y + s0 * 1024 + c);
      yb[u][q] = *(const u32x2*)(p.y + s1 * 1024 + c);
    }
  }
  float4 gg[4], bb[4];
#pragma unroll
  for (int q = 0; q < 4; ++q) {
    gg[q] = *(const float4*)(p.ln2_g + l * 1024 + q * 256 + lane * 4);
    bb[q] = *(const float4*)(p.ln2_b + l * 1024 + q * 256 + lane * 4);
  }
#pragma unroll
  for (int u = 0; u < NT; ++u) {
    const int tok = tok0 + u * tstride;
    float hv[16];
#pragma unroll
    for (int q = 0; q < 4; ++q) {
      hv[q * 4 + 0] = ALPHA * xr[u][q].x + (__uint_as_float(ya[u][q].x << 16) + __uint_as_float(yb[u][q].x << 16));
      hv[q * 4 + 1] = ALPHA * xr[u][q].y + (__uint_as_float(ya[u][q].x & 0xffff0000u) + __uint_as_float(yb[u][q].x & 0xffff0000u));
      hv[q * 4 + 2] = ALPHA * xr[u][q].z + (__uint_as_float(ya[u][q].y << 16) + __uint_as_float(yb[u][q].y << 16));
      hv[q * 4 + 3] = ALPHA * xr[u][q].w + (__uint_as_float(ya[u][q].y & 0xffff0000u) + __uint_as_float(yb[u][q].y & 0xffff0000u));
    }
    float s1s = 0.f;
#pragma unroll
    for (int c = 0; c < 16; ++c) s1s += hv[c];
    const float mu = wave_sum(s1s) * (1.0f / 1024.0f);
    float s2 = 0.f;
#pragma unroll
    for (int c = 0; c < 16; ++c) { const float d = hv[c] - mu; s2 += d * d; }
    const float rstd = rsqrtf(wave_sum(s2) * (1.0f / 1024.0f) + LN_EPS);
#pragma unroll
    for (int q = 0; q < 4; ++q) {
      const int c = q * 256 + lane * 4;
      float4 o;
      o.x = (hv[q * 4 + 0] - mu) * rstd * gg[q].x + bb[q].x; o.y = (hv[q * 4 + 1] - mu) * rstd * gg[q].y + bb[q].y;
      o.z = (hv[q * 4 + 2] - mu) * rstd * gg[q].z + bb[q].z; o.w = (hv[q * 4 + 3] - mu) * rstd * gg[q].w + bb[q].w;
      if (l == 3) *(float4*)(p.out + (size_t)tok * 1024 + c) = o;
      else store_bf16x4(p.xb + (size_t)tok * 1024 + c, o.x, o.y, o.z, o.w);
    }
  }
}

#define XB_TMO      128
#define XB_XCNT(j)  (256  + 64 * (j))
#define XB_XSUB(j)  (1280 + 64 * (j))
#define XB_XGEN(j)  (2304 + 64 * (j))
#define XB_TOP      3328
#define XB_TOPGEN   3392
#define XCD_BAR_WORDS 3456
#define XB_SPIN_CAP (1u << 22)
__device__ __forceinline__ unsigned xb_ld(unsigned* p) { return __hip_atomic_load(p, __ATOMIC_RELAXED, __HIP_MEMORY_SCOPE_AGENT); }
__device__ __forceinline__ unsigned xb_add(unsigned* p, unsigned v) { return __hip_atomic_fetch_add(p, v, __ATOMIC_RELAXED, __HIP_MEMORY_SCOPE_AGENT); }
__device__ __forceinline__ unsigned xb_xcc_id() { return (unsigned)__builtin_amdgcn_s_getreg((3 << 11) | 20) & 0xFu; }
#define XB_SPIN(cond, bar) do { unsigned _sp = 0; while (cond) { __builtin_amdgcn_s_sleep(1); \
    if ((++_sp & 255u) == 0u) { if (xb_ld(&(bar)[XB_TMO])) break; if (_sp > XB_SPIN_CAP) { atomicAdd(&(bar)[XB_TMO], 1u); break; } } } } while (0)
struct XcdBarrier { unsigned* bar; unsigned x; volatile unsigned* st; };
__device__ __forceinline__ XcdBarrier xcd_barrier_post(unsigned* bar, volatile unsigned* st) {
  XcdBarrier b; b.bar = bar; b.x = xb_xcc_id(); b.st = st;
  if (threadIdx.x == 0) (void)xb_add(&bar[XB_XCNT(b.x)], 1u);
  return b;
}
__device__ __forceinline__ void xcd_barrier_complete(unsigned* bar, unsigned x, unsigned& nloc, unsigned& nx) {
  const unsigned G = gridDim.x;
  unsigned sum, cnt, mine, sp = 0u;
  for (;;) {
    sum = 0u; cnt = 0u; mine = 0u;
#pragma unroll
    for (unsigned j = 0; j < 16; ++j) { const unsigned c = xb_ld(&bar[XB_XCNT(j)]); sum += c; cnt += (c > 0u) ? 1u : 0u; mine = (j == x) ? c : mine; }
    if (sum == G) break;
    __builtin_amdgcn_s_sleep(1);
    if ((++sp & 255u) == 0u) { if (xb_ld(&bar[XB_TMO])) break; if (sp > XB_SPIN_CAP) { atomicAdd(&bar[XB_TMO], 1u); break; } }
  }
  nloc = mine > 0u ? mine : 1u; nx = cnt > 0u ? cnt : 1u;
}
__device__ __forceinline__ void xcd_barrier(const XcdBarrier& b) {
  asm volatile("s_waitcnt vmcnt(0)" ::: "memory");
  __syncthreads();
  if (threadIdx.x == 0) {
    unsigned* bar = b.bar;
    __builtin_amdgcn_s_waitcnt(0);
    unsigned nloc = b.st[0], nx = b.st[1];
    if (nloc == 0u) { xcd_barrier_complete(bar, b.x, nloc, nx); b.st[0] = nloc; b.st[1] = nx; }
    const unsigned old = xb_add(&bar[XB_XSUB(b.x)], 1u);
    const unsigned gen = old / nloc;
    if (old + 1u == (gen + 1u) * nloc) {
      __builtin_amdgcn_fence(__ATOMIC_RELEASE, "agent");
      asm volatile("s_waitcnt vmcnt(0)" ::: "memory");
      const unsigned og = xb_add(&bar[XB_TOP], 1u);
      const unsigned tg = og / nx;
      if (og + 1u == (tg + 1u) * nx) xb_add(&bar[XB_TOPGEN], 1u);
      else XB_SPIN(xb_ld(&bar[XB_TOPGEN]) == tg, bar);
      __builtin_amdgcn_fence(__ATOMIC_ACQUIRE, "agent");
      xb_add(&bar[XB_XGEN(b.x)], 1u);
      asm volatile("s_waitcnt vmcnt(0)" ::: "memory");
    } else {
      XB_SPIN(xb_ld(&bar[XB_XGEN(b.x)]) == gen, bar);
      __builtin_amdgcn_fence(__ATOMIC_ACQUIRE, "agent");
      asm volatile("s_waitcnt vmcnt(0)" ::: "memory");
    }
  }
  __syncthreads();
}

__device__ __forceinline__ void run_phase(const Params& p, int ph, int l, int bid, int nblk, unsigned char* smem, float* sbias) {
  switch (ph) {
    case 0: {
      if (bid == 0 && threadIdx.x < 64) p.counts[threadIdx.x] = 0;
      conv_x(p, bid, nblk);
      for (int it = bid; it < NCONV_ITEMS; it += nblk) conv_item(p, 0, it, smem);
    } break;
    case 1: p1_phase(p, l, bid, nblk, smem); break;
    case 2:
      attn_phase(p, l, bid, nblk, smem);
      for (int it = bid; it < 1024; it += nblk) sgu_item(p, l, it, smem);
      break;
    case 3: for (int t = bid; t < 1024; t += nblk) p3_tile(p, l, t, smem); break;
    case 4: for (int it = bid; it < NTOK / 32; it += nblk) p4_batch(p, l, it, smem); break;
    case 5: { const int mtot = moe_total_mtiles(p.counts + l * 16), nt = ((mtot + 7) >> 3) * 32; for (int t = bid; t < nt; t += nblk) p5_tile(p, l, t, mtot, smem); } break;
    case 6: p6_phase(p, l, bid, nblk, smem); break;
    case 7: {
      { const int nw = nblk * 4; int tok = bid * 4 + (threadIdx.x >> 6);
        for (; tok + 3 * nw < NTOK; tok += 4 * nw) p7_tokens<4>(p, l, tok, nw);
        for (; tok < NTOK; tok += nw) p7_tokens<1>(p, l, tok, nw); }
      if (l < 3) for (int it = bid; it < NCONV_ITEMS; it += nblk) conv_item(p, l + 1, it, smem);
    } break;
  }
}

template <int PH>
__global__ void __launch_bounds__(256, 2) phase_kernel(Params p, int l) {
  __shared__ __attribute__((aligned(16))) unsigned char smem[SMEM_BYTES];
  run_phase(p, PH, l, blockIdx.x, gridDim.x, smem, (float*)smem);
}

#if MEGA
__global__ void __launch_bounds__(256, 2) mega_kernel(Params p) {
  __shared__ __attribute__((aligned(16))) unsigned char smem[SMEM_BYTES];
  __shared__ uint4 xb_words;
  float* sbias = (float*)smem;
  cg::grid_group grid = cg::this_grid();
  const int bid = blockIdx.x, nblk = gridDim.x;
  if (threadIdx.x == 0) xb_words = make_uint4(0u, 0u, 0u, 0u);
  __syncthreads();
  XcdBarrier xb = xcd_barrier_post(p.bar, (volatile unsigned*)&xb_words);
  run_phase(p, 0, 0, bid, nblk, smem, sbias);
  if (p.never) grid.sync();
  xcd_barrier(xb);
#pragma unroll 1
  for (int l = 0; l < 4; ++l) {
#pragma unroll 1
    for (int ph = 1; ph <= 7; ++ph) {
      run_phase(p, ph, l, bid, nblk, smem, sbias);
#if DUP_PH
      if (ph == DUP_PH) { xcd_barrier(xb); run_phase(p, ph, l, bid, nblk, smem, sbias); }
#endif
      if (!(l == 3 && ph == 7)) xcd_barrier(xb);
    }
  }
}
#endif

extern "C" void kernel_launch(void* const* d_in, const int* in_sizes, int n_in, void* d_out, int out_size, void* d_ws,
                              size_t ws_size, hipStream_t stream) {
  Params p{};
  p.x = (const float*)d_in[0]; p.w_in = (const float*)d_in[1]; p.w_out = (const float*)d_in[2]; p.rel_bias = (const float*)d_in[3];
  p.sgu_ln_g = (const float*)d_in[4]; p.sgu_ln_b = (const float*)d_in[5]; p.sgu_w = (const float*)d_in[6]; p.sgu_b = (const float*)d_in[7];
  p.mix_g = (const float*)d_in[8]; p.ln1_g = (const float*)d_in[9]; p.ln1_b = (const float*)d_in[10];
  p.rg_w = (const float*)d_in[11]; p.rg_b = (const float*)d_in[12]; p.re_w = (const float*)d_in[13]; p.re_b = (const float*)d_in[14];
  p.w_gate = (const float*)d_in[15]; p.w_up = (const float*)d_in[16]; p.w_down = (const float*)d_in[17];
  p.ln2_g = (const float*)d_in[18]; p.ln2_b = (const float*)d_in[19];
  p.out = (float*)d_out;
  unsigned char* w = (unsigned char*)d_ws;
  size_t o = 0;
  auto take = [&](size_t bytes) { unsigned char* r = w + o; o += (bytes + 255) & ~(size_t)255; return r; };
  p.Wt_in = (bf16_t*)take((size_t)2560 * 1024 * 2);
  p.Wt_out = (bf16_t*)take((size_t)1024 * 1024 * 2);
  p.Wgu = (bf16_t*)take((size_t)16 * 512 * 1024 * 2);
  p.Wdn = (bf16_t*)take((size_t)16 * 1024 * 256 * 2);
  p.Wsgu = (bf16_t*)take((size_t)8 * 128 * 128 * 2);
  p.xb = (bf16_t*)take((size_t)NTOK * 1024 * 2);
  p.x1 = (float*)take((size_t)NTOK * 1024 * 4);
  p.x1lo = (bf16_t*)p.x1;
  unsigned char* r1 = take((size_t)NTOK * 2560 * 2);
  p.qk = (bf16_t*)r1;
  p.vT = (bf16_t*)(r1 + (size_t)NTOK * 1024 * 2);
  p.ub = (bf16_t*)(r1 + (size_t)NTOK * 1536 * 2);
  p.vnT = (bf16_t*)(r1 + (size_t)NTOK * 2048 * 2);
  p.y = (bf16_t*)r1;
  p.hb = (bf16_t*)r1;
  unsigned char* r2 = take((size_t)NTOK * 1024 * 2);
  p.mixed = (bf16_t*)r2;
  p.act = (bf16_t*)r2;
  p.ssq = (float*)take((size_t)NTOK * 16 * 4);
  p.wlist = (float*)take((size_t)16 * NTOK * 4);
  p.list = (int*)take((size_t)16 * NTOK * 4);
  p.tokinfo = (int*)take((size_t)NTOK * 4 * 4);
  p.counts = (int*)take(256);
  p.Wr_eh = (bf16_t*)take(16384 * 2); p.Wr_el = (bf16_t*)take(16384 * 2);
  p.Wr_gh = (bf16_t*)take(16384 * 2); p.Wr_gl = (bf16_t*)take(16384 * 2);
  p.bar = (unsigned*)take(XCD_BAR_WORDS * 4);
#if MEGA
  static int grid_blocks = 0;
  if (!grid_blocks) {
    int dev = 0, cus = 0, per_cu = 0;
    hipGetDevice(&dev);
    hipDeviceGetAttribute(&cus, hipDeviceAttributeMultiprocessorCount, dev);
    hipOccupancyMaxActiveBlocksPerMultiprocessor(&per_cu, mega_kernel, 256, 0);
    if (per_cu > 2) per_cu = 2;
    grid_blocks = cus * per_cu;
  }
  (void)hipMemsetAsync(p.bar, 0, XCD_BAR_WORDS * 4, stream);
  void* args[] = {&p};
  hipError_t e = hipLaunchCooperativeKernel((void*)mega_kernel, dim3(grid_blocks), dim3(256), args, 0, stream);
  if (e != hipSuccess) fprintf(stderr, "cooperative launch failed: %s (grid %d)\n", hipGetErrorString(e), grid_blocks);
#else
  const int G = 512;
  phase_kernel<0><<<G, 256, 0, stream>>>(p, 0);
  for (int l = 0; l < 4; ++l) {
    phase_kernel<1><<<G, 256, 0, stream>>>(p, l);
    phase_kernel<2><<<G, 256, 0, stream>>>(p, l);
    phase_kernel<3><<<G, 256, 0, stream>>>(p, l);
    phase_kernel<4><<<G, 256, 0, stream>>>(p, l);
    phase_kernel<5><<<G, 256, 0, stream>>>(p, l);
    phase_kernel<6><<<G, 256, 0, stream>>>(p, l);
    phase_kernel<7><<<G, 256, 0, stream>>>(p, l);
  }
#endif
}
```
